# Optimizing an MI355X kernel written in HIP

```python
import jax, jax.numpy as jnp
from jax import lax
import numpy as np

D_MODEL = 1024
BATCH = 4
SEQ = 4096
DEPTH = 1

GRID_W = 64
CTX_LEN = 256
HEAD_DIM = 64
NA_HEADS = 8
NA_WIN_R = 8
NA_WIN_C = 16
GQA_HEADS = 8
GQA_KV_HEADS = 2
Q_BLOCK = 128
ROPE_THETA = 10000.0
N_EXPERTS = 32
TOP_K = 4
D_FF = D_MODEL
SWIGLU_LIMIT = 7.0
SWIGLU_ALPHA = 1.702
EXPERT_BLOCK = 128
NORM_EPS = 1e-6

NA_WIDTH = NA_HEADS * HEAD_DIM
GQA_WIDTH = GQA_HEADS * HEAD_DIM
GQA_KV_WIDTH = GQA_KV_HEADS * HEAD_DIM
IN_SPLITS = (NA_WIDTH, NA_WIDTH, GQA_KV_WIDTH, GQA_KV_WIDTH, NA_WIDTH, GQA_WIDTH, D_MODEL, D_MODEL)
KV_COLS = 2 * NA_WIDTH + 2 * GQA_KV_WIDTH
IN_COLS = sum(IN_SPLITS)

kernel_name = 'hybrid_natten_gqa_moe_dit_layer'


def rmsnorm(x, g):
    xf = x.astype(jnp.float32)
    y = xf * lax.rsqrt(jnp.mean(xf * xf, axis=-1, keepdims=True) + NORM_EPS)
    return (y * g.astype(jnp.float32)).astype(x.dtype)


def split_cols(p, sizes):
    return jnp.split(p, np.cumsum(sizes)[:-1].tolist(), axis=-1)


def to_heads(t, n):
    return t.reshape(t.shape[0], t.shape[1], n, HEAD_DIM)


def axial_rope(x, row, col):
    half = HEAD_DIM // 2
    nf = half // 2
    freqs = ROPE_THETA ** (-jnp.arange(nf, dtype=jnp.float32) / nf)

    def rot(xp, pos):
        ang = pos.astype(jnp.float32)[:, None] * freqs
        cos = jnp.cos(ang)[None, :, None, :]
        sin = jnp.sin(ang)[None, :, None, :]
        x1 = xp[..., :nf].astype(jnp.float32)
        x2 = xp[..., nf:].astype(jnp.float32)
        return jnp.concatenate([x1 * cos - x2 * sin, x2 * cos + x1 * sin], axis=-1)

    return jnp.concatenate([rot(x[..., :half], row), rot(x[..., half:], col)], axis=-1).astype(x.dtype)


def gqa_attend(q, k, v):
    s = jnp.einsum('btkgd,bskd->bkgts', q, k)
    p = jax.nn.softmax(s.astype(jnp.float32), axis=-1).astype(q.dtype)
    return jnp.einsum('bkgts,bskd->btkgd', p, v)


def blocked_gqa(q, k, v):
    B, S = q.shape[0], q.shape[1]
    nb = S // Q_BLOCK
    qb = q.reshape(B, nb, Q_BLOCK, *q.shape[2:]).swapaxes(0, 1)
    out = lax.map(lambda blk: gqa_attend(blk, k, v), qb)
    return out.swapaxes(0, 1).reshape(B, S, -1)


def neighbourhood_attention(q, k, v, k_ctx, v_ctx, rpb):
    B, S, H, Dh = q.shape
    rows = S // GRID_W
    kr = min(NA_WIN_R, rows)
    kc = min(NA_WIN_C, GRID_W)
    qg = q.reshape(B, rows, GRID_W, H, Dh)
    kg = k.reshape(B, rows, GRID_W, H, Dh)
    vg = v.reshape(B, rows, GRID_W, H, Dh)
    cols = np.arange(GRID_W)
    c0 = np.clip(cols - kc // 2, 0, GRID_W - kc)
    col_idx = (c0[:, None] + np.arange(kc)[None, :]).astype(np.int32)
    col_off = (col_idx - cols[:, None] + (NA_WIN_C - 1)).astype(np.int32)

    def row_block(r):
        r0 = jnp.clip(r - kr // 2, 0, rows - kr)
        q_r = lax.dynamic_index_in_dim(qg, r, axis=1, keepdims=False)
        k_nb = lax.dynamic_slice_in_dim(kg, r0, kr, axis=1)[:, :, col_idx]
        v_nb = lax.dynamic_slice_in_dim(vg, r0, kr, axis=1)[:, :, col_idx]
        row_off = r0 + jnp.arange(kr, dtype=jnp.int32) - r + (NA_WIN_R - 1)
        bias = rpb[:, row_off[:, None, None], col_off[None, :, :]].transpose(0, 2, 1, 3)
        s_loc = jnp.einsum('bwhd,brwchd->bhwrc', q_r, k_nb) + bias.astype(q.dtype)
        s_ctx = jnp.einsum('bwhd,bnhd->bhwn', q_r, k_ctx)
        s = jnp.concatenate([s_loc.reshape(B, H, GRID_W, kr * kc), s_ctx], axis=-1)
        p = jax.nn.softmax(s.astype(jnp.float32), axis=-1).astype(q.dtype)
        p_loc = p[..., :kr * kc].reshape(B, H, GRID_W, kr, kc)
        p_ctx = p[..., kr * kc:]
        return (jnp.einsum('bhwrc,brwchd->bwhd', p_loc, v_nb)
                + jnp.einsum('bhwn,bnhd->bwhd', p_ctx, v_ctx))

    out = lax.map(row_block, jnp.arange(rows, dtype=jnp.int32))
    return out.transpose(1, 0, 2, 3, 4).reshape(B, S, H * Dh)


def merge_branches(o_a, o_b, g_a, g_b, w_out_a, w_out_b, w_o):
    return (jax.nn.sigmoid(g_a) * (o_a @ w_out_a) + jax.nn.sigmoid(g_b) * (o_b @ w_out_b)) @ w_o


def hybrid_mixer(h, h_ctx, w_in, rpb, g_qn, g_kn, w_out_a, w_out_b, w_o, row, col, update_ctx):
    B, S, _ = h.shape
    C = h_ctx.shape[1]
    scale = HEAD_DIM ** -0.5
    G = GQA_HEADS // GQA_KV_HEADS
    k_a, v_a, k_b, v_b, q_a, q_b, g_a, g_b = split_cols(h @ w_in, IN_SPLITS)
    if update_ctx:
        parts = split_cols(h_ctx @ w_in, IN_SPLITS)
    else:
        parts = split_cols(h_ctx @ w_in[:, :KV_COLS], IN_SPLITS[:4])
    k_ca = to_heads(parts[0], NA_HEADS)
    v_ca = to_heads(parts[1], NA_HEADS)
    k_cb = rmsnorm(to_heads(parts[2], GQA_KV_HEADS), g_kn)
    v_cb = to_heads(parts[3], GQA_KV_HEADS)

    o_a = neighbourhood_attention(to_heads(q_a, NA_HEADS) * scale, to_heads(k_a, NA_HEADS),
                                  to_heads(v_a, NA_HEADS), k_ca, v_ca, rpb)
    qb = axial_rope(rmsnorm(to_heads(q_b, GQA_HEADS), g_qn), row, col) * scale
    kb = axial_rope(rmsnorm(to_heads(k_b, GQA_KV_HEADS), g_kn), row, col)
    k_all = jnp.concatenate([kb, k_cb], axis=1)
    v_all = jnp.concatenate([to_heads(v_b, GQA_KV_HEADS), v_cb], axis=1)
    o_b = blocked_gqa(qb.reshape(B, S, GQA_KV_HEADS, G, HEAD_DIM), k_all, v_all)
    y = merge_branches(o_a, o_b, g_a, g_b, w_out_a, w_out_b, w_o)

    y_ctx = None
    if update_ctx:
        q_ca, q_cb, g_ca, g_cb = parts[4:]
        o_ca = gqa_attend(to_heads(q_ca, NA_HEADS)[:, :, :, None, :] * scale, k_ca, v_ca).reshape(B, C, -1)
        qcb = rmsnorm(to_heads(q_cb, GQA_HEADS), g_qn) * scale
        o_cb = gqa_attend(qcb.reshape(B, C, GQA_KV_HEADS, G, HEAD_DIM), k_cb, v_cb).reshape(B, C, -1)
        y_ctx = merge_branches(o_ca, o_cb, g_ca, g_cb, w_out_a, w_out_b, w_o)
    return y, y_ctx


def moe_ffn(h, w_router, b_router, w_gu, b_gu, w_dn, b_dn):
    T, D = h.shape
    logits = (h @ w_router + b_router).astype(jnp.float32)
    top_logits, top_e = lax.top_k(logits, TOP_K)
    top_w = jax.nn.softmax(top_logits, axis=-1).astype(h.dtype)
    n_assign = T * TOP_K
    flat_e = top_e.reshape(-1)
    flat_tok = jnp.arange(n_assign, dtype=jnp.int32) // TOP_K
    order = jnp.argsort(flat_e)
    e_sorted = flat_e[order]
    counts = jnp.bincount(flat_e, length=N_EXPERTS)
    padded = (counts + EXPERT_BLOCK - 1) // EXPERT_BLOCK * EXPERT_BLOCK
    pad_end = jnp.cumsum(padded)
    pad_start = pad_end - padded
    start = jnp.cumsum(counts) - counts
    dest = pad_start[e_sorted] + jnp.arange(n_assign, dtype=jnp.int32) - start[e_sorted]
    n_blocks = -(-n_assign // EXPERT_BLOCK) + N_EXPERTS
    n_slots = n_blocks * EXPERT_BLOCK
    slot_tok = jnp.full((n_slots,), T, dtype=jnp.int32).at[dest].set(flat_tok[order])
    slot_w = jnp.zeros((n_slots,), h.dtype).at[dest].set(top_w.reshape(-1)[order])
    block_e = jnp.minimum(jnp.searchsorted(pad_end, jnp.arange(n_blocks, dtype=jnp.int32) * EXPERT_BLOCK,
                                           side='right'), N_EXPERTS - 1)
    h_pad = jnp.concatenate([h, jnp.zeros((1, D), h.dtype)], axis=0)
    xb = h_pad[slot_tok].reshape(n_blocks, EXPERT_BLOCK, D)

    def expert_block(args):
        xe, e = args
        gu = xe @ w_gu[e] + b_gu[e]
        x_glu = jnp.minimum(gu[:, :D_FF], SWIGLU_LIMIT)
        x_lin = jnp.clip(gu[:, D_FF:], -SWIGLU_LIMIT, SWIGLU_LIMIT)
        act = (x_lin + 1) * (x_glu * jax.nn.sigmoid(SWIGLU_ALPHA * x_glu))
        return act @ w_dn[e] + b_dn[e]

    yb = lax.map(expert_block, (xb, block_e))
    y = jnp.zeros((T + 1, D), h.dtype).at[slot_tok].add(yb.reshape(n_slots, D) * slot_w[:, None])
    return y[:T]


def setup_inputs(seed: int = 0) -> dict:
    key = jax.random.key(seed)
    ks = jax.random.split(key, 23)
    f32 = jnp.float32
    L = DEPTH

    def nrm(k, shape, s):
        return jax.random.normal(k, shape, f32) * s

    def gain(k, shape):
        return 1.0 + 0.05 * jax.random.normal(k, shape, f32)

    return {
        'x': nrm(ks[0], (BATCH, SEQ, D_MODEL), 1.0),
        'c': nrm(ks[1], (BATCH, D_MODEL), 1.0),
        'ctx': nrm(ks[2], (BATCH, CTX_LEN, D_MODEL), 1.0),
        'c_ctx': nrm(ks[3], (D_MODEL,), 1.0),
        'w_mod': nrm(ks[4], (L, D_MODEL, 6 * D_MODEL), 0.5 * D_MODEL ** -0.5),
        'b_mod': nrm(ks[5], (L, 6 * D_MODEL), 0.02),
        'g_pre_mix': gain(ks[6], (L, D_MODEL)),
        'g_post_mix': gain(ks[7], (L, D_MODEL)),
        'g_pre_ffn': gain(ks[8], (L, D_MODEL)),
        'g_post_ffn': gain(ks[9], (L, D_MODEL)),
        'w_in': nrm(ks[10], (L, D_MODEL, IN_COLS), D_MODEL ** -0.5),
        'rpb': nrm(ks[11], (L, NA_HEADS, 2 * NA_WIN_R - 1, 2 * NA_WIN_C - 1), 0.1),
        'g_qnorm': gain(ks[12], (L, HEAD_DIM)),
        'g_knorm': gain(ks[13], (L, HEAD_DIM)),
        'w_out_a': nrm(ks[14], (L, NA_WIDTH, D_MODEL), NA_WIDTH ** -0.5),
        'w_out_b': nrm(ks[15], (L, GQA_WIDTH, D_MODEL), GQA_WIDTH ** -0.5),
        'w_o': nrm(ks[16], (L, D_MODEL, D_MODEL), D_MODEL ** -0.5),
        'w_router': nrm(ks[17], (L, D_MODEL, N_EXPERTS), D_MODEL ** -0.5),
        'b_router': nrm(ks[18], (L, N_EXPERTS), 0.01),
        'w_gu': nrm(ks[19], (L, N_EXPERTS, D_MODEL, 2 * D_FF), D_MODEL ** -0.5),
        'b_gu': nrm(ks[20], (L, N_EXPERTS, 2 * D_FF), 0.02),
        'w_dn': nrm(ks[21], (L, N_EXPERTS, D_FF, D_MODEL), D_FF ** -0.5),
        'b_dn': nrm(ks[22], (L, N_EXPERTS, D_MODEL), 0.02),
    }


def reference(x, c, ctx, c_ctx, w_mod, b_mod, g_pre_mix, g_post_mix, g_pre_ffn, g_post_ffn,
              w_in, rpb, g_qnorm, g_knorm, w_out_a, w_out_b, w_o,
              w_router, b_router, w_gu, b_gu, w_dn, b_dn):
    B, S, D = x.shape
    C = ctx.shape[1]
    t = jnp.arange(S, dtype=jnp.int32)
    row = t // GRID_W
    col = t % GRID_W
    silu_c = jax.nn.silu(c)
    silu_cc = jax.nn.silu(c_ctx)
    for i in range(DEPTH):
        update_ctx = i < DEPTH - 1
        sh1, sc1, gt1, sh2, sc2, gt2 = jnp.split((silu_c @ w_mod[i] + b_mod[i])[:, None, :], 6, axis=-1)
        n_mod = 6 if update_ctx else 2
        mod_c = jnp.split(silu_cc @ w_mod[i][:, :n_mod * D] + b_mod[i][:n_mod * D], n_mod)

        h = rmsnorm(x, g_pre_mix[i]) * (1 + sc1) + sh1
        h_ctx = rmsnorm(ctx, g_pre_mix[i]) * (1 + mod_c[1]) + mod_c[0]
        y, y_ctx = hybrid_mixer(h, h_ctx, w_in[i], rpb[i], g_qnorm[i], g_knorm[i],
                                w_out_a[i], w_out_b[i], w_o[i], row, col, update_ctx)
        x = x + gt1 * rmsnorm(y, g_post_mix[i])

        h2 = rmsnorm(x, g_pre_ffn[i]) * (1 + sc2) + sh2
        tokens = h2.reshape(B * S, D)
        if update_ctx:
            ctx = ctx + mod_c[2] * rmsnorm(y_ctx, g_post_mix[i])
            h2_ctx = rmsnorm(ctx, g_pre_ffn[i]) * (1 + mod_c[4]) + mod_c[3]
            tokens = jnp.concatenate([tokens, h2_ctx.reshape(B * C, D)], axis=0)
        f = moe_ffn(tokens, w_router[i], b_router[i], w_gu[i], b_gu[i], w_dn[i], b_dn[i])
        x = x + gt2 * rmsnorm(f[:B * S].reshape(B, S, D), g_post_ffn[i])
        if update_ctx:
            ctx = ctx + mod_c[5] * rmsnorm(f[B * S:].reshape(B, C, D), g_post_ffn[i])
    return x
```

```cpp
#include <hip/hip_runtime.h>
#include <cstdint>
#include <cstdio>

#define DEV __device__ __forceinline__
typedef unsigned short bf16;
typedef short bf16x8 __attribute__((ext_vector_type(8)));
typedef float f32x4 __attribute__((ext_vector_type(4)));
typedef unsigned u32x4 __attribute__((ext_vector_type(4)));
typedef unsigned u32x2 __attribute__((ext_vector_type(2)));

constexpr int DM = 1024, NBATCH = 4, SEQ = 4096, T = NBATCH * SEQ, CTXL = 256, TC = NBATCH * CTXL, TR = T + TC;
constexpr int GRIDW = 64, HD = 64;
constexpr int INC = 4352, KVC = 1280;
constexpr int C_KA = 0, C_VA = 512, C_KB = 1024, C_VB = 1152, C_QA = 1280, C_QB = 1792, C_GA = 2304, C_GB = 3328;
constexpr int NE = 32, TOPK = 4, DFF = 1024;
constexpr int NASG = T * TOPK;
constexpr int ECAP = T;
constexpr int ACT_ROWS = NASG + NE * 256;
constexpr float EPS = 1e-6f, LOG2E = 1.4426950408889634f, QSCALE = 0.125f * LOG2E;
constexpr float SW_LIMIT = 7.0f, SW_ALPHA = 1.702f;

constexpr size_t MiB = 1u << 20;
constexpr size_t WS_CTL = 0, CTL_ZERO_BYTES = 1 * MiB;
constexpr size_t WS_MOD = 1 * MiB;
constexpr size_t WS_ROPE = 1 * MiB + 128 * 1024;
constexpr size_t WS_RSTD1 = 1 * MiB + 256 * 1024;
constexpr size_t WS_TOPE = 1 * MiB + 512 * 1024;
constexpr size_t WS_TOPW = 1 * MiB + 768 * 1024;
constexpr size_t WS_LIST = 2 * MiB;
constexpr size_t WS_WTIN = 4 * MiB;
constexpr size_t WS_WTOAB = 13 * MiB;
constexpr size_t WS_WTO = 15 * MiB;
constexpr size_t WS_WTGU = 17 * MiB;
constexpr size_t WS_WTDN = 145 * MiB;
constexpr size_t WS_H = 209 * MiB;
constexpr size_t WS_QA = 243 * MiB;
constexpr size_t WS_KA = 259 * MiB;
constexpr size_t WS_VA = 276 * MiB;
constexpr size_t WS_QB = 293 * MiB;
constexpr size_t WS_KB = 309 * MiB;
constexpr size_t WS_VB = 314 * MiB;
constexpr size_t WS_GA = 319 * MiB;
constexpr size_t WS_GB = 351 * MiB;
constexpr size_t WS_O = 383 * MiB;
constexpr size_t WS_U = 415 * MiB;
constexpr size_t WS_Y = 447 * MiB;
constexpr size_t WS_H2 = 479 * MiB;
constexpr size_t WS_ACT = 511 * MiB;
constexpr size_t WS_YS = 655 * MiB;
constexpr size_t WS_END = 783 * MiB;
constexpr size_t WS_CF32 = 479 * MiB;
constexpr size_t WS_PA = 511 * MiB, WS_PB = 575 * MiB;
static_assert(WS_CF32 + (size_t)TR * INC * 4 <= WS_END, "cf32 overlay");
constexpr int CW_ECNT = 8192;

DEV unsigned f2bf(float f) { unsigned u = __builtin_bit_cast(unsigned, f); return (u + 0x7fffu + ((u >> 16) & 1u)) >> 16; }
DEV unsigned pk2(float lo, float hi) { return f2bf(lo) | (f2bf(hi) << 16); }
DEV float bflo(unsigned w) { return __builtin_bit_cast(float, w << 16); }
DEV float bfhi(unsigned w) { return __builtin_bit_cast(float, w & 0xffff0000u); }
DEV float bf2f(bf16 b) { return __builtin_bit_cast(float, ((unsigned)b) << 16); }
DEV float wave_sum(float v) {
#pragma unroll
    for (int o = 1; o < 64; o <<= 1) v += __shfl_xor(v, o);
    return v;
}
DEV float wave_max(float v) {
#pragma unroll
    for (int o = 1; o < 64; o <<= 1) v = fmaxf(v, __shfl_xor(v, o));
    return v;
}
DEV float sigmoidf_(float x) { return 1.0f / (1.0f + __expf(-x)); }

__global__ void __launch_bounds__(512) k_mod(const float* __restrict__ c, const float* __restrict__ cctx, const float* __restrict__ wmod, const float* __restrict__ bmod, float* __restrict__ mod) {
    __shared__ float sil[5][1024];
    __shared__ float red[64][5][32];
    const int tid = threadIdx.x, n0 = blockIdx.x * 32;
    for (int i = tid; i < 5 * 1024; i += 512) { const int r = i >> 10, k = i & 1023; const float v = r < 4 ? c[r * 1024 + k] : cctx[k]; sil[r][k] = v / (1.0f + __expf(-v)); }
    __syncthreads();
    const int cg = tid & 7, kr = tid >> 3;
    float acc[5][4];
#pragma unroll
    for (int r = 0; r < 5; ++r)
#pragma unroll
        for (int j = 0; j < 4; ++j) acc[r][j] = 0.f;
    for (int k = kr; k < 1024; k += 64) {
        const f32x4 w = *(const f32x4*)(wmod + (size_t)k * 6144 + n0 + 4 * cg);
#pragma unroll
        for (int r = 0; r < 5; ++r) { const float s = sil[r][k]; acc[r][0] += s * w[0]; acc[r][1] += s * w[1]; acc[r][2] += s * w[2]; acc[r][3] += s * w[3]; }
    }
#pragma unroll
    for (int r = 0; r < 5; ++r)
#pragma unroll
        for (int j = 0; j < 4; ++j) red[kr][r][4 * cg + j] = acc[r][j];
    __syncthreads();
    if (tid < 160) { const int r = tid >> 5, n = tid & 31; float s = 0.f; for (int i = 0; i < 64; ++i) s += red[i][r][n]; mod[r * 6144 + n0 + n] = s + bmod[n0 + n]; }
}

__global__ void k_rope_tab(float* __restrict__ tab) {
    const int i = blockIdx.x * blockDim.x + threadIdx.x;
    if (i < 64 * 16) { const int pos = i >> 4, j = i & 15; const float f = powf(10000.0f, -(float)j / 16.0f); const float a = (float)pos * f; tab[2 * i] = cosf(a); tab[2 * i + 1] = sinf(a); }
}

DEV void transpose_item(const float* __restrict__ W, int K, int N, bf16* __restrict__ WT, int ld, int koff, float* scr, int item, int lane) {
    const int nblk = N / 32, kb = item / nblk, nb = item % nblk, k0 = 64 * kb, n0 = 32 * nb;
#pragma unroll 8
    for (int i = 0; i < 32; ++i) { const int kk = 2 * i + (lane >> 5); scr[kk * 33 + (lane & 31)] = W[(size_t)(k0 + kk) * N + n0 + (lane & 31)]; }
    __builtin_amdgcn_s_waitcnt(0xC07F); asm volatile("" ::: "memory");
    const int cch = lane & 7;
#pragma unroll
    for (int j = 0; j < 4; ++j) { const int n = (lane >> 3) + 8 * j; const float* s = scr + (8 * cch) * 33 + n;
        u32x4 o; o.x = pk2(s[0 * 33], s[1 * 33]); o.y = pk2(s[2 * 33], s[3 * 33]); o.z = pk2(s[4 * 33], s[5 * 33]); o.w = pk2(s[6 * 33], s[7 * 33]);
        *(u32x4*)(WT + (size_t)(n0 + n) * ld + koff + k0 + 8 * cch) = o; }
    __builtin_amdgcn_s_waitcnt(0xC07F); asm volatile("" ::: "memory");
}
struct WPtrs { const float *w_in, *w_oa, *w_ob, *w_o, *w_gu, *w_dn; bf16 *t_in, *t_oab, *t_o, *t_gu, *t_dn; };
constexpr int I_IN = 16 * 136, I_OA = 8 * 32, I_O = 16 * 32, I_GU = 16 * 64, I_DN = 16 * 32;
constexpr int NITEMS_W = I_IN + 2 * I_OA + I_O + NE * (I_GU + I_DN);
DEV void convert_item(const WPtrs& P, int it, float* scr, int lane) {
    int r = it;
    if (r < I_IN) { transpose_item(P.w_in, 1024, INC, P.t_in, 1024, 0, scr, r, lane); return; } r -= I_IN;
    if (r < I_OA) { transpose_item(P.w_oa, 512, 1024, P.t_oab, 1024, 0, scr, r, lane); return; } r -= I_OA;
    if (r < I_OA) { transpose_item(P.w_ob, 512, 1024, P.t_oab, 1024, 512, scr, r, lane); return; } r -= I_OA;
    if (r < I_O) { transpose_item(P.w_o, 1024, 1024, P.t_o, 1024, 0, scr, r, lane); return; } r -= I_O;
    if (r < NE * I_GU) { const int e = r / I_GU; transpose_item(P.w_gu + (size_t)e * 1024 * 2048, 1024, 2048, P.t_gu + (size_t)e * 2048 * 1024, 1024, 0, scr, r % I_GU, lane); return; } r -= NE * I_GU;
    { const int e = r / I_DN; transpose_item(P.w_dn + (size_t)e * 1024 * 1024, 1024, 1024, P.t_dn + (size_t)e * 1024 * 1024, 1024, 0, scr, r % I_DN, lane); }
}
__global__ void __launch_bounds__(256) k_convert(WPtrs P) {
    __shared__ float scr_all[4][64 * 33];
    const int wave = threadIdx.x >> 6, lane = threadIdx.x & 63;
    float* scr = scr_all[wave];
    for (int it = blockIdx.x * 4 + wave; it < NITEMS_W; it += gridDim.x * 4) convert_item(P, it, scr, lane);
}

DEV void hnorm_row(int row, const float* __restrict__ x, const float* __restrict__ ctx, const float* __restrict__ g, const float* __restrict__ mod, bf16* __restrict__ H, int lane) {
    const float* src = row < T ? x + (size_t)row * DM : ctx + (size_t)(row - T) * DM;
    const float* mrow = mod + (row < T ? (row / SEQ) : 4) * 6144;
    f32x4 v[4]; float ss = 0.f;
#pragma unroll
    for (int j = 0; j < 4; ++j) { v[j] = *(const f32x4*)(src + 4 * lane + 256 * j); ss += v[j][0] * v[j][0] + v[j][1] * v[j][1] + v[j][2] * v[j][2] + v[j][3] * v[j][3]; }
    const float rstd = rsqrtf(wave_sum(ss) * (1.0f / DM) + EPS);
#pragma unroll
    for (int j = 0; j < 4; ++j) {
        const int cidx = 4 * lane + 256 * j;
        const f32x4 gg = *(const f32x4*)(g + cidx), sh = *(const f32x4*)(mrow + cidx), sc = *(const f32x4*)(mrow + 1024 + cidx);
        float o[4];
#pragma unroll
        for (int q = 0; q < 4; ++q) o[q] = v[j][q] * rstd * gg[q] * (1.0f + sc[q]) + sh[q];
        u32x2 w; w.x = pk2(o[0], o[1]); w.y = pk2(o[2], o[3]);
        *(u32x2*)(H + (size_t)row * DM + cidx) = w;
    }
}
__global__ void __launch_bounds__(512) k_hnorm(const float* x, const float* ctx, const float* g, const float* mod, bf16* H) {
    const int wave = threadIdx.x >> 6, lane = threadIdx.x & 63;
    for (int row = blockIdx.x * 8 + wave; row < TR; row += gridDim.x * 8) hnorm_row(row, x, ctx, g, mod, H, lane);
}

template <int NBT>
DEV void gemm64_core(const bf16* __restrict__ aptr  , const bf16* __restrict__ bptr0, const bf16* __restrict__ bptr1, int K,
                     bf16* sA, bf16* sB, f32x4 (&acc)[NBT][2][2]) {
    const int tid = threadIdx.x, lane = tid & 63, w = tid >> 6, wm = w >> 1, wn = w & 1, fr = lane & 15, fq = lane >> 4;
    const int sr = tid >> 2, sc = tid & 3;
#pragma unroll
    for (int t = 0; t < NBT; ++t)
#pragma unroll
        for (int i = 0; i < 2; ++i)
#pragma unroll
            for (int j = 0; j < 2; ++j) acc[t][i][j] = (f32x4){0.f, 0.f, 0.f, 0.f};
    for (int k0 = 0; k0 < K; k0 += 32) {
        const u32x4 av = *(const u32x4*)(aptr + k0);
        const u32x4 bv0 = *(const u32x4*)(bptr0 + k0);
        u32x4 bv1 = bv0; if (NBT == 2) bv1 = *(const u32x4*)(bptr1 + k0);
        __syncthreads();
        *(u32x4*)(sA + sr * 40 + sc * 8) = av;
        *(u32x4*)(sB + sr * 40 + sc * 8) = bv0;
        if (NBT == 2) *(u32x4*)(sB + 64 * 40 + sr * 40 + sc * 8) = bv1;
        __syncthreads();
        bf16x8 a[2], b[NBT][2];
#pragma unroll
        for (int i = 0; i < 2; ++i) a[i] = *(const bf16x8*)(sA + (wm * 32 + i * 16 + fr) * 40 + fq * 8);
#pragma unroll
        for (int t = 0; t < NBT; ++t)
#pragma unroll
            for (int j = 0; j < 2; ++j) b[t][j] = *(const bf16x8*)(sB + t * 64 * 40 + (wn * 32 + j * 16 + fr) * 40 + fq * 8);
#pragma unroll
        for (int t = 0; t < NBT; ++t)
#pragma unroll
            for (int i = 0; i < 2; ++i)
#pragma unroll
                for (int j = 0; j < 2; ++j) acc[t][i][j] = __builtin_amdgcn_mfma_f32_16x16x32_bf16(a[i], b[t][j], acc[t][i][j], 0, 0, 0);
    }
}
template <bool OUTBF>
__global__ void __launch_bounds__(256) k_gemm(const bf16* __restrict__ A, int lda, const bf16* __restrict__ Bt, int ldb, void* __restrict__ Cv, int ldc, int K) {
    __shared__ __attribute__((aligned(16))) bf16 sA[64 * 40];
    __shared__ __attribute__((aligned(16))) bf16 sB[64 * 40];
    const int tid = threadIdx.x, lane = tid & 63, w = tid >> 6, wm = w >> 1, wn = w & 1, fr = lane & 15, fq = lane >> 4;
    const int m0 = blockIdx.y * 64, n0 = blockIdx.x * 64, sr = tid >> 2, sc = tid & 3;
    f32x4 acc[1][2][2];
    gemm64_core<1>(A + (size_t)(m0 + sr) * lda + sc * 8, Bt + (size_t)(n0 + sr) * ldb + sc * 8, nullptr, K, sA, sB, acc);
#pragma unroll
    for (int i = 0; i < 2; ++i)
#pragma unroll
        for (int j = 0; j < 2; ++j)
#pragma unroll
            for (int r = 0; r < 4; ++r) {
                const int m = m0 + wm * 32 + i * 16 + fq * 4 + r, n = n0 + wn * 32 + j * 16 + fr;
                if (OUTBF) ((bf16*)Cv)[(size_t)m * ldc + n] = (bf16)f2bf(acc[0][i][j][r]); else ((float*)Cv)[(size_t)m * ldc + n] = acc[0][i][j][r];
            }
}

__global__ void __launch_bounds__(256) k_proj_epi(const float* __restrict__ CF, const float* __restrict__ gq, const float* __restrict__ gk, const float* __restrict__ rope,
                                                  bf16* QA, bf16* KA, bf16* VA, bf16* QB, bf16* KB, bf16* VB, bf16* GA, bf16* GB) {
    const int wave = threadIdx.x >> 6, lane = threadIdx.x & 63;
    const int row = blockIdx.x * 4 + wave; if (row >= TR) return;
    const float* cf = CF + (size_t)row * INC;
    const bool lat = row < T;
    const int s = row % SEQ, prow = s / GRIDW, pcol = s % GRIDW;
    for (int cidx = lane; cidx < 512; cidx += 64) { KA[(size_t)row * 512 + cidx] = (bf16)f2bf(cf[C_KA + cidx]); VA[(size_t)row * 512 + cidx] = (bf16)f2bf(cf[C_VA + cidx]); }
    for (int cidx = lane; cidx < 128; cidx += 64) VB[(size_t)row * 128 + cidx] = (bf16)f2bf(cf[C_VB + cidx]);
    for (int h = 0; h < 2; ++h) {
        const float v = cf[C_KB + h * 64 + lane];
        const float rstd = rsqrtf(wave_sum(v * v) * (1.0f / 64.0f) + EPS);
        float y = v * rstd * gk[lane];
        if (lat) {
            const int half = lane >> 5, i = lane & 31, j = i & 15; const int pos = half ? pcol : prow;
            const float cs = rope[(pos * 16 + j) * 2], sn = rope[(pos * 16 + j) * 2 + 1];
            const float other = __shfl_xor(y, 16);
            y = (i < 16) ? (y * cs - other * sn) : (y * cs + other * sn);
        }
        KB[(size_t)row * 128 + h * 64 + lane] = (bf16)f2bf(y);
    }
    if (!lat) return;
    for (int cidx = lane; cidx < 512; cidx += 64) QA[(size_t)row * 512 + cidx] = (bf16)f2bf(cf[C_QA + cidx] * QSCALE);
    for (int h = 0; h < 8; ++h) {
        const float v = cf[C_QB + h * 64 + lane];
        const float rstd = rsqrtf(wave_sum(v * v) * (1.0f / 64.0f) + EPS);
        float y = v * rstd * gq[lane];
        const int half = lane >> 5, i = lane & 31, j = i & 15; const int pos = half ? pcol : prow;
        const float cs = rope[(pos * 16 + j) * 2], sn = rope[(pos * 16 + j) * 2 + 1];
        const float other = __shfl_xor(y, 16);
        y = (i < 16) ? (y * cs - other * sn) : (y * cs + other * sn);
        QB[(size_t)row * 512 + h * 64 + lane] = (bf16)f2bf(y * QSCALE);
    }
    for (int cidx = lane; cidx < 1024; cidx += 64) { GA[(size_t)row * 1024 + cidx] = (bf16)f2bf(sigmoidf_(cf[C_GA + cidx])); GB[(size_t)row * 1024 + cidx] = (bf16)f2bf(sigmoidf_(cf[C_GB + cidx])); }
}

template <int MODE  >
__global__ void __launch_bounds__(256) k_attn_naive(const bf16* __restrict__ Q, const bf16* __restrict__ Kx, const bf16* __restrict__ Vx, const float* __restrict__ rpb, bf16* __restrict__ O) {
    const int wave = threadIdx.x >> 6, lane = threadIdx.x & 63;
    const int task = blockIdx.x * 4 + wave;
    const int t = task >> 3, h = task & 7, b = t / SEQ, s = t % SEQ, r = s / GRIDW, cc = s % GRIDW;
    const int kvpitch = MODE == 0 ? 512 : 128, kvh = MODE == 0 ? h : (h >> 2);
    float q[64];
    {
        const u32x4* qp = (const u32x4*)(Q + (size_t)t * 512 + h * 64);
#pragma unroll
        for (int i = 0; i < 8; ++i) { const u32x4 v = qp[i]; q[8 * i] = bflo(v.x); q[8 * i + 1] = bfhi(v.x); q[8 * i + 2] = bflo(v.y); q[8 * i + 3] = bfhi(v.y); q[8 * i + 4] = bflo(v.z); q[8 * i + 5] = bfhi(v.z); q[8 * i + 6] = bflo(v.w); q[8 * i + 7] = bfhi(v.w); }
    }
    float m = -INFINITY, l = 0.f, o[64];
#pragma unroll
    for (int d = 0; d < 64; ++d) o[d] = 0.f;
    const int r0 = min(max(r - 4, 0), 56), c0 = min(max(cc - 8, 0), 48);
    const int nkeys = MODE == 0 ? 384 : (SEQ + CTXL);
    for (int kidx = lane; kidx < nkeys; kidx += 64) {
        int krow; float bias = 0.f;
        if (MODE == 0) {
            if (kidx < 128) { const int ki = kidx >> 4, kj = kidx & 15; krow = b * SEQ + (r0 + ki) * GRIDW + c0 + kj; bias = rpb[(h * 15 + (r0 + ki - r + 7)) * 31 + (c0 + kj - cc + 15)] * LOG2E; }
            else krow = T + b * CTXL + (kidx - 128);
        } else krow = kidx < SEQ ? b * SEQ + kidx : T + b * CTXL + (kidx - SEQ);
        const u32x4* kp = (const u32x4*)(Kx + (size_t)krow * kvpitch + kvh * 64);
        float sc = bias;
#pragma unroll
        for (int i = 0; i < 8; ++i) { const u32x4 v = kp[i];
            sc += q[8 * i] * bflo(v.x) + q[8 * i + 1] * bfhi(v.x) + q[8 * i + 2] * bflo(v.y) + q[8 * i + 3] * bfhi(v.y) + q[8 * i + 4] * bflo(v.z) + q[8 * i + 5] * bfhi(v.z) + q[8 * i + 6] * bflo(v.w) + q[8 * i + 7] * bfhi(v.w); }
        const float mn = fmaxf(m, sc), f = exp2f(m - mn), p = exp2f(sc - mn);
        l = l * f + p; m = mn;
        const u32x4* vp = (const u32x4*)(Vx + (size_t)krow * kvpitch + kvh * 64);
#pragma unroll
        for (int i = 0; i < 8; ++i) { const u32x4 v = vp[i];
            o[8 * i] = o[8 * i] * f + p * bflo(v.x); o[8 * i + 1] = o[8 * i + 1] * f + p * bfhi(v.x); o[8 * i + 2] = o[8 * i + 2] * f + p * bflo(v.y); o[8 * i + 3] = o[8 * i + 3] * f + p * bfhi(v.y);
            o[8 * i + 4] = o[8 * i + 4] * f + p * bflo(v.z); o[8 * i + 5] = o[8 * i + 5] * f + p * bfhi(v.z); o[8 * i + 6] = o[8 * i + 6] * f + p * bflo(v.w); o[8 * i + 7] = o[8 * i + 7] * f + p * bfhi(v.w); }
    }
    const float M = wave_max(m), f = exp2f(m - M);
    const float L = wave_sum(l * f), inv = 1.0f / L;
    float mine = 0.f;
#pragma unroll
    for (int d = 0; d < 64; ++d) { const float v = wave_sum(o[d] * f); if (lane == d) mine = v; }
    O[(size_t)t * 1024 + (MODE == 0 ? 0 : 512) + h * 64 + lane] = (bf16)f2bf(mine * inv);
}

__global__ void k_merge(const float* __restrict__ PA, const float* __restrict__ PB, const bf16* __restrict__ GA, const bf16* __restrict__ GB, bf16* __restrict__ U) {
    const size_t i = (size_t)blockIdx.x * blockDim.x + threadIdx.x;
    if (i < (size_t)T * 1024) U[i] = (bf16)f2bf(bf2f(GA[i]) * PA[i] + bf2f(GB[i]) * PB[i]);
}

constexpr int RP_LDS = 32 * 1024 * 4 + 4096;
DEV void rowpass_block(int blk, const float* __restrict__ x, const bf16* __restrict__ Y, const float* __restrict__ mod, const float* __restrict__ g_post_mix, const float* __restrict__ g_pre_ffn,
                       const float* __restrict__ w_router, const float* __restrict__ b_router, bf16* __restrict__ H2, float* __restrict__ RSTD1, int* __restrict__ TOPE, float* __restrict__ TOPW,
                       unsigned* __restrict__ ecnt, int* __restrict__ LIST, unsigned char* lds) {
    float* wr = (float*)lds;
    unsigned* hist = (unsigned*)(lds + 32 * 1024 * 4);
    unsigned* base = hist + 32;
    unsigned* asg_e = base + 32;
    unsigned* asg_p = asg_e + 256;
    const int tid = threadIdx.x, wave = tid >> 6, lane = tid & 63;
    for (int i = tid; i < 32 * 1024; i += 512) { const int k = i >> 5, e = i & 31; wr[e * 1024 + k] = w_router[i]; }
    if (tid < 32) hist[tid] = 0u;
    __syncthreads();
    const int t0 = blk * 64, b = t0 / SEQ;
    const float* mrow = mod + b * 6144;
    for (int it = 0; it < 8; ++it) {
        const int t = t0 + wave * 8 + it;
        float yv[16], xv[16];
        float ss = 0.f;
#pragma unroll
        for (int j = 0; j < 4; ++j) {
            const u32x2 yw = *(const u32x2*)(Y + (size_t)t * DM + 4 * lane + 256 * j);
            yv[4 * j] = bflo(yw.x); yv[4 * j + 1] = bfhi(yw.x); yv[4 * j + 2] = bflo(yw.y); yv[4 * j + 3] = bfhi(yw.y);
            const f32x4 xx = *(const f32x4*)(x + (size_t)t * DM + 4 * lane + 256 * j);
            xv[4 * j] = xx[0]; xv[4 * j + 1] = xx[1]; xv[4 * j + 2] = xx[2]; xv[4 * j + 3] = xx[3];
#pragma unroll
            for (int q = 0; q < 4; ++q) ss += yv[4 * j + q] * yv[4 * j + q];
        }
        const float rstd1 = rsqrtf(wave_sum(ss) * (1.0f / DM) + EPS);
        if (lane == 0) RSTD1[t] = rstd1;
        float ss2 = 0.f;
#pragma unroll
        for (int j = 0; j < 4; ++j) {
            const int cidx = 4 * lane + 256 * j;
            const f32x4 gt = *(const f32x4*)(mrow + 2048 + cidx), gp = *(const f32x4*)(g_post_mix + cidx);
#pragma unroll
            for (int q = 0; q < 4; ++q) { const float x1 = xv[4 * j + q] + gt[q] * (yv[4 * j + q] * rstd1 * gp[q]); xv[4 * j + q] = x1; ss2 += x1 * x1; }
        }
        const float rstd2 = rsqrtf(wave_sum(ss2) * (1.0f / DM) + EPS);
#pragma unroll
        for (int j = 0; j < 4; ++j) {
            const int cidx = 4 * lane + 256 * j;
            const f32x4 gf = *(const f32x4*)(g_pre_ffn + cidx), sh = *(const f32x4*)(mrow + 3072 + cidx), sc = *(const f32x4*)(mrow + 4096 + cidx);
#pragma unroll
            for (int q = 0; q < 4; ++q) xv[4 * j + q] = xv[4 * j + q] * rstd2 * gf[q] * (1.0f + sc[q]) + sh[q];
            u32x2 w; w.x = pk2(xv[4 * j], xv[4 * j + 1]); w.y = pk2(xv[4 * j + 2], xv[4 * j + 3]);
            *(u32x2*)(H2 + (size_t)t * DM + cidx) = w;
        }
        float pl[32];
#pragma unroll
        for (int e = 0; e < 32; ++e) {
            float a = 0.f;
#pragma unroll
            for (int j = 0; j < 4; ++j) { const f32x4 w = *(const f32x4*)(wr + e * 1024 + 4 * lane + 256 * j); a += xv[4 * j] * w[0] + xv[4 * j + 1] * w[1] + xv[4 * j + 2] * w[2] + xv[4 * j + 3] * w[3]; }
            pl[e] = a;
        }
#define RP_STEP(D, H) _Pragma("unroll") for (int i = 0; i < H; ++i) { const bool up = (lane & D) != 0; const float snd = up ? pl[i] : pl[i + H]; const float kp = up ? pl[i + H] : pl[i]; pl[i] = kp + __shfl_xor(snd, D); }
        RP_STEP(32, 16) RP_STEP(16, 8) RP_STEP(8, 4) RP_STEP(4, 2) RP_STEP(2, 1)
#undef RP_STEP
        float logit = pl[0] + __shfl_xor(pl[0], 1);
        const int e_mine = lane >> 1;
        logit += b_router[e_mine];
        float val = (lane & 1) ? -INFINITY : logit;
        float tl[4]; int te[4];
#pragma unroll
        for (int k = 0; k < 4; ++k) {
            const float mx = wave_max(val);
            const unsigned long long bal = __ballot(val == mx);
            const int wl = __ffsll((long long)bal) - 1;
            tl[k] = mx; te[k] = wl >> 1;
            if (lane == wl) val = -INFINITY;
        }
        const float e1 = __expf(tl[1] - tl[0]), e2 = __expf(tl[2] - tl[0]), e3 = __expf(tl[3] - tl[0]);
        const float inv = 1.0f / (1.0f + e1 + e2 + e3);
        if (lane < 4) {
            const int ek = lane == 0 ? te[0] : lane == 1 ? te[1] : lane == 2 ? te[2] : te[3];
            const float wk = (lane == 0 ? 1.0f : lane == 1 ? e1 : lane == 2 ? e2 : e3) * inv;
            TOPE[t * 4 + lane] = ek; TOPW[t * 4 + lane] = wk;
            const unsigned p = atomicAdd(&hist[ek], 1u);
            const int la = (wave * 8 + it) * 4 + lane;
            asg_e[la] = (unsigned)ek; asg_p[la] = p;
        }
    }
    __syncthreads();
    if (tid < 32) base[tid] = atomicAdd(&ecnt[tid], hist[tid]);
    __syncthreads();
    if (tid < 256) { const unsigned e = asg_e[tid]; LIST[(size_t)e * ECAP + base[e] + asg_p[tid]] = t0 * 4 + tid; }
    __syncthreads();
}
__global__ void __launch_bounds__(512) k_rowpass(const float* x, const bf16* Y, const float* mod, const float* g_post_mix, const float* g_pre_ffn, const float* w_router, const float* b_router,
                                                 bf16* H2, float* RSTD1, int* TOPE, float* TOPW, unsigned* ecnt, int* LIST) {
    extern __shared__ __attribute__((aligned(16))) unsigned char lds[];
    for (int blk = blockIdx.x; blk < T / 64; blk += gridDim.x) rowpass_block(blk, x, Y, mod, g_post_mix, g_pre_ffn, w_router, b_router, H2, RSTD1, TOPE, TOPW, ecnt, LIST, lds);
}

DEV int expert_base(const unsigned* __restrict__ ecnt, int e) { int bse = 0; for (int i = 0; i < e; ++i) bse += ((int)ecnt[i] + 255) & ~255; return bse; }
__global__ void __launch_bounds__(256) k_moe_gu(const bf16* __restrict__ H2, const bf16* __restrict__ WGU, const float* __restrict__ b_gu, const unsigned* __restrict__ ecnt, const int* __restrict__ LIST, bf16* __restrict__ ACT) {
    __shared__ __attribute__((aligned(16))) bf16 sA[64 * 40];
    __shared__ __attribute__((aligned(16))) bf16 sB[2 * 64 * 40];
    const int e = blockIdx.z, cnt = (int)ecnt[e], m0 = blockIdx.y * 64; if (m0 >= cnt) return;
    const int tid = threadIdx.x, lane = tid & 63, w = tid >> 6, wm = w >> 1, wn = w & 1, fr = lane & 15, fq = lane >> 4, sr = tid >> 2, sc = tid & 3;
    const int n0 = blockIdx.x * 64;
    const int mrow = min(m0 + sr, cnt - 1);
    const int tok = LIST[(size_t)e * ECAP + mrow] >> 2;
    const bf16* wb = WGU + (size_t)e * 2048 * 1024;
    f32x4 acc[2][2][2];
    gemm64_core<2>(H2 + (size_t)tok * DM + sc * 8, wb + (size_t)(n0 + sr) * 1024 + sc * 8, wb + (size_t)(1024 + n0 + sr) * 1024 + sc * 8, 1024, sA, sB, acc);
    const int ebase = expert_base(ecnt, e);
#pragma unroll
    for (int i = 0; i < 2; ++i)
#pragma unroll
        for (int j = 0; j < 2; ++j)
#pragma unroll
            for (int r = 0; r < 4; ++r) {
                const int m = m0 + wm * 32 + i * 16 + fq * 4 + r, n = n0 + wn * 32 + j * 16 + fr;
                if (m < cnt) {
                    const float glu = fminf(acc[0][i][j][r] + b_gu[e * 2048 + n], SW_LIMIT);
                    const float lin = fminf(fmaxf(acc[1][i][j][r] + b_gu[e * 2048 + 1024 + n], -SW_LIMIT), SW_LIMIT);
                    const float a = (lin + 1.0f) * (glu * sigmoidf_(SW_ALPHA * glu));
                    ACT[(size_t)(ebase + m) * DFF + n] = (bf16)f2bf(a);
                }
            }
}
__global__ void __launch_bounds__(256) k_moe_dn(const bf16* __restrict__ ACT, const bf16* __restrict__ WDN, const float* __restrict__ b_dn, const unsigned* __restrict__ ecnt, const int* __restrict__ LIST, const float* __restrict__ TOPW, bf16* __restrict__ YS) {
    __shared__ __attribute__((aligned(16))) bf16 sA[64 * 40];
    __shared__ __attribute__((aligned(16))) bf16 sB[64 * 40];
    const int e = blockIdx.z, cnt = (int)ecnt[e], m0 = blockIdx.y * 64; if (m0 >= cnt) return;
    const int tid = threadIdx.x, lane = tid & 63, w = tid >> 6, wm = w >> 1, wn = w & 1, fr = lane & 15, fq = lane >> 4, sr = tid >> 2, sc = tid & 3;
    const int n0 = blockIdx.x * 64;
    const int ebase = expert_base(ecnt, e);
    const int mrow = min(m0 + sr, cnt - 1);
    f32x4 acc[1][2][2];
    gemm64_core<1>(ACT + (size_t)(ebase + mrow) * DFF + sc * 8, WDN + (size_t)e * 1024 * 1024 + (size_t)(n0 + sr) * 1024 + sc * 8, nullptr, 1024, sA, sB, acc);
#pragma unroll
    for (int i = 0; i < 2; ++i)
#pragma unroll
        for (int j = 0; j < 2; ++j)
#pragma unroll
            for (int r = 0; r < 4; ++r) {
                const int m = m0 + wm * 32 + i * 16 + fq * 4 + r, n = n0 + wn * 32 + j * 16 + fr;
                if (m < cnt) { const int a = LIST[(size_t)e * ECAP + m]; YS[(size_t)a * DM + n] = (bf16)f2bf(TOPW[a] * (acc[0][i][j][r] + b_dn[e * 1024 + n])); }
            }
}

DEV void final_row(int t, const float* __restrict__ x, const bf16* __restrict__ Y, const float* __restrict__ RSTD1, const bf16* __restrict__ YS, const float* __restrict__ mod,
                   const float* __restrict__ g_post_mix, const float* __restrict__ g_post_ffn, float* __restrict__ out, int lane) {
    const float* mrow = mod + (t / SEQ) * 6144;
    const float rstd1 = RSTD1[t];
    float f[16]; float ss = 0.f;
#pragma unroll
    for (int j = 0; j < 4; ++j) {
        float a0 = 0.f, a1 = 0.f, a2 = 0.f, a3 = 0.f;
#pragma unroll
        for (int k = 0; k < 4; ++k) { const u32x2 w = *(const u32x2*)(YS + (size_t)(t * 4 + k) * DM + 4 * lane + 256 * j); a0 += bflo(w.x); a1 += bfhi(w.x); a2 += bflo(w.y); a3 += bfhi(w.y); }
        f[4 * j] = a0; f[4 * j + 1] = a1; f[4 * j + 2] = a2; f[4 * j + 3] = a3;
        ss += a0 * a0 + a1 * a1 + a2 * a2 + a3 * a3;
    }
    const float rstdf = rsqrtf(wave_sum(ss) * (1.0f / DM) + EPS);
#pragma unroll
    for (int j = 0; j < 4; ++j) {
        const int cidx = 4 * lane + 256 * j;
        const f32x4 xx = *(const f32x4*)(x + (size_t)t * DM + cidx);
        const u32x2 yw = *(const u32x2*)(Y + (size_t)t * DM + cidx);
        const f32x4 gt1 = *(const f32x4*)(mrow + 2048 + cidx), gt2 = *(const f32x4*)(mrow + 5120 + cidx), gp = *(const f32x4*)(g_post_mix + cidx), gf = *(const f32x4*)(g_post_ffn + cidx);
        const float yv[4] = {bflo(yw.x), bfhi(yw.x), bflo(yw.y), bfhi(yw.y)};
        f32x4 o;
#pragma unroll
        for (int q = 0; q < 4; ++q) o[q] = xx[q] + gt1[q] * (yv[q] * rstd1 * gp[q]) + gt2[q] * (f[4 * j + q] * rstdf * gf[q]);
        *(f32x4*)(out + (size_t)t * DM + cidx) = o;
    }
}
__global__ void __launch_bounds__(512) k_final(const float* x, const bf16* Y, const float* RSTD1, const bf16* YS, const float* mod, const float* g_post_mix, const float* g_post_ffn, float* out) {
    const int wave = threadIdx.x >> 6, lane = threadIdx.x & 63;
    for (int t = blockIdx.x * 8 + wave; t < T; t += gridDim.x * 8) final_row(t, x, Y, RSTD1, YS, mod, g_post_mix, g_post_ffn, out, lane);
}

extern "C" void kernel_launch(void* const* d_in, const int* in_sizes, int n_in, void* d_out, int out_size, void* d_ws, size_t ws_size, hipStream_t stream) {
    static int ok = 0;
    if (ok == 0) {
        ok = 1;
        if (n_in != 23 || in_sizes[0] != T * DM || out_size != T * DM || ws_size < WS_END) { fprintf(stderr, "kernel_launch: unexpected shapes/workspace (n_in %d, ws %zu)\n", n_in, ws_size); ok = -1; }
        if (hipFuncSetAttribute((const void*)k_rowpass, hipFuncAttributeMaxDynamicSharedMemorySize, RP_LDS) != hipSuccess) { fprintf(stderr, "kernel_launch: hipFuncSetAttribute failed\n"); ok = -1; }
    }
    if (ok < 0) return;
    const float* x = (const float*)d_in[0]; const float* c = (const float*)d_in[1]; const float* ctx = (const float*)d_in[2]; const float* cctx = (const float*)d_in[3];
    const float* w_mod = (const float*)d_in[4]; const float* b_mod = (const float*)d_in[5];
    const float* g_pre_mix = (const float*)d_in[6]; const float* g_post_mix = (const float*)d_in[7]; const float* g_pre_ffn = (const float*)d_in[8]; const float* g_post_ffn = (const float*)d_in[9];
    const float* w_in = (const float*)d_in[10]; const float* rpb = (const float*)d_in[11]; const float* g_qn = (const float*)d_in[12]; const float* g_kn = (const float*)d_in[13];
    const float* w_oa = (const float*)d_in[14]; const float* w_ob = (const float*)d_in[15]; const float* w_o = (const float*)d_in[16];
    const float* w_router = (const float*)d_in[17]; const float* b_router = (const float*)d_in[18];
    const float* w_gu = (const float*)d_in[19]; const float* b_gu = (const float*)d_in[20]; const float* w_dn = (const float*)d_in[21]; const float* b_dn = (const float*)d_in[22];
    unsigned char* ws = (unsigned char*)d_ws;
    float* MOD = (float*)(ws + WS_MOD); float* ROPE = (float*)(ws + WS_ROPE); float* RSTD1 = (float*)(ws + WS_RSTD1); int* TOPE = (int*)(ws + WS_TOPE); float* TOPW = (float*)(ws + WS_TOPW);
    int* LIST = (int*)(ws + WS_LIST); unsigned* ECNT = (unsigned*)(ws + WS_CTL) + CW_ECNT;
    bf16 *WTIN = (bf16*)(ws + WS_WTIN), *WTOAB = (bf16*)(ws + WS_WTOAB), *WTO = (bf16*)(ws + WS_WTO), *WTGU = (bf16*)(ws + WS_WTGU), *WTDN = (bf16*)(ws + WS_WTDN);
    bf16 *H = (bf16*)(ws + WS_H), *QA = (bf16*)(ws + WS_QA), *KA = (bf16*)(ws + WS_KA), *VA = (bf16*)(ws + WS_VA), *QB = (bf16*)(ws + WS_QB), *KB = (bf16*)(ws + WS_KB), *VB = (bf16*)(ws + WS_VB);
    bf16 *GA = (bf16*)(ws + WS_GA), *GB = (bf16*)(ws + WS_GB), *O = (bf16*)(ws + WS_O), *U = (bf16*)(ws + WS_U), *Y = (bf16*)(ws + WS_Y), *H2 = (bf16*)(ws + WS_H2), *ACT = (bf16*)(ws + WS_ACT), *YS = (bf16*)(ws + WS_YS);
    float *CF32 = (float*)(ws + WS_CF32), *PA = (float*)(ws + WS_PA), *PB = (float*)(ws + WS_PB);

    hipMemsetAsync(ws + WS_CTL, 0, CTL_ZERO_BYTES, stream);
    k_mod<<<192, 512, 0, stream>>>(c, cctx, w_mod, b_mod, MOD);
    k_rope_tab<<<4, 256, 0, stream>>>(ROPE);
    WPtrs P{w_in, w_oa, w_ob, w_o, w_gu, w_dn, WTIN, WTOAB, WTO, WTGU, WTDN};
    k_convert<<<2048, 256, 0, stream>>>(P);
    k_hnorm<<<1024, 512, 0, stream>>>(x, ctx, g_pre_mix, MOD, H);
    k_gemm<false><<<dim3(INC / 64, T / 64), 256, 0, stream>>>(H, DM, WTIN, DM, CF32, INC, DM);
    k_gemm<false><<<dim3(KVC / 64, TC / 64), 256, 0, stream>>>(H + (size_t)T * DM, DM, WTIN, DM, CF32 + (size_t)T * INC, INC, DM);
    k_proj_epi<<<TR / 4, 256, 0, stream>>>(CF32, g_qn, g_kn, ROPE, QA, KA, VA, QB, KB, VB, GA, GB);
    k_attn_naive<0><<<T * 8 / 4, 256, 0, stream>>>(QA, KA, VA, rpb, O);
    k_attn_naive<1><<<T * 8 / 4, 256, 0, stream>>>(QB, KB, VB, rpb, O);
    k_gemm<false><<<dim3(1024 / 64, T / 64), 256, 0, stream>>>(O, 1024, WTOAB, 1024, PA, 1024, 512);
    k_gemm<false><<<dim3(1024 / 64, T / 64), 256, 0, stream>>>(O + 512, 1024, WTOAB + 512, 1024, PB, 1024, 512);
    k_merge<<<T * 1024 / 256, 256, 0, stream>>>(PA, PB, GA, GB, U);
    k_gemm<true><<<dim3(1024 / 64, T / 64), 256, 0, stream>>>(U, 1024, WTO, 1024, Y, 1024, 1024);
    k_rowpass<<<256, 512, RP_LDS, stream>>>(x, Y, MOD, g_post_mix, g_pre_ffn, w_router, b_router, H2, RSTD1, TOPE, TOPW, ECNT, LIST);
    k_moe_gu<<<dim3(DFF / 64, ECAP / 64, NE), 256, 0, stream>>>(H2, WTGU, b_gu, ECNT, LIST, ACT);
    k_moe_dn<<<dim3(DM / 64, ECAP / 64, NE), 256, 0, stream>>>(ACT, WTDN, b_dn, ECNT, LIST, TOPW, YS);
    k_final<<<1024, 512, 0, stream>>>(x, Y, RSTD1, YS, MOD, g_post_mix, g_post_ffn, (float*)d_out);
}
```

```cpp
#include <hip/hip_runtime.h>
#include <cstdint>
#include <cstdio>

#define DEV __device__ __forceinline__
typedef unsigned short bf16;
typedef short bf16x8 __attribute__((ext_vector_type(8)));
typedef float f32x4 __attribute__((ext_vector_type(4)));
typedef unsigned u32x4 __attribute__((ext_vector_type(4)));
typedef unsigned u32x2 __attribute__((ext_vector_type(2)));

constexpr int DM = 1024, NBATCH = 4, SEQ = 4096, T = NBATCH * SEQ, CTXL = 256, TC = NBATCH * CTXL, TR = T + TC;
constexpr int GRIDW = 64, HD = 64;
constexpr int INC = 4352, KVC = 1280;
constexpr int C_KA = 0, C_VA = 512, C_KB = 1024, C_VB = 1152, C_QA = 1280, C_QB = 1792, C_GA = 2304, C_GB = 3328;
constexpr int NE = 32, TOPK = 4, DFF = 1024;
constexpr int NASG = T * TOPK;
constexpr int ECAP = T;
constexpr int ACT_ROWS = NASG + NE * 256;
constexpr float EPS = 1e-6f, LOG2E = 1.4426950408889634f, QSCALE = 0.125f * LOG2E;
constexpr float SW_LIMIT = 7.0f, SW_ALPHA = 1.702f;

constexpr size_t MiB = 1u << 20;
constexpr size_t WS_CTL = 0, CTL_ZERO_BYTES = 1 * MiB;
constexpr size_t WS_MOD = 1 * MiB;
constexpr size_t WS_ROPE = 1 * MiB + 128 * 1024;
constexpr size_t WS_RSTD1 = 1 * MiB + 256 * 1024;
constexpr size_t WS_TOPE = 1 * MiB + 512 * 1024;
constexpr size_t WS_TOPW = 1 * MiB + 768 * 1024;
constexpr size_t WS_LIST = 2 * MiB;
constexpr size_t WS_WTIN = 4 * MiB;
constexpr size_t WS_WTOAB = 13 * MiB;
constexpr size_t WS_WTO = 15 * MiB;
constexpr size_t WS_WTGU = 17 * MiB;
constexpr size_t WS_WTDN = 145 * MiB;
constexpr size_t WS_H = 209 * MiB;
constexpr size_t WS_QA = 243 * MiB;
constexpr size_t WS_KA = 259 * MiB;
constexpr size_t WS_VA = 276 * MiB;
constexpr size_t WS_QB = 293 * MiB;
constexpr size_t WS_KB = 309 * MiB;
constexpr size_t WS_VB = 314 * MiB;
constexpr size_t WS_GA = 319 * MiB;
constexpr size_t WS_GB = 351 * MiB;
constexpr size_t WS_O = 383 * MiB;
constexpr size_t WS_U = 415 * MiB;
constexpr size_t WS_Y = 447 * MiB;
constexpr size_t WS_H2 = 479 * MiB;
constexpr size_t WS_ACT = 511 * MiB;
constexpr size_t WS_YS = 655 * MiB;
constexpr size_t WS_END = 783 * MiB;
constexpr size_t WS_CF32 = 479 * MiB;
constexpr size_t WS_PA = 511 * MiB, WS_PB = 575 * MiB;
static_assert(WS_CF32 + (size_t)TR * INC * 4 <= WS_END, "cf32 overlay");
constexpr int CW_ECNT = 2048;

DEV unsigned f2bf(float f) { unsigned u = __builtin_bit_cast(unsigned, f); return (u + 0x7fffu + ((u >> 16) & 1u)) >> 16; }
DEV unsigned pk2(float lo, float hi) { return f2bf(lo) | (f2bf(hi) << 16); }
DEV float bflo(unsigned w) { return __builtin_bit_cast(float, w << 16); }
DEV float bfhi(unsigned w) { return __builtin_bit_cast(float, w & 0xffff0000u); }
DEV float bf2f(bf16 b) { return __builtin_bit_cast(float, ((unsigned)b) << 16); }
DEV float wave_sum(float v) {
#pragma unroll
    for (int o = 1; o < 64; o <<= 1) v += __shfl_xor(v, o);
    return v;
}
DEV float wave_max(float v) {
#pragma unroll
    for (int o = 1; o < 64; o <<= 1) v = fmaxf(v, __shfl_xor(v, o));
    return v;
}
DEV float sigmoidf_(float x) { return 1.0f / (1.0f + __expf(-x)); }

__global__ void __launch_bounds__(512) k_mod(const float* __restrict__ c, const float* __restrict__ cctx, const float* __restrict__ wmod, const float* __restrict__ bmod, float* __restrict__ mod) {
    __shared__ float sil[5][1024];
    __shared__ float red[64][5][32];
    const int tid = threadIdx.x, n0 = blockIdx.x * 32;
    for (int i = tid; i < 5 * 1024; i += 512) { const int r = i >> 10, k = i & 1023; const float v = r < 4 ? c[r * 1024 + k] : cctx[k]; sil[r][k] = v / (1.0f + __expf(-v)); }
    __syncthreads();
    const int cg = tid & 7, kr = tid >> 3;
    float acc[5][4];
#pragma unroll
    for (int r = 0; r < 5; ++r)
#pragma unroll
        for (int j = 0; j < 4; ++j) acc[r][j] = 0.f;
    for (int k = kr; k < 1024; k += 64) {
        const f32x4 w = *(const f32x4*)(wmod + (size_t)k * 6144 + n0 + 4 * cg);
#pragma unroll
        for (int r = 0; r < 5; ++r) { const float s = sil[r][k]; acc[r][0] += s * w[0]; acc[r][1] += s * w[1]; acc[r][2] += s * w[2]; acc[r][3] += s * w[3]; }
    }
#pragma unroll
    for (int r = 0; r < 5; ++r)
#pragma unroll
        for (int j = 0; j < 4; ++j) red[kr][r][4 * cg + j] = acc[r][j];
    __syncthreads();
    if (tid < 160) { const int r = tid >> 5, n = tid & 31; float s = 0.f; for (int i = 0; i < 64; ++i) s += red[i][r][n]; mod[r * 6144 + n0 + n] = s + bmod[n0 + n]; }
}

__global__ void k_rope_tab(float* __restrict__ tab) {
    const int i = blockIdx.x * blockDim.x + threadIdx.x;
    if (i < 64 * 16) { const int pos = i >> 4, j = i & 15; const float f = powf(10000.0f, -(float)j / 16.0f); const float a = (float)pos * f; tab[2 * i] = cosf(a); tab[2 * i + 1] = sinf(a); }
}

DEV void transpose_item(const float* __restrict__ W, int K, int N, bf16* __restrict__ WT, int ld, int koff, float* scr, int item, int lane) {
    const int nblk = N / 32, kb = item / nblk, nb = item % nblk, k0 = 64 * kb, n0 = 32 * nb;
#pragma unroll 8
    for (int i = 0; i < 32; ++i) { const int kk = 2 * i + (lane >> 5); scr[kk * 33 + (lane & 31)] = W[(size_t)(k0 + kk) * N + n0 + (lane & 31)]; }
    __builtin_amdgcn_s_waitcnt(0xC07F); asm volatile("" ::: "memory");
    const int cch = lane & 7;
#pragma unroll
    for (int j = 0; j < 4; ++j) { const int n = (lane >> 3) + 8 * j; const float* s = scr + (8 * cch) * 33 + n;
        u32x4 o; o.x = pk2(s[0 * 33], s[1 * 33]); o.y = pk2(s[2 * 33], s[3 * 33]); o.z = pk2(s[4 * 33], s[5 * 33]); o.w = pk2(s[6 * 33], s[7 * 33]);
        *(u32x4*)(WT + (size_t)(n0 + n) * ld + koff + k0 + 8 * cch) = o; }
    __builtin_amdgcn_s_waitcnt(0xC07F); asm volatile("" ::: "memory");
}
struct WPtrs { const float *w_in, *w_oa, *w_ob, *w_o, *w_gu, *w_dn; bf16 *t_in, *t_oab, *t_o, *t_gu, *t_dn; };
constexpr int I_IN = 16 * 136, I_OA = 8 * 32, I_O = 16 * 32, I_GU = 16 * 64, I_DN = 16 * 32;
constexpr int NITEMS_W = I_IN + 2 * I_OA + I_O + NE * (I_GU + I_DN);
DEV void convert_item(const WPtrs& P, int it, float* scr, int lane) {
    int r = it;
    if (r < I_IN) { transpose_item(P.w_in, 1024, INC, P.t_in, 1024, 0, scr, r, lane); return; } r -= I_IN;
    if (r < I_OA) { transpose_item(P.w_oa, 512, 1024, P.t_oab, 1024, 0, scr, r, lane); return; } r -= I_OA;
    if (r < I_OA) { transpose_item(P.w_ob, 512, 1024, P.t_oab, 1024, 512, scr, r, lane); return; } r -= I_OA;
    if (r < I_O) { transpose_item(P.w_o, 1024, 1024, P.t_o, 1024, 0, scr, r, lane); return; } r -= I_O;
    if (r < NE * I_GU) { const int e = r / I_GU; transpose_item(P.w_gu + (size_t)e * 1024 * 2048, 1024, 2048, P.t_gu + (size_t)e * 2048 * 1024, 1024, 0, scr, r % I_GU, lane); return; } r -= NE * I_GU;
    { const int e = r / I_DN; transpose_item(P.w_dn + (size_t)e * 1024 * 1024, 1024, 1024, P.t_dn + (size_t)e * 1024 * 1024, 1024, 0, scr, r % I_DN, lane); }
}
__global__ void __launch_bounds__(256) k_convert(WPtrs P) {
    __shared__ float scr_all[4][64 * 33];
    const int wave = threadIdx.x >> 6, lane = threadIdx.x & 63;
    float* scr = scr_all[wave];
    for (int it = blockIdx.x * 4 + wave; it < NITEMS_W; it += gridDim.x * 4) convert_item(P, it, scr, lane);
}

DEV void hnorm_row(int row, const float* __restrict__ x, const float* __restrict__ ctx, const float* __restrict__ g, const float* __restrict__ mod, bf16* __restrict__ H, int lane) {
    const float* src = row < T ? x + (size_t)row * DM : ctx + (size_t)(row - T) * DM;
    const float* mrow = mod + (row < T ? (row / SEQ) : 4) * 6144;
    f32x4 v[4]; float ss = 0.f;
#pragma unroll
    for (int j = 0; j < 4; ++j) { v[j] = *(const f32x4*)(src + 4 * lane + 256 * j); ss += v[j][0] * v[j][0] + v[j][1] * v[j][1] + v[j][2] * v[j][2] + v[j][3] * v[j][3]; }
    const float rstd = rsqrtf(wave_sum(ss) * (1.0f / DM) + EPS);
#pragma unroll
    for (int j = 0; j < 4; ++j) {
        const int cidx = 4 * lane + 256 * j;
        const f32x4 gg = *(const f32x4*)(g + cidx), sh = *(const f32x4*)(mrow + cidx), sc = *(const f32x4*)(mrow + 1024 + cidx);
        float o[4];
#pragma unroll
        for (int q = 0; q < 4; ++q) o[q] = v[j][q] * rstd * gg[q] * (1.0f + sc[q]) + sh[q];
        u32x2 w; w.x = pk2(o[0], o[1]); w.y = pk2(o[2], o[3]);
        *(u32x2*)(H + (size_t)row * DM + cidx) = w;
    }
}
__global__ void __launch_bounds__(512) k_hnorm(const float* x, const float* ctx, const float* g, const float* mod, bf16* H) {
    const int wave = threadIdx.x >> 6, lane = threadIdx.x & 63;
    for (int row = blockIdx.x * 8 + wave; row < TR; row += gridDim.x * 8) hnorm_row(row, x, ctx, g, mod, H, lane);
}

template <int NBT>
DEV void gemm64_core(const bf16* __restrict__ aptr  , const bf16* __restrict__ bptr0, const bf16* __restrict__ bptr1, int K,
                     bf16* sA, bf16* sB, f32x4 (&acc)[NBT][2][2]) {
    const int tid = threadIdx.x, lane = tid & 63, w = tid >> 6, wm = w >> 1, wn = w & 1, fr = lane & 15, fq = lane >> 4;
    const int sr = tid >> 2, sc = tid & 3;
#pragma unroll
    for (int t = 0; t < NBT; ++t)
#pragma unroll
        for (int i = 0; i < 2; ++i)
#pragma unroll
            for (int j = 0; j < 2; ++j) acc[t][i][j] = (f32x4){0.f, 0.f, 0.f, 0.f};
    for (int k0 = 0; k0 < K; k0 += 32) {
        const u32x4 av = *(const u32x4*)(aptr + k0);
        const u32x4 bv0 = *(const u32x4*)(bptr0 + k0);
        u32x4 bv1 = bv0; if (NBT == 2) bv1 = *(const u32x4*)(bptr1 + k0);
        __syncthreads();
        *(u32x4*)(sA + sr * 40 + sc * 8) = av;
        *(u32x4*)(sB + sr * 40 + sc * 8) = bv0;
        if (NBT == 2) *(u32x4*)(sB + 64 * 40 + sr * 40 + sc * 8) = bv1;
        __syncthreads();
        bf16x8 a[2], b[NBT][2];
#pragma unroll
        for (int i = 0; i < 2; ++i) a[i] = *(const bf16x8*)(sA + (wm * 32 + i * 16 + fr) * 40 + fq * 8);
#pragma unroll
        for (int t = 0; t < NBT; ++t)
#pragma unroll
            for (int j = 0; j < 2; ++j) b[t][j] = *(const bf16x8*)(sB + t * 64 * 40 + (wn * 32 + j * 16 + fr) * 40 + fq * 8);
#pragma unroll
        for (int t = 0; t < NBT; ++t)
#pragma unroll
            for (int i = 0; i < 2; ++i)
#pragma unroll
                for (int j = 0; j < 2; ++j) acc[t][i][j] = __builtin_amdgcn_mfma_f32_16x16x32_bf16(a[i], b[t][j], acc[t][i][j], 0, 0, 0);
    }
}
template <bool OUTBF>
__global__ void __launch_bounds__(256) k_gemm(const bf16* __restrict__ A, int lda, const bf16* __restrict__ Bt, int ldb, void* __restrict__ Cv, int ldc, int K) {
    __shared__ __attribute__((aligned(16))) bf16 sA[64 * 40];
    __shared__ __attribute__((aligned(16))) bf16 sB[64 * 40];
    const int tid = threadIdx.x, lane = tid & 63, w = tid >> 6, wm = w >> 1, wn = w & 1, fr = lane & 15, fq = lane >> 4;
    const int m0 = blockIdx.y * 64, n0 = blockIdx.x * 64, sr = tid >> 2, sc = tid & 3;
    f32x4 acc[1][2][2];
    gemm64_core<1>(A + (size_t)(m0 + sr) * lda + sc * 8, Bt + (size_t)(n0 + sr) * ldb + sc * 8, nullptr, K, sA, sB, acc);
#pragma unroll
    for (int i = 0; i < 2; ++i)
#pragma unroll
        for (int j = 0; j < 2; ++j)
#pragma unroll
            for (int r = 0; r < 4; ++r) {
                const int m = m0 + wm * 32 + i * 16 + fq * 4 + r, n = n0 + wn * 32 + j * 16 + fr;
                if (OUTBF) ((bf16*)Cv)[(size_t)m * ldc + n] = (bf16)f2bf(acc[0][i][j][r]); else ((float*)Cv)[(size_t)m * ldc + n] = acc[0][i][j][r];
            }
}

__global__ void __launch_bounds__(256) k_proj_epi(const float* __restrict__ CF, const float* __restrict__ gq, const float* __restrict__ gk, const float* __restrict__ rope,
                                                  bf16* QA, bf16* KA, bf16* VA, bf16* QB, bf16* KB, bf16* VB, bf16* GA, bf16* GB) {
    const int wave = threadIdx.x >> 6, lane = threadIdx.x & 63;
    const int row = blockIdx.x * 4 + wave; if (row >= TR) return;
    const float* cf = CF + (size_t)row * INC;
    const bool lat = row < T;
    const int s = row % SEQ, prow = s / GRIDW, pcol = s % GRIDW;
    for (int cidx = lane; cidx < 512; cidx += 64) { KA[(size_t)row * 512 + cidx] = (bf16)f2bf(cf[C_KA + cidx]); VA[(size_t)row * 512 + cidx] = (bf16)f2bf(cf[C_VA + cidx]); }
    for (int cidx = lane; cidx < 128; cidx += 64) VB[(size_t)row * 128 + cidx] = (bf16)f2bf(cf[C_VB + cidx]);
    for (int h = 0; h < 2; ++h) {
        const float v = cf[C_KB + h * 64 + lane];
        const float rstd = rsqrtf(wave_sum(v * v) * (1.0f / 64.0f) + EPS);
        float y = v * rstd * gk[lane];
        if (lat) {
            const int half = lane >> 5, i = lane & 31, j = i & 15; const int pos = half ? pcol : prow;
            const float cs = rope[(pos * 16 + j) * 2], sn = rope[(pos * 16 + j) * 2 + 1];
            const float other = __shfl_xor(y, 16);
            y = (i < 16) ? (y * cs - other * sn) : (y * cs + other * sn);
        }
        KB[(size_t)row * 128 + h * 64 + lane] = (bf16)f2bf(y);
    }
    if (!lat) return;
    for (int cidx = lane; cidx < 512; cidx += 64) QA[(size_t)row * 512 + cidx] = (bf16)f2bf(cf[C_QA + cidx] * QSCALE);
    for (int h = 0; h < 8; ++h) {
        const float v = cf[C_QB + h * 64 + lane];
        const float rstd = rsqrtf(wave_sum(v * v) * (1.0f / 64.0f) + EPS);
        float y = v * rstd * gq[lane];
        const int half = lane >> 5, i = lane & 31, j = i & 15; const int pos = half ? pcol : prow;
        const float cs = rope[(pos * 16 + j) * 2], sn = rope[(pos * 16 + j) * 2 + 1];
        const float other = __shfl_xor(y, 16);
        y = (i < 16) ? (y * cs - other * sn) : (y * cs + other * sn);
        QB[(size_t)row * 512 + h * 64 + lane] = (bf16)f2bf(y * QSCALE);
    }
    for (int cidx = lane; cidx < 1024; cidx += 64) { GA[(size_t)row * 1024 + cidx] = (bf16)f2bf(sigmoidf_(cf[C_GA + cidx])); GB[(size_t)row * 1024 + cidx] = (bf16)f2bf(sigmoidf_(cf[C_GB + cidx])); }
}

template <int MODE  >
__global__ void __launch_bounds__(256) k_attn_naive(const bf16* __restrict__ Q, const bf16* __restrict__ Kx, const bf16* __restrict__ Vx, const float* __restrict__ rpb, bf16* __restrict__ O) {
    const int wave = threadIdx.x >> 6, lane = threadIdx.x & 63;
    const int task = blockIdx.x * 4 + wave;
    const int t = task >> 3, h = task & 7, b = t / SEQ, s = t % SEQ, r = s / GRIDW, cc = s % GRIDW;
    const int kvpitch = MODE == 0 ? 512 : 128, kvh = MODE == 0 ? h : (h >> 2);
    float q[64];
    {
        const u32x4* qp = (const u32x4*)(Q + (size_t)t * 512 + h * 64);
#pragma unroll
        for (int i = 0; i < 8; ++i) { const u32x4 v = qp[i]; q[8 * i] = bflo(v.x); q[8 * i + 1] = bfhi(v.x); q[8 * i + 2] = bflo(v.y); q[8 * i + 3] = bfhi(v.y); q[8 * i + 4] = bflo(v.z); q[8 * i + 5] = bfhi(v.z); q[8 * i + 6] = bflo(v.w); q[8 * i + 7] = bfhi(v.w); }
    }
    float m = -INFINITY, l = 0.f, o[64];
#pragma unroll
    for (int d = 0; d < 64; ++d) o[d] = 0.f;
    const int r0 = min(max(r - 4, 0), 56), c0 = min(max(cc - 8, 0), 48);
    const int nkeys = MODE == 0 ? 384 : (SEQ + CTXL);
    for (int kidx = lane; kidx < nkeys; kidx += 64) {
        int krow; float bias = 0.f;
        if (MODE == 0) {
            if (kidx < 128) { const int ki = kidx >> 4, kj = kidx & 15; krow = b * SEQ + (r0 + ki) * GRIDW + c0 + kj; bias = rpb[(h * 15 + (r0 + ki - r + 7)) * 31 + (c0 + kj - cc + 15)] * LOG2E; }
            else krow = T + b * CTXL + (kidx - 128);
        } else krow = kidx < SEQ ? b * SEQ + kidx : T + b * CTXL + (kidx - SEQ);
        const u32x4* kp = (const u32x4*)(Kx + (size_t)krow * kvpitch + kvh * 64);
        float sc = bias;
#pragma unroll
        for (int i = 0; i < 8; ++i) { const u32x4 v = kp[i];
            sc += q[8 * i] * bflo(v.x) + q[8 * i + 1] * bfhi(v.x) + q[8 * i + 2] * bflo(v.y) + q[8 * i + 3] * bfhi(v.y) + q[8 * i + 4] * bflo(v.z) + q[8 * i + 5] * bfhi(v.z) + q[8 * i + 6] * bflo(v.w) + q[8 * i + 7] * bfhi(v.w); }
        const float mn = fmaxf(m, sc), f = exp2f(m - mn), p = exp2f(sc - mn);
        l = l * f + p; m = mn;
        const u32x4* vp = (const u32x4*)(Vx + (size_t)krow * kvpitch + kvh * 64);
#pragma unroll
        for (int i = 0; i < 8; ++i) { const u32x4 v = vp[i];
            o[8 * i] = o[8 * i] * f + p * bflo(v.x); o[8 * i + 1] = o[8 * i + 1] * f + p * bfhi(v.x); o[8 * i + 2] = o[8 * i + 2] * f + p * bflo(v.y); o[8 * i + 3] = o[8 * i + 3] * f + p * bfhi(v.y);
            o[8 * i + 4] = o[8 * i + 4] * f + p * bflo(v.z); o[8 * i + 5] = o[8 * i + 5] * f + p * bfhi(v.z); o[8 * i + 6] = o[8 * i + 6] * f + p * bflo(v.w); o[8 * i + 7] = o[8 * i + 7] * f + p * bfhi(v.w); }
    }
    const float M = wave_max(m), f = exp2f(m - M);
    const float L = wave_sum(l * f), inv = 1.0f / L;
    float mine = 0.f;
#pragma unroll
    for (int d = 0; d < 64; ++d) { const float v = wave_sum(o[d] * f); if (lane == d) mine = v; }
    O[(size_t)t * 1024 + (MODE == 0 ? 0 : 512) + h * 64 + lane] = (bf16)f2bf(mine * inv);
}

__global__ void k_merge(const float* __restrict__ PA, const float* __restrict__ PB, const bf16* __restrict__ GA, const bf16* __restrict__ GB, bf16* __restrict__ U) {
    const size_t i = (size_t)blockIdx.x * blockDim.x + threadIdx.x;
    if (i < (size_t)T * 1024) U[i] = (bf16)f2bf(bf2f(GA[i]) * PA[i] + bf2f(GB[i]) * PB[i]);
}

constexpr int RP_LDS = 32 * 1024 * 4 + 4096;
DEV void rowpass_block(int blk, const float* __restrict__ x, const bf16* __restrict__ Y, const float* __restrict__ mod, const float* __restrict__ g_post_mix, const float* __restrict__ g_pre_ffn,
                       const float* __restrict__ w_router, const float* __restrict__ b_router, bf16* __restrict__ H2, float* __restrict__ RSTD1, int* __restrict__ TOPE, float* __restrict__ TOPW,
                       unsigned* __restrict__ ecnt, int* __restrict__ LIST, unsigned char* lds, unsigned char* lds_small) {
    float* wr = (float*)lds;
    unsigned* hist = (unsigned*)lds_small;
    unsigned* base = hist + 32;
    unsigned* asg_e = base + 32;
    unsigned* asg_p = asg_e + 256;
    const int tid = threadIdx.x, wave = tid >> 6, lane = tid & 63;
    for (int i = tid; i < 32 * 1024; i += 512) { const int k = i >> 5, e = i & 31; wr[e * 1024 + k] = w_router[i]; }
    if (tid < 32) hist[tid] = 0u;
    __syncthreads();
    const int t0 = blk * 64, b = t0 / SEQ;
    const float* mrow = mod + b * 6144;
    for (int it = 0; it < 8; ++it) {
        const int t = t0 + wave * 8 + it;
        float yv[16], xv[16];
        float ss = 0.f;
#pragma unroll
        for (int j = 0; j < 4; ++j) {
            const u32x2 yw = *(const u32x2*)(Y + (size_t)t * DM + 4 * lane + 256 * j);
            yv[4 * j] = bflo(yw.x); yv[4 * j + 1] = bfhi(yw.x); yv[4 * j + 2] = bflo(yw.y); yv[4 * j + 3] = bfhi(yw.y);
            const f32x4 xx = *(const f32x4*)(x + (size_t)t * DM + 4 * lane + 256 * j);
            xv[4 * j] = xx[0]; xv[4 * j + 1] = xx[1]; xv[4 * j + 2] = xx[2]; xv[4 * j + 3] = xx[3];
#pragma unroll
            for (int q = 0; q < 4; ++q) ss += yv[4 * j + q] * yv[4 * j + q];
        }
        const float rstd1 = rsqrtf(wave_sum(ss) * (1.0f / DM) + EPS);
        if (lane == 0) RSTD1[t] = rstd1;
        float ss2 = 0.f;
#pragma unroll
        for (int j = 0; j < 4; ++j) {
            const int cidx = 4 * lane + 256 * j;
            const f32x4 gt = *(const f32x4*)(mrow + 2048 + cidx), gp = *(const f32x4*)(g_post_mix + cidx);
#pragma unroll
            for (int q = 0; q < 4; ++q) { const float x1 = xv[4 * j + q] + gt[q] * (yv[4 * j + q] * rstd1 * gp[q]); xv[4 * j + q] = x1; ss2 += x1 * x1; }
        }
        const float rstd2 = rsqrtf(wave_sum(ss2) * (1.0f / DM) + EPS);
#pragma unroll
        for (int j = 0; j < 4; ++j) {
            const int cidx = 4 * lane + 256 * j;
            const f32x4 gf = *(const f32x4*)(g_pre_ffn + cidx), sh = *(const f32x4*)(mrow + 3072 + cidx), sc = *(const f32x4*)(mrow + 4096 + cidx);
#pragma unroll
            for (int q = 0; q < 4; ++q) xv[4 * j + q] = xv[4 * j + q] * rstd2 * gf[q] * (1.0f + sc[q]) + sh[q];
            u32x2 w; w.x = pk2(xv[4 * j], xv[4 * j + 1]); w.y = pk2(xv[4 * j + 2], xv[4 * j + 3]);
            *(u32x2*)(H2 + (size_t)t * DM + cidx) = w;
        }
        float pl[32];
#pragma unroll
        for (int e = 0; e < 32; ++e) {
            float a = 0.f;
#pragma unroll
            for (int j = 0; j < 4; ++j) { const f32x4 w = *(const f32x4*)(wr + e * 1024 + 4 * lane + 256 * j); a += xv[4 * j] * w[0] + xv[4 * j + 1] * w[1] + xv[4 * j + 2] * w[2] + xv[4 * j + 3] * w[3]; }
            pl[e] = a;
        }
#define RP_STEP(D, H) _Pragma("unroll") for (int i = 0; i < H; ++i) { const bool up = (lane & D) != 0; const float snd = up ? pl[i] : pl[i + H]; const float kp = up ? pl[i + H] : pl[i]; pl[i] = kp + __shfl_xor(snd, D); }
        RP_STEP(32, 16) RP_STEP(16, 8) RP_STEP(8, 4) RP_STEP(4, 2) RP_STEP(2, 1)
#undef RP_STEP
        float logit = pl[0] + __shfl_xor(pl[0], 1);
        const int e_mine = lane >> 1;
        logit += b_router[e_mine];
        float val = (lane & 1) ? -INFINITY : logit;
        float tl[4]; int te[4];
#pragma unroll
        for (int k = 0; k < 4; ++k) {
            const float mx = wave_max(val);
            const unsigned long long bal = __ballot(val == mx);
            const int wl = __ffsll((long long)bal) - 1;
            tl[k] = mx; te[k] = wl >> 1;
            if (lane == wl) val = -INFINITY;
        }
        const float e1 = __expf(tl[1] - tl[0]), e2 = __expf(tl[2] - tl[0]), e3 = __expf(tl[3] - tl[0]);
        const float inv = 1.0f / (1.0f + e1 + e2 + e3);
        if (lane < 4) {
            const int ek = lane == 0 ? te[0] : lane == 1 ? te[1] : lane == 2 ? te[2] : te[3];
            const float wk = (lane == 0 ? 1.0f : lane == 1 ? e1 : lane == 2 ? e2 : e3) * inv;
            TOPE[t * 4 + lane] = ek; TOPW[t * 4 + lane] = wk;
            const unsigned p = atomicAdd(&hist[ek], 1u);
            const int la = (wave * 8 + it) * 4 + lane;
            asg_e[la] = (unsigned)ek; asg_p[la] = p;
        }
    }
    __syncthreads();
    if (tid < 32) base[tid] = atomicAdd(&ecnt[tid], hist[tid]);
    __syncthreads();
    if (tid < 256) { const unsigned e = asg_e[tid]; LIST[(size_t)e * ECAP + base[e] + asg_p[tid]] = t0 * 4 + tid; }
    __syncthreads();
}
__global__ void __launch_bounds__(512) k_rowpass(const float* x, const bf16* Y, const float* mod, const float* g_post_mix, const float* g_pre_ffn, const float* w_router, const float* b_router,
                                                 bf16* H2, float* RSTD1, int* TOPE, float* TOPW, unsigned* ecnt, int* LIST) {
    extern __shared__ __attribute__((aligned(16))) unsigned char lds[];
    for (int blk = blockIdx.x; blk < T / 64; blk += gridDim.x) rowpass_block(blk, x, Y, mod, g_post_mix, g_pre_ffn, w_router, b_router, H2, RSTD1, TOPE, TOPW, ecnt, LIST, lds, lds + 32 * 1024 * 4);
}

DEV int expert_base(const unsigned* __restrict__ ecnt, int e) { int bse = 0; for (int i = 0; i < e; ++i) bse += ((int)ecnt[i] + 255) & ~255; return bse; }
__global__ void __launch_bounds__(256) k_moe_gu(const bf16* __restrict__ H2, const bf16* __restrict__ WGU, const float* __restrict__ b_gu, const unsigned* __restrict__ ecnt, const int* __restrict__ LIST, bf16* __restrict__ ACT) {
    __shared__ __attribute__((aligned(16))) bf16 sA[64 * 40];
    __shared__ __attribute__((aligned(16))) bf16 sB[2 * 64 * 40];
    const int e = blockIdx.z, cnt = (int)ecnt[e], m0 = blockIdx.y * 64; if (m0 >= cnt) return;
    const int tid = threadIdx.x, lane = tid & 63, w = tid >> 6, wm = w >> 1, wn = w & 1, fr = lane & 15, fq = lane >> 4, sr = tid >> 2, sc = tid & 3;
    const int n0 = blockIdx.x * 64;
    const int mrow = min(m0 + sr, cnt - 1);
    const int tok = LIST[(size_t)e * ECAP + mrow] >> 2;
    const bf16* wb = WGU + (size_t)e * 2048 * 1024;
    f32x4 acc[2][2][2];
    gemm64_core<2>(H2 + (size_t)tok * DM + sc * 8, wb + (size_t)(n0 + sr) * 1024 + sc * 8, wb + (size_t)(1024 + n0 + sr) * 1024 + sc * 8, 1024, sA, sB, acc);
    const int ebase = expert_base(ecnt, e);
#pragma unroll
    for (int i = 0; i < 2; ++i)
#pragma unroll
        for (int j = 0; j < 2; ++j)
#pragma unroll
            for (int r = 0; r < 4; ++r) {
                const int m = m0 + wm * 32 + i * 16 + fq * 4 + r, n = n0 + wn * 32 + j * 16 + fr;
                if (m < cnt) {
                    const float glu = fminf(acc[0][i][j][r] + b_gu[e * 2048 + n], SW_LIMIT);
                    const float lin = fminf(fmaxf(acc[1][i][j][r] + b_gu[e * 2048 + 1024 + n], -SW_LIMIT), SW_LIMIT);
                    const float a = (lin + 1.0f) * (glu * sigmoidf_(SW_ALPHA * glu));
                    ACT[(size_t)(ebase + m) * DFF + n] = (bf16)f2bf(a);
                }
            }
}
__global__ void __launch_bounds__(256) k_moe_dn(const bf16* __restrict__ ACT, const bf16* __restrict__ WDN, const float* __restrict__ b_dn, const unsigned* __restrict__ ecnt, const int* __restrict__ LIST, const float* __restrict__ TOPW, bf16* __restrict__ YS) {
    __shared__ __attribute__((aligned(16))) bf16 sA[64 * 40];
    __shared__ __attribute__((aligned(16))) bf16 sB[64 * 40];
    const int e = blockIdx.z, cnt = (int)ecnt[e], m0 = blockIdx.y * 64; if (m0 >= cnt) return;
    const int tid = threadIdx.x, lane = tid & 63, w = tid >> 6, wm = w >> 1, wn = w & 1, fr = lane & 15, fq = lane >> 4, sr = tid >> 2, sc = tid & 3;
    const int n0 = blockIdx.x * 64;
    const int ebase = expert_base(ecnt, e);
    const int mrow = min(m0 + sr, cnt - 1);
    f32x4 acc[1][2][2];
    gemm64_core<1>(ACT + (size_t)(ebase + mrow) * DFF + sc * 8, WDN + (size_t)e * 1024 * 1024 + (size_t)(n0 + sr) * 1024 + sc * 8, nullptr, 1024, sA, sB, acc);
#pragma unroll
    for (int i = 0; i < 2; ++i)
#pragma unroll
        for (int j = 0; j < 2; ++j)
#pragma unroll
            for (int r = 0; r < 4; ++r) {
                const int m = m0 + wm * 32 + i * 16 + fq * 4 + r, n = n0 + wn * 32 + j * 16 + fr;
                if (m < cnt) { const int a = LIST[(size_t)e * ECAP + m]; YS[(size_t)a * DM + n] = (bf16)f2bf(TOPW[a] * (acc[0][i][j][r] + b_dn[e * 1024 + n])); }
            }
}

DEV void final_row(int t, const float* __restrict__ x, const bf16* __restrict__ Y, const float* __restrict__ RSTD1, const bf16* __restrict__ YS, const float* __restrict__ mod,
                   const float* __restrict__ g_post_mix, const float* __restrict__ g_post_ffn, float* __restrict__ out, int lane) {
    const float* mrow = mod + (t / SEQ) * 6144;
    const float rstd1 = RSTD1[t];
    float f[16]; float ss = 0.f;
#pragma unroll
    for (int j = 0; j < 4; ++j) {
        float a0 = 0.f, a1 = 0.f, a2 = 0.f, a3 = 0.f;
#pragma unroll
        for (int k = 0; k < 4; ++k) { const u32x2 w = *(const u32x2*)(YS + (size_t)(t * 4 + k) * DM + 4 * lane + 256 * j); a0 += bflo(w.x); a1 += bfhi(w.x); a2 += bflo(w.y); a3 += bfhi(w.y); }
        f[4 * j] = a0; f[4 * j + 1] = a1; f[4 * j + 2] = a2; f[4 * j + 3] = a3;
        ss += a0 * a0 + a1 * a1 + a2 * a2 + a3 * a3;
    }
    const float rstdf = rsqrtf(wave_sum(ss) * (1.0f / DM) + EPS);
#pragma unroll
    for (int j = 0; j < 4; ++j) {
        const int cidx = 4 * lane + 256 * j;
        const f32x4 xx = *(const f32x4*)(x + (size_t)t * DM + cidx);
        const u32x2 yw = *(const u32x2*)(Y + (size_t)t * DM + cidx);
        const f32x4 gt1 = *(const f32x4*)(mrow + 2048 + cidx), gt2 = *(const f32x4*)(mrow + 5120 + cidx), gp = *(const f32x4*)(g_post_mix + cidx), gf = *(const f32x4*)(g_post_ffn + cidx);
        const float yv[4] = {bflo(yw.x), bfhi(yw.x), bflo(yw.y), bfhi(yw.y)};
        f32x4 o;
#pragma unroll
        for (int q = 0; q < 4; ++q) o[q] = xx[q] + gt1[q] * (yv[q] * rstd1 * gp[q]) + gt2[q] * (f[4 * j + q] * rstdf * gf[q]);
        *(f32x4*)(out + (size_t)t * DM + cidx) = o;
    }
}
__global__ void __launch_bounds__(512) k_final(const float* x, const bf16* Y, const float* RSTD1, const bf16* YS, const float* mod, const float* g_post_mix, const float* g_post_ffn, float* out) {
    const int wave = threadIdx.x >> 6, lane = threadIdx.x & 63;
    for (int t = blockIdx.x * 8 + wave; t < T; t += gridDim.x * 8) final_row(t, x, Y, RSTD1, YS, mod, g_post_mix, g_post_ffn, out, lane);
}

#define LAS __attribute__((address_space(3)))
#define GAS __attribute__((address_space(1)))
typedef GAS unsigned gu32;
#define RLX_AGENT __ATOMIC_RELAXED, __HIP_MEMORY_SCOPE_AGENT
constexpr int NWAVES = 8;
constexpr int RING_OFF = 0, RING_BYTES = 131072;
constexpr int ROPE_OFF = 131072;
constexpr int MISC_OFF = 139264;
constexpr int NAX_OFF = 143360;
constexpr int LDS_BYTES = 163840;
constexpr int CW_TMO = 0, CW_CODE = 1, CW_BAR = 4096;

#define XB_TMO      128
#define XB_XCNT(j)  (256  + 64 * (j))
#define XB_XSUB(j)  (1280 + 64 * (j))
#define XB_XGEN(j)  (2304 + 64 * (j))
#define XB_TOP      3328
#define XB_TOPGEN   3392
#define XCD_BAR_WORDS 3456
#define XB_SPIN_CAP (1u << 18)
__device__ __forceinline__ unsigned xb_ld(unsigned* p)              { return __hip_atomic_load(p, __ATOMIC_RELAXED, __HIP_MEMORY_SCOPE_AGENT); }
__device__ __forceinline__ unsigned xb_add(unsigned* p, unsigned v) { return __hip_atomic_fetch_add(p, v, __ATOMIC_RELAXED, __HIP_MEMORY_SCOPE_AGENT); }
__device__ __forceinline__ unsigned xb_xcc_id() { return (unsigned)__builtin_amdgcn_s_getreg((3 << 11) | 20) & 0xFu; }
#define XB_SPIN(cond, bar) do { unsigned _sp = 0; while (cond) { __builtin_amdgcn_s_sleep(1); \
    if ((++_sp & 255u) == 0u) { if (xb_ld(&(bar)[XB_TMO])) break; if (_sp > XB_SPIN_CAP) { atomicAdd(&(bar)[XB_TMO], 1u); break; } } } } while (0)
struct XcdBarrier { unsigned* bar; unsigned x; volatile LAS unsigned* st; };
__device__ __forceinline__ XcdBarrier xcd_barrier_post(unsigned* bar, volatile LAS unsigned* st) {
    XcdBarrier b; b.bar = bar; b.x = xb_xcc_id(); b.st = st;
    if (threadIdx.x == 0) (void)xb_add(&bar[XB_XCNT(b.x)], 1u);
    return b;
}
__device__ __forceinline__ void xcd_barrier_complete(unsigned* bar, unsigned x, unsigned& nloc, unsigned& nx) {
    const unsigned G = gridDim.x * gridDim.y * gridDim.z;
    unsigned sum, cnt, mine, sp = 0u;
    for (;;) {
        sum = 0u; cnt = 0u; mine = 0u;
#pragma unroll
        for (unsigned j = 0; j < 16; ++j) { const unsigned c = xb_ld(&bar[XB_XCNT(j)]); sum += c; cnt += (c > 0u) ? 1u : 0u; mine = (j == x) ? c : mine; }
        if (sum == G) break;
        __builtin_amdgcn_s_sleep(1);
        if ((++sp & 255u) == 0u) { if (xb_ld(&bar[XB_TMO])) break; if (sp > XB_SPIN_CAP) { atomicAdd(&bar[XB_TMO], 1u); break; } }
    }
    nloc = mine > 0u ? mine : 1u; nx = cnt > 0u ? cnt : 1u;
}
__device__ __forceinline__ void xcd_barrier(const XcdBarrier& b) {
    asm volatile("s_waitcnt vmcnt(0)" ::: "memory");
    __syncthreads();
    if (threadIdx.x == 0) {
        unsigned* bar = b.bar;
        __builtin_amdgcn_s_waitcnt(0);
        unsigned nloc = b.st[0], nx = b.st[1];
        if (nloc == 0u) { xcd_barrier_complete(bar, b.x, nloc, nx); b.st[0] = nloc; b.st[1] = nx; }
        const unsigned old = xb_add(&bar[XB_XSUB(b.x)], 1u);
        const unsigned gen = old / nloc;
        if (old + 1u == (gen + 1u) * nloc) {
            __builtin_amdgcn_fence(__ATOMIC_RELEASE, "agent");
            asm volatile("s_waitcnt vmcnt(0)" ::: "memory");
            const unsigned og = xb_add(&bar[XB_TOP], 1u);
            const unsigned tg = og / nx;
            if (og + 1u == (tg + 1u) * nx) xb_add(&bar[XB_TOPGEN], 1u);
            else XB_SPIN(xb_ld(&bar[XB_TOPGEN]) == tg, bar);
            __builtin_amdgcn_fence(__ATOMIC_ACQUIRE, "agent");
            xb_add(&bar[XB_XGEN(b.x)], 1u);
            asm volatile("s_waitcnt vmcnt(0)" ::: "memory");
        } else {
            XB_SPIN(xb_ld(&bar[XB_XGEN(b.x)]) == gen, bar);
            __builtin_amdgcn_fence(__ATOMIC_ACQUIRE, "agent");
            asm volatile("s_waitcnt vmcnt(0)" ::: "memory");
        }
    }
    __syncthreads();
}

namespace pg8 {
#define PG8_LAS __attribute__((address_space(3)))
constexpr int BM = 256, BK = 64, HALF = 128, HTB = HALF * BK * 2, STAGE_BYTES = 8 * HTB;
constexpr int KDIM = 1024, NT = KDIM / BK, PITCH = KDIM * 2;
__host__ __device__ __forceinline__ int lds_byte(int r, int c) { const int st = (r >> 4) * 2 + (c >> 5), rr = r & 15, cc = c & 31, ob = rr * 64 + cc * 2; return st * 1024 + (ob ^ (((ob >> 9) & 1) << 5)); }
__host__ __device__ __forceinline__ void stage_rc(int b, int& R, int& C) { const int st = b / 1024, sb = b % 1024, swz = sb ^ (((sb >> 9) & 1) << 5); R = (st >> 1) * 16 + swz / 64; C = (st & 1) * 32 + (swz % 64) / 2; }

struct GU {
    unsigned a;
    unsigned b;
    unsigned rows;
    int pm, pn, e, cnt;
};
template <int BMAP> __device__ __forceinline__ int bmap_row(int R) { return BMAP == 0 ? R : BMAP == 1 ? (64 * (R >> 5) + (R & 31)) : (16 * (R >> 5) + (R & 15) + 1024 * ((R >> 4) & 1)); }
template <int BMAP> __device__ __forceinline__ size_t bmap_hstep() { return (size_t)(BMAP == 0 ? 128 : BMAP == 1 ? 32 : 64) * PITCH; }

template <class Epi, class Sched, bool GATHER, int BMAP>
__device__ __forceinline__ void gemm_phase(PG8_LAS unsigned char* lds, const Sched& S, const Epi& E) {
    const int tid = threadIdx.x, wid = __builtin_amdgcn_readfirstlane(tid >> 6), lane = tid & 63, wr = wid >> 2, wc = wid & 3, fr = lane & 15, fq = lane >> 4;
    constexpr int nt = NT;
    int Rr[2], Cc[2]; unsigned voffB[2];
#pragma unroll
    for (int i = 0; i < 2; ++i) { stage_rc(tid * 16 + i * 8192, Rr[i], Cc[i]); voffB[i] = (unsigned)(bmap_row<BMAP>(Rr[i]) * KDIM + Cc[i]) * 2u; }
    const size_t kstep = (size_t)(BK * 2);
    const size_t hstepB = bmap_hstep<BMAP>();
    const unsigned ldsw = (unsigned)wid * 1024u;
    const int aoff = lds_byte(wr * 64 + fr, fq * 8), boff = lds_byte(wc * 32 + fr, fq * 8);
#define PG8_SA(b, h) (((b) * 2 + (h)) * HTB)
#define PG8_SB(b, h) ((4 + (b) * 2 + (h)) * HTB)
#define PG8_STAGE(bufoff, gbase, voff) do { _Pragma("unroll") for (int _i = 0; _i < 2; ++_i) \
        __builtin_amdgcn_global_load_lds((const unsigned*)((const char*)(gbase) + (voff)[_i]), (PG8_LAS unsigned*)(lds + (bufoff) + ldsw + _i * 8192), 16, 0, 0); } while (0)
#define PG8_LDA(dst, b, h) do { _Pragma("unroll") for (int m = 0; m < 4; ++m) _Pragma("unroll") for (int k = 0; k < 2; ++k) dst[m][k] = *(const PG8_LAS bf16x8*)(lds + PG8_SA(b, h) + aoff + m * 2048 + k * 1024); } while (0)
#define PG8_LDB(dst, b, h) do { _Pragma("unroll") for (int n = 0; n < 2; ++n) _Pragma("unroll") for (int k = 0; k < 2; ++k) dst[n][k] = *(const PG8_LAS bf16x8*)(lds + PG8_SB(b, h) + boff + n * 2048 + k * 1024); } while (0)
#define PG8_MMA(ai, bj, At, Bt) do { __builtin_amdgcn_s_setprio(1); _Pragma("unroll") for (int m = 0; m < 4; ++m) _Pragma("unroll") for (int n = 0; n < 2; ++n) _Pragma("unroll") for (int k = 0; k < 2; ++k) \
        acc[ai][bj][m][n] = __builtin_amdgcn_mfma_f32_16x16x32_bf16(Bt[n][k], At[m][k], acc[ai][bj][m][n], 0, 0, 0); __builtin_amdgcn_s_setprio(0); } while (0)
#define PG8_WAIT_V(n) asm volatile("s_waitcnt vmcnt(" #n ")" ::: "memory")
#define PG8_WAIT_L(n) asm volatile("s_waitcnt lgkmcnt(" #n ")" ::: "memory")
#define PG8_BAR __builtin_amdgcn_s_barrier()
#define PG8_SCHED __builtin_amdgcn_sched_barrier(0)
#define PG8_AOFFS(dst, u) do { _Pragma("unroll") for (int _h = 0; _h < 2; ++_h) _Pragma("unroll") for (int _i = 0; _i < 2; ++_i) { \
        int _row = 128 * _h + Rr[_i]; if (GATHER) { const int _rr = _row < (u).cnt ? _row : 0; _row = S.rowlist[(u).rows + _rr] >> 2; } \
        dst[_h][_i] = (unsigned)(_row * KDIM + Cc[_i]) * 2u; } } while (0)
    GU cur, nxt; int ui = 0;
    if (!S.next(0, cur)) return;
    f32x4 acc[2][2][4][2];
#pragma unroll
    for (int a = 0; a < 2; ++a)
#pragma unroll
        for (int b = 0; b < 2; ++b)
#pragma unroll
            for (int m = 0; m < 4; ++m)
#pragma unroll
                for (int n = 0; n < 2; ++n) acc[a][b][m][n] = (f32x4){0.f, 0.f, 0.f, 0.f};
    bf16x8 At[4][2], B0[2][2], B1[2][2];
    unsigned voA[2][2], nvoA[2][2];
    if constexpr (GATHER) { PG8_AOFFS(voA, cur); } else {
#pragma unroll
        for (int h = 0; h < 2; ++h)
#pragma unroll
            for (int i = 0; i < 2; ++i) { voA[h][i] = (unsigned)((128 * h + Rr[i]) * KDIM + Cc[i]) * 2u; nvoA[h][i] = voA[h][i]; } }
    const char* cA = S.Abase + cur.a; const char* cB = S.Bbase + cur.b;
    PG8_STAGE(PG8_SB(0, 0), cB, voffB); PG8_STAGE(PG8_SB(0, 1), cB + hstepB, voffB); PG8_STAGE(PG8_SA(0, 0), cA, voA[0]); PG8_STAGE(PG8_SA(0, 1), cA, voA[1]);
    if (wr == 1) PG8_BAR;
    PG8_WAIT_V(2); PG8_BAR;
    PG8_STAGE(PG8_SB(1, 0), cB + kstep, voffB); PG8_STAGE(PG8_SA(1, 0), cA + kstep, voA[0]); PG8_STAGE(PG8_SB(1, 1), cB + hstepB + kstep, voffB);
    PG8_WAIT_V(6); PG8_BAR;
    for (;;) {
        const bool has_next = S.next(ui + 1, nxt);
        const char* nA = has_next ? S.Abase + nxt.a : cA; const char* nB = has_next ? S.Bbase + nxt.b : cB;
        if constexpr (GATHER) { if (has_next) { PG8_AOFFS(nvoA, nxt); } else {
#pragma unroll
            for (int h = 0; h < 2; ++h)
#pragma unroll
                for (int i = 0; i < 2; ++i) nvoA[h][i] = voA[h][i]; } }
        for (int t = 0; t < nt; t += 2) {
            const bool last = (t == nt - 2);
            const char* a1 = cA + (size_t)(t + 1) * kstep;
            const char* a2 = last ? nA : cA + (size_t)(t + 2) * kstep; const char* b2 = last ? nB : cB + (size_t)(t + 2) * kstep;
            const char* a3 = a2 + kstep; const char* b3 = b2 + kstep;
            unsigned vo2[2][2];
#pragma unroll
            for (int h = 0; h < 2; ++h)
#pragma unroll
                for (int i = 0; i < 2; ++i) vo2[h][i] = GATHER ? (last ? nvoA[h][i] : voA[h][i]) : voA[h][i];
            if constexpr (Epi::HAS_MID) { if (t == nt / 2) E.mid(acc, cur, wr, wc, fr, fq); }
            PG8_LDB(B0, 0, 0); PG8_LDB(B1, 0, 1); PG8_SCHED; PG8_LDA(At, 0, 0); PG8_STAGE(PG8_SA(1, 1), a1, voA[1]);
            PG8_WAIT_V(8); PG8_WAIT_L(0); PG8_BAR; PG8_MMA(0, 0, At, B0); PG8_MMA(0, 1, At, B1); PG8_BAR; PG8_SCHED;
            PG8_LDA(At, 0, 1); PG8_STAGE(PG8_SB(0, 0), b2, voffB); PG8_STAGE(PG8_SB(0, 1), b2 + hstepB, voffB); PG8_STAGE(PG8_SA(0, 0), a2, vo2[0]);
            PG8_WAIT_V(8); PG8_WAIT_L(0); PG8_BAR; PG8_MMA(1, 0, At, B0); PG8_MMA(1, 1, At, B1); PG8_BAR; PG8_SCHED;
            PG8_LDB(B0, 1, 0); PG8_LDB(B1, 1, 1); PG8_SCHED; PG8_LDA(At, 1, 0); PG8_STAGE(PG8_SA(0, 1), a2, vo2[1]);
            PG8_WAIT_V(8); PG8_WAIT_L(0); PG8_BAR; PG8_MMA(0, 0, At, B0); PG8_MMA(0, 1, At, B1); PG8_BAR; PG8_SCHED;
            PG8_LDA(At, 1, 1); PG8_STAGE(PG8_SB(1, 0), b3, voffB); PG8_STAGE(PG8_SB(1, 1), b3 + hstepB, voffB); PG8_STAGE(PG8_SA(1, 0), a3, vo2[0]);
            PG8_WAIT_V(8); PG8_WAIT_L(0); PG8_BAR; PG8_MMA(1, 0, At, B0); PG8_MMA(1, 1, At, B1); PG8_BAR; PG8_SCHED;
        }
        if (wr == 0) PG8_BAR;
        E(acc, cur, wr, wc, fr, fq);
        if (!has_next) break;
#pragma unroll
        for (int a = 0; a < 2; ++a)
#pragma unroll
            for (int b = 0; b < 2; ++b)
#pragma unroll
                for (int m = 0; m < 4; ++m)
#pragma unroll
                    for (int n = 0; n < 2; ++n) acc[a][b][m][n] = (f32x4){0.f, 0.f, 0.f, 0.f};
        cur = nxt; cA = nA; cB = nB; ++ui;
        if constexpr (GATHER) {
#pragma unroll
        for (int h = 0; h < 2; ++h)
#pragma unroll
            for (int i = 0; i < 2; ++i) voA[h][i] = nvoA[h][i]; }
        if (wr == 1) PG8_BAR;
    }
    PG8_WAIT_V(0);
    PG8_BAR;
#undef PG8_SA
#undef PG8_SB
#undef PG8_STAGE
#undef PG8_LDA
#undef PG8_LDB
#undef PG8_MMA
#undef PG8_WAIT_V
#undef PG8_WAIT_L
#undef PG8_BAR
#undef PG8_SCHED
#undef PG8_AOFFS
}
}

namespace attn_body {
using bf16x8=__attribute__((ext_vector_type(8)))short;
using s16x4=__attribute__((ext_vector_type(4)))short;
using f32x16=__attribute__((ext_vector_type(16)))float;
using u32x4=__attribute__((ext_vector_type(4)))unsigned;
constexpr int D=64;
constexpr int NW=8,QBLK=32,QB=QBLK*NW,KVBLK=64;
__device__ __forceinline__ int crow(int r,int hi){return (r&3)+8*(r>>2)+4*hi;}
#define SBAR() __builtin_amdgcn_sched_barrier(0)
constexpr int NSLOT=3, SLOTB=8192;
constexpr int LDS_K=0, LDS_V=NSLOT*SLOTB, LDS_WS=2*NSLOT*SLOTB, LDS_OST=LDS_WS+NW*64*4, LDS_BYTES=LDS_OST+NW*4096;
__device__ __forceinline__ void glds16(const void*gsrc,unsigned lds_dst){unsigned keep;
  asm volatile("s_mov_b32 %0, m0\n\ts_mov_b32 m0, %2\n\ts_nop 0\n\tglobal_load_lds_dwordx4 %1, off\n\ts_mov_b32 m0, %0":"=&s"(keep):"v"(gsrc),"s"(lds_dst):"memory");}
__device__ __forceinline__ float max3f(float a,float b,float c){float r;asm("v_max3_f32 %0, %1, %2, %3":"=v"(r):"v"(a),"v"(b),"v"(c));return r;}
__device__ __forceinline__ float max2f(float a,float b){float r;asm("v_max_f32_e32 %0, %1, %2":"=v"(r):"v"(a),"v"(b));return r;}
__device__ __forceinline__ float fadd_s(float a,float b){float r;asm("v_add_f32_e32 %0, %1, %2":"=v"(r):"v"(a),"v"(b));return r;}
__device__ __forceinline__ float fsub_s(float a,float b){float r;asm("v_sub_f32_e32 %0, %1, %2":"=v"(r):"v"(a),"v"(b));return r;}
typedef float f32x2_t __attribute__((ext_vector_type(2))); typedef __bf16 bf16x2_t __attribute__((ext_vector_type(2)));
__device__ __forceinline__ unsigned cvtpk_s(float lo,float hi){f32x2_t v={lo,hi};bf16x2_t b=__builtin_convertvector(v,bf16x2_t);return __builtin_bit_cast(unsigned,b);}
#define WAIT_BAR(N) asm volatile("s_waitcnt vmcnt(" #N ") lgkmcnt(0)\n\ts_barrier":::"memory")
__device__ __forceinline__ void qkt(f32x16&p0,f32x16&p1,const char*Kslot,const bf16x8*qr,const f32x16&negm,int r32,int hi){
  const char*kb=Kslot+hi*1024+r32*16;
  #pragma unroll
  for(int d0=0;d0<4;++d0){
    const bf16x8 b0=*reinterpret_cast<const bf16x8*>(kb+d0*2048);
    const bf16x8 b1=*reinterpret_cast<const bf16x8*>(kb+d0*2048+512);
    if(d0==0){p0=__builtin_amdgcn_mfma_f32_32x32x16_bf16(b0,qr[0],negm,0,0,0);p1=__builtin_amdgcn_mfma_f32_32x32x16_bf16(b1,qr[0],negm,0,0,0);}
    else{p0=__builtin_amdgcn_mfma_f32_32x32x16_bf16(b0,qr[d0],p0,0,0,0);p1=__builtin_amdgcn_mfma_f32_32x32x16_bf16(b1,qr[d0],p1,0,0,0);}}
}
typedef __attribute__((address_space(3))) const char* lds_cptr;
typedef short v4i16_t __attribute__((ext_vector_type(4)));
__device__ __forceinline__ void kload8(bf16x8*kf,lds_cptr kp){
  kf[0]=*(const __attribute__((address_space(3))) bf16x8*)(kp);      kf[1]=*(const __attribute__((address_space(3))) bf16x8*)(kp+512);
  kf[2]=*(const __attribute__((address_space(3))) bf16x8*)(kp+2048); kf[3]=*(const __attribute__((address_space(3))) bf16x8*)(kp+2560);
  kf[4]=*(const __attribute__((address_space(3))) bf16x8*)(kp+4096); kf[5]=*(const __attribute__((address_space(3))) bf16x8*)(kp+4608);
  kf[6]=*(const __attribute__((address_space(3))) bf16x8*)(kp+6144); kf[7]=*(const __attribute__((address_space(3))) bf16x8*)(kp+6656);
}
__device__ __forceinline__ void kload2(bf16x8*kf,lds_cptr kp,int j){ kf[2*j]=*(const __attribute__((address_space(3))) bf16x8*)(kp+j*2048); kf[2*j+1]=*(const __attribute__((address_space(3))) bf16x8*)(kp+j*2048+512); }
__device__ __forceinline__ s16x4 vtr(lds_cptr p){ return __builtin_bit_cast(s16x4,__builtin_amdgcn_ds_read_tr16_b64_v4i16((__attribute__((address_space(3))) v4i16_t*)p)); }
__device__ __forceinline__ float rowmax(const f32x16&p0,const f32x16&p1){
  float a=max3f(p0[0],p0[1],p1[0]),b=max3f(p0[2],p0[3],p1[1]);a=max3f(a,p1[2],p1[3]);
  #pragma unroll
  for(int r=4;r<16;r+=4){a=max3f(a,p0[r],p0[r+1]);b=max3f(b,p0[r+2],p0[r+3]);a=max3f(a,p1[r],p1[r+1]);b=max3f(b,p1[r+2],p1[r+3]);}
  const float m=max2f(a,b);
  auto rr=__builtin_amdgcn_permlane32_swap(__float_as_uint(m),__float_as_uint(m),false,false);
  return max2f(__uint_as_float(rr[0]),__uint_as_float(rr[1]));
}
__device__ __forceinline__ void pv(f32x16*o,int vb,bf16x8 pa0,bf16x8 pa1,bf16x8 pa2,bf16x8 pa3){
  #pragma unroll
  for(int d0=0;d0<2;++d0){s16x4 lo[4],hi[4];
    #pragma unroll
    for(int ks=0;ks<4;++ks){
      asm volatile("ds_read_b64_tr_b16 %0,%1 offset:%c2":"=&v"(lo[ks]):"v"(vb),"i"(d0*4096+ks*1024):"memory");
      asm volatile("ds_read_b64_tr_b16 %0,%1 offset:%c2":"=&v"(hi[ks]):"v"(vb),"i"(d0*4096+ks*1024+512):"memory");}
    asm volatile("s_waitcnt lgkmcnt(0)":::"memory");SBAR();
    #define PK(k) (bf16x8){lo[k][0],lo[k][1],lo[k][2],lo[k][3],hi[k][0],hi[k][1],hi[k][2],hi[k][3]}
    o[d0]=__builtin_amdgcn_mfma_f32_32x32x16_bf16(pa0,PK(0),o[d0],0,0,0);
    o[d0]=__builtin_amdgcn_mfma_f32_32x32x16_bf16(pa1,PK(1),o[d0],0,0,0);
    o[d0]=__builtin_amdgcn_mfma_f32_32x32x16_bf16(pa2,PK(2),o[d0],0,0,0);
    o[d0]=__builtin_amdgcn_mfma_f32_32x32x16_bf16(pa3,PK(3),o[d0],0,0,0);
    #undef PK
  }
}
#define ATTN_STORE16(p,v) (*(u32x4*)(p)=(v))
constexpr int QP=512, KVP=128, OP=1024;
template<int THRL> __device__ __forceinline__ void gqa_unit(int b,int h,int qb,const bf16*Q,const bf16*__restrict__ K,const bf16*__restrict__ V,bf16*O,char*shm){
  const int tid=threadIdx.x,lane=tid&63,r32=lane&31,hi=lane>>5; const int wid=__builtin_amdgcn_readfirstlane(tid>>6);
  const int q0=qb*QB; const int kvh=h>>2;
  const bf16*Qw=Q+((long)b*SEQ+q0+wid*QBLK)*QP+h*D;
  const unsigned lds0=(unsigned)(uintptr_t)shm;
  float*wsf=(float*)(shm+LDS_WS)+wid*64;
  #define TROW(t) ((t)<64?(long)b*SEQ+(long)(t)*64:(long)T+(long)b*CTXL+(long)((t)-64)*64)
  const bf16*ksrc=K+(long)lane*KVP+kvh*D+wid*8;
  const bf16*vsrc=V+(long)(16*(wid&3)+(lane>>2))*KVP+kvh*D+(wid>>2)*32+(lane&3)*8;
  const unsigned kdst=lds0+LDS_K+wid*1024, vdst=lds0+LDS_V+wid*1024;
  #define DMA_K(t,slot) glds16(ksrc+TROW(t)*KVP,(unsigned)__builtin_amdgcn_readfirstlane(kdst+(slot)))
  #define DMA_V(t,slot) glds16(vsrc+TROW(t)*KVP,(unsigned)__builtin_amdgcn_readfirstlane(vdst+(slot)))
  const int vb0=(int)(lds0+LDS_V)+((lane>>4)&1)*32+(lane&3)*8+(4*hi+((lane&15)>>2))*64;
  const char*Kbase=shm+LDS_K; bf16x8 kf[8];
  const lds_cptr shm3=(lds_cptr)shm; const lds_cptr kp0=shm3+LDS_K+hi*1024+r32*16; const lds_cptr vp0=shm3+LDS_V+((lane>>4)&1)*32+(lane&3)*8+(4*hi+((lane&15)>>2))*64;
  constexpr int NT=(SEQ+CTXL)/KVBLK;
  DMA_K(0,0);DMA_V(0,0);DMA_K(1,SLOTB);
  bf16x8 qr[4];
  #pragma unroll
  for(int d0=0;d0<4;++d0)qr[d0]=*reinterpret_cast<const bf16x8*>(&Qw[(long)r32*QP+d0*16+hi*8]);
  float mhat=0.f,l_reg=0.f;f32x16 o[2];o[0]=f32x16{};o[1]=f32x16{};f32x16 negm=f32x16{};asm volatile("":"+v"(negm));
  bool resc=false;
  #define START(P0,P1) do{ const float rm=rowmax(P0,P1); resc=false; \
    { const float dl=rm; mhat=fadd_s(mhat,dl); \
      _Pragma("unroll") for(int r=0;r<16;++r){P0[r]=fsub_s(P0[r],dl);P1[r]=fsub_s(P1[r],dl);} \
      _Pragma("unroll") for(int r=0;r<16;++r)negm[r]=-mhat; asm volatile("":"+v"(negm)); } \
    _Pragma("unroll") for(int r=0;r<16;++r)P0[r]=__builtin_amdgcn_exp2f(P0[r]); }while(0)
  #define RESC() do{ if(resc){ asm volatile("s_waitcnt lgkmcnt(0)":::"memory"); \
      _Pragma("unroll") for(int d_=0;d_<2;++d_) _Pragma("unroll") for(int r=0;r<16;++r)o[d_][r]*=wsf[crow(r,hi)]; } }while(0)
  f32x16 pA0,pA1,pB0,pB1;
  int sl_prev=0,sl_cur=0,sl_next=SLOTB;
  #define ROT() do{sl_prev=sl_cur;sl_cur=sl_next;sl_next=(sl_next==(NSLOT-1)*SLOTB)?0:sl_next+SLOTB;}while(0)
  DMA_K(2,2*SLOTB);
  WAIT_BAR(3);
  qkt(pA0,pA1,Kbase,qr,negm,r32,hi);asm volatile("s_nop 15\n\ts_nop 7":"+v"(pA0),"+v"(pA1));
  START(pA0,pA1);
  _Pragma("unroll") for(int r=0;r<16;++r)pA1[r]=__builtin_amdgcn_exp2f(pA1[r]);
  WAIT_BAR(0);
  DMA_K(3,0);DMA_V(1,SLOTB);
  ROT();
  kload8(kf,kp0+sl_cur);
  WAIT_BAR(2);
  s16x4 vlo[8],vhi[8]; u32x4 pw0,pw1,pw2,pw3;
  #define PKW(P,B) cvtpk_s(P[B],P[B+1])
  #define PAF(k) __builtin_bit_cast(bf16x8,pw##k)
  #define VFR(i) (bf16x8){vlo[i][0],vlo[i][1],vlo[i][2],vlo[i][3],vhi[i][0],vhi[i][1],vhi[i][2],vhi[i][3]}
  #define PIN(x) asm volatile("":"+v"(x))
  #define MX3(a,b,c) __builtin_fmaxf(__builtin_fmaxf((a),(b)),(c))
  #define GAPA(MF,A0,A1,A2,A3,W0,W1,PW) do{ MF; sacc+=A0; sacc+=A1; sacc+=A2; sacc+=A3; PIN(sacc); W0; W1; PIN(PW); SBAR(); }while(0)
  #define EX(v) __builtin_amdgcn_exp2f(v)
  #define GAPB(MF,X,B) do{ MF; X[B]=EX(X[B]); X[B+1]=EX(X[B+1]); X[B+2]=EX(X[B+2]); X[B+3]=EX(X[B+3]); PIN(X); SBAR(); }while(0)
  #define VRD(i) do{ vlo[i]=vtr(vp_+(((i)>>2)*4096+((i)&3)*1024)); vhi[i]=vtr(vp_+(((i)>>2)*4096+((i)&3)*1024+512)); }while(0)
  #define KRD(G,j) do{ if(G){ kload2(kf,kp0+sl_next,j); SBAR(); } }while(0)
  #define STEP(C0,C1,P0,P1,t,GK,GV,GL) do{ SBAR(); \
    const lds_cptr vp_=vp0+sl_prev; \
    VRD(0); SBAR(); float sacc=(P0[0]+P0[1]); \
    GAPA(C0=__builtin_amdgcn_mfma_f32_32x32x16_bf16(kf[0],qr[0],negm,0,0,0), P0[2],P0[3],P0[4],P0[5],     pw0[0]=PKW(P0,0), pw0[1]=PKW(P0,2), pw0); \
    VRD(4); SBAR(); GAPA(C1=__builtin_amdgcn_mfma_f32_32x32x16_bf16(kf[1],qr[0],negm,0,0,0), P0[6],P0[7],P0[8],P0[9],     pw0[2]=PKW(P0,4), pw0[3]=PKW(P0,6), pw0); \
    VRD(1); SBAR(); GAPA(C0=__builtin_amdgcn_mfma_f32_32x32x16_bf16(kf[2],qr[1],C0,0,0,0),   P0[10],P0[11],P0[12],P0[13], pw1[0]=PKW(P0,8), pw1[1]=PKW(P0,10), pw1); \
    VRD(5); SBAR(); GAPA(C1=__builtin_amdgcn_mfma_f32_32x32x16_bf16(kf[3],qr[1],C1,0,0,0),   P0[14],P0[15],P1[0],P1[1],   pw1[2]=PKW(P0,12),pw1[3]=PKW(P0,14), pw1); \
    VRD(2); SBAR(); GAPA(C0=__builtin_amdgcn_mfma_f32_32x32x16_bf16(kf[4],qr[2],C0,0,0,0),   P1[2],P1[3],P1[4],P1[5],     pw2[0]=PKW(P1,0), pw2[1]=PKW(P1,2), pw2); \
    VRD(6); SBAR(); GAPA(C1=__builtin_amdgcn_mfma_f32_32x32x16_bf16(kf[5],qr[2],C1,0,0,0),   P1[6],P1[7],P1[8],P1[9],     pw2[2]=PKW(P1,4), pw2[3]=PKW(P1,6), pw2); \
    VRD(3); SBAR(); GAPA(C0=__builtin_amdgcn_mfma_f32_32x32x16_bf16(kf[6],qr[3],C0,0,0,0),   P1[10],P1[11],P1[12],P1[13], pw3[0]=PKW(P1,8), pw3[1]=PKW(P1,10), pw3); \
    VRD(7); SBAR(); GAPA(C1=__builtin_amdgcn_mfma_f32_32x32x16_bf16(kf[7],qr[3],C1,0,0,0),   P1[14],P1[15],0.f,0.f,       pw3[2]=PKW(P1,12),pw3[3]=PKW(P1,14), pw3); \
    l_reg+=sacc; \
    if(GK){DMA_K((t)+3,sl_cur);} if(GV){DMA_V((t)+1,sl_next);} \
    { float a=MX3(C0[0],C0[1],C1[0]),b=MX3(C0[2],C0[3],C1[1]); a=MX3(a,C1[2],C1[3]); \
      _Pragma("unroll") for(int r=4;r<16;r+=4){a=MX3(a,C0[r],C0[r+1]);b=MX3(b,C0[r+2],C0[r+3]);a=MX3(a,C1[r],C1[r+1]);b=MX3(b,C1[r+2],C1[r+3]);} \
      float rm=__builtin_fmaxf(a,b); { auto rr=__builtin_amdgcn_permlane32_swap(__float_as_uint(rm),__float_as_uint(rm),false,false); rm=__builtin_fmaxf(__uint_as_float(rr[0]),__uint_as_float(rr[1])); } \
      resc=false; \
      if(__builtin_expect(__any(rm>(float)THRL),0)){ const float dl=__builtin_fmaxf(rm,0.f); mhat+=dl; \
        _Pragma("unroll") for(int r=0;r<16;++r){C0[r]-=dl;C1[r]-=dl;} \
        _Pragma("unroll") for(int r=0;r<16;++r)negm[r]=-mhat; asm volatile("":"+v"(negm)); \
        const float f=__builtin_amdgcn_exp2f(-dl); l_reg*=f; if(hi==0)wsf[r32]=f; resc=true; } } \
    SBAR(); \
    GAPB(o[0]=__builtin_amdgcn_mfma_f32_32x32x16_bf16(PAF(0),VFR(0),o[0],0,0,0), C0,0); \
    GAPB(o[1]=__builtin_amdgcn_mfma_f32_32x32x16_bf16(PAF(0),VFR(4),o[1],0,0,0), C0,4); \
    KRD(GL,0); GAPB(o[0]=__builtin_amdgcn_mfma_f32_32x32x16_bf16(PAF(1),VFR(1),o[0],0,0,0), C0,8); \
    KRD(GL,1); GAPB(o[1]=__builtin_amdgcn_mfma_f32_32x32x16_bf16(PAF(1),VFR(5),o[1],0,0,0), C0,12); \
    KRD(GL,2); GAPB(o[0]=__builtin_amdgcn_mfma_f32_32x32x16_bf16(PAF(2),VFR(2),o[0],0,0,0), C1,0); \
    KRD(GL,3); GAPB(o[1]=__builtin_amdgcn_mfma_f32_32x32x16_bf16(PAF(2),VFR(6),o[1],0,0,0), C1,4); \
    GAPB(o[0]=__builtin_amdgcn_mfma_f32_32x32x16_bf16(PAF(3),VFR(3),o[0],0,0,0), C1,8); \
    GAPB(o[1]=__builtin_amdgcn_mfma_f32_32x32x16_bf16(PAF(3),VFR(7),o[1],0,0,0), C1,12); \
    }while(0)
  int t=1;
  for(;t+5<NT;t+=2){
    STEP(pB0,pB1,pA0,pA1,t,true,true,true);     WAIT_BAR(2); RESC(); ROT();
    STEP(pA0,pA1,pB0,pB1,t+1,true,true,true);   WAIT_BAR(2); RESC(); ROT();
  }
  #define ENDW(tt) do{ if((tt)+3<NT){WAIT_BAR(2);} else if((tt)+2<NT){WAIT_BAR(1);} else {WAIT_BAR(0);} }while(0)
  for(;t+1<NT;t+=2){
    STEP(pB0,pB1,pA0,pA1,t,(t+3<NT),(t+1<NT),(t+1<NT));       ENDW(t);   RESC(); ROT();
    STEP(pA0,pA1,pB0,pB1,t+1,(t+4<NT),(t+2<NT),(t+2<NT));     ENDW(t+1); RESC(); ROT();
  }
  STEP(pB0,pB1,pA0,pA1,NT-1,false,false,false); RESC();
  { float sacc=pB0[0]+pB0[1]; _Pragma("unroll") for(int r=2;r<16;++r)sacc+=pB0[r]; _Pragma("unroll") for(int r=0;r<16;++r)sacc+=pB1[r]; l_reg+=sacc;
    pw0=(u32x4){PKW(pB0,0),PKW(pB0,2),PKW(pB0,4),PKW(pB0,6)};pw1=(u32x4){PKW(pB0,8),PKW(pB0,10),PKW(pB0,12),PKW(pB0,14)};pw2=(u32x4){PKW(pB1,0),PKW(pB1,2),PKW(pB1,4),PKW(pB1,6)};pw3=(u32x4){PKW(pB1,8),PKW(pB1,10),PKW(pB1,12),PKW(pB1,14)};
    SBAR(); pv(o,vb0+sl_cur,PAF(0),PAF(1),PAF(2),PAF(3)); }
  #undef PKW
  #undef PAF
  #undef VFR
  #undef PIN
  #undef MX3
  #undef GAPA
  #undef GAPB
  #undef EX
  #undef VRD
  #undef KRD
  #undef STEP
  #undef ENDW
  {auto rr=__builtin_amdgcn_permlane32_swap(__float_as_uint(l_reg),__float_as_uint(l_reg),false,false);l_reg=__uint_as_float(rr[0])+__uint_as_float(rr[1]);}
  if(hi==0)wsf[32+r32]=l_reg;asm volatile("s_waitcnt lgkmcnt(0)":::"memory");
  float rli[16];
  #pragma unroll
  for(int r=0;r<16;++r)rli[r]=__builtin_amdgcn_rcpf(wsf[32+crow(r,hi)]);
  bf16*Ow=O+((long)b*SEQ+q0+wid*QBLK)*OP+512+h*D;
  { bf16*stg=(bf16*)(shm+LDS_OST)+wid*2048;
    #pragma unroll
    for(int r=0;r<16;++r){const int orow=crow(r,hi);
      #pragma unroll
      for(int d0=0;d0<2;++d0)stg[orow*64+d0*32+r32]=(bf16)f2bf(o[d0][r]*rli[r]);}
    asm volatile("s_waitcnt lgkmcnt(0)":::"memory");
    #pragma unroll
    for(int i=0;i<4;++i){const int row=i*8+(lane>>3),ch=lane&7; const u32x4 v=*(const u32x4*)(stg+row*64+ch*8); ATTN_STORE16(Ow+(long)row*OP+ch*8,v);} }
  asm volatile("s_waitcnt lgkmcnt(0)\n\ts_barrier":::"memory");
  #undef DMA_K
  #undef DMA_V
  #undef TROW
  #undef START
  #undef RESC
  #undef ROT
}

constexpr int NAP=512;
__device__ __forceinline__ void na_unit(int b,int r,const bf16*Q,const bf16*__restrict__ K,const bf16*__restrict__ V,bf16*O,char*shm,const float*rpbl_all,float*wsf_all){
  const int tid=threadIdx.x,lane=tid&63,r32=lane&31,hi=lane>>5; const int h=__builtin_amdgcn_readfirstlane(tid>>6);
  char*wl=shm+h*16384; const unsigned lds0=(unsigned)(uintptr_t)wl;
  const float*rpbl=rpbl_all+h*480;
  const int r0=min(max(r-4,0),56);
  const long qrow0=(long)b*SEQ+(long)r*GRIDW;
  bf16x8 qr[2][4];
  #pragma unroll
  for(int qb=0;qb<2;++qb)
    #pragma unroll
    for(int d0=0;d0<4;++d0)qr[qb][d0]=*reinterpret_cast<const bf16x8*>(&Q[(qrow0+qb*32+r32)*NAP+h*D+d0*16+hi*8]);
  f32x16 o[2][2]; float mrow[2],lrow[2];
  #pragma unroll
  for(int qb=0;qb<2;++qb){o[qb][0]=f32x16{};o[qb][1]=f32x16{};mrow[qb]=-INFINITY;lrow[qb]=0.f;}
  float*wsf=wsf_all+h*64;
  const f32x16 zero=f32x16{};
  const int vb0=(int)(lds0+8192)+((lane>>4)&1)*32+(lane&3)*8+(4*hi+((lane&15)>>2))*64;
  for(int t=0;t<12;++t){
    const long krow0=t<8?(long)b*SEQ+(long)(r0+t)*GRIDW:(long)T+(long)b*CTXL+(long)(t-8)*64;
    #pragma unroll
    for(int c=0;c<8;++c)glds16(K+(krow0+lane)*NAP+h*D+c*8,(unsigned)__builtin_amdgcn_readfirstlane(lds0+c*1024));
    #pragma unroll
    for(int p=0;p<8;++p)glds16(V+(krow0+16*(p&3)+(lane>>2))*NAP+h*D+(p>>2)*32+(lane&3)*8,(unsigned)__builtin_amdgcn_readfirstlane(lds0+8192+p*1024));
    asm volatile("s_waitcnt vmcnt(0)":::"memory");
    #pragma unroll
    for(int qb=0;qb<2;++qb){
      f32x16 p0,p1;
      qkt(p0,p1,wl,qr[qb],zero,r32,hi);
      asm volatile("s_nop 15\n\ts_nop 7":"+v"(p0),"+v"(p1));
      if(t<8){
        const int qc=qb*32+r32, c0=min(max(qc-8,0),48);
        const float*bp=rpbl+(r0+t-r+7)*32+15-qc+4*hi;
        #pragma unroll
        for(int rr=0;rr<16;++rr){
          const int kc0=(rr&3)+8*(rr>>2)+4*hi;
          p0[rr]=((unsigned)(kc0-c0)<16u)?p0[rr]+bp[(rr&3)+8*(rr>>2)]:-INFINITY;
          p1[rr]=((unsigned)(kc0+32-c0)<16u)?p1[rr]+bp[(rr&3)+8*(rr>>2)+32]:-INFINITY; }
      }
      const float rm=rowmax(p0,p1);
      const float mn=fmaxf(mrow[qb],rm), f=__builtin_amdgcn_exp2f(mrow[qb]-mn);
      mrow[qb]=mn;
      float sacc=0.f;
      #pragma unroll
      for(int rr=0;rr<16;++rr){p0[rr]=__builtin_amdgcn_exp2f(p0[rr]-mn);p1[rr]=__builtin_amdgcn_exp2f(p1[rr]-mn);sacc+=p0[rr]+p1[rr];}
      lrow[qb]=lrow[qb]*f+sacc;
      if(hi==0)wsf[r32]=f;
      asm volatile("s_waitcnt lgkmcnt(0)":::"memory");
      #pragma unroll
      for(int d_=0;d_<2;++d_)
        #pragma unroll
        for(int rr=0;rr<16;++rr)o[qb][d_][rr]*=wsf[crow(rr,hi)];
      u32x4 pw0=(u32x4){cvtpk_s(p0[0],p0[1]),cvtpk_s(p0[2],p0[3]),cvtpk_s(p0[4],p0[5]),cvtpk_s(p0[6],p0[7])};
      u32x4 pw1=(u32x4){cvtpk_s(p0[8],p0[9]),cvtpk_s(p0[10],p0[11]),cvtpk_s(p0[12],p0[13]),cvtpk_s(p0[14],p0[15])};
      u32x4 pw2=(u32x4){cvtpk_s(p1[0],p1[1]),cvtpk_s(p1[2],p1[3]),cvtpk_s(p1[4],p1[5]),cvtpk_s(p1[6],p1[7])};
      u32x4 pw3=(u32x4){cvtpk_s(p1[8],p1[9]),cvtpk_s(p1[10],p1[11]),cvtpk_s(p1[12],p1[13]),cvtpk_s(p1[14],p1[15])};
      SBAR();
      pv(o[qb],vb0,__builtin_bit_cast(bf16x8,pw0),__builtin_bit_cast(bf16x8,pw1),__builtin_bit_cast(bf16x8,pw2),__builtin_bit_cast(bf16x8,pw3));
    }
    asm volatile("s_waitcnt lgkmcnt(0)":::"memory");
  }
  #pragma unroll
  for(int qb=0;qb<2;++qb){
    float l=lrow[qb];
    {auto rr=__builtin_amdgcn_permlane32_swap(__float_as_uint(l),__float_as_uint(l),false,false);l=__uint_as_float(rr[0])+__uint_as_float(rr[1]);}
    if(hi==0)wsf[r32]=l;asm volatile("s_waitcnt lgkmcnt(0)":::"memory");
    bf16*stg=(bf16*)wl+qb*2048;
    #pragma unroll
    for(int rr=0;rr<16;++rr){const int orow=crow(rr,hi); const float rl=__builtin_amdgcn_rcpf(wsf[orow]);
      #pragma unroll
      for(int d0=0;d0<2;++d0)stg[orow*64+d0*32+r32]=(bf16)f2bf(o[qb][d0][rr]*rl);}
    asm volatile("s_waitcnt lgkmcnt(0)":::"memory");
    bf16*Ow=O+(qrow0+qb*32)*OP+h*D;
    #pragma unroll
    for(int i=0;i<4;++i){const int row=i*8+(lane>>3),ch=lane&7; const u32x4 v=*(const u32x4*)(stg+row*64+ch*8); ATTN_STORE16(Ow+(long)row*OP+ch*8,v);}
  }
  asm volatile("s_waitcnt lgkmcnt(0)":::"memory");
}
#undef SBAR
#undef WAIT_BAR
}

struct MKArgs { const float* in[23]; float* out; unsigned char* ws; int ph_lo, ph_hi, li, pad; };
struct Frame {
    LAS unsigned char* lds; volatile LAS unsigned* MISC; unsigned* ctl;
    int tid, lane, wave, vcu, G;
};

struct ProjEpi {
    static constexpr bool HAS_MID = false;
    bf16 *QA, *KA, *VA, *QB, *KB, *VB, *GA, *GB; const float *gq, *gk; const LAS float* rope;
    __device__ __forceinline__ void store_plain(const f32x4 (&acc)[2][2][4][2], bf16* dst, int pitch, int rowbase, int colbase, int fq, float scale, bool sig) const {
#pragma unroll
        for (int ai = 0; ai < 2; ++ai)
#pragma unroll
            for (int m = 0; m < 4; ++m) { bf16* rp = dst + (size_t)(rowbase + ai * 128 + m * 16) * pitch + colbase + 4 * fq;
#pragma unroll
                for (int bj = 0; bj < 2; ++bj)
#pragma unroll
                    for (int n = 0; n < 2; ++n) { f32x4 v = acc[ai][bj][m][n];
                        if (sig) {
#pragma unroll
                            for (int j = 0; j < 4; ++j) v[j] = __builtin_amdgcn_rcpf(1.0f + __builtin_amdgcn_exp2f(-LOG2E * v[j])); }
                        else v = v * scale;
                        u32x2 w; w.x = pk2(v[0], v[1]); w.y = pk2(v[2], v[3]);
                        *(u32x2*)(rp + bj * 32 + n * 16) = w; } }
    }
    __device__ __forceinline__ void store_head(const f32x4 (&acc)[2][2][4][2], bf16* dst, int pitch, int rowbase, int colbase, int prow0, int fr, int fq, const float* g, float scale, bool do_rope) const {
        f32x4 gg[2][2];
#pragma unroll
        for (int bj = 0; bj < 2; ++bj)
#pragma unroll
            for (int n = 0; n < 2; ++n) gg[bj][n] = *(const f32x4*)(g + bj * 32 + n * 16 + 4 * fq);
#pragma unroll
        for (int ai = 0; ai < 2; ++ai)
#pragma unroll
            for (int m = 0; m < 4; ++m) {
                float ss = 0.f;
#pragma unroll
                for (int bj = 0; bj < 2; ++bj)
#pragma unroll
                    for (int n = 0; n < 2; ++n) { const f32x4 v = acc[ai][bj][m][n]; ss += (v[0] * v[0] + v[1] * v[1]) + (v[2] * v[2] + v[3] * v[3]); }
                ss += __shfl_xor(ss, 16); ss += __shfl_xor(ss, 32);
                const float rs = rsqrtf(ss * (1.0f / 64.0f) + EPS) * scale;
                bf16* rp = dst + (size_t)(rowbase + ai * 128 + m * 16) * pitch + colbase + 4 * fq;
                const int prow = (prow0 + 2 * ai) & 63, pcol = 16 * m + fr;
#pragma unroll
                for (int bj = 0; bj < 2; ++bj) {
                    f32x4 y0 = acc[ai][bj][m][0] * rs * gg[bj][0], y1 = acc[ai][bj][m][1] * rs * gg[bj][1];
                    if (do_rope) {
                        const int pos = bj ? pcol : prow;
                        const LAS f32x4* tp = (const LAS f32x4*)(rope + pos * 32 + fq * 8);
                        const f32x4 t0 = tp[0], t1 = tp[1];
                        const f32x4 cs = (f32x4){t0[0], t0[2], t1[0], t1[2]}, sn = (f32x4){t0[1], t0[3], t1[1], t1[3]};
                        const f32x4 o0 = y0 * cs - y1 * sn, o1 = y1 * cs + y0 * sn; y0 = o0; y1 = o1;
                    }
                    u32x2 w0, w1; w0.x = pk2(y0[0], y0[1]); w0.y = pk2(y0[2], y0[3]); w1.x = pk2(y1[0], y1[1]); w1.y = pk2(y1[2], y1[3]);
                    *(u32x2*)(rp + bj * 32) = w0; *(u32x2*)(rp + bj * 32 + 16) = w1;
                }
            }
    }
    __device__ __forceinline__ void operator()(const f32x4 (&acc)[2][2][4][2], const pg8::GU& u, int wr, int wc, int fr_in, int fq_in) const {
        int fr = fr_in, fq = fq_in; asm volatile("" : "+v"(fr), "+v"(fq));
        const int rowbase = u.pm * 256 + wr * 64 + fr, pn = u.pn, prow0 = 4 * u.pm + wr;
        if (pn < 2) store_plain(acc, KA, 512, rowbase, 256 * pn + 64 * wc, fq, 1.0f, false);
        else if (pn < 4) store_plain(acc, VA, 512, rowbase, 256 * (pn - 2) + 64 * wc, fq, 1.0f, false);
        else if (pn == 4) { if (wc < 2) store_head(acc, KB, 128, rowbase, 64 * wc, prow0, fr, fq, gk, 1.0f, u.pm < 64); else store_plain(acc, VB, 128, rowbase, 64 * (wc - 2), fq, 1.0f, false); }
        else if (pn < 7) store_plain(acc, QA, 512, rowbase, 256 * (pn - 5) + 64 * wc, fq, QSCALE, false);
        else if (pn < 9) store_head(acc, QB, 512, rowbase, 256 * (pn - 7) + 64 * wc, prow0, fr, fq, gq, QSCALE, true);
        else if (pn < 13) store_plain(acc, GA, 1024, rowbase, 256 * (pn - 9) + 64 * wc, fq, 1.0f, true);
        else store_plain(acc, GB, 1024, rowbase, 256 * (pn - 13) + 64 * wc, fq, 1.0f, true);
    }
};
struct ProjSched {
    const char* Abase; const char* Bbase; const int* rowlist; int v, G;
    __device__ __forceinline__ bool next(int i, pg8::GU& u) const {
        const int id = i * G + v; constexpr int NL = 64 * 17, NC = 4 * 5;
        if (id >= NL + NC) return false;
        int pm, pn; if (id < NL) { pm = id / 17; pn = id % 17; } else { const int c = id - NL; pm = 64 + c / 5; pn = c % 5; }
        u.pm = pm; u.pn = pn; u.e = 0; u.cnt = 256; u.rows = 0u;
        u.a = (unsigned)pm * 256u * pg8::PITCH; u.b = (unsigned)pn * 256u * pg8::PITCH;
        return true;
    }
};


struct Dense4Sched {
    const char* Abase; const char* Bbase; const int* rowlist; int v, G;
    __device__ __forceinline__ bool next(int i, pg8::GU& u) const {
        const int id = i * G + v; if (id >= 64 * 4) return false;
        u.pm = id >> 2; u.pn = id & 3; u.e = 0; u.cnt = 256; u.rows = 0u;
        u.a = (unsigned)u.pm * 256u * pg8::PITCH; u.b = (unsigned)u.pn * 256u * pg8::PITCH; return true;
    }
};
struct UEpi {
    static constexpr bool HAS_MID = true;
    const bf16 *GA, *GB; bf16* U;
    __device__ __forceinline__ void mid(f32x4 (&acc)[2][2][4][2], const pg8::GU& u, int wr, int wc, int fr_in, int fq_in) const {
        int fr = fr_in, fq = fq_in; asm volatile("" : "+v"(fr), "+v"(fq));
        const size_t base = (size_t)(u.pm * 256 + wr * 64 + fr) * 1024 + u.pn * 256 + wc * 32 + 4 * fq;
#pragma unroll
        for (int ai = 0; ai < 2; ++ai)
#pragma unroll
            for (int m = 0; m < 4; ++m)
#pragma unroll
                for (int bj = 0; bj < 2; ++bj)
#pragma unroll
                    for (int n = 0; n < 2; ++n) { const size_t o = base + (size_t)(ai * 128 + m * 16) * 1024 + bj * 128 + n * 16;
                        const u32x2 a = *(const u32x2*)(GA + o), b = *(const u32x2*)(GB + o);
                        f32x4 r; r[0] = bflo(a.x) * __builtin_amdgcn_rcpf(bflo(b.x)); r[1] = bfhi(a.x) * __builtin_amdgcn_rcpf(bfhi(b.x)); r[2] = bflo(a.y) * __builtin_amdgcn_rcpf(bflo(b.y)); r[3] = bfhi(a.y) * __builtin_amdgcn_rcpf(bfhi(b.y));
                        acc[ai][bj][m][n] = acc[ai][bj][m][n] * r; }
    }
    __device__ __forceinline__ void operator()(const f32x4 (&acc)[2][2][4][2], const pg8::GU& u, int wr, int wc, int fr_in, int fq_in) const {
        int fr = fr_in, fq = fq_in; asm volatile("" : "+v"(fr), "+v"(fq));
        const size_t base = (size_t)(u.pm * 256 + wr * 64 + fr) * 1024 + u.pn * 256 + wc * 32 + 4 * fq;
#pragma unroll
        for (int ai = 0; ai < 2; ++ai)
#pragma unroll
            for (int m = 0; m < 4; ++m)
#pragma unroll
                for (int bj = 0; bj < 2; ++bj)
#pragma unroll
                    for (int n = 0; n < 2; ++n) { const size_t o = base + (size_t)(ai * 128 + m * 16) * 1024 + bj * 128 + n * 16;
                        const u32x2 b = *(const u32x2*)(GB + o); const f32x4 v = acc[ai][bj][m][n];
                        u32x2 w; w.x = pk2(v[0] * bflo(b.x), v[1] * bfhi(b.x)); w.y = pk2(v[2] * bflo(b.y), v[3] * bfhi(b.y));
                        *(u32x2*)(U + o) = w; }
    }
};
struct YEpi {
    static constexpr bool HAS_MID = false;
    bf16* Y;
    __device__ __forceinline__ void operator()(const f32x4 (&acc)[2][2][4][2], const pg8::GU& u, int wr, int wc, int fr_in, int fq_in) const {
        int fr = fr_in, fq = fq_in; asm volatile("" : "+v"(fr), "+v"(fq));
        const size_t base = (size_t)(u.pm * 256 + wr * 64 + fr) * 1024 + u.pn * 256 + wc * 32 + 4 * fq;
#pragma unroll
        for (int ai = 0; ai < 2; ++ai)
#pragma unroll
            for (int m = 0; m < 4; ++m)
#pragma unroll
                for (int bj = 0; bj < 2; ++bj)
#pragma unroll
                    for (int n = 0; n < 2; ++n) { const f32x4 v = acc[ai][bj][m][n]; u32x2 w; w.x = pk2(v[0], v[1]); w.y = pk2(v[2], v[3]);
                        *(u32x2*)(Y + base + (size_t)(ai * 128 + m * 16) * 1024 + bj * 128 + n * 16) = w; }
    }
};
constexpr int MW_TSTART = 700, MW_ECN = 740;
__device__ __forceinline__ void moe_table(const Frame& F, const unsigned* ecnt) {
    if (F.tid < 32) F.MISC[MW_ECN + F.tid] = ecnt[F.tid];
    __syncthreads();
    if (F.tid == 0) { unsigned t = 0; for (int e = 0; e < 32; ++e) { F.MISC[MW_TSTART + e] = t; t += (F.MISC[MW_ECN + e] + 255u) >> 8; } F.MISC[MW_TSTART + 32] = t; }
    __syncthreads();
}
template <int NPN  , bool GU_PHASE>
struct MoeSched {
    const char* Abase; const char* Bbase; const int* rowlist; volatile LAS unsigned* MISC; int v, G;
    __device__ __forceinline__ bool next(int i, pg8::GU& u) const {
        const int id = i * G + v; const int tile = id / NPN, pn = id % NPN;
        if (tile >= (int)MISC[MW_TSTART + 32]) return false;
        int e = 0;
        for (int k = 1; k < 32; ++k) e += (tile >= (int)MISC[MW_TSTART + k]) ? 1 : 0;
        e = __builtin_amdgcn_readfirstlane(e);
        const int mt = tile - (int)__builtin_amdgcn_readfirstlane(MISC[MW_TSTART + e]);
        const int cnt_e = (int)__builtin_amdgcn_readfirstlane(MISC[MW_ECN + e]);
        u.pm = tile; u.pn = pn; u.e = e; u.cnt = min(256, cnt_e - mt * 256); u.rows = (unsigned)(e * ECAP + mt * 256);
        if (GU_PHASE) { u.a = 0u; u.b = (unsigned)(e * 2048 + pn * 128) * pg8::PITCH; }
        else { u.a = (unsigned)tile * 256u * pg8::PITCH; u.b = (unsigned)(e * 1024 + pn * 256) * pg8::PITCH; }
        return true;
    }
};
struct GuEpi {
    static constexpr bool HAS_MID = false;
    const float* b_gu; bf16* ACT;
    __device__ __forceinline__ void operator()(const f32x4 (&acc)[2][2][4][2], const pg8::GU& u, int wr, int wc, int fr_in, int fq_in) const {
        int fr = fr_in, fq = fq_in; asm volatile("" : "+v"(fr), "+v"(fq));
        const int c0 = u.pn * 128 + wc * 16 + 4 * fq;
        f32x4 bg[2], bl[2];
#pragma unroll
        for (int bj = 0; bj < 2; ++bj) { bg[bj] = *(const f32x4*)(b_gu + u.e * 2048 + c0 + bj * 64); bl[bj] = *(const f32x4*)(b_gu + u.e * 2048 + 1024 + c0 + bj * 64); }
#pragma unroll
        for (int ai = 0; ai < 2; ++ai)
#pragma unroll
            for (int m = 0; m < 4; ++m) { const int r = ai * 128 + wr * 64 + m * 16 + fr;
                if (r < u.cnt) {
#pragma unroll
                    for (int bj = 0; bj < 2; ++bj) { const f32x4 g = acc[ai][bj][m][0] + bg[bj], l = acc[ai][bj][m][1] + bl[bj]; float a[4];
#pragma unroll
                        for (int j = 0; j < 4; ++j) { const float glu = fminf(g[j], SW_LIMIT), lin = fminf(fmaxf(l[j], -SW_LIMIT), SW_LIMIT);
                            a[j] = (lin + 1.0f) * glu * __builtin_amdgcn_rcpf(1.0f + __builtin_amdgcn_exp2f(-SW_ALPHA * LOG2E * glu)); }
                        u32x2 w; w.x = pk2(a[0], a[1]); w.y = pk2(a[2], a[3]);
                        *(u32x2*)(ACT + (size_t)(u.pm * 256 + r) * DFF + c0 + bj * 64) = w; } } }
    }
};
struct DnEpi {
    static constexpr bool HAS_MID = false;
    const float* b_dn; const int* LIST; const float* TOPW; bf16* YS;
    __device__ __forceinline__ void operator()(const f32x4 (&acc)[2][2][4][2], const pg8::GU& u, int wr, int wc, int fr_in, int fq_in) const {
        int fr = fr_in, fq = fq_in; asm volatile("" : "+v"(fr), "+v"(fq));
        const int c0 = u.pn * 256 + wc * 32 + 4 * fq;
        f32x4 bb[2][2];
#pragma unroll
        for (int bj = 0; bj < 2; ++bj)
#pragma unroll
            for (int n = 0; n < 2; ++n) bb[bj][n] = *(const f32x4*)(b_dn + u.e * 1024 + c0 + bj * 128 + n * 16);
#pragma unroll
        for (int ai = 0; ai < 2; ++ai)
#pragma unroll
            for (int m = 0; m < 4; ++m) { const int r = ai * 128 + wr * 64 + m * 16 + fr;
                if (r < u.cnt) { const int a = LIST[u.rows + r]; const float w = TOPW[a];
#pragma unroll
                    for (int bj = 0; bj < 2; ++bj)
#pragma unroll
                        for (int n = 0; n < 2; ++n) { const f32x4 v = (acc[ai][bj][m][n] + bb[bj][n]) * w; u32x2 o; o.x = pk2(v[0], v[1]); o.y = pk2(v[2], v[3]);
                            *(u32x2*)(YS + (size_t)a * DM + c0 + bj * 128 + n * 16) = o; } } }
    }
};

__global__ void __launch_bounds__(NWAVES * 64, 2) mk_fwd(MKArgs args) {
    extern __shared__ __attribute__((aligned(16))) unsigned char lds[];
    Frame F;
    F.lds = (LAS unsigned char*)lds; F.MISC = (volatile LAS unsigned*)(F.lds + MISC_OFF);
    F.tid = threadIdx.x; F.lane = F.tid & 63; F.wave = __builtin_amdgcn_readfirstlane(F.tid >> 6);
    F.G = gridDim.x; { const int bx = blockIdx.x; F.vcu = (F.G % 8 == 0) ? (bx % 8) * (F.G / 8) + bx / 8 : bx; }
    unsigned char* ws = args.ws;
    F.ctl = (unsigned*)(ws + WS_CTL);
    const float* x = args.in[0]; const float* c = args.in[1]; const float* ctx = args.in[2]; const float* cctx = args.in[3];
    const float* w_mod = args.in[4]; const float* b_mod = args.in[5]; const float* g_pre_mix = args.in[6];
    const float* g_qn = args.in[12]; const float* g_kn = args.in[13];
    float* MOD = (float*)(ws + WS_MOD);
    bf16 *WTIN = (bf16*)(ws + WS_WTIN), *H = (bf16*)(ws + WS_H);
    for (int u = F.tid; u < (LDS_BYTES - MISC_OFF) / 4; u += NWAVES * 64) ((LAS unsigned*)(F.lds + MISC_OFF))[u] = 0u;
    { LAS float* rt = (LAS float*)(F.lds + ROPE_OFF);
      for (int i = F.tid; i < 64 * 16; i += NWAVES * 64) { const int pos = i >> 4, j = i & 15; const float f = powf(10000.0f, -(float)j / 16.0f); const float a = (float)pos * f; rt[2 * i] = cosf(a); rt[2 * i + 1] = sinf(a); } }
    __syncthreads();
    const bool use_bar = (args.ph_hi - args.ph_lo) > 1;
    XcdBarrier bar; bar.bar = F.ctl + CW_BAR + args.li * XCD_BAR_WORDS; bar.x = 0; bar.st = nullptr;
    if (use_bar) bar = xcd_barrier_post(F.ctl + CW_BAR + args.li * XCD_BAR_WORDS, F.MISC + 8);
    const int lo = args.ph_lo, hi = args.ph_hi;
#define IN(k) (lo <= (k) && (k) < hi)
#define BOTH(k) (IN(k) && IN((k) + 1))
#define GRID_BAR() xcd_barrier(bar)

    if (IN(0)) {
        if (F.vcu < 192) {
            LAS float* sil = (LAS float*)(F.lds + RING_OFF);
            LAS float* red = (LAS float*)(F.lds + RING_OFF + 20480);
            const int tid = F.tid, n0 = F.vcu * 32;
            for (int i = tid; i < 5 * 1024; i += 512) { const int r = i >> 10, k = i & 1023; const float v = r < 4 ? c[r * 1024 + k] : cctx[k]; sil[i] = v / (1.0f + __expf(-v)); }
            __syncthreads();
            const int cg = tid & 7, kr = tid >> 3;
            float acc[5][4];
#pragma unroll
            for (int r = 0; r < 5; ++r)
#pragma unroll
                for (int j = 0; j < 4; ++j) acc[r][j] = 0.f;
            for (int k = kr; k < 1024; k += 64) {
                const f32x4 w = *(const f32x4*)(w_mod + (size_t)k * 6144 + n0 + 4 * cg);
#pragma unroll
                for (int r = 0; r < 5; ++r) { const float s = sil[r * 1024 + k]; acc[r][0] += s * w[0]; acc[r][1] += s * w[1]; acc[r][2] += s * w[2]; acc[r][3] += s * w[3]; }
            }
#pragma unroll
            for (int r = 0; r < 5; ++r)
#pragma unroll
                for (int j = 0; j < 4; ++j) red[(kr * 5 + r) * 32 + 4 * cg + j] = acc[r][j];
            __syncthreads();
            if (tid < 160) { const int r = tid >> 5, n = tid & 31; float s = 0.f; for (int i = 0; i < 64; ++i) s += red[(i * 5 + r) * 32 + n]; MOD[r * 6144 + n0 + n] = s + b_mod[n0 + n]; }
            __syncthreads();
        }
        {
            WPtrs P{args.in[10], args.in[14], args.in[15], args.in[16], args.in[19], args.in[21], WTIN, (bf16*)(ws + WS_WTOAB), (bf16*)(ws + WS_WTO), (bf16*)(ws + WS_WTGU), (bf16*)(ws + WS_WTDN)};
            float* scr = (float*)(lds + RING_OFF + 61440 + F.wave * 8448);
            for (int it = F.vcu * NWAVES + F.wave; it < NITEMS_W; it += F.G * NWAVES) convert_item(P, it, scr, F.lane);
        }
        if (BOTH(0)) GRID_BAR();
    }
    if (IN(1)) {
        for (int row = F.vcu * NWAVES + F.wave; row < TR; row += F.G * NWAVES) hnorm_row(row, x, ctx, g_pre_mix, MOD, H, F.lane);
        if (BOTH(1)) GRID_BAR();
    }
    if (IN(2)) {
        ProjSched S{(const char*)H, (const char*)WTIN, nullptr, F.vcu, F.G};
        ProjEpi E{(bf16*)(ws + WS_QA), (bf16*)(ws + WS_KA), (bf16*)(ws + WS_VA), (bf16*)(ws + WS_QB), (bf16*)(ws + WS_KB), (bf16*)(ws + WS_VB), (bf16*)(ws + WS_GA), (bf16*)(ws + WS_GB), g_qn, g_kn, (const LAS float*)(F.lds + ROPE_OFF)};
        pg8::gemm_phase<ProjEpi, ProjSched, false, 1>(F.lds + RING_OFF, S, E);
        if (BOTH(2)) GRID_BAR();
    }
    if (IN(3)) {
        { LAS float* rp = (LAS float*)(F.lds + NAX_OFF); const float* rpb = args.in[11];
          for (int i = F.tid; i < 8 * 480; i += NWAVES * 64) { const int h = i / 480, rem = i % 480, ro = rem >> 5, co = rem & 31; rp[i] = co < 31 ? rpb[(h * 15 + ro) * 31 + co] * LOG2E : 0.f; } }
        __syncthreads();
        const bf16 *QAp = (const bf16*)(ws + WS_QA), *KAp = (const bf16*)(ws + WS_KA), *VAp = (const bf16*)(ws + WS_VA), *QBp = (const bf16*)(ws + WS_QB), *KBp = (const bf16*)(ws + WS_KB), *VBp = (const bf16*)(ws + WS_VB);
        bf16* Op = (bf16*)(ws + WS_O);
        for (int id = F.vcu; id < 512; id += F.G) {
            const int v = id & 255, i2 = id >> 8, bk = v >> 5, local = (v & 31) + 32 * i2;
            attn_body::gqa_unit<8>(bk >> 1, (bk & 1) * 4 + (local >> 4), local & 15, QBp, KBp, VBp, Op, (char*)lds + RING_OFF);
        }
        for (int id = F.vcu; id < 256; id += F.G)
            attn_body::na_unit(id >> 6, id & 63, QAp, KAp, VAp, Op, (char*)lds + RING_OFF, (const float*)(lds + NAX_OFF), (float*)(lds + NAX_OFF + 15360));
        if (BOTH(3)) GRID_BAR();
    }
    if (IN(4)) {
        Dense4Sched S{(const char*)(ws + WS_O), (const char*)(ws + WS_WTOAB), nullptr, F.vcu, F.G};
        UEpi E{(const bf16*)(ws + WS_GA), (const bf16*)(ws + WS_GB), (bf16*)(ws + WS_U)};
        pg8::gemm_phase<UEpi, Dense4Sched, false, 0>(F.lds + RING_OFF, S, E);
        if (BOTH(4)) GRID_BAR();
    }
    if (IN(5)) {
        Dense4Sched S{(const char*)(ws + WS_U), (const char*)(ws + WS_WTO), nullptr, F.vcu, F.G};
        YEpi E{(bf16*)(ws + WS_Y)};
        pg8::gemm_phase<YEpi, Dense4Sched, false, 0>(F.lds + RING_OFF, S, E);
        if (BOTH(5)) GRID_BAR();
    }
    if (IN(6)) {
        for (int blk = F.vcu; blk < T / 64; blk += F.G)
            rowpass_block(blk, x, (const bf16*)(ws + WS_Y), MOD, args.in[7], args.in[8], args.in[17], args.in[18], (bf16*)(ws + WS_H2), (float*)(ws + WS_RSTD1), (int*)(ws + WS_TOPE), (float*)(ws + WS_TOPW),
                          F.ctl + CW_ECNT, (int*)(ws + WS_LIST), lds + RING_OFF, lds + MISC_OFF + 256);
        if (BOTH(6)) GRID_BAR();
    }
    if (IN(7)) {
        moe_table(F, F.ctl + CW_ECNT);
        MoeSched<8, true> S{(const char*)(ws + WS_H2), (const char*)(ws + WS_WTGU), (const int*)(ws + WS_LIST), F.MISC, F.vcu, F.G};
        GuEpi E{args.in[20], (bf16*)(ws + WS_ACT)};
        pg8::gemm_phase<GuEpi, MoeSched<8, true>, true, 2>(F.lds + RING_OFF, S, E);
        if (BOTH(7)) GRID_BAR();
    }
    if (IN(8)) {
        moe_table(F, F.ctl + CW_ECNT);
        MoeSched<4, false> S{(const char*)(ws + WS_ACT), (const char*)(ws + WS_WTDN), (const int*)(ws + WS_LIST), F.MISC, F.vcu, F.G};
        DnEpi E{args.in[22], (const int*)(ws + WS_LIST), (const float*)(ws + WS_TOPW), (bf16*)(ws + WS_YS)};
        pg8::gemm_phase<DnEpi, MoeSched<4, false>, false, 0>(F.lds + RING_OFF, S, E);
        if (BOTH(8)) GRID_BAR();
    }
    if (IN(9)) {
        for (int t = F.vcu * NWAVES + F.wave; t < T; t += F.G * NWAVES)
            final_row(t, x, (const bf16*)(ws + WS_Y), (const float*)(ws + WS_RSTD1), (const bf16*)(ws + WS_YS), MOD, args.in[7], args.in[9], args.out, F.lane);
    }
#undef IN
#undef BOTH
#undef GRID_BAR
}

#ifndef MK_SPLIT
#define MK_SPLIT 0
#endif
extern "C" void kernel_launch(void* const* d_in, const int* in_sizes, int n_in, void* d_out, int out_size, void* d_ws, size_t ws_size, hipStream_t stream) {
    static int grid = 0;
    if (grid == 0) {
        grid = -1;
        if (n_in != 23 || in_sizes[0] != T * DM || out_size != T * DM || ws_size < WS_END) { fprintf(stderr, "kernel_launch: unexpected shapes/workspace (n_in %d, ws %zu)\n", n_in, ws_size); return; }
        if (hipFuncSetAttribute((const void*)k_rowpass, hipFuncAttributeMaxDynamicSharedMemorySize, RP_LDS) != hipSuccess) { fprintf(stderr, "kernel_launch: hipFuncSetAttribute failed\n"); return; }
        if (hipFuncSetAttribute((const void*)mk_fwd, hipFuncAttributeMaxDynamicSharedMemorySize, LDS_BYTES) != hipSuccess) { fprintf(stderr, "kernel_launch: hipFuncSetAttribute(mk_fwd) failed\n"); return; }
        int dev = 0, cus = 0, per_cu = 0;
        if (hipGetDevice(&dev) != hipSuccess || hipDeviceGetAttribute(&cus, hipDeviceAttributeMultiprocessorCount, dev) != hipSuccess) return;
        if (hipOccupancyMaxActiveBlocksPerMultiprocessor(&per_cu, (const void*)mk_fwd, NWAVES * 64, LDS_BYTES) != hipSuccess || per_cu < 1) { fprintf(stderr, "kernel_launch: occupancy query says %d blocks per CU\n", per_cu); (void)hipGetLastError(); return; }
        grid = cus;
    }
    if (grid < 0) return;
    const float* x = (const float*)d_in[0];
    const float* g_post_mix = (const float*)d_in[7]; const float* g_pre_ffn = (const float*)d_in[8]; const float* g_post_ffn = (const float*)d_in[9];
    const float* rpb = (const float*)d_in[11];
    const float* w_router = (const float*)d_in[17]; const float* b_router = (const float*)d_in[18];
    const float* b_gu = (const float*)d_in[20]; const float* b_dn = (const float*)d_in[22];
    unsigned char* ws = (unsigned char*)d_ws;
    float* MOD = (float*)(ws + WS_MOD); float* RSTD1 = (float*)(ws + WS_RSTD1); int* TOPE = (int*)(ws + WS_TOPE); float* TOPW = (float*)(ws + WS_TOPW);
    int* LIST = (int*)(ws + WS_LIST); unsigned* ECNT = (unsigned*)(ws + WS_CTL) + CW_ECNT;
    bf16 *WTOAB = (bf16*)(ws + WS_WTOAB), *WTO = (bf16*)(ws + WS_WTO), *WTGU = (bf16*)(ws + WS_WTGU), *WTDN = (bf16*)(ws + WS_WTDN);
    bf16 *QA = (bf16*)(ws + WS_QA), *KA = (bf16*)(ws + WS_KA), *VA = (bf16*)(ws + WS_VA), *QB = (bf16*)(ws + WS_QB), *KB = (bf16*)(ws + WS_KB), *VB = (bf16*)(ws + WS_VB);
    bf16 *GA = (bf16*)(ws + WS_GA), *GB = (bf16*)(ws + WS_GB), *O = (bf16*)(ws + WS_O), *U = (bf16*)(ws + WS_U), *Y = (bf16*)(ws + WS_Y), *H2 = (bf16*)(ws + WS_H2), *ACT = (bf16*)(ws + WS_ACT), *YS = (bf16*)(ws + WS_YS);
    float *PA = (float*)(ws + WS_PA), *PB = (float*)(ws + WS_PB);

    (void)hipMemsetAsync(ws + WS_CTL, 0, CTL_ZERO_BYTES, stream);
    MKArgs a{};
    for (int i = 0; i < 23; ++i) a.in[i] = (const float*)d_in[i];
    a.out = (float*)d_out; a.ws = ws;
    auto run = [&](int lo, int hi, int li) {
        if (MK_SPLIT) { for (int p = lo; p < hi; ++p) { a.ph_lo = p; a.ph_hi = p + 1; a.li = p; hipLaunchKernelGGL(mk_fwd, dim3(grid), dim3(NWAVES * 64), LDS_BYTES, stream, a); } }
        else { a.ph_lo = lo; a.ph_hi = hi; a.li = li; hipLaunchKernelGGL(mk_fwd, dim3(grid), dim3(NWAVES * 64), LDS_BYTES, stream, a); } };
    run(0, 10, 0);
}
```

```cpp
#include <hip/hip_runtime.h>
#include <cstdint>
#include <cstdio>

#define DEV __device__ __forceinline__
typedef unsigned short bf16;
typedef short bf16x8 __attribute__((ext_vector_type(8)));
typedef float f32x4 __attribute__((ext_vector_type(4)));
typedef unsigned u32x4 __attribute__((ext_vector_type(4)));
typedef unsigned u32x2 __attribute__((ext_vector_type(2)));

constexpr int DM = 1024, NBATCH = 4, SEQ = 4096, T = NBATCH * SEQ, CTXL = 256, TC = NBATCH * CTXL, TR = T + TC;
constexpr int GRIDW = 64, HD = 64;
constexpr int INC = 4352, KVC = 1280;
constexpr int C_KA = 0, C_VA = 512, C_KB = 1024, C_VB = 1152, C_QA = 1280, C_QB = 1792, C_GA = 2304, C_GB = 3328;
constexpr int NE = 32, TOPK = 4, DFF = 1024;
constexpr int NASG = T * TOPK;
constexpr int ECAP = T;
constexpr int ACT_ROWS = NASG + NE * 256;
constexpr float EPS = 1e-6f, LOG2E = 1.4426950408889634f, QSCALE = 0.125f * LOG2E;
constexpr float SW_LIMIT = 7.0f, SW_ALPHA = 1.702f;

constexpr size_t MiB = 1u << 20;
constexpr size_t WS_CTL = 0, CTL_ZERO_BYTES = 1 * MiB;
constexpr size_t WS_MOD = 1 * MiB;
constexpr size_t WS_ROPE = 1 * MiB + 128 * 1024;
constexpr size_t WS_RSTD1 = 1 * MiB + 256 * 1024;
constexpr size_t WS_TOPE = 1 * MiB + 512 * 1024;
constexpr size_t WS_TOPW = 1 * MiB + 768 * 1024;
constexpr size_t WS_LIST = 2 * MiB;
constexpr size_t WS_WTIN = 4 * MiB;
constexpr size_t WS_WTOAB = 13 * MiB;
constexpr size_t WS_WTO = 15 * MiB;
constexpr size_t WS_WTGU = 17 * MiB;
constexpr size_t WS_WTDN = 145 * MiB;
constexpr size_t WS_H = 209 * MiB;
constexpr size_t WS_QA = 243 * MiB;
constexpr size_t WS_KA = 259 * MiB;
constexpr size_t WS_VA = 276 * MiB;
constexpr size_t WS_QB = 293 * MiB;
constexpr size_t WS_KB = 309 * MiB;
constexpr size_t WS_VB = 314 * MiB;
constexpr size_t WS_GA = 319 * MiB;
constexpr size_t WS_GB = 351 * MiB;
constexpr size_t WS_O = 383 * MiB;
constexpr size_t WS_U = 415 * MiB;
constexpr size_t WS_Y = 447 * MiB;
constexpr size_t WS_H2 = 479 * MiB;
constexpr size_t WS_ACT = 511 * MiB;
constexpr size_t WS_YS = 655 * MiB;
constexpr size_t WS_END = 783 * MiB;
constexpr size_t WS_CF32 = 479 * MiB;
constexpr size_t WS_PA = 511 * MiB, WS_PB = 575 * MiB;
static_assert(WS_CF32 + (size_t)TR * INC * 4 <= WS_END, "cf32 overlay");
constexpr int CW_ECNT = 2048;

#ifndef MOE_FP8
#define MOE_FP8 1
#endif
constexpr float W8_SCALE = 32.0f, ACT8_SCALE = 4.0f;
constexpr int MOE_PITCH = MOE_FP8 ? 1024 : 2048;
DEV unsigned f2bf(float f) { unsigned u = __builtin_bit_cast(unsigned, f); return (u + 0x7fffu + ((u >> 16) & 1u)) >> 16; }
DEV unsigned pk2(float lo, float hi) { return f2bf(lo) | (f2bf(hi) << 16); }
DEV float bflo(unsigned w) { return __builtin_bit_cast(float, w << 16); }
DEV float bfhi(unsigned w) { return __builtin_bit_cast(float, w & 0xffff0000u); }
DEV unsigned pk4_fp8(float a, float b, float c, float d) {
    a = fminf(fmaxf(a, -448.f), 448.f); b = fminf(fmaxf(b, -448.f), 448.f); c = fminf(fmaxf(c, -448.f), 448.f); d = fminf(fmaxf(d, -448.f), 448.f);
    int w = __builtin_amdgcn_cvt_pk_fp8_f32(a, b, 0, false); w = __builtin_amdgcn_cvt_pk_fp8_f32(c, d, w, true); return (unsigned)w; }
DEV float bf2f(bf16 b) { return __builtin_bit_cast(float, ((unsigned)b) << 16); }
DEV float wave_sum(float v) {
#pragma unroll
    for (int o = 1; o < 64; o <<= 1) v += __shfl_xor(v, o);
    return v;
}
DEV float wave_max(float v) {
#pragma unroll
    for (int o = 1; o < 64; o <<= 1) v = fmaxf(v, __shfl_xor(v, o));
    return v;
}
DEV int lane_now() { int l; asm volatile("v_mbcnt_lo_u32_b32 %0, -1, 0\n\tv_mbcnt_hi_u32_b32 %0, -1, %0" : "=v"(l)); return l; }
DEV float sigmoidf_(float x) { return 1.0f / (1.0f + __expf(-x)); }


DEV void transpose_item(const float* __restrict__ W, int K, int N, bf16* __restrict__ WT, int ld, int koff, float* scr, int item, int lane) {
    const int nblk = N / 32, kb = item / nblk, nb = item % nblk, k0 = 64 * kb, n0 = 32 * nb;
#pragma unroll 8
    for (int i = 0; i < 32; ++i) { const int kk = 2 * i + (lane >> 5); scr[kk * 33 + (lane & 31)] = W[(size_t)(k0 + kk) * N + n0 + (lane & 31)]; }
    __builtin_amdgcn_s_waitcnt(0xC07F); asm volatile("" ::: "memory");
    const int cch = lane & 7;
#pragma unroll
    for (int j = 0; j < 4; ++j) { const int n = (lane >> 3) + 8 * j; const float* s = scr + (8 * cch) * 33 + n;
        u32x4 o; o.x = pk2(s[0 * 33], s[1 * 33]); o.y = pk2(s[2 * 33], s[3 * 33]); o.z = pk2(s[4 * 33], s[5 * 33]); o.w = pk2(s[6 * 33], s[7 * 33]);
        *(u32x4*)(WT + (size_t)(n0 + n) * ld + koff + k0 + 8 * cch) = o; }
    __builtin_amdgcn_s_waitcnt(0xC07F); asm volatile("" ::: "memory");
}
DEV void transpose_item_fp8(const float* __restrict__ W, int K, int N, unsigned char* __restrict__ WT, float scale, float* scr, int item, int lane) {
    const int nblk = N / 32, kb = item / nblk, nb = item % nblk, k0 = 64 * kb, n0 = 32 * nb;
#pragma unroll 8
    for (int i = 0; i < 32; ++i) { const int kk = 2 * i + (lane >> 5); scr[kk * 33 + (lane & 31)] = W[(size_t)(k0 + kk) * N + n0 + (lane & 31)]; }
    __builtin_amdgcn_s_waitcnt(0xC07F); asm volatile("" ::: "memory");
    const int cch = lane & 7;
#pragma unroll
    for (int j = 0; j < 4; ++j) { const int n = (lane >> 3) + 8 * j; const float* s = scr + (8 * cch) * 33 + n;
        u32x2 o; o.x = pk4_fp8(s[0 * 33] * scale, s[1 * 33] * scale, s[2 * 33] * scale, s[3 * 33] * scale); o.y = pk4_fp8(s[4 * 33] * scale, s[5 * 33] * scale, s[6 * 33] * scale, s[7 * 33] * scale);
        *(u32x2*)(WT + (size_t)(n0 + n) * K + k0 + 8 * cch) = o; }
    __builtin_amdgcn_s_waitcnt(0xC07F); asm volatile("" ::: "memory");
}
struct WPtrs { const float *w_in, *w_oa, *w_ob, *w_o, *w_gu, *w_dn; bf16 *t_in, *t_oab, *t_o, *t_gu, *t_dn; };
constexpr int I_IN = 16 * 136, I_OA = 8 * 32, I_O = 16 * 32, I_GU = 16 * 64, I_DN = 16 * 32;
constexpr int NITEMS_W = I_IN + 2 * I_OA + I_O + NE * (I_GU + I_DN);
DEV void convert_item(const WPtrs& P, int it, float* scr, int lane) {
    int r = it;
    if (r < I_IN) { transpose_item(P.w_in, 1024, INC, P.t_in, 1024, 0, scr, r, lane); return; } r -= I_IN;
    if (r < I_OA) { transpose_item(P.w_oa, 512, 1024, P.t_oab, 1024, 0, scr, r, lane); return; } r -= I_OA;
    if (r < I_OA) { transpose_item(P.w_ob, 512, 1024, P.t_oab, 1024, 512, scr, r, lane); return; } r -= I_OA;
    if (r < I_O) { transpose_item(P.w_o, 1024, 1024, P.t_o, 1024, 0, scr, r, lane); return; } r -= I_O;
    if (r < NE * I_GU) { const int e = r / I_GU;
        if (MOE_FP8) transpose_item_fp8(P.w_gu + (size_t)e * 1024 * 2048, 1024, 2048, (unsigned char*)P.t_gu + (size_t)e * 2048 * 1024, W8_SCALE, scr, r % I_GU, lane);
        else transpose_item(P.w_gu + (size_t)e * 1024 * 2048, 1024, 2048, P.t_gu + (size_t)e * 2048 * 1024, 1024, 0, scr, r % I_GU, lane);
        return; } r -= NE * I_GU;
    { const int e = r / I_DN;
        if (MOE_FP8) transpose_item_fp8(P.w_dn + (size_t)e * 1024 * 1024, 1024, 1024, (unsigned char*)P.t_dn + (size_t)e * 1024 * 1024, W8_SCALE, scr, r % I_DN, lane);
        else transpose_item(P.w_dn + (size_t)e * 1024 * 1024, 1024, 1024, P.t_dn + (size_t)e * 1024 * 1024, 1024, 0, scr, r % I_DN, lane); }
}


DEV void hnorm_row(int row, const float* __restrict__ x, const float* __restrict__ ctx, const float* __restrict__ g, const float* __restrict__ mod, bf16* __restrict__ H, int lane) {
    const float* src = row < T ? x + (size_t)row * DM : ctx + (size_t)(row - T) * DM;
    const float* mrow = mod + (row < T ? (row / SEQ) : 4) * 6144;
    f32x4 v[4]; float ss = 0.f;
#pragma unroll
    for (int j = 0; j < 4; ++j) { v[j] = *(const f32x4*)(src + 4 * lane + 256 * j); ss += v[j][0] * v[j][0] + v[j][1] * v[j][1] + v[j][2] * v[j][2] + v[j][3] * v[j][3]; }
    const float rstd = rsqrtf(wave_sum(ss) * (1.0f / DM) + EPS);
#pragma unroll
    for (int j = 0; j < 4; ++j) {
        const int cidx = 4 * lane + 256 * j;
        const f32x4 gg = *(const f32x4*)(g + cidx), sh = *(const f32x4*)(mrow + cidx), sc = *(const f32x4*)(mrow + 1024 + cidx);
        float o[4];
#pragma unroll
        for (int q = 0; q < 4; ++q) o[q] = v[j][q] * rstd * gg[q] * (1.0f + sc[q]) + sh[q];
        u32x2 w; w.x = pk2(o[0], o[1]); w.y = pk2(o[2], o[3]);
        *(u32x2*)(H + (size_t)row * DM + cidx) = w;
    }
}


constexpr int RP_LDS = 32 * 1024 * 4 + 4096;
DEV void rowpass_block(int blk, const float* __restrict__ x, const bf16* __restrict__ Y, const float* __restrict__ mod, const float* __restrict__ g_post_mix, const float* __restrict__ g_pre_ffn,
                       const float* __restrict__ w_router, const float* __restrict__ b_router, bf16* __restrict__ H2, float* __restrict__ RSTD1, int* __restrict__ TOPE, float* __restrict__ TOPW,
                       unsigned* __restrict__ ecnt, int* __restrict__ LIST, unsigned char* lds, unsigned char* lds_small, int wave) {
    float* wr = (float*)lds;
    unsigned* hist = (unsigned*)lds_small;
    unsigned* base = hist + 32;
    unsigned* asg_e = base + 32;
    unsigned* asg_p = asg_e + 256;
    const int lane = lane_now(), tid = wave * 64 + lane;
    for (int i = tid; i < 32 * 1024; i += 512) { const int k = i >> 5, e = i & 31; wr[e * 1024 + k] = w_router[i]; }
    if (tid < 32) hist[tid] = 0u;
    __syncthreads();
    const int t0 = blk * 64, b = t0 / SEQ;
    const float* mrow = mod + b * 6144;
    for (int it = 0; it < 8; ++it) {
        const int t = t0 + wave * 8 + it;
        float yv[16], xv[16];
        float ss = 0.f;
#pragma unroll
        for (int j = 0; j < 4; ++j) {
            const u32x2 yw = *(const u32x2*)(Y + (size_t)t * DM + 4 * lane + 256 * j);
            yv[4 * j] = bflo(yw.x); yv[4 * j + 1] = bfhi(yw.x); yv[4 * j + 2] = bflo(yw.y); yv[4 * j + 3] = bfhi(yw.y);
            const f32x4 xx = *(const f32x4*)(x + (size_t)t * DM + 4 * lane + 256 * j);
            xv[4 * j] = xx[0]; xv[4 * j + 1] = xx[1]; xv[4 * j + 2] = xx[2]; xv[4 * j + 3] = xx[3];
#pragma unroll
            for (int q = 0; q < 4; ++q) ss += yv[4 * j + q] * yv[4 * j + q];
        }
        const float rstd1 = rsqrtf(wave_sum(ss) * (1.0f / DM) + EPS);
        if (lane == 0) RSTD1[t] = rstd1;
        float ss2 = 0.f;
#pragma unroll
        for (int j = 0; j < 4; ++j) {
            const int cidx = 4 * lane + 256 * j;
            const f32x4 gt = *(const f32x4*)(mrow + 2048 + cidx), gp = *(const f32x4*)(g_post_mix + cidx);
#pragma unroll
            for (int q = 0; q < 4; ++q) { const float x1 = xv[4 * j + q] + gt[q] * (yv[4 * j + q] * rstd1 * gp[q]); xv[4 * j + q] = x1; ss2 += x1 * x1; }
        }
        const float rstd2 = rsqrtf(wave_sum(ss2) * (1.0f / DM) + EPS);
#pragma unroll
        for (int j = 0; j < 4; ++j) {
            const int cidx = 4 * lane + 256 * j;
            const f32x4 gf = *(const f32x4*)(g_pre_ffn + cidx), sh = *(const f32x4*)(mrow + 3072 + cidx), sc = *(const f32x4*)(mrow + 4096 + cidx);
#pragma unroll
            for (int q = 0; q < 4; ++q) xv[4 * j + q] = xv[4 * j + q] * rstd2 * gf[q] * (1.0f + sc[q]) + sh[q];
            if (MOE_FP8) *(unsigned*)((unsigned char*)H2 + (size_t)t * DM + cidx) = pk4_fp8(xv[4 * j], xv[4 * j + 1], xv[4 * j + 2], xv[4 * j + 3]);
            else { u32x2 w; w.x = pk2(xv[4 * j], xv[4 * j + 1]); w.y = pk2(xv[4 * j + 2], xv[4 * j + 3]); *(u32x2*)(H2 + (size_t)t * DM + cidx) = w; }
        }
        float pl[32];
#pragma unroll
        for (int e = 0; e < 32; ++e) {
            float a = 0.f;
#pragma unroll
            for (int j = 0; j < 4; ++j) { const f32x4 w = *(const f32x4*)(wr + e * 1024 + 4 * lane + 256 * j); a += xv[4 * j] * w[0] + xv[4 * j + 1] * w[1] + xv[4 * j + 2] * w[2] + xv[4 * j + 3] * w[3]; }
            pl[e] = a;
        }
#define RP_STEP(D, H) _Pragma("unroll") for (int i = 0; i < H; ++i) { const bool up = (lane & D) != 0; const float snd = up ? pl[i] : pl[i + H]; const float kp = up ? pl[i + H] : pl[i]; pl[i] = kp + __shfl_xor(snd, D); }
        RP_STEP(32, 16) RP_STEP(16, 8) RP_STEP(8, 4) RP_STEP(4, 2) RP_STEP(2, 1)
#undef RP_STEP
        float logit = pl[0] + __shfl_xor(pl[0], 1);
        const int e_mine = lane >> 1;
        logit += b_router[e_mine];
        float val = (lane & 1) ? -INFINITY : logit;
        float tl[4]; int te[4];
#pragma unroll
        for (int k = 0; k < 4; ++k) {
            const float mx = wave_max(val);
            const unsigned long long bal = __ballot(val == mx);
            const int wl = __ffsll((long long)bal) - 1;
            tl[k] = mx; te[k] = wl >> 1;
            if (lane == wl) val = -INFINITY;
        }
        const float e1 = __expf(tl[1] - tl[0]), e2 = __expf(tl[2] - tl[0]), e3 = __expf(tl[3] - tl[0]);
        const float inv = 1.0f / (1.0f + e1 + e2 + e3);
        if (lane < 4) {
            const int ek = lane == 0 ? te[0] : lane == 1 ? te[1] : lane == 2 ? te[2] : te[3];
            const float wk = (lane == 0 ? 1.0f : lane == 1 ? e1 : lane == 2 ? e2 : e3) * inv;
            TOPE[t * 4 + lane] = ek; TOPW[t * 4 + lane] = wk;
            const unsigned p = atomicAdd(&hist[ek], 1u);
            const int la = (wave * 8 + it) * 4 + lane;
            asg_e[la] = (unsigned)ek; asg_p[la] = p;
        }
    }
    __syncthreads();
    if (tid < 32) base[tid] = atomicAdd(&ecnt[tid], hist[tid]);
    __syncthreads();
    if (tid < 256) { const unsigned e = asg_e[tid]; LIST[(size_t)e * ECAP + base[e] + asg_p[tid]] = t0 * 4 + tid; }
    __syncthreads();
}


DEV void final_row(int t, const float* __restrict__ x, const bf16* __restrict__ Y, const float* __restrict__ RSTD1, const bf16* __restrict__ YS, const float* __restrict__ mod,
                   const float* __restrict__ g_post_mix, const float* __restrict__ g_post_ffn, float* __restrict__ out, int lane) {
    const float* mrow = mod + (t / SEQ) * 6144;
    const float rstd1 = RSTD1[t];
    float f[16]; float ss = 0.f;
#pragma unroll
    for (int j = 0; j < 4; ++j) {
        float a0 = 0.f, a1 = 0.f, a2 = 0.f, a3 = 0.f;
#pragma unroll
        for (int k = 0; k < 4; ++k) { const u32x2 w = *(const u32x2*)(YS + (size_t)(t * 4 + k) * DM + 4 * lane + 256 * j); a0 += bflo(w.x); a1 += bfhi(w.x); a2 += bflo(w.y); a3 += bfhi(w.y); }
        f[4 * j] = a0; f[4 * j + 1] = a1; f[4 * j + 2] = a2; f[4 * j + 3] = a3;
        ss += a0 * a0 + a1 * a1 + a2 * a2 + a3 * a3;
    }
    const float rstdf = rsqrtf(wave_sum(ss) * (1.0f / DM) + EPS);
#pragma unroll
    for (int j = 0; j < 4; ++j) {
        const int cidx = 4 * lane + 256 * j;
        const f32x4 xx = *(const f32x4*)(x + (size_t)t * DM + cidx);
        const u32x2 yw = *(const u32x2*)(Y + (size_t)t * DM + cidx);
        const f32x4 gt1 = *(const f32x4*)(mrow + 2048 + cidx), gt2 = *(const f32x4*)(mrow + 5120 + cidx), gp = *(const f32x4*)(g_post_mix + cidx), gf = *(const f32x4*)(g_post_ffn + cidx);
        const float yv[4] = {bflo(yw.x), bfhi(yw.x), bflo(yw.y), bfhi(yw.y)};
        f32x4 o;
#pragma unroll
        for (int q = 0; q < 4; ++q) o[q] = xx[q] + gt1[q] * (yv[q] * rstd1 * gp[q]) + gt2[q] * (f[4 * j + q] * rstdf * gf[q]);
        *(f32x4*)(out + (size_t)t * DM + cidx) = o;
    }
}


#define LAS __attribute__((address_space(3)))
#define GAS __attribute__((address_space(1)))
typedef GAS unsigned gu32;
#define RLX_AGENT __ATOMIC_RELAXED, __HIP_MEMORY_SCOPE_AGENT
constexpr int NWAVES = 8;

constexpr int RING_OFF = 0, RING_BYTES = 131072;
constexpr int ROPE_OFF = 131072;
constexpr int MISC_OFF = 139264;
constexpr int NAX_OFF = 143360;
constexpr int LDS_BYTES = 163840;
constexpr int CW_TMO = 0, CW_CODE = 1, CW_BAR = 4096;

#define XB_TMO      128
#define XB_XCNT(j)  (256  + 64 * (j))
#define XB_XSUB(j)  (1280 + 64 * (j))
#define XB_XGEN(j)  (2304 + 64 * (j))
#define XB_TOP      3328
#define XB_TOPGEN   3392
#define XCD_BAR_WORDS 3456
#define XB_SPIN_CAP (1u << 18)
__device__ __forceinline__ unsigned xb_ld(unsigned* p)              { return __hip_atomic_load(p, __ATOMIC_RELAXED, __HIP_MEMORY_SCOPE_AGENT); }
__device__ __forceinline__ unsigned xb_add(unsigned* p, unsigned v) { return __hip_atomic_fetch_add(p, v, __ATOMIC_RELAXED, __HIP_MEMORY_SCOPE_AGENT); }
__device__ __forceinline__ unsigned xb_xcc_id() { return (unsigned)__builtin_amdgcn_s_getreg((3 << 11) | 20) & 0xFu; }
#define XB_SPIN(cond, bar) do { unsigned _sp = 0; while (cond) { __builtin_amdgcn_s_sleep(1); \
    if ((++_sp & 255u) == 0u) { if (xb_ld(&(bar)[XB_TMO])) break; if (_sp > XB_SPIN_CAP) { atomicAdd(&(bar)[XB_TMO], 1u); break; } } } } while (0)
struct XcdBarrier { unsigned* bar; unsigned x; volatile LAS unsigned* st; };
__device__ __forceinline__ XcdBarrier xcd_barrier_post(unsigned* bar, volatile LAS unsigned* st) {
    XcdBarrier b; b.bar = bar; b.x = xb_xcc_id(); b.st = st;
    if (threadIdx.x == 0) (void)xb_add(&bar[XB_XCNT(b.x)], 1u);
    return b;
}
__device__ __forceinline__ void xcd_barrier_complete(unsigned* bar, unsigned x, unsigned& nloc, unsigned& nx) {
    const unsigned G = gridDim.x * gridDim.y * gridDim.z;
    unsigned sum, cnt, mine, sp = 0u;
    for (;;) {
        sum = 0u; cnt = 0u; mine = 0u;
#pragma unroll
        for (unsigned j = 0; j < 16; ++j) { const unsigned c = xb_ld(&bar[XB_XCNT(j)]); sum += c; cnt += (c > 0u) ? 1u : 0u; mine = (j == x) ? c : mine; }
        if (sum == G) break;
        __builtin_amdgcn_s_sleep(1);
        if ((++sp & 255u) == 0u) { if (xb_ld(&bar[XB_TMO])) break; if (sp > XB_SPIN_CAP) { atomicAdd(&bar[XB_TMO], 1u); break; } }
    }
    nloc = mine > 0u ? mine : 1u; nx = cnt > 0u ? cnt : 1u;
}
__device__ __forceinline__ void xcd_barrier(const XcdBarrier& b, int wave) {
    asm volatile("s_waitcnt vmcnt(0)" ::: "memory");
    __syncthreads();
    if (wave == 0 && lane_now() == 0) {
        unsigned* bar = b.bar;
        __builtin_amdgcn_s_waitcnt(0);
        unsigned nloc = b.st[0], nx = b.st[1];
        if (nloc == 0u) { xcd_barrier_complete(bar, b.x, nloc, nx); b.st[0] = nloc; b.st[1] = nx; }
        const unsigned old = xb_add(&bar[XB_XSUB(b.x)], 1u);
        const unsigned gen = old / nloc;
        if (old + 1u == (gen + 1u) * nloc) {
            __builtin_amdgcn_fence(__ATOMIC_RELEASE, "agent");
            asm volatile("s_waitcnt vmcnt(0)" ::: "memory");
            const unsigned og = xb_add(&bar[XB_TOP], 1u);
            const unsigned tg = og / nx;
            if (og + 1u == (tg + 1u) * nx) xb_add(&bar[XB_TOPGEN], 1u);
            else XB_SPIN(xb_ld(&bar[XB_TOPGEN]) == tg, bar);
            __builtin_amdgcn_fence(__ATOMIC_ACQUIRE, "agent");
            xb_add(&bar[XB_XGEN(b.x)], 1u);
            asm volatile("s_waitcnt vmcnt(0)" ::: "memory");
        } else {
            XB_SPIN(xb_ld(&bar[XB_XGEN(b.x)]) == gen, bar);
            __builtin_amdgcn_fence(__ATOMIC_ACQUIRE, "agent");
            asm volatile("s_waitcnt vmcnt(0)" ::: "memory");
        }
    }
    __syncthreads();
}

namespace pg8 {
#define PG8_LAS __attribute__((address_space(3)))
constexpr int BM = 256, BK = 64, HALF = 128, HTB = HALF * BK * 2, STAGE_BYTES = 8 * HTB;
constexpr int KDIM = 1024, NT = KDIM / BK, PITCH = KDIM * 2;
__host__ __device__ __forceinline__ int lds_byte(int r, int c) { const int st = (r >> 4) * 2 + (c >> 5), rr = r & 15, cc = c & 31, ob = rr * 64 + cc * 2; return st * 1024 + (ob ^ (((ob >> 9) & 1) << 5)); }
__host__ __device__ __forceinline__ void stage_rc(int b, int& R, int& C) { const int st = b / 1024, sb = b % 1024, swz = sb ^ (((sb >> 9) & 1) << 5); R = (st >> 1) * 16 + swz / 64; C = (st & 1) * 32 + (swz % 64) / 2; }

struct GU {
    unsigned a;
    unsigned b;
    unsigned rows;
    int pm, pn, e, cnt;
};
template <int BMAP> __device__ __forceinline__ int bmap_row(int R) { return BMAP == 0 ? R : BMAP == 1 ? (64 * (R >> 5) + (R & 31)) : (16 * (R >> 5) + (R & 15) + 1024 * ((R >> 4) & 1)); }
template <int BMAP> __device__ __forceinline__ int bmap_hrows() { return BMAP == 0 ? 128 : BMAP == 1 ? 32 : 64; }
typedef int v8i32 __attribute__((ext_vector_type(8)));
typedef int v4i32 __attribute__((ext_vector_type(4)));
__device__ __forceinline__ bf16x8 lo8(v8i32 v) { return __builtin_bit_cast(bf16x8, (v4i32)__builtin_shufflevector(v, v, 0, 1, 2, 3)); }
__device__ __forceinline__ bf16x8 hi8(v8i32 v) { return __builtin_bit_cast(bf16x8, (v4i32)__builtin_shufflevector(v, v, 4, 5, 6, 7)); }
__device__ __forceinline__ v8i32 cat8(bf16x8 lo, bf16x8 hi) { const v4i32 a = __builtin_bit_cast(v4i32, lo), b = __builtin_bit_cast(v4i32, hi); return __builtin_shufflevector(a, b, 0, 1, 2, 3, 4, 5, 6, 7); }

template <class Epi, class Sched, bool GATHER, int BMAP, bool FP8 = false>
__device__ __forceinline__ void gemm_phase(PG8_LAS unsigned char* lds, const Sched& S, const Epi& E, int wid) {
    const int lane = lane_now(), tid = wid * 64 + lane, wr = wid >> 2, wc = wid & 3, fr = lane & 15, fq = lane >> 4;
    constexpr int nt = FP8 ? 8 : NT; constexpr int RPITCH = FP8 ? 1024 : PITCH;
    int Rr[2], Cc[2]; unsigned voffB[2];
#pragma unroll
    for (int i = 0; i < 2; ++i) { stage_rc(tid * 16 + i * 8192, Rr[i], Cc[i]); voffB[i] = (unsigned)(bmap_row<BMAP>(Rr[i]) * RPITCH + Cc[i] * 2); }
    const size_t kstep = (size_t)(BK * 2);
    const size_t hstepB = (size_t)bmap_hrows<BMAP>() * RPITCH;
    const unsigned ldsw = (unsigned)wid * 1024u;
    const int aoff = lds_byte(wr * 64 + fr, fq * 8), boff = lds_byte(wc * 32 + fr, fq * 8);
#define PG8_SA(b, h) (((b) * 2 + (h)) * HTB)
#define PG8_SB(b, h) ((4 + (b) * 2 + (h)) * HTB)
#define PG8_STAGE(bufoff, gbase, voff) do { _Pragma("unroll") for (int _i = 0; _i < 2; ++_i) { unsigned _o = (voff)[_i]; asm volatile("" : "+v"(_o));     \
        __builtin_amdgcn_global_load_lds((const unsigned*)((const char*)(gbase) + _o), (PG8_LAS unsigned*)(lds + (bufoff) + ldsw + _i * 8192), 16, 0, 0); } } while (0)
#define PG8_LDA(dst, b, h) do { _Pragma("unroll") for (int m = 0; m < 4; ++m) dst[m] = cat8(*(const PG8_LAS bf16x8*)(lds + PG8_SA(b, h) + aoff + m * 2048), *(const PG8_LAS bf16x8*)(lds + PG8_SA(b, h) + aoff + m * 2048 + 1024)); } while (0)
#define PG8_LDB(dst, b, h) do { _Pragma("unroll") for (int n = 0; n < 2; ++n) dst[n] = cat8(*(const PG8_LAS bf16x8*)(lds + PG8_SB(b, h) + boff + n * 2048), *(const PG8_LAS bf16x8*)(lds + PG8_SB(b, h) + boff + n * 2048 + 1024)); } while (0)
#define PG8_MMA(ai, bj, At, Bt) do { __builtin_amdgcn_s_setprio(1); if constexpr (FP8) asm volatile("s_nop 1"); _Pragma("unroll") for (int m = 0; m < 4; ++m) _Pragma("unroll") for (int n = 0; n < 2; ++n) { \
        if constexpr (FP8) asm volatile("v_mfma_f32_16x16x128_f8f6f4 %0, %1, %2, %0" : "+v"(acc[ai][bj][m][n]) : "v"(Bt[n]), "v"(At[m]));   \
        else { acc[ai][bj][m][n] = __builtin_amdgcn_mfma_f32_16x16x32_bf16(lo8(Bt[n]), lo8(At[m]), acc[ai][bj][m][n], 0, 0, 0); acc[ai][bj][m][n] = __builtin_amdgcn_mfma_f32_16x16x32_bf16(hi8(Bt[n]), hi8(At[m]), acc[ai][bj][m][n], 0, 0, 0); } } \
        __builtin_amdgcn_s_setprio(0); } while (0)
#define PG8_WAIT_V(n) asm volatile("s_waitcnt vmcnt(" #n ")" ::: "memory")
#define PG8_WAIT_L(n) asm volatile("s_waitcnt lgkmcnt(" #n ")" ::: "memory")
#define PG8_BAR __builtin_amdgcn_s_barrier()
#define PG8_SCHED __builtin_amdgcn_sched_barrier(0)
#define PG8_AOFFS(dst, u) do { _Pragma("unroll") for (int _h = 0; _h < 2; ++_h) _Pragma("unroll") for (int _i = 0; _i < 2; ++_i) { \
        int _row = 128 * _h + Rr[_i]; if (GATHER) { const int _rr = _row < (u).cnt ? _row : 0; _row = S.rowlist[(u).rows + _rr] >> 2; } \
        dst[_h][_i] = (unsigned)(_row * RPITCH + Cc[_i] * 2); } } while (0)
    GU cur, nxt; int ui = 0;
    if (!S.next(0, cur)) return;
    f32x4 acc[2][2][4][2];
#pragma unroll
    for (int a = 0; a < 2; ++a)
#pragma unroll
        for (int b = 0; b < 2; ++b)
#pragma unroll
            for (int m = 0; m < 4; ++m)
#pragma unroll
                for (int n = 0; n < 2; ++n) acc[a][b][m][n] = (f32x4){0.f, 0.f, 0.f, 0.f};
    v8i32 At[4], B0[2], B1[2];
    unsigned voA[2][2], nvoA[2][2];
    if constexpr (GATHER) { PG8_AOFFS(voA, cur); } else {
#pragma unroll
        for (int h = 0; h < 2; ++h)
#pragma unroll
            for (int i = 0; i < 2; ++i) { voA[h][i] = (unsigned)((128 * h + Rr[i]) * RPITCH + Cc[i] * 2); nvoA[h][i] = voA[h][i]; } }
    const char* cA = S.Abase + cur.a; const char* cB = S.Bbase + cur.b;
    PG8_STAGE(PG8_SB(0, 0), cB, voffB); PG8_STAGE(PG8_SB(0, 1), cB + hstepB, voffB); PG8_STAGE(PG8_SA(0, 0), cA, voA[0]); PG8_STAGE(PG8_SA(0, 1), cA, voA[1]);
    if (wr == 1) PG8_BAR;
    PG8_WAIT_V(2); PG8_BAR;
    PG8_STAGE(PG8_SB(1, 0), cB + kstep, voffB); PG8_STAGE(PG8_SA(1, 0), cA + kstep, voA[0]); PG8_STAGE(PG8_SB(1, 1), cB + hstepB + kstep, voffB);
    PG8_WAIT_V(6); PG8_BAR;
    for (;;) {
        const bool has_next = S.next(ui + 1, nxt);
        const char* nA = has_next ? S.Abase + nxt.a : cA; const char* nB = has_next ? S.Bbase + nxt.b : cB;

#pragma unroll 1
        for (int t = 0; t < nt; t += 2) {
            const bool last = (t == nt - 2);
            const char* a1 = cA + (size_t)(t + 1) * kstep;
            const char* a2 = last ? nA : cA + (size_t)(t + 2) * kstep; const char* b2 = last ? nB : cB + (size_t)(t + 2) * kstep;
            const char* a3 = a2 + kstep; const char* b3 = b2 + kstep;
            unsigned vo2[2][2];
            if constexpr (GATHER) { if (last && has_next) { PG8_AOFFS(nvoA, nxt); } }
#pragma unroll
            for (int h = 0; h < 2; ++h)
#pragma unroll
                for (int i = 0; i < 2; ++i) vo2[h][i] = GATHER ? ((last && has_next) ? nvoA[h][i] : voA[h][i]) : voA[h][i];
            if constexpr (Epi::HAS_MID) { if (t == nt / 2) E.mid(acc, cur, wr, wc); }
            PG8_LDB(B0, 0, 0); PG8_LDB(B1, 0, 1); PG8_SCHED; PG8_LDA(At, 0, 0); PG8_STAGE(PG8_SA(1, 1), a1, voA[1]);
            PG8_WAIT_V(8); PG8_WAIT_L(0); PG8_BAR; PG8_MMA(0, 0, At, B0); PG8_MMA(0, 1, At, B1); PG8_BAR; PG8_SCHED;
            PG8_LDA(At, 0, 1); PG8_STAGE(PG8_SB(0, 0), b2, voffB); PG8_STAGE(PG8_SB(0, 1), b2 + hstepB, voffB); PG8_STAGE(PG8_SA(0, 0), a2, vo2[0]);
            PG8_WAIT_V(8); PG8_WAIT_L(0); PG8_BAR; PG8_MMA(1, 0, At, B0); PG8_MMA(1, 1, At, B1); PG8_BAR; PG8_SCHED;
            PG8_LDB(B0, 1, 0); PG8_LDB(B1, 1, 1); PG8_SCHED; PG8_LDA(At, 1, 0); PG8_STAGE(PG8_SA(0, 1), a2, vo2[1]);
            PG8_WAIT_V(8); PG8_WAIT_L(0); PG8_BAR; PG8_MMA(0, 0, At, B0); PG8_MMA(0, 1, At, B1); PG8_BAR; PG8_SCHED;
            PG8_LDA(At, 1, 1); PG8_STAGE(PG8_SB(1, 0), b3, voffB); PG8_STAGE(PG8_SB(1, 1), b3 + hstepB, voffB); PG8_STAGE(PG8_SA(1, 0), a3, vo2[0]);
            PG8_WAIT_V(8); PG8_WAIT_L(0); PG8_BAR; PG8_MMA(1, 0, At, B0); PG8_MMA(1, 1, At, B1); PG8_BAR; PG8_SCHED;
        }
        if (wr == 0) PG8_BAR;
        if constexpr (FP8) asm volatile("s_nop 15\n\ts_nop 7" ::: "memory");
        E(acc, cur, wr, wc);
        if (!has_next) break;
#pragma unroll
        for (int a = 0; a < 2; ++a)
#pragma unroll
            for (int b = 0; b < 2; ++b)
#pragma unroll
                for (int m = 0; m < 4; ++m)
#pragma unroll
                    for (int n = 0; n < 2; ++n) acc[a][b][m][n] = (f32x4){0.f, 0.f, 0.f, 0.f};
        cur = nxt; cA = nA; cB = nB; ++ui;
        if constexpr (GATHER) {
#pragma unroll
        for (int h = 0; h < 2; ++h)
#pragma unroll
            for (int i = 0; i < 2; ++i) voA[h][i] = nvoA[h][i]; }
        if (wr == 1) PG8_BAR;
    }
    PG8_WAIT_V(0);
    PG8_BAR;
#undef PG8_SA
#undef PG8_SB
#undef PG8_STAGE
#undef PG8_LDA
#undef PG8_LDB
#undef PG8_MMA
#undef PG8_WAIT_V
#undef PG8_WAIT_L
#undef PG8_BAR
#undef PG8_SCHED
#undef PG8_AOFFS
}
}

namespace attn_body {
using bf16x8=__attribute__((ext_vector_type(8)))short;
using s16x4=__attribute__((ext_vector_type(4)))short;
using f32x16=__attribute__((ext_vector_type(16)))float;
using u32x4=__attribute__((ext_vector_type(4)))unsigned;
constexpr int D=64;
constexpr int NW=8,QBLK=32,QB=QBLK*NW,KVBLK=64;
__device__ __forceinline__ int crow(int r,int hi){return (r&3)+8*(r>>2)+4*hi;}
#define SBAR() __builtin_amdgcn_sched_barrier(0)
constexpr int NSLOT=3, SLOTB=8192;
constexpr int LDS_K=0, LDS_V=NSLOT*SLOTB, LDS_WS=2*NSLOT*SLOTB, LDS_OST=LDS_WS+NW*64*4, LDS_BYTES=LDS_OST+NW*4096;
__device__ __forceinline__ void glds16(const void*gsrc,unsigned lds_dst){unsigned keep;
  asm volatile("s_mov_b32 %0, m0\n\ts_mov_b32 m0, %2\n\ts_nop 0\n\tglobal_load_lds_dwordx4 %1, off\n\ts_mov_b32 m0, %0":"=&s"(keep):"v"(gsrc),"s"(lds_dst):"memory");}
__device__ __forceinline__ float max3f(float a,float b,float c){float r;asm("v_max3_f32 %0, %1, %2, %3":"=v"(r):"v"(a),"v"(b),"v"(c));return r;}
__device__ __forceinline__ float max2f(float a,float b){float r;asm("v_max_f32_e32 %0, %1, %2":"=v"(r):"v"(a),"v"(b));return r;}
__device__ __forceinline__ float fadd_s(float a,float b){float r;asm("v_add_f32_e32 %0, %1, %2":"=v"(r):"v"(a),"v"(b));return r;}
__device__ __forceinline__ float fsub_s(float a,float b){float r;asm("v_sub_f32_e32 %0, %1, %2":"=v"(r):"v"(a),"v"(b));return r;}
typedef float f32x2_t __attribute__((ext_vector_type(2))); typedef __bf16 bf16x2_t __attribute__((ext_vector_type(2)));
__device__ __forceinline__ unsigned cvtpk_s(float lo,float hi){f32x2_t v={lo,hi};bf16x2_t b=__builtin_convertvector(v,bf16x2_t);return __builtin_bit_cast(unsigned,b);}
#define WAIT_BAR(N) asm volatile("s_waitcnt vmcnt(" #N ") lgkmcnt(0)\n\ts_barrier":::"memory")
__device__ __forceinline__ void qkt(f32x16&p0,f32x16&p1,const char*Kslot,const bf16x8*qr,const f32x16&negm,int r32,int hi){
  const char*kb=Kslot+hi*1024+r32*16;
  #pragma unroll
  for(int d0=0;d0<4;++d0){
    const bf16x8 b0=*reinterpret_cast<const bf16x8*>(kb+d0*2048);
    const bf16x8 b1=*reinterpret_cast<const bf16x8*>(kb+d0*2048+512);
    if(d0==0){p0=__builtin_amdgcn_mfma_f32_32x32x16_bf16(b0,qr[0],negm,0,0,0);p1=__builtin_amdgcn_mfma_f32_32x32x16_bf16(b1,qr[0],negm,0,0,0);}
    else{p0=__builtin_amdgcn_mfma_f32_32x32x16_bf16(b0,qr[d0],p0,0,0,0);p1=__builtin_amdgcn_mfma_f32_32x32x16_bf16(b1,qr[d0],p1,0,0,0);}}
}
typedef __attribute__((address_space(3))) const char* lds_cptr;
typedef short v4i16_t __attribute__((ext_vector_type(4)));
__device__ __forceinline__ void kload8(bf16x8*kf,lds_cptr kp){
  kf[0]=*(const __attribute__((address_space(3))) bf16x8*)(kp);      kf[1]=*(const __attribute__((address_space(3))) bf16x8*)(kp+512);
  kf[2]=*(const __attribute__((address_space(3))) bf16x8*)(kp+2048); kf[3]=*(const __attribute__((address_space(3))) bf16x8*)(kp+2560);
  kf[4]=*(const __attribute__((address_space(3))) bf16x8*)(kp+4096); kf[5]=*(const __attribute__((address_space(3))) bf16x8*)(kp+4608);
  kf[6]=*(const __attribute__((address_space(3))) bf16x8*)(kp+6144); kf[7]=*(const __attribute__((address_space(3))) bf16x8*)(kp+6656);
}
__device__ __forceinline__ void kload2(bf16x8*kf,lds_cptr kp,int j){ kf[2*j]=*(const __attribute__((address_space(3))) bf16x8*)(kp+j*2048); kf[2*j+1]=*(const __attribute__((address_space(3))) bf16x8*)(kp+j*2048+512); }
__device__ __forceinline__ s16x4 vtr(lds_cptr p){ return __builtin_bit_cast(s16x4,__builtin_amdgcn_ds_read_tr16_b64_v4i16((__attribute__((address_space(3))) v4i16_t*)p)); }
__device__ __forceinline__ float rowmax(const f32x16&p0,const f32x16&p1){
  float a=max3f(p0[0],p0[1],p1[0]),b=max3f(p0[2],p0[3],p1[1]);a=max3f(a,p1[2],p1[3]);
  #pragma unroll
  for(int r=4;r<16;r+=4){a=max3f(a,p0[r],p0[r+1]);b=max3f(b,p0[r+2],p0[r+3]);a=max3f(a,p1[r],p1[r+1]);b=max3f(b,p1[r+2],p1[r+3]);}
  const float m=max2f(a,b);
  auto rr=__builtin_amdgcn_permlane32_swap(__float_as_uint(m),__float_as_uint(m),false,false);
  return max2f(__uint_as_float(rr[0]),__uint_as_float(rr[1]));
}
__device__ __forceinline__ void pv(f32x16*o,int vb,bf16x8 pa0,bf16x8 pa1,bf16x8 pa2,bf16x8 pa3){
  #pragma unroll
  for(int d0=0;d0<2;++d0){s16x4 lo[4],hi[4];
    #pragma unroll
    for(int ks=0;ks<4;++ks){
      asm volatile("ds_read_b64_tr_b16 %0,%1 offset:%c2":"=&v"(lo[ks]):"v"(vb),"i"(d0*4096+ks*1024):"memory");
      asm volatile("ds_read_b64_tr_b16 %0,%1 offset:%c2":"=&v"(hi[ks]):"v"(vb),"i"(d0*4096+ks*1024+512):"memory");}
    asm volatile("s_waitcnt lgkmcnt(0)":::"memory");SBAR();
    #define PK(k) (bf16x8){lo[k][0],lo[k][1],lo[k][2],lo[k][3],hi[k][0],hi[k][1],hi[k][2],hi[k][3]}
    o[d0]=__builtin_amdgcn_mfma_f32_32x32x16_bf16(pa0,PK(0),o[d0],0,0,0);
    o[d0]=__builtin_amdgcn_mfma_f32_32x32x16_bf16(pa1,PK(1),o[d0],0,0,0);
    o[d0]=__builtin_amdgcn_mfma_f32_32x32x16_bf16(pa2,PK(2),o[d0],0,0,0);
    o[d0]=__builtin_amdgcn_mfma_f32_32x32x16_bf16(pa3,PK(3),o[d0],0,0,0);
    #undef PK
  }
}
#define ATTN_STORE16(p,v) (*(u32x4*)(p)=(v))
constexpr int QP=512, KVP=128, OP=1024;
template<int THRL> __device__ __forceinline__ void gqa_unit(int b,int h,int qb,const bf16*Q,const bf16*__restrict__ K,const bf16*__restrict__ V,bf16*O,char*shm,int wid_in){
  const int lane=lane_now(),r32=lane&31,hi=lane>>5; const int wid=wid_in;
  const int q0=qb*QB; const int kvh=h>>2;
  const bf16*Qw=Q+((long)b*SEQ+q0+wid*QBLK)*QP+h*D;
  const unsigned lds0=(unsigned)(uintptr_t)shm;
  float*wsf=(float*)(shm+LDS_WS)+wid*64;
  #define TROW(t) ((t)<64?(long)b*SEQ+(long)(t)*64:(long)T+(long)b*CTXL+(long)((t)-64)*64)
  const bf16*ksrc=K+(long)lane*KVP+kvh*D+wid*8;
  const bf16*vsrc=V+(long)(16*(wid&3)+(lane>>2))*KVP+kvh*D+(wid>>2)*32+(lane&3)*8;
  const unsigned kdst=lds0+LDS_K+wid*1024, vdst=lds0+LDS_V+wid*1024;
  #define DMA_K(t,slot) glds16(ksrc+TROW(t)*KVP,(unsigned)__builtin_amdgcn_readfirstlane(kdst+(slot)))
  #define DMA_V(t,slot) glds16(vsrc+TROW(t)*KVP,(unsigned)__builtin_amdgcn_readfirstlane(vdst+(slot)))
  const int vb0=(int)(lds0+LDS_V)+((lane>>4)&1)*32+(lane&3)*8+(4*hi+((lane&15)>>2))*64;
  const char*Kbase=shm+LDS_K; bf16x8 kf[8];
  const lds_cptr shm3=(lds_cptr)shm; const lds_cptr kp0=shm3+LDS_K+hi*1024+r32*16; const lds_cptr vp0=shm3+LDS_V+((lane>>4)&1)*32+(lane&3)*8+(4*hi+((lane&15)>>2))*64;
  constexpr int NT=(SEQ+CTXL)/KVBLK;
  DMA_K(0,0);DMA_V(0,0);DMA_K(1,SLOTB);
  bf16x8 qr[4];
  #pragma unroll
  for(int d0=0;d0<4;++d0)qr[d0]=*reinterpret_cast<const bf16x8*>(&Qw[(long)r32*QP+d0*16+hi*8]);
  float mhat=0.f,l_reg=0.f;f32x16 o[2];o[0]=f32x16{};o[1]=f32x16{};f32x16 negm=f32x16{};asm volatile("":"+v"(negm));
  bool resc=false;
  #define START(P0,P1) do{ const float rm=rowmax(P0,P1); resc=false; \
    { const float dl=rm; mhat=fadd_s(mhat,dl); \
      _Pragma("unroll") for(int r=0;r<16;++r){P0[r]=fsub_s(P0[r],dl);P1[r]=fsub_s(P1[r],dl);} \
      _Pragma("unroll") for(int r=0;r<16;++r)negm[r]=-mhat; asm volatile("":"+v"(negm)); } \
    _Pragma("unroll") for(int r=0;r<16;++r)P0[r]=__builtin_amdgcn_exp2f(P0[r]); }while(0)
  #define RESC() do{ if(resc){ asm volatile("s_waitcnt lgkmcnt(0)":::"memory"); \
      _Pragma("unroll") for(int d_=0;d_<2;++d_) _Pragma("unroll") for(int r=0;r<16;++r)o[d_][r]*=wsf[crow(r,hi)]; } }while(0)
  f32x16 pA0,pA1,pB0,pB1;
  int sl_prev=0,sl_cur=0,sl_next=SLOTB;
  #define ROT() do{sl_prev=sl_cur;sl_cur=sl_next;sl_next=(sl_next==(NSLOT-1)*SLOTB)?0:sl_next+SLOTB;}while(0)
  DMA_K(2,2*SLOTB);
  WAIT_BAR(3);
  qkt(pA0,pA1,Kbase,qr,negm,r32,hi);asm volatile("s_nop 15\n\ts_nop 7":"+v"(pA0),"+v"(pA1));
  START(pA0,pA1);
  _Pragma("unroll") for(int r=0;r<16;++r)pA1[r]=__builtin_amdgcn_exp2f(pA1[r]);
  WAIT_BAR(0);
  DMA_K(3,0);DMA_V(1,SLOTB);
  ROT();
  kload8(kf,kp0+sl_cur);
  WAIT_BAR(2);
  s16x4 vlo[8],vhi[8]; u32x4 pw0,pw1,pw2,pw3;
  #define PKW(P,B) cvtpk_s(P[B],P[B+1])
  #define PAF(k) __builtin_bit_cast(bf16x8,pw##k)
  #define VFR(i) (bf16x8){vlo[i][0],vlo[i][1],vlo[i][2],vlo[i][3],vhi[i][0],vhi[i][1],vhi[i][2],vhi[i][3]}
  #define PIN(x) asm volatile("":"+v"(x))
  #define MX3(a,b,c) __builtin_fmaxf(__builtin_fmaxf((a),(b)),(c))
  #define GAPA(MF,A0,A1,A2,A3,W0,W1,PW) do{ MF; sacc+=A0; sacc+=A1; sacc+=A2; sacc+=A3; PIN(sacc); W0; W1; PIN(PW); SBAR(); }while(0)
  #define EX(v) __builtin_amdgcn_exp2f(v)
  #define GAPB(MF,X,B) do{ MF; X[B]=EX(X[B]); X[B+1]=EX(X[B+1]); X[B+2]=EX(X[B+2]); X[B+3]=EX(X[B+3]); PIN(X); SBAR(); }while(0)
  #define VRD(i) do{ vlo[i]=vtr(vp_+(((i)>>2)*4096+((i)&3)*1024)); vhi[i]=vtr(vp_+(((i)>>2)*4096+((i)&3)*1024+512)); }while(0)
  #define KRD(G,j) do{ if(G){ kload2(kf,kp0+sl_next,j); SBAR(); } }while(0)
  #define STEP(C0,C1,P0,P1,t,GK,GV,GL) do{ SBAR(); \
    const lds_cptr vp_=vp0+sl_prev; \
    VRD(0); SBAR(); float sacc=(P0[0]+P0[1]); \
    GAPA(C0=__builtin_amdgcn_mfma_f32_32x32x16_bf16(kf[0],qr[0],negm,0,0,0), P0[2],P0[3],P0[4],P0[5],     pw0[0]=PKW(P0,0), pw0[1]=PKW(P0,2), pw0); \
    VRD(4); SBAR(); GAPA(C1=__builtin_amdgcn_mfma_f32_32x32x16_bf16(kf[1],qr[0],negm,0,0,0), P0[6],P0[7],P0[8],P0[9],     pw0[2]=PKW(P0,4), pw0[3]=PKW(P0,6), pw0); \
    VRD(1); SBAR(); GAPA(C0=__builtin_amdgcn_mfma_f32_32x32x16_bf16(kf[2],qr[1],C0,0,0,0),   P0[10],P0[11],P0[12],P0[13], pw1[0]=PKW(P0,8), pw1[1]=PKW(P0,10), pw1); \
    VRD(5); SBAR(); GAPA(C1=__builtin_amdgcn_mfma_f32_32x32x16_bf16(kf[3],qr[1],C1,0,0,0),   P0[14],P0[15],P1[0],P1[1],   pw1[2]=PKW(P0,12),pw1[3]=PKW(P0,14), pw1); \
    VRD(2); SBAR(); GAPA(C0=__builtin_amdgcn_mfma_f32_32x32x16_bf16(kf[4],qr[2],C0,0,0,0),   P1[2],P1[3],P1[4],P1[5],     pw2[0]=PKW(P1,0), pw2[1]=PKW(P1,2), pw2); \
    VRD(6); SBAR(); GAPA(C1=__builtin_amdgcn_mfma_f32_32x32x16_bf16(kf[5],qr[2],C1,0,0,0),   P1[6],P1[7],P1[8],P1[9],     pw2[2]=PKW(P1,4), pw2[3]=PKW(P1,6), pw2); \
    VRD(3); SBAR(); GAPA(C0=__builtin_amdgcn_mfma_f32_32x32x16_bf16(kf[6],qr[3],C0,0,0,0),   P1[10],P1[11],P1[12],P1[13], pw3[0]=PKW(P1,8), pw3[1]=PKW(P1,10), pw3); \
    VRD(7); SBAR(); GAPA(C1=__builtin_amdgcn_mfma_f32_32x32x16_bf16(kf[7],qr[3],C1,0,0,0),   P1[14],P1[15],0.f,0.f,       pw3[2]=PKW(P1,12),pw3[3]=PKW(P1,14), pw3); \
    l_reg+=sacc; \
    if(GK){DMA_K((t)+3,sl_cur);} if(GV){DMA_V((t)+1,sl_next);} \
    { float a=MX3(C0[0],C0[1],C1[0]),b=MX3(C0[2],C0[3],C1[1]); a=MX3(a,C1[2],C1[3]); \
      _Pragma("unroll") for(int r=4;r<16;r+=4){a=MX3(a,C0[r],C0[r+1]);b=MX3(b,C0[r+2],C0[r+3]);a=MX3(a,C1[r],C1[r+1]);b=MX3(b,C1[r+2],C1[r+3]);} \
      float rm=__builtin_fmaxf(a,b); { auto rr=__builtin_amdgcn_permlane32_swap(__float_as_uint(rm),__float_as_uint(rm),false,false); rm=__builtin_fmaxf(__uint_as_float(rr[0]),__uint_as_float(rr[1])); } \
      resc=false; \
      if(__builtin_expect(__any(rm>(float)THRL),0)){ const float dl=__builtin_fmaxf(rm,0.f); mhat+=dl; \
        _Pragma("unroll") for(int r=0;r<16;++r){C0[r]-=dl;C1[r]-=dl;} \
        _Pragma("unroll") for(int r=0;r<16;++r)negm[r]=-mhat; asm volatile("":"+v"(negm)); \
        const float f=__builtin_amdgcn_exp2f(-dl); l_reg*=f; if(hi==0)wsf[r32]=f; resc=true; } } \
    SBAR(); \
    GAPB(o[0]=__builtin_amdgcn_mfma_f32_32x32x16_bf16(PAF(0),VFR(0),o[0],0,0,0), C0,0); \
    GAPB(o[1]=__builtin_amdgcn_mfma_f32_32x32x16_bf16(PAF(0),VFR(4),o[1],0,0,0), C0,4); \
    KRD(GL,0); GAPB(o[0]=__builtin_amdgcn_mfma_f32_32x32x16_bf16(PAF(1),VFR(1),o[0],0,0,0), C0,8); \
    KRD(GL,1); GAPB(o[1]=__builtin_amdgcn_mfma_f32_32x32x16_bf16(PAF(1),VFR(5),o[1],0,0,0), C0,12); \
    KRD(GL,2); GAPB(o[0]=__builtin_amdgcn_mfma_f32_32x32x16_bf16(PAF(2),VFR(2),o[0],0,0,0), C1,0); \
    KRD(GL,3); GAPB(o[1]=__builtin_amdgcn_mfma_f32_32x32x16_bf16(PAF(2),VFR(6),o[1],0,0,0), C1,4); \
    GAPB(o[0]=__builtin_amdgcn_mfma_f32_32x32x16_bf16(PAF(3),VFR(3),o[0],0,0,0), C1,8); \
    GAPB(o[1]=__builtin_amdgcn_mfma_f32_32x32x16_bf16(PAF(3),VFR(7),o[1],0,0,0), C1,12); \
    }while(0)
  int t=1;
  for(;t+5<NT;t+=2){
    STEP(pB0,pB1,pA0,pA1,t,true,true,true);     WAIT_BAR(2); RESC(); ROT();
    STEP(pA0,pA1,pB0,pB1,t+1,true,true,true);   WAIT_BAR(2); RESC(); ROT();
  }
  #define ENDW(tt) do{ if((tt)+3<NT){WAIT_BAR(2);} else if((tt)+2<NT){WAIT_BAR(1);} else {WAIT_BAR(0);} }while(0)
  for(;t+1<NT;t+=2){
    STEP(pB0,pB1,pA0,pA1,t,(t+3<NT),(t+1<NT),(t+1<NT));       ENDW(t);   RESC(); ROT();
    STEP(pA0,pA1,pB0,pB1,t+1,(t+4<NT),(t+2<NT),(t+2<NT));     ENDW(t+1); RESC(); ROT();
  }
  STEP(pB0,pB1,pA0,pA1,NT-1,false,false,false); RESC();
  { float sacc=pB0[0]+pB0[1]; _Pragma("unroll") for(int r=2;r<16;++r)sacc+=pB0[r]; _Pragma("unroll") for(int r=0;r<16;++r)sacc+=pB1[r]; l_reg+=sacc;
    pw0=(u32x4){PKW(pB0,0),PKW(pB0,2),PKW(pB0,4),PKW(pB0,6)};pw1=(u32x4){PKW(pB0,8),PKW(pB0,10),PKW(pB0,12),PKW(pB0,14)};pw2=(u32x4){PKW(pB1,0),PKW(pB1,2),PKW(pB1,4),PKW(pB1,6)};pw3=(u32x4){PKW(pB1,8),PKW(pB1,10),PKW(pB1,12),PKW(pB1,14)};
    SBAR(); pv(o,vb0+sl_cur,PAF(0),PAF(1),PAF(2),PAF(3)); }
  #undef PKW
  #undef PAF
  #undef VFR
  #undef PIN
  #undef MX3
  #undef GAPA
  #undef GAPB
  #undef EX
  #undef VRD
  #undef KRD
  #undef STEP
  #undef ENDW
  {auto rr=__builtin_amdgcn_permlane32_swap(__float_as_uint(l_reg),__float_as_uint(l_reg),false,false);l_reg=__uint_as_float(rr[0])+__uint_as_float(rr[1]);}
  if(hi==0)wsf[32+r32]=l_reg;asm volatile("s_waitcnt lgkmcnt(0)":::"memory");
  float rli[16];
  #pragma unroll
  for(int r=0;r<16;++r)rli[r]=__builtin_amdgcn_rcpf(wsf[32+crow(r,hi)]);
  bf16*Ow=O+((long)b*SEQ+q0+wid*QBLK)*OP+512+h*D;
  { bf16*stg=(bf16*)(shm+LDS_OST)+wid*2048;
    #pragma unroll
    for(int r=0;r<16;++r){const int orow=crow(r,hi);
      #pragma unroll
      for(int d0=0;d0<2;++d0)stg[orow*64+d0*32+r32]=(bf16)f2bf(o[d0][r]*rli[r]);}
    asm volatile("s_waitcnt lgkmcnt(0)":::"memory");
    #pragma unroll
    for(int i=0;i<4;++i){const int row=i*8+(lane>>3),ch=lane&7; const u32x4 v=*(const u32x4*)(stg+row*64+ch*8); ATTN_STORE16(Ow+(long)row*OP+ch*8,v);} }
  asm volatile("s_waitcnt lgkmcnt(0)\n\ts_barrier":::"memory");
  #undef DMA_K
  #undef DMA_V
  #undef TROW
  #undef START
  #undef RESC
  #undef ROT
}

constexpr int NAP=512;
__device__ __forceinline__ void na_unit(int b,int r,const bf16*Q,const bf16*__restrict__ K,const bf16*__restrict__ V,bf16*O,char*shm,const float*rpbl_all,float*wsf_all,int wid_in){
  const int lane=lane_now(),r32=lane&31,hi=lane>>5; const int h=wid_in;
  char*wl=shm+h*16384; const unsigned lds0=(unsigned)(uintptr_t)wl;
  const float*rpbl=rpbl_all+h*480;
  const int r0=min(max(r-4,0),56);
  const long qrow0=(long)b*SEQ+(long)r*GRIDW;
  bf16x8 qr[2][4];
  #pragma unroll
  for(int qb=0;qb<2;++qb)
    #pragma unroll
    for(int d0=0;d0<4;++d0)qr[qb][d0]=*reinterpret_cast<const bf16x8*>(&Q[(qrow0+qb*32+r32)*NAP+h*D+d0*16+hi*8]);
  f32x16 o[2][2]; float mrow[2],lrow[2];
  #pragma unroll
  for(int qb=0;qb<2;++qb){o[qb][0]=f32x16{};o[qb][1]=f32x16{};mrow[qb]=-INFINITY;lrow[qb]=0.f;}
  float*wsf=wsf_all+h*64;
  const f32x16 zero=f32x16{};
  const int vb0=(int)(lds0+8192)+((lane>>4)&1)*32+(lane&3)*8+(4*hi+((lane&15)>>2))*64;
  for(int t=0;t<12;++t){
    const long krow0=t<8?(long)b*SEQ+(long)(r0+t)*GRIDW:(long)T+(long)b*CTXL+(long)(t-8)*64;
    #pragma unroll
    for(int c=0;c<8;++c)glds16(K+(krow0+lane)*NAP+h*D+c*8,(unsigned)__builtin_amdgcn_readfirstlane(lds0+c*1024));
    #pragma unroll
    for(int p=0;p<8;++p)glds16(V+(krow0+16*(p&3)+(lane>>2))*NAP+h*D+(p>>2)*32+(lane&3)*8,(unsigned)__builtin_amdgcn_readfirstlane(lds0+8192+p*1024));
    asm volatile("s_waitcnt vmcnt(0)":::"memory");
    #pragma unroll
    for(int qb=0;qb<2;++qb){
      f32x16 p0,p1;
      qkt(p0,p1,wl,qr[qb],zero,r32,hi);
      asm volatile("s_nop 15\n\ts_nop 7":"+v"(p0),"+v"(p1));
      if(t<8){
        const int qc=qb*32+r32, c0=min(max(qc-8,0),48);
        const float*bp=rpbl+(r0+t-r+7)*32+15-qc+4*hi;
        #pragma unroll
        for(int rr=0;rr<16;++rr){
          const int kc0=(rr&3)+8*(rr>>2)+4*hi;
          p0[rr]=((unsigned)(kc0-c0)<16u)?p0[rr]+bp[(rr&3)+8*(rr>>2)]:-INFINITY;
          p1[rr]=((unsigned)(kc0+32-c0)<16u)?p1[rr]+bp[(rr&3)+8*(rr>>2)+32]:-INFINITY; }
      }
      const float rm=rowmax(p0,p1);
      const float mn=fmaxf(mrow[qb],rm), f=__builtin_amdgcn_exp2f(mrow[qb]-mn);
      mrow[qb]=mn;
      float sacc=0.f;
      #pragma unroll
      for(int rr=0;rr<16;++rr){p0[rr]=__builtin_amdgcn_exp2f(p0[rr]-mn);p1[rr]=__builtin_amdgcn_exp2f(p1[rr]-mn);sacc+=p0[rr]+p1[rr];}
      lrow[qb]=lrow[qb]*f+sacc;
      if(hi==0)wsf[r32]=f;
      asm volatile("s_waitcnt lgkmcnt(0)":::"memory");
      #pragma unroll
      for(int d_=0;d_<2;++d_)
        #pragma unroll
        for(int rr=0;rr<16;++rr)o[qb][d_][rr]*=wsf[crow(rr,hi)];
      u32x4 pw0=(u32x4){cvtpk_s(p0[0],p0[1]),cvtpk_s(p0[2],p0[3]),cvtpk_s(p0[4],p0[5]),cvtpk_s(p0[6],p0[7])};
      u32x4 pw1=(u32x4){cvtpk_s(p0[8],p0[9]),cvtpk_s(p0[10],p0[11]),cvtpk_s(p0[12],p0[13]),cvtpk_s(p0[14],p0[15])};
      u32x4 pw2=(u32x4){cvtpk_s(p1[0],p1[1]),cvtpk_s(p1[2],p1[3]),cvtpk_s(p1[4],p1[5]),cvtpk_s(p1[6],p1[7])};
      u32x4 pw3=(u32x4){cvtpk_s(p1[8],p1[9]),cvtpk_s(p1[10],p1[11]),cvtpk_s(p1[12],p1[13]),cvtpk_s(p1[14],p1[15])};
      SBAR();
      pv(o[qb],vb0,__builtin_bit_cast(bf16x8,pw0),__builtin_bit_cast(bf16x8,pw1),__builtin_bit_cast(bf16x8,pw2),__builtin_bit_cast(bf16x8,pw3));
    }
    asm volatile("s_waitcnt lgkmcnt(0)":::"memory");
  }
  #pragma unroll
  for(int qb=0;qb<2;++qb){
    float l=lrow[qb];
    {auto rr=__builtin_amdgcn_permlane32_swap(__float_as_uint(l),__float_as_uint(l),false,false);l=__uint_as_float(rr[0])+__uint_as_float(rr[1]);}
    if(hi==0)wsf[r32]=l;asm volatile("s_waitcnt lgkmcnt(0)":::"memory");
    bf16*stg=(bf16*)wl+qb*2048;
    #pragma unroll
    for(int rr=0;rr<16;++rr){const int orow=crow(rr,hi); const float rl=__builtin_amdgcn_rcpf(wsf[orow]);
      #pragma unroll
      for(int d0=0;d0<2;++d0)stg[orow*64+d0*32+r32]=(bf16)f2bf(o[qb][d0][rr]*rl);}
    asm volatile("s_waitcnt lgkmcnt(0)":::"memory");
    bf16*Ow=O+(qrow0+qb*32)*OP+h*D;
    #pragma unroll
    for(int i=0;i<4;++i){const int row=i*8+(lane>>3),ch=lane&7; const u32x4 v=*(const u32x4*)(stg+row*64+ch*8); ATTN_STORE16(Ow+(long)row*OP+ch*8,v);}
  }
  asm volatile("s_waitcnt lgkmcnt(0)":::"memory");
}
#undef SBAR
#undef WAIT_BAR
}

struct MKArgs { const float* in[23]; float* out; unsigned char* ws; int ph_lo, ph_hi, li, pad; };
struct Frame {
    LAS unsigned char* lds; volatile LAS unsigned* MISC; unsigned* ctl;
    int wave, vcu, G;
};
#define FLANE (lane_now())
#define FTID (F.wave * 64 + lane_now())

struct ProjEpi {
    static constexpr bool HAS_MID = false;
    bf16 *QA, *KA, *VA, *QB, *KB, *VB, *GA, *GB; const float *gq, *gk; const LAS float* rope;
    __device__ __forceinline__ void store_plain(const f32x4 (&acc)[2][2][4][2], bf16* dst, int pitch, int rowbase, int colbase, int fq, float scale, bool sig) const {
#pragma unroll
        for (int ai = 0; ai < 2; ++ai)
#pragma unroll
            for (int m = 0; m < 4; ++m) { bf16* rp = dst + (size_t)(rowbase + ai * 128 + m * 16) * pitch + colbase + 4 * fq;
#pragma unroll
                for (int bj = 0; bj < 2; ++bj)
#pragma unroll
                    for (int n = 0; n < 2; ++n) { f32x4 v = acc[ai][bj][m][n];
                        if (sig) {
#pragma unroll
                            for (int j = 0; j < 4; ++j) v[j] = __builtin_amdgcn_rcpf(1.0f + __builtin_amdgcn_exp2f(-LOG2E * v[j])); }
                        else v = v * scale;
                        u32x2 w; w.x = pk2(v[0], v[1]); w.y = pk2(v[2], v[3]);
                        *(u32x2*)(rp + bj * 32 + n * 16) = w; } }
    }
    __device__ __forceinline__ void store_head(const f32x4 (&acc)[2][2][4][2], bf16* dst, int pitch, int rowbase, int colbase, int prow0, int fr, int fq, const float* g, float scale, bool do_rope) const {
        f32x4 gg[2][2];
#pragma unroll
        for (int bj = 0; bj < 2; ++bj)
#pragma unroll
            for (int n = 0; n < 2; ++n) gg[bj][n] = *(const f32x4*)(g + bj * 32 + n * 16 + 4 * fq);
#pragma unroll
        for (int ai = 0; ai < 2; ++ai)
#pragma unroll
            for (int m = 0; m < 4; ++m) {
                float ss = 0.f;
#pragma unroll
                for (int bj = 0; bj < 2; ++bj)
#pragma unroll
                    for (int n = 0; n < 2; ++n) { const f32x4 v = acc[ai][bj][m][n]; ss += (v[0] * v[0] + v[1] * v[1]) + (v[2] * v[2] + v[3] * v[3]); }
                ss += __shfl_xor(ss, 16); ss += __shfl_xor(ss, 32);
                const float rs = rsqrtf(ss * (1.0f / 64.0f) + EPS) * scale;
                bf16* rp = dst + (size_t)(rowbase + ai * 128 + m * 16) * pitch + colbase + 4 * fq;
                const int prow = (prow0 + 2 * ai) & 63, pcol = 16 * m + fr;
#pragma unroll
                for (int bj = 0; bj < 2; ++bj) {
                    f32x4 y0 = acc[ai][bj][m][0] * rs * gg[bj][0], y1 = acc[ai][bj][m][1] * rs * gg[bj][1];
                    if (do_rope) {
                        const int pos = bj ? pcol : prow;
                        const LAS f32x4* tp = (const LAS f32x4*)(rope + pos * 32 + fq * 8);
                        const f32x4 t0 = tp[0], t1 = tp[1];
                        const f32x4 cs = (f32x4){t0[0], t0[2], t1[0], t1[2]}, sn = (f32x4){t0[1], t0[3], t1[1], t1[3]};
                        const f32x4 o0 = y0 * cs - y1 * sn, o1 = y1 * cs + y0 * sn; y0 = o0; y1 = o1;
                    }
                    u32x2 w0, w1; w0.x = pk2(y0[0], y0[1]); w0.y = pk2(y0[2], y0[3]); w1.x = pk2(y1[0], y1[1]); w1.y = pk2(y1[2], y1[3]);
                    *(u32x2*)(rp + bj * 32) = w0; *(u32x2*)(rp + bj * 32 + 16) = w1;
                }
            }
    }
    __device__ __forceinline__ void operator()(const f32x4 (&acc)[2][2][4][2], const pg8::GU& u, int wr, int wc) const {
        const int lane_ = lane_now(), fr = lane_ & 15, fq = lane_ >> 4;
        const int rowbase = u.pm * 256 + wr * 64 + fr, pn = u.pn, prow0 = 4 * u.pm + wr;
        if (pn < 2) store_plain(acc, KA, 512, rowbase, 256 * pn + 64 * wc, fq, 1.0f, false);
        else if (pn < 4) store_plain(acc, VA, 512, rowbase, 256 * (pn - 2) + 64 * wc, fq, 1.0f, false);
        else if (pn == 4) { if (wc < 2) store_head(acc, KB, 128, rowbase, 64 * wc, prow0, fr, fq, gk, 1.0f, u.pm < 64); else store_plain(acc, VB, 128, rowbase, 64 * (wc - 2), fq, 1.0f, false); }
        else if (pn < 7) store_plain(acc, QA, 512, rowbase, 256 * (pn - 5) + 64 * wc, fq, QSCALE, false);
        else if (pn < 9) store_head(acc, QB, 512, rowbase, 256 * (pn - 7) + 64 * wc, prow0, fr, fq, gq, QSCALE, true);
        else if (pn < 13) store_plain(acc, GA, 1024, rowbase, 256 * (pn - 9) + 64 * wc, fq, 1.0f, true);
        else store_plain(acc, GB, 1024, rowbase, 256 * (pn - 13) + 64 * wc, fq, 1.0f, true);
    }
};
struct ProjSched {
    const char* Abase; const char* Bbase; const int* rowlist; int v, G;
    __device__ __forceinline__ bool next(int i, pg8::GU& u) const {
        const int id = i * G + v; constexpr int NL = 64 * 17, NC = 4 * 5;
        if (id >= NL + NC) return false;
        int pm, pn; if (id < NL) { pm = id / 17; pn = id % 17; } else { const int c = id - NL; pm = 64 + c / 5; pn = c % 5; }
        u.pm = pm; u.pn = pn; u.e = 0; u.cnt = 256; u.rows = 0u;
        u.a = (unsigned)pm * 256u * pg8::PITCH; u.b = (unsigned)pn * 256u * pg8::PITCH;
        return true;
    }
};


struct Dense4Sched {
    const char* Abase; const char* Bbase; const int* rowlist; int v, G;
    __device__ __forceinline__ bool next(int i, pg8::GU& u) const {
        const int id = i * G + v; if (id >= 64 * 4) return false;
        u.pm = id >> 2; u.pn = id & 3; u.e = 0; u.cnt = 256; u.rows = 0u;
        u.a = (unsigned)u.pm * 256u * pg8::PITCH; u.b = (unsigned)u.pn * 256u * pg8::PITCH; return true;
    }
};
struct UEpi {
    static constexpr bool HAS_MID = true;
    const bf16 *GA, *GB; bf16* U;
    __device__ __forceinline__ void mid(f32x4 (&acc)[2][2][4][2], const pg8::GU& u, int wr, int wc) const {
        const int lane_ = lane_now(), fr = lane_ & 15, fq = lane_ >> 4;
        const size_t base = (size_t)(u.pm * 256 + wr * 64 + fr) * 1024 + u.pn * 256 + wc * 32 + 4 * fq;
#pragma unroll
        for (int ai = 0; ai < 2; ++ai)
#pragma unroll
            for (int m = 0; m < 4; ++m)
#pragma unroll
                for (int bj = 0; bj < 2; ++bj)
#pragma unroll
                    for (int n = 0; n < 2; ++n) { const size_t o = base + (size_t)(ai * 128 + m * 16) * 1024 + bj * 128 + n * 16;
                        const u32x2 a = *(const u32x2*)(GA + o), b = *(const u32x2*)(GB + o);
                        f32x4 r; r[0] = bflo(a.x) * __builtin_amdgcn_rcpf(bflo(b.x)); r[1] = bfhi(a.x) * __builtin_amdgcn_rcpf(bfhi(b.x)); r[2] = bflo(a.y) * __builtin_amdgcn_rcpf(bflo(b.y)); r[3] = bfhi(a.y) * __builtin_amdgcn_rcpf(bfhi(b.y));
                        acc[ai][bj][m][n] = acc[ai][bj][m][n] * r; }
    }
    __device__ __forceinline__ void operator()(const f32x4 (&acc)[2][2][4][2], const pg8::GU& u, int wr, int wc) const {
        const int lane_ = lane_now(), fr = lane_ & 15, fq = lane_ >> 4;
        const size_t base = (size_t)(u.pm * 256 + wr * 64 + fr) * 1024 + u.pn * 256 + wc * 32 + 4 * fq;
#pragma unroll
        for (int ai = 0; ai < 2; ++ai)
#pragma unroll
            for (int m = 0; m < 4; ++m)
#pragma unroll
                for (int bj = 0; bj < 2; ++bj)
#pragma unroll
                    for (int n = 0; n < 2; ++n) { const size_t o = base + (size_t)(ai * 128 + m * 16) * 1024 + bj * 128 + n * 16;
                        const u32x2 b = *(const u32x2*)(GB + o); const f32x4 v = acc[ai][bj][m][n];
                        u32x2 w; w.x = pk2(v[0] * bflo(b.x), v[1] * bfhi(b.x)); w.y = pk2(v[2] * bflo(b.y), v[3] * bfhi(b.y));
                        *(u32x2*)(U + o) = w; }
    }
};
struct YEpi {
    static constexpr bool HAS_MID = false;
    bf16* Y;
    __device__ __forceinline__ void operator()(const f32x4 (&acc)[2][2][4][2], const pg8::GU& u, int wr, int wc) const {
        const int lane_ = lane_now(), fr = lane_ & 15, fq = lane_ >> 4;
        const size_t base = (size_t)(u.pm * 256 + wr * 64 + fr) * 1024 + u.pn * 256 + wc * 32 + 4 * fq;
#pragma unroll
        for (int ai = 0; ai < 2; ++ai)
#pragma unroll
            for (int m = 0; m < 4; ++m)
#pragma unroll
                for (int bj = 0; bj < 2; ++bj)
#pragma unroll
                    for (int n = 0; n < 2; ++n) { const f32x4 v = acc[ai][bj][m][n]; u32x2 w; w.x = pk2(v[0], v[1]); w.y = pk2(v[2], v[3]);
                        *(u32x2*)(Y + base + (size_t)(ai * 128 + m * 16) * 1024 + bj * 128 + n * 16) = w; }
    }
};
constexpr int MW_TSTART = 700, MW_ECN = 740;
__device__ __forceinline__ void moe_table(const Frame& F, const unsigned* ecnt) {
    if (FTID < 32) F.MISC[MW_ECN + FTID] = ecnt[FTID];
    __syncthreads();
    if (FTID == 0) { unsigned t = 0; for (int e = 0; e < 32; ++e) { F.MISC[MW_TSTART + e] = t; t += (F.MISC[MW_ECN + e] + 255u) >> 8; } F.MISC[MW_TSTART + 32] = t; }
    __syncthreads();
}
template <int NPN  , bool GU_PHASE>
struct MoeSched {
    const char* Abase; const char* Bbase; const int* rowlist; volatile LAS unsigned* MISC; int v, G;
    __device__ __forceinline__ bool next(int i, pg8::GU& u) const {
        const int id = i * G + v; const int tile = id / NPN, pn = id % NPN;
        if (tile >= (int)__builtin_amdgcn_readfirstlane(MISC[MW_TSTART + 32])) return false;
        int e = 0;
#pragma unroll
        for (int st = 16; st >= 1; st >>= 1) { if (tile >= (int)__builtin_amdgcn_readfirstlane(MISC[MW_TSTART + e + st])) e += st; }
        const int mt = tile - (int)__builtin_amdgcn_readfirstlane(MISC[MW_TSTART + e]);
        const int cnt_e = (int)__builtin_amdgcn_readfirstlane(MISC[MW_ECN + e]);
        u.pm = tile; u.pn = pn; u.e = e; u.cnt = min(256, cnt_e - mt * 256); u.rows = (unsigned)(e * ECAP + mt * 256);
        if (GU_PHASE) { u.a = 0u; u.b = (unsigned)(e * 2048 + pn * 128) * MOE_PITCH; }
        else { u.a = (unsigned)tile * 256u * MOE_PITCH; u.b = (unsigned)(e * 1024 + pn * 256) * MOE_PITCH; }
        return true;
    }
};
struct GuEpi {
    static constexpr bool HAS_MID = false;
    const float* b_gu; bf16* ACT;
    __device__ __forceinline__ void operator()(const f32x4 (&acc)[2][2][4][2], const pg8::GU& u, int wr, int wc) const {
        const int lane_ = lane_now(), fr = lane_ & 15, fq = lane_ >> 4;
        const int c0 = u.pn * 128 + wc * 16 + 4 * fq;
        f32x4 bg[2], bl[2];
#pragma unroll
        for (int bj = 0; bj < 2; ++bj) { bg[bj] = *(const f32x4*)(b_gu + u.e * 2048 + c0 + bj * 64); bl[bj] = *(const f32x4*)(b_gu + u.e * 2048 + 1024 + c0 + bj * 64); }
#pragma unroll
        for (int ai = 0; ai < 2; ++ai)
#pragma unroll
            for (int m = 0; m < 4; ++m) { const int r = ai * 128 + wr * 64 + m * 16 + fr;
                if (r < u.cnt) {
#pragma unroll
                    for (int bj = 0; bj < 2; ++bj) { constexpr float ws_ = MOE_FP8 ? 1.0f / W8_SCALE : 1.0f; const f32x4 g = acc[ai][bj][m][0] * ws_ + bg[bj], l = acc[ai][bj][m][1] * ws_ + bl[bj]; float a[4];
#pragma unroll
                        for (int j = 0; j < 4; ++j) { const float glu = fminf(g[j], SW_LIMIT), lin = fminf(fmaxf(l[j], -SW_LIMIT), SW_LIMIT);
                            a[j] = (lin + 1.0f) * glu * __builtin_amdgcn_rcpf(1.0f + __builtin_amdgcn_exp2f(-SW_ALPHA * LOG2E * glu)); }
                        if (MOE_FP8) *(unsigned*)((unsigned char*)ACT + (size_t)(u.pm * 256 + r) * DFF + c0 + bj * 64) = pk4_fp8(a[0] * ACT8_SCALE, a[1] * ACT8_SCALE, a[2] * ACT8_SCALE, a[3] * ACT8_SCALE);
                        else { u32x2 w; w.x = pk2(a[0], a[1]); w.y = pk2(a[2], a[3]); *(u32x2*)(ACT + (size_t)(u.pm * 256 + r) * DFF + c0 + bj * 64) = w; } } } }
    }
};
struct DnEpi {
    static constexpr bool HAS_MID = false;
    const float* b_dn; const int* LIST; const float* TOPW; bf16* YS;
    __device__ __forceinline__ void operator()(const f32x4 (&acc)[2][2][4][2], const pg8::GU& u, int wr, int wc) const {
        const int lane_ = lane_now(), fr = lane_ & 15, fq = lane_ >> 4;
        const int c0 = u.pn * 256 + wc * 32 + 4 * fq;
        f32x4 bb[2][2];
#pragma unroll
        for (int bj = 0; bj < 2; ++bj)
#pragma unroll
            for (int n = 0; n < 2; ++n) bb[bj][n] = *(const f32x4*)(b_dn + u.e * 1024 + c0 + bj * 128 + n * 16);
#pragma unroll
        for (int ai = 0; ai < 2; ++ai)
#pragma unroll
            for (int m = 0; m < 4; ++m) { const int r = ai * 128 + wr * 64 + m * 16 + fr;
                if (r < u.cnt) { const int a = LIST[u.rows + r]; const float w = TOPW[a];
#pragma unroll
                    for (int bj = 0; bj < 2; ++bj)
#pragma unroll
                        for (int n = 0; n < 2; ++n) { constexpr float ds_ = MOE_FP8 ? 1.0f / (W8_SCALE * ACT8_SCALE) : 1.0f; const f32x4 v = (acc[ai][bj][m][n] * ds_ + bb[bj][n]) * w; u32x2 o; o.x = pk2(v[0], v[1]); o.y = pk2(v[2], v[3]);
                            *(u32x2*)(YS + (size_t)a * DM + c0 + bj * 128 + n * 16) = o; } } }
    }
};

__global__ void __launch_bounds__(NWAVES * 64, 2) mk_fwd(MKArgs args) {
    extern __shared__ __attribute__((aligned(16))) unsigned char lds[];
    Frame F;
    F.lds = (LAS unsigned char*)lds; F.MISC = (volatile LAS unsigned*)(F.lds + MISC_OFF);
    F.wave = __builtin_amdgcn_readfirstlane(threadIdx.x >> 6);

    F.G = gridDim.x; { const int bx = blockIdx.x; F.vcu = (F.G % 8 == 0) ? (bx % 8) * (F.G / 8) + bx / 8 : bx; }
    unsigned char* ws = args.ws;
    F.ctl = (unsigned*)(ws + WS_CTL);
    const float* x = args.in[0]; const float* c = args.in[1]; const float* ctx = args.in[2]; const float* cctx = args.in[3];
    const float* w_mod = args.in[4]; const float* b_mod = args.in[5]; const float* g_pre_mix = args.in[6];
    const float* g_qn = args.in[12]; const float* g_kn = args.in[13];
    float* MOD = (float*)(ws + WS_MOD);
    bf16 *WTIN = (bf16*)(ws + WS_WTIN), *H = (bf16*)(ws + WS_H);
    for (int u = FTID; u < (LDS_BYTES - MISC_OFF) / 4; u += NWAVES * 64) ((LAS unsigned*)(F.lds + MISC_OFF))[u] = 0u;
    { LAS float* rt = (LAS float*)(F.lds + ROPE_OFF);
      for (int i = FTID; i < 64 * 16; i += NWAVES * 64) { const int pos = i >> 4, j = i & 15; const float f = powf(10000.0f, -(float)j / 16.0f); const float a = (float)pos * f; rt[2 * i] = cosf(a); rt[2 * i + 1] = sinf(a); } }
    __syncthreads();
    const bool use_bar = (args.ph_hi - args.ph_lo) > 1;
    XcdBarrier bar; bar.bar = F.ctl + CW_BAR + args.li * XCD_BAR_WORDS; bar.x = 0; bar.st = nullptr;
    if (use_bar) bar = xcd_barrier_post(F.ctl + CW_BAR + args.li * XCD_BAR_WORDS, F.MISC + 8);
    const int lo = args.ph_lo, hi = args.ph_hi;
#define IN(k) (lo <= (k) && (k) < hi)
#define BOTH(k) (IN(k) && IN((k) + 1))
#define GRID_BAR() xcd_barrier(bar, F.wave)

    if (IN(0)) {
        if (F.vcu < 192) {
            LAS float* sil = (LAS float*)(F.lds + RING_OFF);
            LAS float* red = (LAS float*)(F.lds + RING_OFF + 20480);
            const int tid = FTID, n0 = F.vcu * 32;
            for (int i = tid; i < 5 * 1024; i += 512) { const int r = i >> 10, k = i & 1023; const float v = r < 4 ? c[r * 1024 + k] : cctx[k]; sil[i] = v / (1.0f + __expf(-v)); }
            __syncthreads();
            const int cg = tid & 7, kr = tid >> 3;
            float acc[5][4];
#pragma unroll
            for (int r = 0; r < 5; ++r)
#pragma unroll
                for (int j = 0; j < 4; ++j) acc[r][j] = 0.f;
            for (int k = kr; k < 1024; k += 64) {
                const f32x4 w = *(const f32x4*)(w_mod + (size_t)k * 6144 + n0 + 4 * cg);
#pragma unroll
                for (int r = 0; r < 5; ++r) { const float s = sil[r * 1024 + k]; acc[r][0] += s * w[0]; acc[r][1] += s * w[1]; acc[r][2] += s * w[2]; acc[r][3] += s * w[3]; }
            }
#pragma unroll
            for (int r = 0; r < 5; ++r)
#pragma unroll
                for (int j = 0; j < 4; ++j) red[(kr * 5 + r) * 32 + 4 * cg + j] = acc[r][j];
            __syncthreads();
            if (tid < 160) { const int r = tid >> 5, n = tid & 31; float s = 0.f; for (int i = 0; i < 64; ++i) s += red[(i * 5 + r) * 32 + n]; MOD[r * 6144 + n0 + n] = s + b_mod[n0 + n]; }
            __syncthreads();
        }
        {
            WPtrs P{args.in[10], args.in[14], args.in[15], args.in[16], args.in[19], args.in[21], WTIN, (bf16*)(ws + WS_WTOAB), (bf16*)(ws + WS_WTO), (bf16*)(ws + WS_WTGU), (bf16*)(ws + WS_WTDN)};
            float* scr = (float*)(lds + RING_OFF + 61440 + F.wave * 8448);
            for (int it = F.vcu * NWAVES + F.wave; it < NITEMS_W; it += F.G * NWAVES) convert_item(P, it, scr, FLANE);
        }
        if (BOTH(0)) GRID_BAR();
    }
    if (IN(1)) {
        for (int row = F.vcu * NWAVES + F.wave; row < TR; row += F.G * NWAVES) hnorm_row(row, x, ctx, g_pre_mix, MOD, H, FLANE);
        if (BOTH(1)) GRID_BAR();
    }
    if (IN(2)) {
        ProjSched S{(const char*)H, (const char*)WTIN, nullptr, F.vcu, F.G};
        ProjEpi E{(bf16*)(ws + WS_QA), (bf16*)(ws + WS_KA), (bf16*)(ws + WS_VA), (bf16*)(ws + WS_QB), (bf16*)(ws + WS_KB), (bf16*)(ws + WS_VB), (bf16*)(ws + WS_GA), (bf16*)(ws + WS_GB), g_qn, g_kn, (const LAS float*)(F.lds + ROPE_OFF)};
        pg8::gemm_phase<ProjEpi, ProjSched, false, 1>(F.lds + RING_OFF, S, E, F.wave);
        if (BOTH(2)) GRID_BAR();
    }
    if (IN(3)) {
        { LAS float* rp = (LAS float*)(F.lds + NAX_OFF); const float* rpb = args.in[11];
          for (int i = FTID; i < 8 * 480; i += NWAVES * 64) { const int h = i / 480, rem = i % 480, ro = rem >> 5, co = rem & 31; rp[i] = co < 31 ? rpb[(h * 15 + ro) * 31 + co] * LOG2E : 0.f; } }
        __syncthreads();
        const bf16 *QAp = (const bf16*)(ws + WS_QA), *KAp = (const bf16*)(ws + WS_KA), *VAp = (const bf16*)(ws + WS_VA), *QBp = (const bf16*)(ws + WS_QB), *KBp = (const bf16*)(ws + WS_KB), *VBp = (const bf16*)(ws + WS_VB);
        bf16* Op = (bf16*)(ws + WS_O);
        for (int id = F.vcu; id < 512; id += F.G) {
            const int v = id & 255, i2 = id >> 8, bk = v >> 5, local = (v & 31) + 32 * i2;
            attn_body::gqa_unit<8>(bk >> 1, (bk & 1) * 4 + (local >> 4), local & 15, QBp, KBp, VBp, Op, (char*)lds + RING_OFF, F.wave);
        }
        for (int id = F.vcu; id < 256; id += F.G)
            attn_body::na_unit(id >> 6, id & 63, QAp, KAp, VAp, Op, (char*)lds + RING_OFF, (const float*)(lds + NAX_OFF), (float*)(lds + NAX_OFF + 15360), F.wave);
        if (BOTH(3)) GRID_BAR();
    }
    if (IN(4)) {
        Dense4Sched S{(const char*)(ws + WS_O), (const char*)(ws + WS_WTOAB), nullptr, F.vcu, F.G};
        UEpi E{(const bf16*)(ws + WS_GA), (const bf16*)(ws + WS_GB), (bf16*)(ws + WS_U)};
        pg8::gemm_phase<UEpi, Dense4Sched, false, 0>(F.lds + RING_OFF, S, E, F.wave);
        if (BOTH(4)) GRID_BAR();
    }
    if (IN(5)) {
        Dense4Sched S{(const char*)(ws + WS_U), (const char*)(ws + WS_WTO), nullptr, F.vcu, F.G};
        YEpi E{(bf16*)(ws + WS_Y)};
        pg8::gemm_phase<YEpi, Dense4Sched, false, 0>(F.lds + RING_OFF, S, E, F.wave);
        if (BOTH(5)) GRID_BAR();
    }
    if (IN(6)) {
        for (int blk = F.vcu; blk < T / 64; blk += F.G)
            rowpass_block(blk, x, (const bf16*)(ws + WS_Y), MOD, args.in[7], args.in[8], args.in[17], args.in[18], (bf16*)(ws + WS_H2), (float*)(ws + WS_RSTD1), (int*)(ws + WS_TOPE), (float*)(ws + WS_TOPW),
                          F.ctl + CW_ECNT, (int*)(ws + WS_LIST), lds + RING_OFF, lds + MISC_OFF + 256, F.wave);
        if (BOTH(6)) GRID_BAR();
    }
    if (IN(7)) {
        moe_table(F, F.ctl + CW_ECNT);
        MoeSched<8, true> S{(const char*)(ws + WS_H2), (const char*)(ws + WS_WTGU), (const int*)(ws + WS_LIST), F.MISC, F.vcu, F.G};
        GuEpi E{args.in[20], (bf16*)(ws + WS_ACT)};
        pg8::gemm_phase<GuEpi, MoeSched<8, true>, true, 2, MOE_FP8 != 0>(F.lds + RING_OFF, S, E, F.wave);
        if (BOTH(7)) GRID_BAR();
    }
    if (IN(8)) {
        moe_table(F, F.ctl + CW_ECNT);
        MoeSched<4, false> S{(const char*)(ws + WS_ACT), (const char*)(ws + WS_WTDN), (const int*)(ws + WS_LIST), F.MISC, F.vcu, F.G};
        DnEpi E{args.in[22], (const int*)(ws + WS_LIST), (const float*)(ws + WS_TOPW), (bf16*)(ws + WS_YS)};
        pg8::gemm_phase<DnEpi, MoeSched<4, false>, false, 0, MOE_FP8 != 0>(F.lds + RING_OFF, S, E, F.wave);
        if (BOTH(8)) GRID_BAR();
    }
    if (IN(9)) {
        for (int t = F.vcu * NWAVES + F.wave; t < T; t += F.G * NWAVES)
            final_row(t, x, (const bf16*)(ws + WS_Y), (const float*)(ws + WS_RSTD1), (const bf16*)(ws + WS_YS), MOD, args.in[7], args.in[9], args.out, FLANE);
    }
#undef IN
#undef BOTH
#undef GRID_BAR
}

#ifndef MK_SPLIT
#define MK_SPLIT 0
#endif
extern "C" void kernel_launch(void* const* d_in, const int* in_sizes, int n_in, void* d_out, int out_size, void* d_ws, size_t ws_size, hipStream_t stream) {
    static int grid = 0;
    if (grid == 0) {
        grid = -1;
        if (n_in != 23 || in_sizes[0] != T * DM || out_size != T * DM || ws_size < WS_END) { fprintf(stderr, "kernel_launch: unexpected shapes/workspace (n_in %d, ws %zu)\n", n_in, ws_size); return; }
        if (hipFuncSetAttribute((const void*)mk_fwd, hipFuncAttributeMaxDynamicSharedMemorySize, LDS_BYTES) != hipSuccess) { fprintf(stderr, "kernel_launch: hipFuncSetAttribute(mk_fwd) failed\n"); return; }
        int dev = 0, cus = 0, per_cu = 0;
        if (hipGetDevice(&dev) != hipSuccess || hipDeviceGetAttribute(&cus, hipDeviceAttributeMultiprocessorCount, dev) != hipSuccess) return;
        if (hipOccupancyMaxActiveBlocksPerMultiprocessor(&per_cu, (const void*)mk_fwd, NWAVES * 64, LDS_BYTES) != hipSuccess || per_cu < 1) { fprintf(stderr, "kernel_launch: occupancy query says %d blocks per CU\n", per_cu); (void)hipGetLastError(); return; }
        grid = cus;
    }
    if (grid < 0) return;
    const float* x = (const float*)d_in[0];
    const float* g_post_mix = (const float*)d_in[7]; const float* g_pre_ffn = (const float*)d_in[8]; const float* g_post_ffn = (const float*)d_in[9];
    const float* rpb = (const float*)d_in[11];
    const float* w_router = (const float*)d_in[17]; const float* b_router = (const float*)d_in[18];
    const float* b_gu = (const float*)d_in[20]; const float* b_dn = (const float*)d_in[22];
    unsigned char* ws = (unsigned char*)d_ws;
    float* MOD = (float*)(ws + WS_MOD); float* RSTD1 = (float*)(ws + WS_RSTD1); int* TOPE = (int*)(ws + WS_TOPE); float* TOPW = (float*)(ws + WS_TOPW);
    int* LIST = (int*)(ws + WS_LIST); unsigned* ECNT = (unsigned*)(ws + WS_CTL) + CW_ECNT;
    bf16 *WTOAB = (bf16*)(ws + WS_WTOAB), *WTO = (bf16*)(ws + WS_WTO), *WTGU = (bf16*)(ws + WS_WTGU), *WTDN = (bf16*)(ws + WS_WTDN);
    bf16 *QA = (bf16*)(ws + WS_QA), *KA = (bf16*)(ws + WS_KA), *VA = (bf16*)(ws + WS_VA), *QB = (bf16*)(ws + WS_QB), *KB = (bf16*)(ws + WS_KB), *VB = (bf16*)(ws + WS_VB);
    bf16 *GA = (bf16*)(ws + WS_GA), *GB = (bf16*)(ws + WS_GB), *O = (bf16*)(ws + WS_O), *U = (bf16*)(ws + WS_U), *Y = (bf16*)(ws + WS_Y), *H2 = (bf16*)(ws + WS_H2), *ACT = (bf16*)(ws + WS_ACT), *YS = (bf16*)(ws + WS_YS);
    float *PA = (float*)(ws + WS_PA), *PB = (float*)(ws + WS_PB);

    (void)hipMemsetAsync(ws + WS_CTL, 0, CTL_ZERO_BYTES, stream);
    MKArgs a{};
    for (int i = 0; i < 23; ++i) a.in[i] = (const float*)d_in[i];
    a.out = (float*)d_out; a.ws = ws;
    auto run = [&](int lo, int hi, int li) {
        if (MK_SPLIT) { for (int p = lo; p < hi; ++p) { a.ph_lo = p; a.ph_hi = p + 1; a.li = p; hipLaunchKernelGGL(mk_fwd, dim3(grid), dim3(NWAVES * 64), LDS_BYTES, stream, a); } }
        else { a.ph_lo = lo; a.ph_hi = hi; a.li = li; hipLaunchKernelGGL(mk_fwd, dim3(grid), dim3(NWAVES * 64), LDS_BYTES, stream, a); } };
    run(0, 10, 0);
}
```

```cpp
#include <hip/hip_runtime.h>
#include <cstdint>
#include <cstdio>

#define DEV __device__ __forceinline__
typedef unsigned short bf16;
typedef short bf16x8 __attribute__((ext_vector_type(8)));
typedef float f32x4 __attribute__((ext_vector_type(4)));
typedef unsigned u32x4 __attribute__((ext_vector_type(4)));
typedef unsigned u32x2 __attribute__((ext_vector_type(2)));

constexpr int DM = 1024, NBATCH = 4, SEQ = 4096, T = NBATCH * SEQ, CTXL = 256, TC = NBATCH * CTXL, TR = T + TC;
constexpr int GRIDW = 64, HD = 64;
constexpr int INC = 4352, KVC = 1280;
constexpr int C_KA = 0, C_VA = 512, C_KB = 1024, C_VB = 1152, C_QA = 1280, C_QB = 1792, C_GA = 2304, C_GB = 3328;
constexpr int NE = 32, TOPK = 4, DFF = 1024;
constexpr int NASG = T * TOPK;
constexpr int ECAP = T;
constexpr int ACT_ROWS = NASG + NE * 256;
constexpr float EPS = 1e-6f, LOG2E = 1.4426950408889634f, QSCALE = 0.125f * LOG2E;
constexpr float SW_LIMIT = 7.0f, SW_ALPHA = 1.702f;

constexpr size_t MiB = 1u << 20;
constexpr size_t WS_CTL = 0, CTL_ZERO_BYTES = 1 * MiB;
constexpr size_t WS_MOD = 1 * MiB;
constexpr size_t WS_ROPE = 1 * MiB + 128 * 1024;
constexpr size_t WS_RSTD1 = 1 * MiB + 256 * 1024;
constexpr size_t WS_TOPE = 1 * MiB + 512 * 1024;
constexpr size_t WS_TOPW = 1 * MiB + 768 * 1024;
constexpr size_t WS_LIST = 2 * MiB;
constexpr size_t WS_WTIN = 783 * MiB;
constexpr size_t WS_WTOAB = 13 * MiB;
constexpr size_t WS_WTO = 15 * MiB;
constexpr size_t WS_WTGU = 17 * MiB;
constexpr size_t WS_WTDN = 145 * MiB;
constexpr size_t WS_H = 209 * MiB;
constexpr size_t WS_QA = 243 * MiB;
constexpr size_t WS_KA = 259 * MiB;
constexpr size_t WS_VA = 276 * MiB;
constexpr size_t WS_QB = 293 * MiB;
constexpr size_t WS_KB = 309 * MiB;
constexpr size_t WS_VB = 314 * MiB;
constexpr size_t WS_GA = 319 * MiB;
constexpr size_t WS_GB = 351 * MiB;
constexpr size_t WS_O = 383 * MiB;
constexpr size_t WS_U = 415 * MiB;
constexpr size_t WS_Y = 447 * MiB;
constexpr size_t WS_H2 = 479 * MiB;
constexpr size_t WS_ACT = 511 * MiB;
constexpr size_t WS_YS = 655 * MiB;
constexpr size_t WS_END = 792 * MiB;
constexpr size_t WS_X1B = WS_QA;
constexpr size_t WS_CF32 = 479 * MiB;
constexpr size_t WS_PA = 511 * MiB, WS_PB = 575 * MiB;
static_assert(WS_CF32 + (size_t)TR * INC * 4 <= WS_END, "cf32 overlay");
constexpr int CW_ECNT = 2048;

#ifndef MOE_FP8
#define MOE_FP8 1
#endif
#ifndef PROJ_FP8
#define PROJ_FP8 1
#endif
constexpr int PROJ_PITCH = PROJ_FP8 ? 1024 : 2048;
constexpr float W8_SCALE = 32.0f, ACT8_SCALE = 4.0f, YS8_SCALE = 16.0f;
constexpr int MOE_PITCH = MOE_FP8 ? 1024 : 2048;
DEV unsigned f2bf(float f) { unsigned u = __builtin_bit_cast(unsigned, f); return (u + 0x7fffu + ((u >> 16) & 1u)) >> 16; }
typedef float f32x2_t __attribute__((ext_vector_type(2))); typedef __bf16 bf16x2_t __attribute__((ext_vector_type(2)));
DEV unsigned pk2(float lo, float hi) { f32x2_t v = {lo, hi}; bf16x2_t b = __builtin_convertvector(v, bf16x2_t); return __builtin_bit_cast(unsigned, b); }
DEV float bflo(unsigned w) { return __builtin_bit_cast(float, w << 16); }
DEV float bfhi(unsigned w) { return __builtin_bit_cast(float, w & 0xffff0000u); }
DEV unsigned pk4_fp8(float a, float b, float c, float d) {
    int w = __builtin_amdgcn_cvt_pk_fp8_f32(a, b, 0, false); w = __builtin_amdgcn_cvt_pk_fp8_f32(c, d, w, true); return (unsigned)w; }
DEV float bf2f(bf16 b) { return __builtin_bit_cast(float, ((unsigned)b) << 16); }
#define DPPF(v, ctrl) __builtin_bit_cast(float, __builtin_amdgcn_update_dpp(0, __builtin_bit_cast(int, (v)), (ctrl), 0xF, 0xF, true))
DEV float wave_sum(float v) {
    v += DPPF(v, 0xB1); v += DPPF(v, 0x4E); v += DPPF(v, 0x141); v += DPPF(v, 0x140);
    { auto r = __builtin_amdgcn_permlane16_swap(__float_as_uint(v), __float_as_uint(v), false, false); v = __uint_as_float(r[0]) + __uint_as_float(r[1]); }
    { auto r = __builtin_amdgcn_permlane32_swap(__float_as_uint(v), __float_as_uint(v), false, false); v = __uint_as_float(r[0]) + __uint_as_float(r[1]); }
    return v;
}
DEV float wave_max(float v) {
    v = fmaxf(v, DPPF(v, 0xB1)); v = fmaxf(v, DPPF(v, 0x4E)); v = fmaxf(v, DPPF(v, 0x141)); v = fmaxf(v, DPPF(v, 0x140));
    { auto r = __builtin_amdgcn_permlane16_swap(__float_as_uint(v), __float_as_uint(v), false, false); v = fmaxf(__uint_as_float(r[0]), __uint_as_float(r[1])); }
    { auto r = __builtin_amdgcn_permlane32_swap(__float_as_uint(v), __float_as_uint(v), false, false); v = fmaxf(__uint_as_float(r[0]), __uint_as_float(r[1])); }
    return v;
}
#ifndef WT_STORES
#define WT_STORES 1
#endif
DEV void wt16(void* base, unsigned off, u32x4 v) { if (WT_STORES) __builtin_amdgcn_raw_buffer_store_b128(v, __builtin_amdgcn_make_buffer_rsrc(base, 0, 0x7fffffff, 0x00020000), (int)off, 0, 16); else *(u32x4*)((char*)base + off) = v; }
DEV void wt8(void* base, unsigned off, u32x2 v) { *(u32x2*)((char*)base + off) = v; }
DEV void wt4(void* base, unsigned off, unsigned v) { *(unsigned*)((char*)base + off) = v; }
DEV int lane_now() { int l; asm volatile("v_mbcnt_lo_u32_b32 %0, -1, 0\n\tv_mbcnt_hi_u32_b32 %0, -1, %0" : "=v"(l)); return l; }
DEV float sigmoidf_(float x) { return 1.0f / (1.0f + __expf(-x)); }


DEV void transpose_item(const float* __restrict__ W, int K, int N, bf16* __restrict__ WT, int ld, int koff, float* scr, int item, int lane) {
    const int nblk = N / 32, kb = item / nblk, nb = item % nblk, k0 = 64 * kb, n0 = 32 * nb;
#pragma unroll 8
    for (int i = 0; i < 32; ++i) { const int kk = 2 * i + (lane >> 5); scr[kk * 33 + (lane & 31)] = __builtin_nontemporal_load(&W[(size_t)(k0 + kk) * N + n0 + (lane & 31)]); }
    __builtin_amdgcn_s_waitcnt(0xC07F); asm volatile("" ::: "memory");
    const int cch = lane & 7;
#pragma unroll
    for (int j = 0; j < 4; ++j) { const int n = (lane >> 3) + 8 * j; const float* s = scr + (8 * cch) * 33 + n;
        u32x4 o; o.x = pk2(s[0 * 33], s[1 * 33]); o.y = pk2(s[2 * 33], s[3 * 33]); o.z = pk2(s[4 * 33], s[5 * 33]); o.w = pk2(s[6 * 33], s[7 * 33]);
        *(u32x4*)(WT + (size_t)(n0 + n) * ld + koff + k0 + 8 * cch) = o; }
    __builtin_amdgcn_s_waitcnt(0xC07F); asm volatile("" ::: "memory");
}
DEV void transpose_item_fp8(const float* __restrict__ W, int K, int N, unsigned char* __restrict__ WT, float scale, float* scr, int item, int lane) {
    const int nblk = N / 32, kb = item / nblk, nb = item % nblk, k0 = 64 * kb, n0 = 32 * nb;
#pragma unroll 8
    for (int i = 0; i < 32; ++i) { const int kk = 2 * i + (lane >> 5); scr[kk * 33 + (lane & 31)] = __builtin_nontemporal_load(&W[(size_t)(k0 + kk) * N + n0 + (lane & 31)]); }
    __builtin_amdgcn_s_waitcnt(0xC07F); asm volatile("" ::: "memory");
    const int cch = lane & 7;
#pragma unroll
    for (int j = 0; j < 4; ++j) { const int n = (lane >> 3) + 8 * j; const float* s = scr + (8 * cch) * 33 + n;
        u32x2 o; o.x = pk4_fp8(s[0 * 33] * scale, s[1 * 33] * scale, s[2 * 33] * scale, s[3 * 33] * scale); o.y = pk4_fp8(s[4 * 33] * scale, s[5 * 33] * scale, s[6 * 33] * scale, s[7 * 33] * scale);
        wt8(WT, (unsigned)((n0 + n) * K + k0 + 8 * cch), o); }
    __builtin_amdgcn_s_waitcnt(0xC07F); asm volatile("" ::: "memory");
}
struct WPtrs { const float *w_in, *w_oa, *w_ob, *w_o, *w_gu, *w_dn; bf16 *t_in, *t_oab, *t_o, *t_gu, *t_dn; };
constexpr int I_IN = 16 * 136, I_OA = 8 * 32, I_O = 16 * 32, I_GU = 16 * 64, I_DN = 16 * 32;
constexpr int NITEMS_W = I_IN + 2 * I_OA + I_O + NE * (I_GU + I_DN);
DEV void convert_item(const WPtrs& P, int it, float* scr, int lane) {
    int r = it;
    if (r < I_IN) { if (PROJ_FP8) transpose_item_fp8(P.w_in, 1024, INC, (unsigned char*)P.t_in, W8_SCALE, scr, r, lane); else transpose_item(P.w_in, 1024, INC, P.t_in, 1024, 0, scr, r, lane); return; } r -= I_IN;
    if (r < I_OA) { transpose_item(P.w_oa, 512, 1024, P.t_oab, 1024, 0, scr, r, lane); return; } r -= I_OA;
    if (r < I_OA) { transpose_item(P.w_ob, 512, 1024, P.t_oab, 1024, 512, scr, r, lane); return; } r -= I_OA;
    if (r < I_O) { transpose_item(P.w_o, 1024, 1024, P.t_o, 1024, 0, scr, r, lane); return; } r -= I_O;
    if (r < NE * I_GU) { const int e = r / I_GU;
        if (MOE_FP8) transpose_item_fp8(P.w_gu + (size_t)e * 1024 * 2048, 1024, 2048, (unsigned char*)P.t_gu + (size_t)e * 2048 * 1024, W8_SCALE, scr, r % I_GU, lane);
        else transpose_item(P.w_gu + (size_t)e * 1024 * 2048, 1024, 2048, P.t_gu + (size_t)e * 2048 * 1024, 1024, 0, scr, r % I_GU, lane);
        return; } r -= NE * I_GU;
    { const int e = r / I_DN;
        if (MOE_FP8) transpose_item_fp8(P.w_dn + (size_t)e * 1024 * 1024, 1024, 1024, (unsigned char*)P.t_dn + (size_t)e * 1024 * 1024, W8_SCALE, scr, r % I_DN, lane);
        else transpose_item(P.w_dn + (size_t)e * 1024 * 1024, 1024, 1024, P.t_dn + (size_t)e * 1024 * 1024, 1024, 0, scr, r % I_DN, lane); }
}


DEV void hnorm_rows4(int r0, int stride, const float* __restrict__ x, const float* __restrict__ g, const float* __restrict__ mod, bf16* __restrict__ H, int lane) {
    f32x4 v[4][4], sh[2][4], sc[2][4], gg[4];
#pragma unroll
    for (int a = 0; a < 4; ++a)
#pragma unroll
        for (int j = 0; j < 4; ++j) v[a][j] = __builtin_nontemporal_load((const f32x4*)(x + (size_t)(r0 + a * stride) * DM + 4 * lane + 256 * j));
#pragma unroll
    for (int p = 0; p < 2; ++p) { const float* mrow = mod + ((r0 + 2 * p * stride) / SEQ) * 6144;
#pragma unroll
        for (int j = 0; j < 4; ++j) { sh[p][j] = *(const f32x4*)(mrow + 4 * lane + 256 * j); sc[p][j] = *(const f32x4*)(mrow + 1024 + 4 * lane + 256 * j); } }
#pragma unroll
    for (int j = 0; j < 4; ++j) gg[j] = *(const f32x4*)(g + 4 * lane + 256 * j);
    float rstd[4];
#pragma unroll
    for (int a = 0; a < 4; ++a) { float ss = 0.f;
#pragma unroll
        for (int j = 0; j < 4; ++j) ss += v[a][j][0] * v[a][j][0] + v[a][j][1] * v[a][j][1] + v[a][j][2] * v[a][j][2] + v[a][j][3] * v[a][j][3];
        rstd[a] = rsqrtf(wave_sum(ss) * (1.0f / DM) + EPS); }
    unsigned d[4][4];
#pragma unroll
    for (int a = 0; a < 4; ++a)
#pragma unroll
        for (int j = 0; j < 4; ++j) { float o[4];
#pragma unroll
            for (int q = 0; q < 4; ++q) o[q] = v[a][j][q] * rstd[a] * gg[j][q] * (1.0f + sc[a >> 1][j][q]) + sh[a >> 1][j][q];
            d[a][j] = pk4_fp8(o[0], o[1], o[2], o[3]); }
    const bool b0 = (lane & 1) != 0, b1 = (lane & 2) != 0;
#pragma unroll
    for (int a = 0; a < 4; ++a) {
        unsigned pq[4], e[4];
#pragma unroll
        for (int j = 0; j < 4; ++j) pq[j] = (unsigned)__builtin_amdgcn_mov_dpp((int)d[a][j], 0xB1, 0xF, 0xF, true);
        e[0] = b0 ? pq[1] : d[a][0]; e[1] = b0 ? d[a][1] : pq[0]; e[2] = b0 ? pq[3] : d[a][2]; e[3] = b0 ? d[a][3] : pq[2];
#pragma unroll
        for (int j = 0; j < 4; ++j) pq[j] = (unsigned)__builtin_amdgcn_mov_dpp((int)e[j], 0x4E, 0xF, 0xF, true);
        u32x4 w; w.x = b1 ? pq[2] : e[0]; w.y = b1 ? pq[3] : e[1]; w.z = b1 ? e[2] : pq[0]; w.w = b1 ? e[3] : pq[1];
        wt16(H, (unsigned)((r0 + a * stride) * DM + 256 * (lane & 3) + 16 * (lane >> 2)), w);
    }
}
DEV void hnorm_row(int row, const float* __restrict__ x, const float* __restrict__ ctx, const float* __restrict__ g, const float* __restrict__ mod, bf16* __restrict__ H, int lane) {
    const float* src = row < T ? x + (size_t)row * DM : ctx + (size_t)(row - T) * DM;
    const float* mrow = mod + (row < T ? (row / SEQ) : 4) * 6144;
    f32x4 v[4]; float ss = 0.f;
#pragma unroll
    for (int j = 0; j < 4; ++j) { v[j] = __builtin_nontemporal_load((const f32x4*)(src + 4 * lane + 256 * j)); ss += v[j][0] * v[j][0] + v[j][1] * v[j][1] + v[j][2] * v[j][2] + v[j][3] * v[j][3]; }
    const float rstd = rsqrtf(wave_sum(ss) * (1.0f / DM) + EPS);
#pragma unroll
    for (int j = 0; j < 4; ++j) {
        const int cidx = 4 * lane + 256 * j;
        const f32x4 gg = *(const f32x4*)(g + cidx), sh = *(const f32x4*)(mrow + cidx), sc = *(const f32x4*)(mrow + 1024 + cidx);
        float o[4];
#pragma unroll
        for (int q = 0; q < 4; ++q) o[q] = v[j][q] * rstd * gg[q] * (1.0f + sc[q]) + sh[q];
        if (PROJ_FP8) wt4(H, (unsigned)(row * DM + cidx), pk4_fp8(o[0], o[1], o[2], o[3]));
        else { u32x2 w; w.x = pk2(o[0], o[1]); w.y = pk2(o[2], o[3]); *(u32x2*)(H + (size_t)row * DM + cidx) = w; }
    }
}


DEV void route_token(float (&pl)[32], int t, int la0, int lane, const float* __restrict__ b_router, int* __restrict__ TOPE, float* __restrict__ TOPW, unsigned* hist, unsigned* asg_e, unsigned* asg_p, float* asg_w) {
#define RP_STEP(D, H) _Pragma("unroll") for (int i = 0; i < H; ++i) { const bool up = (lane & D) != 0; const float snd = up ? pl[i] : pl[i + H]; const float kp = up ? pl[i + H] : pl[i]; pl[i] = kp + __shfl_xor(snd, D); }
#pragma unroll
    for (int i = 0; i < 16; ++i) { auto r = __builtin_amdgcn_permlane32_swap(__float_as_uint(pl[i]), __float_as_uint(pl[i + 16]), false, false); pl[i] = __uint_as_float(r[0]) + __uint_as_float(r[1]); }
#pragma unroll
    for (int i = 0; i < 8; ++i) { auto r = __builtin_amdgcn_permlane16_swap(__float_as_uint(pl[i]), __float_as_uint(pl[i + 8]), false, false); pl[i] = __uint_as_float(r[0]) + __uint_as_float(r[1]); }
    RP_STEP(8, 4) RP_STEP(4, 2) RP_STEP(2, 1)
#undef RP_STEP
    float logit = pl[0] + __shfl_xor(pl[0], 1);
    logit += b_router[lane >> 1];
    float val = (lane & 1) ? -INFINITY : logit;
    float tl[4]; int te[4];
#pragma unroll
    for (int k = 0; k < 4; ++k) {
        const float mx = wave_max(val);
        const unsigned long long bal = __ballot(val == mx);
        const int wl = __ffsll((long long)bal) - 1;
        tl[k] = mx; te[k] = wl >> 1;
        if (lane == wl) val = -INFINITY;
    }
    const float e1 = __expf(tl[1] - tl[0]), e2 = __expf(tl[2] - tl[0]), e3 = __expf(tl[3] - tl[0]);
    const float inv = 1.0f / (1.0f + e1 + e2 + e3);
    if (lane < 4) {
        const int ek = lane == 0 ? te[0] : lane == 1 ? te[1] : lane == 2 ? te[2] : te[3];
        const float wk = (lane == 0 ? 1.0f : lane == 1 ? e1 : lane == 2 ? e2 : e3) * inv;
        TOPE[t * 4 + lane] = ek; TOPW[t * 4 + lane] = wk;
        const unsigned p = atomicAdd(&hist[ek], 1u);
        asg_e[la0 + lane] = (unsigned)ek; asg_p[la0 + lane] = p; asg_w[la0 + lane] = wk;
    }
}
constexpr int RP_WSTRIDE = 1028;
DEV void rowpass_block(int blk, const float* __restrict__ x, const bf16* __restrict__ Y, const float* __restrict__ mod, const float* __restrict__ g_post_mix, const float* __restrict__ g_pre_ffn,
                       const float* __restrict__ w_router, const float* __restrict__ b_router, bf16* __restrict__ H2, float* __restrict__ RSTD1, int* __restrict__ TOPE, float* __restrict__ TOPW,
                       unsigned* __restrict__ ecnt, int* __restrict__ LIST, unsigned char* lds, unsigned char* lds_small, int wave, bf16* __restrict__ X1B) {
    float* wr = (float*)lds;
    unsigned* hist = (unsigned*)lds_small;
    unsigned* base = hist + 32;
    unsigned* asg_e = base + 32;
    unsigned* asg_p = asg_e + 256;
    float* asg_w = (float*)(asg_p + 256);
    const int lane = lane_now(), tid = wave * 64 + lane;
    for (int i = tid; i < 8 * 1024; i += 512) { const int k = i >> 3, c = i & 7; const f32x4 w = *(const f32x4*)(w_router + k * 32 + 4 * c);
        wr[(4 * c + 0) * RP_WSTRIDE + k] = w[0]; wr[(4 * c + 1) * RP_WSTRIDE + k] = w[1]; wr[(4 * c + 2) * RP_WSTRIDE + k] = w[2]; wr[(4 * c + 3) * RP_WSTRIDE + k] = w[3]; }
    if (tid < 32) hist[tid] = 0u;
    __syncthreads();
    const int t0 = blk * 64, b = t0 / SEQ;
    const float* mrow = mod + b * 6144;
    f32x4 xn[2][4]; u32x2 yn[2][4];
#pragma unroll
    for (int u = 0; u < 2; ++u)
#pragma unroll
        for (int j = 0; j < 4; ++j) { const int t = t0 + wave * 8 + u; xn[u][j] = __builtin_nontemporal_load((const f32x4*)(x + (size_t)t * DM + 4 * lane + 256 * j)); yn[u][j] = __builtin_nontemporal_load((const u32x2*)(Y + (size_t)t * DM + 4 * lane + 256 * j)); }
#pragma unroll 1
    for (int it = 0; it < 4; ++it) {
        float xv[2][16];
        int lofs = 4 * lane; asm volatile("" : "+v"(lofs));
        f32x4 xc[2][4]; u32x2 yc[2][4];
#pragma unroll
        for (int u = 0; u < 2; ++u)
#pragma unroll
            for (int j = 0; j < 4; ++j) { xc[u][j] = xn[u][j]; yc[u][j] = yn[u][j]; }
        if (it < 3) {
#pragma unroll
            for (int u = 0; u < 2; ++u)
#pragma unroll
                for (int j = 0; j < 4; ++j) { const int t = t0 + wave * 8 + (it + 1) * 2 + u; xn[u][j] = __builtin_nontemporal_load((const f32x4*)(x + (size_t)t * DM + lofs + 256 * j)); yn[u][j] = __builtin_nontemporal_load((const u32x2*)(Y + (size_t)t * DM + lofs + 256 * j)); }
        }
#pragma unroll
        for (int u = 0; u < 2; ++u) {
            const int t = t0 + wave * 8 + it * 2 + u;
            float yv[16]; float ss = 0.f;
#pragma unroll
            for (int j = 0; j < 4; ++j) {
                const u32x2 yw = yc[u][j];
                yv[4 * j] = bflo(yw.x); yv[4 * j + 1] = bfhi(yw.x); yv[4 * j + 2] = bflo(yw.y); yv[4 * j + 3] = bfhi(yw.y);
                const f32x4 xx = xc[u][j];
                xv[u][4 * j] = xx[0]; xv[u][4 * j + 1] = xx[1]; xv[u][4 * j + 2] = xx[2]; xv[u][4 * j + 3] = xx[3];
#pragma unroll
                for (int q = 0; q < 4; ++q) ss += yv[4 * j + q] * yv[4 * j + q];
            }
            const float rstd1 = rsqrtf(wave_sum(ss) * (1.0f / DM) + EPS);
            if (lane == 0) RSTD1[t] = rstd1;
            float ss2 = 0.f;
#pragma unroll
            for (int j = 0; j < 4; ++j) {
                const int cidx = lofs + 256 * j;
                const f32x4 gt = *(const f32x4*)(mrow + 2048 + cidx), gp = *(const f32x4*)(g_post_mix + cidx);
#pragma unroll
                for (int q = 0; q < 4; ++q) { const float x1 = xv[u][4 * j + q] + gt[q] * (yv[4 * j + q] * rstd1 * gp[q]); xv[u][4 * j + q] = x1; ss2 += x1 * x1; }
                { u32x2 xw; xw.x = pk2(xv[u][4 * j], xv[u][4 * j + 1]); xw.y = pk2(xv[u][4 * j + 2], xv[u][4 * j + 3]); *(u32x2*)(X1B + (size_t)t * DM + cidx) = xw; }
            }
            const float rstd2 = rsqrtf(wave_sum(ss2) * (1.0f / DM) + EPS);
#pragma unroll
            for (int j = 0; j < 4; ++j) {
                const int cidx = lofs + 256 * j;
                const f32x4 gf = *(const f32x4*)(g_pre_ffn + cidx), sh = *(const f32x4*)(mrow + 3072 + cidx), sc = *(const f32x4*)(mrow + 4096 + cidx);
#pragma unroll
                for (int q = 0; q < 4; ++q) xv[u][4 * j + q] = xv[u][4 * j + q] * rstd2 * gf[q] * (1.0f + sc[q]) + sh[q];
                if (MOE_FP8) wt4(H2, (unsigned)(t * DM + cidx), pk4_fp8(xv[u][4 * j], xv[u][4 * j + 1], xv[u][4 * j + 2], xv[u][4 * j + 3]));
                else { u32x2 w; w.x = pk2(xv[u][4 * j], xv[u][4 * j + 1]); w.y = pk2(xv[u][4 * j + 2], xv[u][4 * j + 3]); *(u32x2*)(H2 + (size_t)t * DM + cidx) = w; }
            }
        }
        using f32x2 = __attribute__((ext_vector_type(2))) float;
        f32x2 xp[16];
#pragma unroll
        for (int k = 0; k < 16; ++k) xp[k] = (f32x2){xv[0][k], xv[1][k]};
        float pl0[32], pl1[32];
#pragma unroll
        for (int e2 = 0; e2 < 32; e2 += 2) {
            f32x4 w[2][4];
#pragma unroll
            for (int q = 0; q < 2; ++q)
#pragma unroll
                for (int j = 0; j < 4; ++j) w[q][j] = *(const f32x4*)(wr + (e2 + q) * RP_WSTRIDE + lofs + 256 * j);
#pragma unroll
            for (int q = 0; q < 2; ++q) {
                f32x2 a = (f32x2){0.f, 0.f}, b2 = (f32x2){0.f, 0.f};
#pragma unroll
                for (int j = 0; j < 4; ++j) {
                    a = xp[4 * j] * (f32x2){w[q][j][0], w[q][j][0]} + a; b2 = xp[4 * j + 1] * (f32x2){w[q][j][1], w[q][j][1]} + b2;
                    a = xp[4 * j + 2] * (f32x2){w[q][j][2], w[q][j][2]} + a; b2 = xp[4 * j + 3] * (f32x2){w[q][j][3], w[q][j][3]} + b2; }
                a = a + b2;
                asm volatile("" : "+v"(a));
                pl0[e2 + q] = a.x; pl1[e2 + q] = a.y;
            }
            __builtin_amdgcn_sched_barrier(0);
        }
        route_token(pl0, t0 + wave * 8 + it * 2, (wave * 8 + it * 2) * 4, lane, b_router, TOPE, TOPW, hist, asg_e, asg_p, asg_w);
        route_token(pl1, t0 + wave * 8 + it * 2 + 1, (wave * 8 + it * 2 + 1) * 4, lane, b_router, TOPE, TOPW, hist, asg_e, asg_p, asg_w);
    }
    __syncthreads();
    if (tid < 32) base[tid] = atomicAdd(&ecnt[tid], hist[tid]);
    __syncthreads();
    if (tid < 256) { const unsigned e = asg_e[tid]; u32x2 ent; ent.x = (unsigned)(t0 * 4 + tid); ent.y = __builtin_bit_cast(unsigned, asg_w[tid]); *(u32x2*)(LIST + 2 * ((size_t)e * ECAP + base[e] + asg_p[tid])) = ent; }
    __syncthreads();
}

DEV void final_rows2(int t0, int t1, const bf16* __restrict__ X1B, const bf16* __restrict__ YS, const float* __restrict__ mod, const float* __restrict__ g_post_ffn, float* __restrict__ out, int lane) {
    const float* mrow = mod + (t0 / SEQ) * 6144;
    const int tt[2] = {t0, t1};
    unsigned w[2][4][4]; u32x2 xw[2][4];
#pragma unroll
    for (int a = 0; a < 2; ++a) {
#pragma unroll
        for (int j = 0; j < 4; ++j)
#pragma unroll
            for (int k = 0; k < 4; ++k) w[a][j][k] = __builtin_nontemporal_load((const unsigned*)((const unsigned char*)YS + (size_t)(tt[a] * 4 + k) * DM + 4 * lane + 256 * j));
#pragma unroll
        for (int j = 0; j < 4; ++j) xw[a][j] = __builtin_nontemporal_load((const u32x2*)(X1B + (size_t)tt[a] * DM + 4 * lane + 256 * j));
    }
    float f[2][16], ss[2];
#pragma unroll
    for (int a = 0; a < 2; ++a) { ss[a] = 0.f;
#pragma unroll
        for (int j = 0; j < 4; ++j) { float a0 = 0.f, a1 = 0.f, a2 = 0.f, a3 = 0.f;
#pragma unroll
            for (int k = 0; k < 4; ++k) { const auto lo = __builtin_amdgcn_cvt_pk_f32_fp8((int)w[a][j][k], false), hi = __builtin_amdgcn_cvt_pk_f32_fp8((int)w[a][j][k], true); a0 += lo[0]; a1 += lo[1]; a2 += hi[0]; a3 += hi[1]; }
            a0 *= 1.0f / YS8_SCALE; a1 *= 1.0f / YS8_SCALE; a2 *= 1.0f / YS8_SCALE; a3 *= 1.0f / YS8_SCALE;
            f[a][4 * j] = a0; f[a][4 * j + 1] = a1; f[a][4 * j + 2] = a2; f[a][4 * j + 3] = a3;
            ss[a] += a0 * a0 + a1 * a1 + a2 * a2 + a3 * a3; } }
    const float rstdf[2] = {rsqrtf(wave_sum(ss[0]) * (1.0f / DM) + EPS), rsqrtf(wave_sum(ss[1]) * (1.0f / DM) + EPS)};
#pragma unroll
    for (int j = 0; j < 4; ++j) {
        const int cidx = 4 * lane + 256 * j;
        const f32x4 gt2 = *(const f32x4*)(mrow + 5120 + cidx), gf = *(const f32x4*)(g_post_ffn + cidx);
#pragma unroll
        for (int a = 0; a < 2; ++a) {
            const float xv[4] = {bflo(xw[a][j].x), bfhi(xw[a][j].x), bflo(xw[a][j].y), bfhi(xw[a][j].y)};
            f32x4 o;
#pragma unroll
            for (int q = 0; q < 4; ++q) o[q] = xv[q] + gt2[q] * (f[a][4 * j + q] * rstdf[a] * gf[q]);
            __builtin_nontemporal_store(o, (f32x4*)(out + (size_t)tt[a] * DM + cidx)); }
    }
}
DEV void final_row(int t, const float* __restrict__ x, const bf16* __restrict__ Y, const float* __restrict__ RSTD1, const bf16* __restrict__ YS, const float* __restrict__ mod,
                   const float* __restrict__ g_post_mix, const float* __restrict__ g_post_ffn, float* __restrict__ out, int lane) {
    const float* mrow = mod + (t / SEQ) * 6144;
    const float rstd1 = RSTD1[t];
    float f[16]; float ss = 0.f;
#pragma unroll
    for (int j = 0; j < 4; ++j) {
        float a0 = 0.f, a1 = 0.f, a2 = 0.f, a3 = 0.f;
#pragma unroll
        for (int k = 0; k < 4; ++k) {
            if (MOE_FP8) { const unsigned w = __builtin_nontemporal_load((const unsigned*)((const unsigned char*)YS + (size_t)(t * 4 + k) * DM + 4 * lane + 256 * j));
                const auto lo = __builtin_amdgcn_cvt_pk_f32_fp8((int)w, false), hi = __builtin_amdgcn_cvt_pk_f32_fp8((int)w, true); a0 += lo[0]; a1 += lo[1]; a2 += hi[0]; a3 += hi[1]; }
            else { const u32x2 w = *(const u32x2*)(YS + (size_t)(t * 4 + k) * DM + 4 * lane + 256 * j); a0 += bflo(w.x); a1 += bfhi(w.x); a2 += bflo(w.y); a3 += bfhi(w.y); } }
        if (MOE_FP8) { a0 *= 1.0f / YS8_SCALE; a1 *= 1.0f / YS8_SCALE; a2 *= 1.0f / YS8_SCALE; a3 *= 1.0f / YS8_SCALE; }
        f[4 * j] = a0; f[4 * j + 1] = a1; f[4 * j + 2] = a2; f[4 * j + 3] = a3;
        ss += a0 * a0 + a1 * a1 + a2 * a2 + a3 * a3;
    }
    const float rstdf = rsqrtf(wave_sum(ss) * (1.0f / DM) + EPS);
#pragma unroll
    for (int j = 0; j < 4; ++j) {
        const int cidx = 4 * lane + 256 * j;
        const f32x4 xx = __builtin_nontemporal_load((const f32x4*)(x + (size_t)t * DM + cidx));
        const u32x2 yw = __builtin_nontemporal_load((const u32x2*)(Y + (size_t)t * DM + cidx));
        const f32x4 gt1 = *(const f32x4*)(mrow + 2048 + cidx), gt2 = *(const f32x4*)(mrow + 5120 + cidx), gp = *(const f32x4*)(g_post_mix + cidx), gf = *(const f32x4*)(g_post_ffn + cidx);
        const float yv[4] = {bflo(yw.x), bfhi(yw.x), bflo(yw.y), bfhi(yw.y)};
        f32x4 o;
#pragma unroll
        for (int q = 0; q < 4; ++q) o[q] = xx[q] + gt1[q] * (yv[q] * rstd1 * gp[q]) + gt2[q] * (f[4 * j + q] * rstdf * gf[q]);
        __builtin_nontemporal_store(o, (f32x4*)(out + (size_t)t * DM + cidx));
    }
}


#define LAS __attribute__((address_space(3)))
#define GAS __attribute__((address_space(1)))
typedef GAS unsigned gu32;
#define RLX_AGENT __ATOMIC_RELAXED, __HIP_MEMORY_SCOPE_AGENT
constexpr int NWAVES = 8;
#ifndef PROBE_SEL
#define PROBE_SEL 0
#endif
constexpr int MW_PROBE = 1000;
#define PROBE_BEGIN(id) unsigned long long _pb##id = 0; if (PROBE_SEL == (id)) _pb##id = __builtin_amdgcn_s_memrealtime();
#define PROBE_MARK(id) do { if (PROBE_SEL == (id) && F.wave == 0) { const unsigned _d = (unsigned)(__builtin_amdgcn_s_memrealtime() - _pbstart); if (lane_now() == 0) __hip_atomic_fetch_add((LAS unsigned*)(F.lds + MISC_OFF) + MW_PROBE, _d, __ATOMIC_RELAXED, __HIP_MEMORY_SCOPE_WORKGROUP); } } while (0)
#define PROBE_END(id, miscp) do { if (PROBE_SEL == (id)) { const unsigned _d = (unsigned)(__builtin_amdgcn_s_memrealtime() - _pb##id); if (lane_now() == 0) __hip_atomic_fetch_add((LAS unsigned*)(miscp) + MW_PROBE, _d, __ATOMIC_RELAXED, __HIP_MEMORY_SCOPE_WORKGROUP); } } while (0)

constexpr int RING_OFF = 0, RING_BYTES = 131072;
constexpr int ROPE_OFF = 131072;
constexpr int MISC_OFF = 139264;
constexpr int NAX_OFF = 143360;
constexpr int LDS_BYTES = 163840;
constexpr int CW_TMO = 0, CW_CODE = 1, CW_BAR = 4096;

#define XB_TMO      128
#define XB_XCNT(j)  (256  + 64 * (j))
#define XB_XSUB(j)  (1280 + 64 * (j))
#define XB_XGEN(j)  (2304 + 64 * (j))
#define XB_TOP      3328
#define XB_TOPGEN   3392
#define XCD_BAR_WORDS 3456
#define XB_SPIN_CAP (1u << 18)
__device__ __forceinline__ unsigned xb_ld(unsigned* p)              { return __hip_atomic_load(p, __ATOMIC_RELAXED, __HIP_MEMORY_SCOPE_AGENT); }
__device__ __forceinline__ unsigned xb_add(unsigned* p, unsigned v) { return __hip_atomic_fetch_add(p, v, __ATOMIC_RELAXED, __HIP_MEMORY_SCOPE_AGENT); }
__device__ __forceinline__ unsigned xb_xcc_id() { return (unsigned)__builtin_amdgcn_s_getreg((3 << 11) | 20) & 0xFu; }
#define XB_SPIN(cond, bar) do { unsigned _sp = 0; while (cond) { __builtin_amdgcn_s_sleep(1); \
    if ((++_sp & 255u) == 0u) { if (xb_ld(&(bar)[XB_TMO])) break; if (_sp > XB_SPIN_CAP) { atomicAdd(&(bar)[XB_TMO], 1u); break; } } } } while (0)
struct XcdBarrier { unsigned* bar; unsigned x; volatile LAS unsigned* st; };
__device__ __forceinline__ XcdBarrier xcd_barrier_post(unsigned* bar, volatile LAS unsigned* st) {
    XcdBarrier b; b.bar = bar; b.x = xb_xcc_id(); b.st = st;
    if (threadIdx.x == 0) (void)xb_add(&bar[XB_XCNT(b.x)], 1u);
    return b;
}
__device__ __forceinline__ void xcd_barrier_complete(unsigned* bar, unsigned x, unsigned& nloc, unsigned& nx) {
    const unsigned G = gridDim.x * gridDim.y * gridDim.z;
    unsigned sum, cnt, mine, sp = 0u;
    for (;;) {
        sum = 0u; cnt = 0u; mine = 0u;
#pragma unroll
        for (unsigned j = 0; j < 16; ++j) { const unsigned c = xb_ld(&bar[XB_XCNT(j)]); sum += c; cnt += (c > 0u) ? 1u : 0u; mine = (j == x) ? c : mine; }
        if (sum == G) break;
        __builtin_amdgcn_s_sleep(1);
        if ((++sp & 255u) == 0u) { if (xb_ld(&bar[XB_TMO])) break; if (sp > XB_SPIN_CAP) { atomicAdd(&bar[XB_TMO], 1u); break; } }
    }
    nloc = mine > 0u ? mine : 1u; nx = cnt > 0u ? cnt : 1u;
}
__device__ __forceinline__ void xcd_barrier(const XcdBarrier& b, int wave) {
    asm volatile("s_waitcnt vmcnt(0)" ::: "memory");
    __syncthreads();
    if (wave == 0 && lane_now() == 0) {
        unsigned* bar = b.bar;
        __builtin_amdgcn_s_waitcnt(0);
        unsigned nloc = b.st[0], nx = b.st[1];
        if (nloc == 0u) { xcd_barrier_complete(bar, b.x, nloc, nx); b.st[0] = nloc; b.st[1] = nx; }
        const unsigned old = xb_add(&bar[XB_XSUB(b.x)], 1u);
        const unsigned gen = old / nloc;
        if (old + 1u == (gen + 1u) * nloc) {
            __builtin_amdgcn_fence(__ATOMIC_RELEASE, "agent");
            asm volatile("s_waitcnt vmcnt(0)" ::: "memory");
            const unsigned og = xb_add(&bar[XB_TOP], 1u);
            const unsigned tg = og / nx;
            if (og + 1u == (tg + 1u) * nx) xb_add(&bar[XB_TOPGEN], 1u);
            else XB_SPIN(xb_ld(&bar[XB_TOPGEN]) == tg, bar);
            __builtin_amdgcn_fence(__ATOMIC_ACQUIRE, "agent");
            xb_add(&bar[XB_XGEN(b.x)], 1u);
            asm volatile("s_waitcnt vmcnt(0)" ::: "memory");
        } else {
            XB_SPIN(xb_ld(&bar[XB_XGEN(b.x)]) == gen, bar);
            __builtin_amdgcn_fence(__ATOMIC_ACQUIRE, "agent");
            asm volatile("s_waitcnt vmcnt(0)" ::: "memory");
        }
    }
    __syncthreads();
}


constexpr int CW_CNTO = 32768, CW_CNTU = 36864, CW_CNTY = 40960, CW_CNTM = 45056, CW_CNTA = 49152;
__device__ __forceinline__ void panel_signal(unsigned* cnt) {
    asm volatile("s_waitcnt vmcnt(0)" ::: "memory");
    if (lane_now() == 0) (void)__hip_atomic_fetch_add(cnt, 1u, __ATOMIC_RELAXED, __HIP_MEMORY_SCOPE_AGENT);
}
__device__ __forceinline__ void panel_wait(unsigned* cnt, unsigned want, unsigned* tmo, int wave) {
    if (wave == 0) {
        unsigned sp = 0u;
        while (__hip_atomic_load(cnt, __ATOMIC_RELAXED, __HIP_MEMORY_SCOPE_AGENT) < want) {
            __builtin_amdgcn_s_sleep(2);
            if (++sp > (1u << 20)) { if (lane_now() == 0) __hip_atomic_store(tmo, 0xC0DEu, __ATOMIC_RELAXED, __HIP_MEMORY_SCOPE_AGENT); break; }
        }
        __builtin_amdgcn_fence(__ATOMIC_ACQUIRE, "agent");
        asm volatile("s_waitcnt vmcnt(0)" ::: "memory");
    }
    __syncthreads();
}

namespace pg8 {
#define PG8_LAS __attribute__((address_space(3)))
constexpr int BM = 256, BK = 64, HALF = 128, HTB = HALF * BK * 2, STAGE_BYTES = 8 * HTB;
constexpr int KDIM = 1024, NT = KDIM / BK, PITCH = KDIM * 2;
__host__ __device__ __forceinline__ int lds_byte(int r, int c) { const int st = (r >> 4) * 2 + (c >> 5), rr = r & 15, cc = c & 31, ob = rr * 64 + cc * 2; return st * 1024 + (ob ^ (((ob >> 9) & 1) << 5)); }
__host__ __device__ __forceinline__ void stage_rc(int b, int& R, int& C) { const int st = b / 1024, sb = b % 1024, swz = sb ^ (((sb >> 9) & 1) << 5); R = (st >> 1) * 16 + swz / 64; C = (st & 1) * 32 + (swz % 64) / 2; }

struct GU {
    unsigned a;
    unsigned b;
    unsigned rows;
    int pm, pn, e, cnt;
};
__host__ __device__ __forceinline__ int perm32(int rho) { const int n = rho >> 4, i = rho & 15; return 8 * (i >> 2) + 4 * n + (i & 3); }
template <int BMAP> __device__ __forceinline__ int bmap_row(int R) { return BMAP == 0 ? R : BMAP == 1 ? (64 * (R >> 5) + perm32(R & 31)) : BMAP == 2 ? (32 * (R >> 5) + 8 * ((R & 15) >> 2) + (R & 3) + 1024 * ((R >> 4) & 1)) : ((R & ~31) + perm32(R & 31)); }
template <int BMAP> __device__ __forceinline__ int bmap_hrows() { return (BMAP == 0 || BMAP == 3) ? 128 : BMAP == 1 ? 32 : 4; }
typedef int v8i32 __attribute__((ext_vector_type(8)));
typedef int v4i32 __attribute__((ext_vector_type(4)));
__device__ __forceinline__ bf16x8 lo8(v8i32 v) { return __builtin_bit_cast(bf16x8, (v4i32)__builtin_shufflevector(v, v, 0, 1, 2, 3)); }
__device__ __forceinline__ bf16x8 hi8(v8i32 v) { return __builtin_bit_cast(bf16x8, (v4i32)__builtin_shufflevector(v, v, 4, 5, 6, 7)); }
__device__ __forceinline__ v8i32 cat8(bf16x8 lo, bf16x8 hi) { const v4i32 a = __builtin_bit_cast(v4i32, lo), b = __builtin_bit_cast(v4i32, hi); return __builtin_shufflevector(a, b, 0, 1, 2, 3, 4, 5, 6, 7); }

template <class Epi, class Sched, bool GATHER, int BMAP, bool FP8 = false>
__device__ __forceinline__ void gemm_phase(PG8_LAS unsigned char* lds, const Sched& S, const Epi& E, int wid) {
    const int lane = lane_now(), tid = wid * 64 + lane, wr = wid >> 2, wc = wid & 3, fr = lane & 15, fq = lane >> 4;
    constexpr int nt = FP8 ? 8 : NT; constexpr int RPITCH = FP8 ? 1024 : PITCH;
    int Rr[2], Cc[2]; unsigned voffB[2];
#pragma unroll
    for (int i = 0; i < 2; ++i) { stage_rc(tid * 16 + i * 8192, Rr[i], Cc[i]); voffB[i] = (unsigned)(bmap_row<BMAP>(Rr[i]) * RPITCH + Cc[i] * 2); }
    const size_t kstep = (size_t)(BK * 2);
    const size_t hstepB = (size_t)bmap_hrows<BMAP>() * RPITCH;
    const unsigned ldsw = (unsigned)wid * 1024u;
    const int aoff = lds_byte(wr * 64 + fr, fq * 8), boff = lds_byte(wc * 32 + fr, fq * 8);
#define PG8_SA(b, h) (((b) * 2 + (h)) * HTB)
#define PG8_SB(b, h) ((4 + (b) * 2 + (h)) * HTB)
#define PG8_STAGE(bufoff, gbase, voff) do { _Pragma("unroll") for (int _i = 0; _i < 2; ++_i) { unsigned _o = (voff)[_i]; asm volatile("" : "+v"(_o));     \
        __builtin_amdgcn_global_load_lds((const unsigned*)((const char*)(gbase) + _o), (PG8_LAS unsigned*)(lds + (bufoff) + ldsw + _i * 8192), 16, 0, 0); } } while (0)
#define PG8_LDA(dst, b, h) do { _Pragma("unroll") for (int m = 0; m < 4; ++m) dst[m] = cat8(*(const PG8_LAS bf16x8*)(lds + PG8_SA(b, h) + aoff + m * 2048), *(const PG8_LAS bf16x8*)(lds + PG8_SA(b, h) + aoff + m * 2048 + 1024)); } while (0)
#define PG8_LDB(dst, b, h) do { _Pragma("unroll") for (int n = 0; n < 2; ++n) dst[n] = cat8(*(const PG8_LAS bf16x8*)(lds + PG8_SB(b, h) + boff + n * 2048), *(const PG8_LAS bf16x8*)(lds + PG8_SB(b, h) + boff + n * 2048 + 1024)); } while (0)
#define PG8_MMA(ai, bj, At, Bt) do { __builtin_amdgcn_s_setprio(1); if constexpr (FP8) asm volatile("s_nop 1"); _Pragma("unroll") for (int m = 0; m < 4; ++m) _Pragma("unroll") for (int n = 0; n < 2; ++n) { \
        if constexpr (FP8) asm volatile("v_mfma_f32_16x16x128_f8f6f4 %0, %1, %2, %0" : "+v"(acc[ai][bj][m][n]) : "v"(Bt[n]), "v"(At[m]));   \
        else { acc[ai][bj][m][n] = __builtin_amdgcn_mfma_f32_16x16x32_bf16(lo8(Bt[n]), lo8(At[m]), acc[ai][bj][m][n], 0, 0, 0); acc[ai][bj][m][n] = __builtin_amdgcn_mfma_f32_16x16x32_bf16(hi8(Bt[n]), hi8(At[m]), acc[ai][bj][m][n], 0, 0, 0); } } \
        __builtin_amdgcn_s_setprio(0); } while (0)
#define PG8_WAIT_V(n) asm volatile("s_waitcnt vmcnt(" #n ")" ::: "memory")
#define PG8_WAIT_L(n) asm volatile("s_waitcnt lgkmcnt(" #n ")" ::: "memory")
#define PG8_BAR __builtin_amdgcn_s_barrier()
#define PG8_SCHED __builtin_amdgcn_sched_barrier(0)
#define PG8_AOFFS(dst, u) do { _Pragma("unroll") for (int _h = 0; _h < 2; ++_h) _Pragma("unroll") for (int _i = 0; _i < 2; ++_i) { \
        int _row = 128 * _h + Rr[_i]; if (GATHER) { const int _rr = _row < (u).cnt ? _row : 0; _row = S.rowlist[2 * ((u).rows + _rr)] >> 2; } \
        dst[_h][_i] = (unsigned)(_row * RPITCH + Cc[_i] * 2); } } while (0)
#define PG8_AREQ(raw, u) do { _Pragma("unroll") for (int _h = 0; _h < 2; ++_h) _Pragma("unroll") for (int _i = 0; _i < 2; ++_i) { \
        const int _row = 128 * _h + Rr[_i]; const int _rr = _row < (u).cnt ? _row : 0; const int* _p = S.rowlist + 2 * ((u).rows + _rr); \
        asm volatile("global_load_dword %0, %1, off" : "=v"(raw[_h][_i]) : "v"(_p) : "memory"); } } while (0)
#define PG8_AFIN(dst, raw) do { _Pragma("unroll") for (int _h = 0; _h < 2; ++_h) _Pragma("unroll") for (int _i = 0; _i < 2; ++_i) dst[_h][_i] = (unsigned)(((int)raw[_h][_i] >> 2) * RPITCH + Cc[_i] * 2); } while (0)
    GU cur, nxt; int ui = 0;
    if (!S.next(0, cur)) return;
    unsigned araw[2][2] = {{0u, 0u}, {0u, 0u}};
    typename Epi::Pre pre;
    f32x4 acc[2][2][4][2];
#pragma unroll
    for (int a = 0; a < 2; ++a)
#pragma unroll
        for (int b = 0; b < 2; ++b)
#pragma unroll
            for (int m = 0; m < 4; ++m)
#pragma unroll
                for (int n = 0; n < 2; ++n) acc[a][b][m][n] = (f32x4){0.f, 0.f, 0.f, 0.f};
    v8i32 At[4], B0[2], B1[2];
    unsigned voA[2][2], nvoA[2][2];
    if constexpr (GATHER) { PG8_AOFFS(voA, cur); } else {
#pragma unroll
        for (int h = 0; h < 2; ++h)
#pragma unroll
            for (int i = 0; i < 2; ++i) { voA[h][i] = (unsigned)((128 * h + Rr[i]) * RPITCH + Cc[i] * 2); nvoA[h][i] = voA[h][i]; } }
    const char* cA = S.Abase + cur.a; const char* cB = S.Bbase + cur.b;
    PG8_STAGE(PG8_SB(0, 0), cB, voffB); PG8_STAGE(PG8_SB(0, 1), cB + hstepB, voffB); PG8_STAGE(PG8_SA(0, 0), cA, voA[0]); PG8_STAGE(PG8_SA(0, 1), cA, voA[1]);
    if (wr == 1) PG8_BAR;
    PG8_WAIT_V(2); PG8_BAR;
    PG8_STAGE(PG8_SB(1, 0), cB + kstep, voffB); PG8_STAGE(PG8_SA(1, 0), cA + kstep, voA[0]); PG8_STAGE(PG8_SB(1, 1), cB + hstepB + kstep, voffB);
    PG8_WAIT_V(6); PG8_BAR;
    for (;;) {
        const bool has_next = S.next(ui + 1, nxt);
        const char* nA = has_next ? S.Abase + nxt.a : cA; const char* nB = has_next ? S.Bbase + nxt.b : cB;

        PROBE_BEGIN(1) PROBE_BEGIN(11)
#pragma unroll 1
        for (int t = 0; t < nt; t += 2) {
            const bool last = (t == nt - 2);
            const char* a1 = cA + (size_t)(t + 1) * kstep;
            const char* a2 = last ? nA : cA + (size_t)(t + 2) * kstep; const char* b2 = last ? nB : cB + (size_t)(t + 2) * kstep;
            const char* a3 = a2 + kstep; const char* b3 = b2 + kstep;
            unsigned vo2[2][2];
            if constexpr (GATHER) {
                if (t == nt - 4 && has_next) { PG8_AREQ(araw, nxt); }
                if (last && has_next) { asm volatile("s_waitcnt vmcnt(16)" : "+v"(araw[0][0]), "+v"(araw[0][1]), "+v"(araw[1][0]), "+v"(araw[1][1]) :: "memory"); PG8_AFIN(nvoA, araw); } }
#pragma unroll
            for (int h = 0; h < 2; ++h)
#pragma unroll
                for (int i = 0; i < 2; ++i) vo2[h][i] = GATHER ? ((last && has_next) ? nvoA[h][i] : voA[h][i]) : voA[h][i];
            if constexpr (Sched::HAS_DEP) { if (last && has_next) S.a_ready(ui + 1, nxt, wid); }
            if constexpr (Epi::HAS_MID) { if (t == nt / 2) E.mid(acc, cur, wr, wc); }
            if constexpr (Epi::HAS_PRE) { if (last) E.prefetch(pre, cur, wr, wc); }
            PG8_LDB(B0, 0, 0); PG8_LDB(B1, 0, 1); PG8_SCHED; PG8_LDA(At, 0, 0); PG8_STAGE(PG8_SA(1, 1), a1, voA[1]);
            PG8_WAIT_V(8); PG8_WAIT_L(0); PG8_BAR; PG8_MMA(0, 0, At, B0); PG8_MMA(0, 1, At, B1); PG8_BAR; PG8_SCHED;
            PG8_LDA(At, 0, 1); PG8_STAGE(PG8_SB(0, 0), b2, voffB); PG8_STAGE(PG8_SB(0, 1), b2 + hstepB, voffB); PG8_STAGE(PG8_SA(0, 0), a2, vo2[0]);
            PG8_WAIT_V(8); PG8_WAIT_L(0); PG8_BAR; PG8_MMA(1, 0, At, B0); PG8_MMA(1, 1, At, B1); PG8_BAR; PG8_SCHED;
            PG8_LDB(B0, 1, 0); PG8_LDB(B1, 1, 1); PG8_SCHED; PG8_LDA(At, 1, 0); PG8_STAGE(PG8_SA(0, 1), a2, vo2[1]);
            PG8_WAIT_V(8); PG8_WAIT_L(0); PG8_BAR; PG8_MMA(0, 0, At, B0); PG8_MMA(0, 1, At, B1); PG8_BAR; PG8_SCHED;
            PG8_LDA(At, 1, 1); PG8_STAGE(PG8_SB(1, 0), b3, voffB); PG8_STAGE(PG8_SB(1, 1), b3 + hstepB, voffB); PG8_STAGE(PG8_SA(1, 0), a3, vo2[0]);
            PG8_WAIT_V(8); PG8_WAIT_L(0); PG8_BAR; PG8_MMA(1, 0, At, B0); PG8_MMA(1, 1, At, B1); PG8_BAR; PG8_SCHED;
        }
        if (FP8 && GATHER && wid == 0) PROBE_END(1, lds + MISC_OFF); if (FP8 && !GATHER && wid == 0) PROBE_END(11, lds + MISC_OFF);
        PROBE_BEGIN(2) PROBE_BEGIN(12)
        if (wr == 0) PG8_BAR;
        if constexpr (FP8) asm volatile("s_nop 15\n\ts_nop 7" ::: "memory");
        if constexpr (Epi::HAS_PRE) { E.wait(pre); E(acc, cur, wr, wc, pre); } else E(acc, cur, wr, wc);
        if constexpr (Sched::HAS_DONE) S.done(cur);
        if (FP8 && GATHER && wid == 0) PROBE_END(2, lds + MISC_OFF); if (FP8 && !GATHER && wid == 0) PROBE_END(12, lds + MISC_OFF);
        if (!has_next) break;
#pragma unroll
        for (int a = 0; a < 2; ++a)
#pragma unroll
            for (int b = 0; b < 2; ++b)
#pragma unroll
                for (int m = 0; m < 4; ++m)
#pragma unroll
                    for (int n = 0; n < 2; ++n) acc[a][b][m][n] = (f32x4){0.f, 0.f, 0.f, 0.f};
        cur = nxt; cA = nA; cB = nB; ++ui;
        if constexpr (GATHER) {
#pragma unroll
        for (int h = 0; h < 2; ++h)
#pragma unroll
            for (int i = 0; i < 2; ++i) voA[h][i] = nvoA[h][i]; }
        if (wr == 1) PG8_BAR;
    }
    PG8_WAIT_V(0);
    PG8_BAR;
#undef PG8_SA
#undef PG8_SB
#undef PG8_STAGE
#undef PG8_LDA
#undef PG8_LDB
#undef PG8_MMA
#undef PG8_WAIT_V
#undef PG8_WAIT_L
#undef PG8_BAR
#undef PG8_SCHED
#undef PG8_AOFFS
}
}

namespace attn_body {
using bf16x8=__attribute__((ext_vector_type(8)))short;
using s16x4=__attribute__((ext_vector_type(4)))short;
using f32x16=__attribute__((ext_vector_type(16)))float;
using u32x4=__attribute__((ext_vector_type(4)))unsigned;
constexpr int D=64;
constexpr int NW=8,QBLK=32,QB=QBLK*NW,KVBLK=64;
__device__ __forceinline__ int crow(int r,int hi){return (r&3)+8*(r>>2)+4*hi;}
#define SBAR() __builtin_amdgcn_sched_barrier(0)
constexpr int NSLOT=3, SLOTB=8192;
constexpr int LDS_K=0, LDS_V=NSLOT*SLOTB, LDS_WS=2*NSLOT*SLOTB, LDS_OST=LDS_WS+NW*64*4, LDS_BYTES=LDS_OST+NW*4096;
__device__ __forceinline__ void glds16(const void*gsrc,unsigned lds_dst){unsigned keep;
  asm volatile("s_mov_b32 %0, m0\n\ts_mov_b32 m0, %2\n\ts_nop 0\n\tglobal_load_lds_dwordx4 %1, off\n\ts_mov_b32 m0, %0":"=&s"(keep):"v"(gsrc),"s"(lds_dst):"memory");}
__device__ __forceinline__ float max3f(float a,float b,float c){float r;asm("v_max3_f32 %0, %1, %2, %3":"=v"(r):"v"(a),"v"(b),"v"(c));return r;}
__device__ __forceinline__ float max2f(float a,float b){float r;asm("v_max_f32_e32 %0, %1, %2":"=v"(r):"v"(a),"v"(b));return r;}
__device__ __forceinline__ float fadd_s(float a,float b){float r;asm("v_add_f32_e32 %0, %1, %2":"=v"(r):"v"(a),"v"(b));return r;}
__device__ __forceinline__ float fsub_s(float a,float b){float r;asm("v_sub_f32_e32 %0, %1, %2":"=v"(r):"v"(a),"v"(b));return r;}
__device__ __forceinline__ unsigned cvtpk_s(float lo,float hi){f32x2_t v={lo,hi};bf16x2_t b=__builtin_convertvector(v,bf16x2_t);return __builtin_bit_cast(unsigned,b);}
#define WAIT_BAR(N) asm volatile("s_waitcnt vmcnt(" #N ") lgkmcnt(0)\n\ts_barrier":::"memory")
__device__ __forceinline__ void qkt(f32x16&p0,f32x16&p1,const char*Kslot,const bf16x8*qr,const f32x16&negm,int r32,int hi){
  const char*kb=Kslot+hi*1024+r32*16;
  #pragma unroll
  for(int d0=0;d0<4;++d0){
    const bf16x8 b0=*reinterpret_cast<const bf16x8*>(kb+d0*2048);
    const bf16x8 b1=*reinterpret_cast<const bf16x8*>(kb+d0*2048+512);
    if(d0==0){p0=__builtin_amdgcn_mfma_f32_32x32x16_bf16(b0,qr[0],negm,0,0,0);p1=__builtin_amdgcn_mfma_f32_32x32x16_bf16(b1,qr[0],negm,0,0,0);}
    else{p0=__builtin_amdgcn_mfma_f32_32x32x16_bf16(b0,qr[d0],p0,0,0,0);p1=__builtin_amdgcn_mfma_f32_32x32x16_bf16(b1,qr[d0],p1,0,0,0);}}
}
typedef __attribute__((address_space(3))) const char* lds_cptr;
typedef short v4i16_t __attribute__((ext_vector_type(4)));
__device__ __forceinline__ void kload8(bf16x8*kf,lds_cptr kp){
  kf[0]=*(const __attribute__((address_space(3))) bf16x8*)(kp);      kf[1]=*(const __attribute__((address_space(3))) bf16x8*)(kp+512);
  kf[2]=*(const __attribute__((address_space(3))) bf16x8*)(kp+2048); kf[3]=*(const __attribute__((address_space(3))) bf16x8*)(kp+2560);
  kf[4]=*(const __attribute__((address_space(3))) bf16x8*)(kp+4096); kf[5]=*(const __attribute__((address_space(3))) bf16x8*)(kp+4608);
  kf[6]=*(const __attribute__((address_space(3))) bf16x8*)(kp+6144); kf[7]=*(const __attribute__((address_space(3))) bf16x8*)(kp+6656);
}
__device__ __forceinline__ void kload2(bf16x8*kf,lds_cptr kp,int j){ kf[2*j]=*(const __attribute__((address_space(3))) bf16x8*)(kp+j*2048); kf[2*j+1]=*(const __attribute__((address_space(3))) bf16x8*)(kp+j*2048+512); }
__device__ __forceinline__ s16x4 vtr(lds_cptr p){ return __builtin_bit_cast(s16x4,__builtin_amdgcn_ds_read_tr16_b64_v4i16((__attribute__((address_space(3))) v4i16_t*)p)); }
__device__ __forceinline__ float rowmax(const f32x16&p0,const f32x16&p1){
  float a=max3f(p0[0],p0[1],p1[0]),b=max3f(p0[2],p0[3],p1[1]);a=max3f(a,p1[2],p1[3]);
  #pragma unroll
  for(int r=4;r<16;r+=4){a=max3f(a,p0[r],p0[r+1]);b=max3f(b,p0[r+2],p0[r+3]);a=max3f(a,p1[r],p1[r+1]);b=max3f(b,p1[r+2],p1[r+3]);}
  const float m=max2f(a,b);
  auto rr=__builtin_amdgcn_permlane32_swap(__float_as_uint(m),__float_as_uint(m),false,false);
  return max2f(__uint_as_float(rr[0]),__uint_as_float(rr[1]));
}
__device__ __forceinline__ void pv(f32x16*o,int vb,bf16x8 pa0,bf16x8 pa1,bf16x8 pa2,bf16x8 pa3){
  #pragma unroll
  for(int d0=0;d0<2;++d0){s16x4 lo[4],hi[4];
    #pragma unroll
    for(int ks=0;ks<4;++ks){
      asm volatile("ds_read_b64_tr_b16 %0,%1 offset:%c2":"=&v"(lo[ks]):"v"(vb),"i"(d0*4096+ks*1024):"memory");
      asm volatile("ds_read_b64_tr_b16 %0,%1 offset:%c2":"=&v"(hi[ks]):"v"(vb),"i"(d0*4096+ks*1024+512):"memory");}
    asm volatile("s_waitcnt lgkmcnt(0)":::"memory");SBAR();
    #define PK(k) (bf16x8){lo[k][0],lo[k][1],lo[k][2],lo[k][3],hi[k][0],hi[k][1],hi[k][2],hi[k][3]}
    o[d0]=__builtin_amdgcn_mfma_f32_32x32x16_bf16(pa0,PK(0),o[d0],0,0,0);
    o[d0]=__builtin_amdgcn_mfma_f32_32x32x16_bf16(pa1,PK(1),o[d0],0,0,0);
    o[d0]=__builtin_amdgcn_mfma_f32_32x32x16_bf16(pa2,PK(2),o[d0],0,0,0);
    o[d0]=__builtin_amdgcn_mfma_f32_32x32x16_bf16(pa3,PK(3),o[d0],0,0,0);
    #undef PK
  }
}
#define ATTN_STORE16(p,v) (*(u32x4*)(p)=(v))
constexpr int QP=512, KVP=128, OP=1024;
constexpr int GQ_NJ=5, GQ_ND=3, GQ_NH=2*(GQ_NJ+GQ_ND);
template<int THRL> __device__ __forceinline__ void gqa_unit(int b,int h,int qb,const bf16*Q,const bf16*__restrict__ K,const bf16*__restrict__ V,bf16*O,char*shm,int wid_in,unsigned*cntO,const float*sW,unsigned char*sWT,int sitem0,const float*sWd,unsigned char*sWTd,int sitemD){
  const int lane=lane_now(),r32=lane&31,hi=lane>>5; const int wid=wid_in;
  const int q0=qb*QB; const int kvh=h>>2;
  const bf16*Qw=Q+((long)b*SEQ+q0+wid*QBLK)*QP+h*D;
  const unsigned lds0=(unsigned)(uintptr_t)shm;
  float*wsf=(float*)(shm+LDS_WS)+wid*64;
  #define TROW(t) ((t)<64?(long)b*SEQ+(long)(t)*64:(long)T+(long)b*CTXL+(long)((t)-64)*64)
  const bf16*ksrc=K+(long)lane*KVP+kvh*D+wid*8;
  const bf16*vsrc=V+(long)(16*(wid&3)+(lane>>2))*KVP+kvh*D+(wid>>2)*32+(lane&3)*8;
  const unsigned kdst=lds0+LDS_K+wid*1024, vdst=lds0+LDS_V+wid*1024;
  #define DMA_K(t,slot) glds16(ksrc+TROW(t)*KVP,(unsigned)__builtin_amdgcn_readfirstlane(kdst+(slot)))
  #define DMA_V(t,slot) glds16(vsrc+TROW(t)*KVP,(unsigned)__builtin_amdgcn_readfirstlane(vdst+(slot)))
  const int vb0=(int)(lds0+LDS_V)+((lane>>4)&1)*32+(lane&3)*8+(4*hi+((lane&15)>>2))*64;
  const char*Kbase=shm+LDS_K; bf16x8 kf[8];
  const lds_cptr shm3=(lds_cptr)shm; const lds_cptr kp0=shm3+LDS_K+hi*1024+r32*16; const lds_cptr vp0=shm3+LDS_V+((lane>>4)&1)*32+(lane&3)*8+(4*hi+((lane&15)>>2))*64;
  constexpr int NT=(SEQ+CTXL)/KVBLK;
  DMA_K(0,0);DMA_V(0,0);DMA_K(1,SLOTB);
  bf16x8 qr[4];
  #pragma unroll
  for(int d0=0;d0<4;++d0)qr[d0]=*reinterpret_cast<const bf16x8*>(&Qw[(long)r32*QP+d0*16+hi*8]);
  float mhat=0.f,l_reg=0.f;f32x16 o[2];o[0]=f32x16{};o[1]=f32x16{};f32x16 negm=f32x16{};asm volatile("":"+v"(negm));
  bool resc=false;
  #define START(P0,P1) do{ const float rm=rowmax(P0,P1); resc=false; \
    { const float dl=rm; mhat=fadd_s(mhat,dl); \
      _Pragma("unroll") for(int r=0;r<16;++r){P0[r]=fsub_s(P0[r],dl);P1[r]=fsub_s(P1[r],dl);} \
      _Pragma("unroll") for(int r=0;r<16;++r)negm[r]=-mhat; asm volatile("":"+v"(negm)); } \
    _Pragma("unroll") for(int r=0;r<16;++r)P0[r]=__builtin_amdgcn_exp2f(P0[r]); }while(0)
  #define RESC() do{ if(resc){ asm volatile("s_waitcnt lgkmcnt(0)":::"memory"); \
      _Pragma("unroll") for(int d_=0;d_<2;++d_) _Pragma("unroll") for(int r=0;r<16;++r)o[d_][r]*=wsf[crow(r,hi)]; } }while(0)
  f32x16 pA0,pA1,pB0,pB1;
  int sl_prev=0,sl_cur=0,sl_next=SLOTB;
  #define ROT() do{sl_prev=sl_cur;sl_cur=sl_next;sl_next=(sl_next==(NSLOT-1)*SLOTB)?0:sl_next+SLOTB;}while(0)
  DMA_K(2,2*SLOTB);
  WAIT_BAR(3);
  qkt(pA0,pA1,Kbase,qr,negm,r32,hi);asm volatile("s_nop 15\n\ts_nop 7":"+v"(pA0),"+v"(pA1));
  START(pA0,pA1);
  _Pragma("unroll") for(int r=0;r<16;++r)pA1[r]=__builtin_amdgcn_exp2f(pA1[r]);
  WAIT_BAR(0);
  DMA_K(3,0);DMA_V(1,SLOTB);
  ROT();
  kload8(kf,kp0+sl_cur);
  WAIT_BAR(2);
  s16x4 vlo[8],vhi[8]; u32x4 pw0,pw1,pw2,pw3;
  #define PKW(P,B) cvtpk_s(P[B],P[B+1])
  #define PAF(k) __builtin_bit_cast(bf16x8,pw##k)
  #define VFR(i) (bf16x8){vlo[i][0],vlo[i][1],vlo[i][2],vlo[i][3],vhi[i][0],vhi[i][1],vhi[i][2],vhi[i][3]}
  #define PIN(x) asm volatile("":"+v"(x))
  #define MX3(a,b,c) __builtin_fmaxf(__builtin_fmaxf((a),(b)),(c))
  #define GAPA(MF,A0,A1,A2,A3,W0,W1,PW) do{ MF; sacc+=A0; sacc+=A1; sacc+=A2; sacc+=A3; PIN(sacc); W0; W1; PIN(PW); SBAR(); }while(0)
  #define EX(v) __builtin_amdgcn_exp2f(v)
  #define GAPB(MF,X,B) do{ MF; X[B]=EX(X[B]); X[B+1]=EX(X[B+1]); X[B+2]=EX(X[B+2]); X[B+3]=EX(X[B+3]); PIN(X); SBAR(); }while(0)
  #define VRD(i) do{ vlo[i]=vtr(vp_+(((i)>>2)*4096+((i)&3)*1024)); vhi[i]=vtr(vp_+(((i)>>2)*4096+((i)&3)*1024+512)); }while(0)
  #define KRD(G,j) do{ if(G){ kload2(kf,kp0+sl_next,j); SBAR(); } }while(0)
  #define STEP(C0,C1,P0,P1,t,GK,GV,GL) do{ SBAR(); \
    const lds_cptr vp_=vp0+sl_prev; \
    VRD(0); SBAR(); float sacc=(P0[0]+P0[1]); \
    GAPA(C0=__builtin_amdgcn_mfma_f32_32x32x16_bf16(kf[0],qr[0],negm,0,0,0), P0[2],P0[3],P0[4],P0[5],     pw0[0]=PKW(P0,0), pw0[1]=PKW(P0,2), pw0); \
    VRD(4); SBAR(); GAPA(C1=__builtin_amdgcn_mfma_f32_32x32x16_bf16(kf[1],qr[0],negm,0,0,0), P0[6],P0[7],P0[8],P0[9],     pw0[2]=PKW(P0,4), pw0[3]=PKW(P0,6), pw0); \
    VRD(1); SBAR(); GAPA(C0=__builtin_amdgcn_mfma_f32_32x32x16_bf16(kf[2],qr[1],C0,0,0,0),   P0[10],P0[11],P0[12],P0[13], pw1[0]=PKW(P0,8), pw1[1]=PKW(P0,10), pw1); \
    VRD(5); SBAR(); GAPA(C1=__builtin_amdgcn_mfma_f32_32x32x16_bf16(kf[3],qr[1],C1,0,0,0),   P0[14],P0[15],P1[0],P1[1],   pw1[2]=PKW(P0,12),pw1[3]=PKW(P0,14), pw1); \
    VRD(2); SBAR(); GAPA(C0=__builtin_amdgcn_mfma_f32_32x32x16_bf16(kf[4],qr[2],C0,0,0,0),   P1[2],P1[3],P1[4],P1[5],     pw2[0]=PKW(P1,0), pw2[1]=PKW(P1,2), pw2); \
    VRD(6); SBAR(); GAPA(C1=__builtin_amdgcn_mfma_f32_32x32x16_bf16(kf[5],qr[2],C1,0,0,0),   P1[6],P1[7],P1[8],P1[9],     pw2[2]=PKW(P1,4), pw2[3]=PKW(P1,6), pw2); \
    VRD(3); SBAR(); GAPA(C0=__builtin_amdgcn_mfma_f32_32x32x16_bf16(kf[6],qr[3],C0,0,0,0),   P1[10],P1[11],P1[12],P1[13], pw3[0]=PKW(P1,8), pw3[1]=PKW(P1,10), pw3); \
    VRD(7); SBAR(); GAPA(C1=__builtin_amdgcn_mfma_f32_32x32x16_bf16(kf[7],qr[3],C1,0,0,0),   P1[14],P1[15],0.f,0.f,       pw3[2]=PKW(P1,12),pw3[3]=PKW(P1,14), pw3); \
    l_reg+=sacc; \
    if(GK){DMA_K((t)+3,sl_cur);} if(GV){DMA_V((t)+1,sl_next);} \
    { float a=MX3(C0[0],C0[1],C1[0]),b=MX3(C0[2],C0[3],C1[1]); a=MX3(a,C1[2],C1[3]); \
      _Pragma("unroll") for(int r=4;r<16;r+=4){a=MX3(a,C0[r],C0[r+1]);b=MX3(b,C0[r+2],C0[r+3]);a=MX3(a,C1[r],C1[r+1]);b=MX3(b,C1[r+2],C1[r+3]);} \
      float rm=__builtin_fmaxf(a,b); { auto rr=__builtin_amdgcn_permlane32_swap(__float_as_uint(rm),__float_as_uint(rm),false,false); rm=__builtin_fmaxf(__uint_as_float(rr[0]),__uint_as_float(rr[1])); } \
      resc=false; \
      if(__builtin_expect(__any(rm>(float)THRL),0)){ const float dl=__builtin_fmaxf(rm,0.f); mhat+=dl; \
        _Pragma("unroll") for(int r=0;r<16;++r){C0[r]-=dl;C1[r]-=dl;} \
        _Pragma("unroll") for(int r=0;r<16;++r)negm[r]=-mhat; asm volatile("":"+v"(negm)); \
        const float f=__builtin_amdgcn_exp2f(-dl); l_reg*=f; if(hi==0)wsf[r32]=f; resc=true; } } \
    SBAR(); \
    GAPB(o[0]=__builtin_amdgcn_mfma_f32_32x32x16_bf16(PAF(0),VFR(0),o[0],0,0,0), C0,0); \
    GAPB(o[1]=__builtin_amdgcn_mfma_f32_32x32x16_bf16(PAF(0),VFR(4),o[1],0,0,0), C0,4); \
    KRD(GL,0); GAPB(o[0]=__builtin_amdgcn_mfma_f32_32x32x16_bf16(PAF(1),VFR(1),o[0],0,0,0), C0,8); \
    KRD(GL,1); GAPB(o[1]=__builtin_amdgcn_mfma_f32_32x32x16_bf16(PAF(1),VFR(5),o[1],0,0,0), C0,12); \
    KRD(GL,2); GAPB(o[0]=__builtin_amdgcn_mfma_f32_32x32x16_bf16(PAF(2),VFR(2),o[0],0,0,0), C1,0); \
    KRD(GL,3); GAPB(o[1]=__builtin_amdgcn_mfma_f32_32x32x16_bf16(PAF(2),VFR(6),o[1],0,0,0), C1,4); \
    GAPB(o[0]=__builtin_amdgcn_mfma_f32_32x32x16_bf16(PAF(3),VFR(3),o[0],0,0,0), C1,8); \
    GAPB(o[1]=__builtin_amdgcn_mfma_f32_32x32x16_bf16(PAF(3),VFR(7),o[1],0,0,0), C1,12); \
    }while(0)
  f32x4 sv[4]; unsigned sw[4];
  #pragma unroll
  for(int i=0;i<4;++i){sv[i]=(f32x4){0.f,0.f,0.f,0.f};sw[i]=0u;}
  #define GQ_DN(bi) (((bi)>>1)>=GQ_NJ)
  #define GQ_I(bi) (GQ_DN(bi)?sitemD+((bi)>>1)-GQ_NJ:sitem0+((bi)>>1))
  #define GQ_LNB(bi) (GQ_DN(bi)?5:6)
  #define GQ_E(bi) (GQ_I(bi)>>(4+GQ_LNB(bi)))
  #define GQ_KB(bi) ((GQ_I(bi)>>GQ_LNB(bi))&15)
  #define GQ_NB(bi) (GQ_I(bi)&((1<<GQ_LNB(bi))-1))
  #define GQ_SBASE(bi) ((const char*)(GQ_DN(bi)?sWd:sW)+(((((size_t)GQ_E(bi)*1024+(size_t)(64*GQ_KB(bi)+4*((bi)&1)))<<(5+GQ_LNB(bi)))+(size_t)(32*GQ_NB(bi)))<<2))
  #define GQ_DBASE(bi) ((GQ_DN(bi)?sWTd:sWT)+((size_t)GQ_E(bi)<<(15+GQ_LNB(bi)))+(size_t)(32*GQ_NB(bi))*1024+64*GQ_KB(bi))
  #define GQ_ISSUE(bi) do{ const int l_=lane_now(); const unsigned vo_=((unsigned)(l_>>3)<<(10+GQ_LNB(bi)))|((unsigned)(l_&7)<<4); const char*sb_=GQ_SBASE(bi); \
      _Pragma("unroll") for(int i=0;i<4;++i){ const char*sbi_=sb_+((size_t)i<<(7+GQ_LNB(bi))); asm volatile("global_load_dwordx4 %0, %1, %2 nt":"=v"(sv[i]):"v"(vo_),"s"(sbi_):"memory"); } }while(0)
  #define GQ_CONSUME(bi) do{ const f32x4 t0_=sv[0]*W8_SCALE,t1_=sv[1]*W8_SCALE,t2_=sv[2]*W8_SCALE,t3_=sv[3]*W8_SCALE; \
      if(((bi)&1)==0){ _Pragma("unroll") for(int j=0;j<4;++j)sw[j]=pk4_fp8(t0_[j],t1_[j],t2_[j],t3_[j]); } \
      else { const int l_=lane_now(); const unsigned do_=((unsigned)(l_&7)<<12)|((unsigned)(l_>>3)<<3); unsigned char*db_=GQ_DBASE(bi); \
        _Pragma("unroll") for(int j=0;j<4;++j){ u32x2 ow; ow.x=sw[j]; ow.y=pk4_fp8(t0_[j],t1_[j],t2_[j],t3_[j]); *(u32x2*)(db_+do_+j*1024)=ow; } } }while(0)
  int t=1;
  #pragma unroll 1
  for(;t+5<NT;t+=2){
    const int it=(t-1)>>1;
    STEP(pB0,pB1,pA0,pA1,t,true,true,true);
    if(sW==nullptr||it<1||it>GQ_NH){ asm volatile("s_waitcnt vmcnt(2)":::"memory"); } else if(!((it&1)&&it>=3)){ asm volatile("s_waitcnt vmcnt(6)":::"memory"); }
    asm volatile("s_waitcnt vmcnt(10) lgkmcnt(0)\n\ts_barrier":"+v"(sv[0]),"+v"(sv[1]),"+v"(sv[2]),"+v"(sv[3])::"memory");
    RESC(); ROT();
    STEP(pA0,pA1,pB0,pB1,t+1,true,true,true);
    asm volatile("s_waitcnt vmcnt(2) lgkmcnt(0)\n\ts_barrier":"+v"(sv[0]),"+v"(sv[1]),"+v"(sv[2]),"+v"(sv[3])::"memory");
    if(sW!=nullptr){
      if(it>=1&&it<=GQ_NH) GQ_CONSUME(it-1);
      if(it<GQ_NH){
        GQ_ISSUE(it); } }
    RESC(); ROT();
  }
  #undef GQ_SBASE
  #undef GQ_DBASE
  #undef GQ_ISSUE
  #undef GQ_CONSUME
  #undef GQ_DN
  #undef GQ_I
  #undef GQ_LNB
  #undef GQ_E
  #undef GQ_KB
  #undef GQ_NB
  #define ENDW(tt) do{ if((tt)+3<NT){WAIT_BAR(2);} else if((tt)+2<NT){WAIT_BAR(1);} else {WAIT_BAR(0);} }while(0)
  for(;t+1<NT;t+=2){
    STEP(pB0,pB1,pA0,pA1,t,(t+3<NT),(t+1<NT),(t+1<NT));       ENDW(t);   RESC(); ROT();
    STEP(pA0,pA1,pB0,pB1,t+1,(t+4<NT),(t+2<NT),(t+2<NT));     ENDW(t+1); RESC(); ROT();
  }
  STEP(pB0,pB1,pA0,pA1,NT-1,false,false,false); RESC();
  { float sacc=pB0[0]+pB0[1]; _Pragma("unroll") for(int r=2;r<16;++r)sacc+=pB0[r]; _Pragma("unroll") for(int r=0;r<16;++r)sacc+=pB1[r]; l_reg+=sacc;
    pw0=(u32x4){PKW(pB0,0),PKW(pB0,2),PKW(pB0,4),PKW(pB0,6)};pw1=(u32x4){PKW(pB0,8),PKW(pB0,10),PKW(pB0,12),PKW(pB0,14)};pw2=(u32x4){PKW(pB1,0),PKW(pB1,2),PKW(pB1,4),PKW(pB1,6)};pw3=(u32x4){PKW(pB1,8),PKW(pB1,10),PKW(pB1,12),PKW(pB1,14)};
    SBAR(); pv(o,vb0+sl_cur,PAF(0),PAF(1),PAF(2),PAF(3)); }
  #undef PKW
  #undef PAF
  #undef VFR
  #undef PIN
  #undef MX3
  #undef GAPA
  #undef GAPB
  #undef EX
  #undef VRD
  #undef KRD
  #undef STEP
  #undef ENDW
  {auto rr=__builtin_amdgcn_permlane32_swap(__float_as_uint(l_reg),__float_as_uint(l_reg),false,false);l_reg=__uint_as_float(rr[0])+__uint_as_float(rr[1]);}
  if(hi==0)wsf[32+r32]=l_reg;asm volatile("s_waitcnt lgkmcnt(0)":::"memory");
  float rli[16];
  #pragma unroll
  for(int r=0;r<16;++r)rli[r]=__builtin_amdgcn_rcpf(wsf[32+crow(r,hi)]);
  bf16*Ow=O+((long)b*SEQ+q0+wid*QBLK)*OP+512+h*D;
  { bf16*stg=(bf16*)(shm+LDS_OST)+wid*2048;
    #pragma unroll
    for(int r=0;r<16;++r){const int orow=crow(r,hi);
      #pragma unroll
      for(int d0=0;d0<2;++d0)stg[orow*64+d0*32+r32]=(bf16)f2bf(o[d0][r]*rli[r]);}
    asm volatile("s_waitcnt lgkmcnt(0)":::"memory");
    #pragma unroll
    for(int i=0;i<4;++i){const int row=i*8+(lane>>3),ch=lane&7; const u32x4 v=*(const u32x4*)(stg+row*64+ch*8); wt16(O,(unsigned)(((b*SEQ+q0+wid*QBLK+row)*OP+512+h*D+ch*8)*2),v);} }
  if(cntO) panel_signal(cntO+64*((b*SEQ+q0)>>8));
  asm volatile("s_waitcnt lgkmcnt(0)\n\ts_barrier":::"memory");
  #undef DMA_K
  #undef DMA_V
  #undef TROW
  #undef START
  #undef RESC
  #undef ROT
}

template<int MODE> __device__ __forceinline__ void na_softmax(f32x16&p0,f32x16&p1,float&mref,float&lrow,f32x16*o,float*wsf,const float*bp,int c0,int r32,int hi,u32x4*pw){
  #define NA_LIVE0(rr) (MODE!=2||(rr)>=12)
  #define NA_LIVE1(rr) (MODE!=1||(rr)<4)
  if(MODE!=0){
    #pragma unroll
    for(int rr=0;rr<16;++rr){ const int kc0=(rr&3)+8*(rr>>2)+4*hi;
      if(NA_LIVE0(rr))p0[rr]=((unsigned)(kc0-c0)<16u)?p0[rr]+bp[(rr&3)+8*(rr>>2)]:-INFINITY;
      if(NA_LIVE1(rr))p1[rr]=((unsigned)(kc0+32-c0)<16u)?p1[rr]+bp[(rr&3)+8*(rr>>2)+32]:-INFINITY; }
  }
  float rm=-INFINITY;
  #pragma unroll
  for(int rr=0;rr<16;++rr){ if(NA_LIVE0(rr))rm=fmaxf(rm,p0[rr]); if(NA_LIVE1(rr))rm=fmaxf(rm,p1[rr]); }
  { auto q=__builtin_amdgcn_permlane32_swap(__float_as_uint(rm),__float_as_uint(rm),false,false); rm=fmaxf(__uint_as_float(q[0]),__uint_as_float(q[1])); }
  if(__any(rm>mref+8.0f)){
    const float mn=fmaxf(mref,rm), f=__builtin_amdgcn_exp2f(mref-mn);
    mref=mn; lrow*=f;
    if(hi==0)wsf[r32]=f;
    asm volatile("s_waitcnt lgkmcnt(0)":::"memory");
    #pragma unroll
    for(int d_=0;d_<2;++d_)
      #pragma unroll
      for(int rr=0;rr<16;++rr)o[d_][rr]*=wsf[crow(rr,hi)];
    asm volatile("s_waitcnt lgkmcnt(0)":::"memory");
  }
  float sacc=0.f;
  #pragma unroll
  for(int rr=0;rr<16;++rr){
    if(NA_LIVE0(rr)){p0[rr]=__builtin_amdgcn_exp2f(p0[rr]-mref);sacc+=p0[rr];}else p0[rr]=0.f;
    if(NA_LIVE1(rr)){p1[rr]=__builtin_amdgcn_exp2f(p1[rr]-mref);sacc+=p1[rr];}else p1[rr]=0.f; }
  lrow+=sacc;
  pw[0]=(u32x4){cvtpk_s(p0[0],p0[1]),cvtpk_s(p0[2],p0[3]),cvtpk_s(p0[4],p0[5]),cvtpk_s(p0[6],p0[7])};
  pw[1]=(u32x4){cvtpk_s(p0[8],p0[9]),cvtpk_s(p0[10],p0[11]),cvtpk_s(p0[12],p0[13]),cvtpk_s(p0[14],p0[15])};
  pw[2]=(u32x4){cvtpk_s(p1[0],p1[1]),cvtpk_s(p1[2],p1[3]),cvtpk_s(p1[4],p1[5]),cvtpk_s(p1[6],p1[7])};
  pw[3]=(u32x4){cvtpk_s(p1[8],p1[9]),cvtpk_s(p1[10],p1[11]),cvtpk_s(p1[12],p1[13]),cvtpk_s(p1[14],p1[15])};
  #undef NA_LIVE0
  #undef NA_LIVE1
}
constexpr int NAP=512;
#ifndef NA_SJ_EVERY
#define NA_SJ_EVERY 2
#endif
constexpr int NA_NSIDE=6;
__device__ __forceinline__ void na_unit(int b,int r,const bf16*Q,const bf16*__restrict__ K,const bf16*__restrict__ V,bf16*O,char*shm,const float*rpbl_all,float*wsf_all,int wid_in,const float*sW,unsigned char*sWT,int sitem0,unsigned*cntO){
  const int lane=lane_now(),r32=lane&31,hi=lane>>5; const int h=wid_in;
  char*wl=shm+h*16384; const unsigned lds0=(unsigned)(uintptr_t)wl;
  const float*rpbl=rpbl_all+h*480;
  const int r0=min(max(r-4,0),56);
  const long qrow0=(long)b*SEQ+(long)r*GRIDW;
  bf16x8 qr[2][4];
  #pragma unroll
  for(int qb=0;qb<2;++qb)
    #pragma unroll
    for(int d0=0;d0<4;++d0)qr[qb][d0]=*reinterpret_cast<const bf16x8*>(&Q[(qrow0+qb*32+r32)*NAP+h*D+d0*16+hi*8]);
  f32x16 o[2][2]; float mrow[2],lrow[2];
  #pragma unroll
  for(int qb=0;qb<2;++qb){o[qb][0]=f32x16{};o[qb][1]=f32x16{};mrow[qb]=-INFINITY;lrow[qb]=0.f;}
  float*wsf=wsf_all+h*64;
  const f32x16 zero=f32x16{};
  const int vb0=(int)(lds0+8192)+((lane>>4)&1)*32+(lane&3)*8+(4*hi+((lane&15)>>2))*64;
  #define NA_KROW0(tt) ((tt)<8?(long)b*SEQ+(long)(r0+(tt))*GRIDW:(long)T+(long)b*CTXL+(long)((tt)-8)*64)
  #define NA_DMA_K(tt) do{ const long kr_=NA_KROW0(tt); _Pragma("unroll") for(int c=0;c<8;++c)glds16(K+(kr_+lane)*NAP+h*D+c*8,lds0+c*1024); }while(0)
  #define NA_DMA_V(tt) do{ const long kr_=NA_KROW0(tt); _Pragma("unroll") for(int p=0;p<8;++p)glds16(V+(kr_+16*(p&3)+(lane>>2))*NAP+h*D+(p>>2)*32+(lane&3)*8,lds0+8192+p*1024); }while(0)
  NA_DMA_K(0); NA_DMA_V(0);
  #pragma unroll
  for(int qb=0;qb<2;++qb)
    #pragma unroll
    for(int d0=0;d0<4;++d0)asm volatile("":"+v"(qr[qb][d0]));
  f32x4 sv[4]; unsigned sw[4];
  #pragma unroll
  for(int i=0;i<4;++i){sv[i]=(f32x4){0.f,0.f,0.f,0.f};sw[i]=0u;}
  #define NA_SJ_I(bi) (sitem0+((bi)>>1))
  #define NA_SJ_SBASE(bi) ((const char*)sW+((((size_t)(NA_SJ_I(bi)>>10)*1024+(size_t)(64*((NA_SJ_I(bi)&1023)>>6)+4*((bi)&1)))*2048+(size_t)(32*(NA_SJ_I(bi)&63)))<<2))
  #define NA_SJ_DBASE(bi) (sWT+((size_t)(NA_SJ_I(bi)>>10)<<21)+(size_t)(32*(NA_SJ_I(bi)&63))*1024+64*((NA_SJ_I(bi)&1023)>>6))
  #define NA_SJ_ISSUE(bi) do{ const int l_=lane_now(); const unsigned vo_=((unsigned)(l_>>3)<<16)|((unsigned)(l_&7)<<4); const char*sb_=NA_SJ_SBASE(bi); \
      _Pragma("unroll") for(int i=0;i<4;++i){ const char*sbi_=sb_+((size_t)i<<13); asm volatile("global_load_dwordx4 %0, %1, %2 nt":"=v"(sv[i]):"v"(vo_),"s"(sbi_):"memory"); } }while(0)
  #define NA_SJ_CONSUME(bi) do{ const f32x4 t0_=sv[0]*W8_SCALE,t1_=sv[1]*W8_SCALE,t2_=sv[2]*W8_SCALE,t3_=sv[3]*W8_SCALE; \
      if(((bi)&1)==0){ _Pragma("unroll") for(int j=0;j<4;++j)sw[j]=pk4_fp8(t0_[j],t1_[j],t2_[j],t3_[j]); } \
      else { const int l_=lane_now(); const unsigned do_=((unsigned)(l_&7)<<12)|((unsigned)(l_>>3)<<3); unsigned char*db_=NA_SJ_DBASE(bi); \
        _Pragma("unroll") for(int j=0;j<4;++j){ u32x2 ow; ow.x=sw[j]; ow.y=pk4_fp8(t0_[j],t1_[j],t2_[j],t3_[j]); *(u32x2*)(db_+do_+j*1024)=ow; } } }while(0)
  #pragma unroll 1
  for(int t=0;t<12;++t){
    if(t==0) asm volatile("s_waitcnt vmcnt(8)":::"memory"); else asm volatile("s_waitcnt vmcnt(12)":::"memory");
    u32x4 pw[2][4];
    #pragma unroll
    for(int qb=0;qb<2;++qb){
      f32x16 p0,p1;
      qkt(p0,p1,wl,qr[qb],zero,r32,hi);
      asm volatile("s_nop 15\n\ts_nop 7":"+v"(p0),"+v"(p1));
      if(qb==1){ asm volatile("s_waitcnt lgkmcnt(0)":::"memory");
                 if(t<11) NA_DMA_K(t+1); }
      { const int qc=qb*32+r32, c0=min(max(qc-8,0),48);
        const float*bp=rpbl+(r0+t-r+7)*32+15-qc+4*hi;
        if(t<8){ if(qb==0) na_softmax<1>(p0,p1,mrow[qb],lrow[qb],o[qb],wsf,bp,c0,r32,hi,pw[qb]); else na_softmax<2>(p0,p1,mrow[qb],lrow[qb],o[qb],wsf,bp,c0,r32,hi,pw[qb]); }
        else na_softmax<0>(p0,p1,mrow[qb],lrow[qb],o[qb],wsf,bp,c0,r32,hi,pw[qb]); }
    }
    if(t==11) asm volatile("s_waitcnt vmcnt(0)":::"memory");
    asm volatile("s_waitcnt vmcnt(8)":"+v"(sv[0]),"+v"(sv[1]),"+v"(sv[2]),"+v"(sv[3])::"memory");
    if(t>0) NA_SJ_CONSUME(t-1);
    NA_SJ_ISSUE(t);
    SBAR();
    #pragma unroll
    for(int qb=0;qb<2;++qb)
      pv(o[qb],vb0,__builtin_bit_cast(bf16x8,pw[qb][0]),__builtin_bit_cast(bf16x8,pw[qb][1]),__builtin_bit_cast(bf16x8,pw[qb][2]),__builtin_bit_cast(bf16x8,pw[qb][3]));
    asm volatile("s_waitcnt lgkmcnt(0)":::"memory");
    if(t<11) NA_DMA_V(t+1);
  }
  asm volatile("s_waitcnt vmcnt(0)":"+v"(sv[0]),"+v"(sv[1]),"+v"(sv[2]),"+v"(sv[3])::"memory");
  NA_SJ_CONSUME(11);
  #undef NA_SJ_CONSUME
  #undef NA_SJ_I
  #undef NA_SJ_SBASE
  #undef NA_SJ_DBASE
  #undef NA_SJ_ISSUE
  #undef NA_KROW0
  #undef NA_DMA_K
  #undef NA_DMA_V
  const int lane_e=lane_now(), hi_e=lane_e>>5, r32_e=lane_e&31;
  #pragma unroll
  for(int qb=0;qb<2;++qb){
    float l=lrow[qb];
    {auto rr=__builtin_amdgcn_permlane32_swap(__float_as_uint(l),__float_as_uint(l),false,false);l=__uint_as_float(rr[0])+__uint_as_float(rr[1]);}
    if(hi_e==0)wsf[r32_e]=l;asm volatile("s_waitcnt lgkmcnt(0)":::"memory");
    bf16*stg=(bf16*)wl+qb*2048;
    #pragma unroll
    for(int rr=0;rr<16;++rr){const int orow=crow(rr,hi_e); const float rl=__builtin_amdgcn_rcpf(wsf[orow]);
      #pragma unroll
      for(int d0=0;d0<2;++d0)stg[orow*64+d0*32+r32_e]=(bf16)f2bf(o[qb][d0][rr]*rl);}
    asm volatile("s_waitcnt lgkmcnt(0)":::"memory");
    bf16*Ow=O+(qrow0+qb*32)*OP+h*D;
    #pragma unroll
    for(int i=0;i<4;++i){const int row=i*8+(lane_e>>3),ch=lane_e&7; const u32x4 v=*(const u32x4*)(stg+row*64+ch*8); wt16(O,(unsigned)(((int)qrow0+qb*32+row)*OP+h*D+ch*8)*2u,v);}
  }
  if(cntO) panel_signal(cntO+64*((int)(qrow0>>8)));
  asm volatile("s_waitcnt lgkmcnt(0)":::"memory");
}
#undef SBAR
#undef WAIT_BAR
}

struct MKArgs { const float* in[23]; float* out; unsigned char* ws; int ph_lo, ph_hi, li, pad; };
struct Frame {
    LAS unsigned char* lds; volatile LAS unsigned* MISC; unsigned* ctl;
    int wave, vcu, G;
};
#define FLANE (lane_now())
#define FTID (F.wave * 64 + lane_now())

struct ProjEpi {
    static constexpr bool HAS_MID = false, HAS_PRE = false; struct Pre {};
    bf16 *QA, *KA, *VA, *QB, *KB, *VB, *GA, *GB; const float *gq, *gk; const LAS float* rope;
    __device__ __forceinline__ void store_plain(const f32x4 (&acc)[2][2][4][2], bf16* dst, int pitch, int rowbase, int colbase, int fq, float scale, bool sig) const {
#pragma unroll
        for (int ai = 0; ai < 2; ++ai)
#pragma unroll
            for (int m = 0; m < 4; ++m) { const unsigned ro = (unsigned)((rowbase + ai * 128 + m * 16) * pitch + colbase + 8 * fq) * 2u;
#pragma unroll
                for (int bj = 0; bj < 2; ++bj) { f32x4 v0 = acc[ai][bj][m][0], v1 = acc[ai][bj][m][1];
                    u32x4 w;
                    constexpr float IS = PROJ_FP8 ? 1.0f / W8_SCALE : 1.0f;
                    if (sig) {
#pragma unroll
                        for (int j = 0; j < 4; ++j) v0[j] = __builtin_amdgcn_rcpf(1.0f + __builtin_amdgcn_exp2f((-LOG2E * IS) * v0[j]));
                        w.x = pk2(v0[0], v0[1]); w.y = pk2(v0[2], v0[3]); __builtin_amdgcn_sched_barrier(0);
#pragma unroll
                        for (int j = 0; j < 4; ++j) v1[j] = __builtin_amdgcn_rcpf(1.0f + __builtin_amdgcn_exp2f((-LOG2E * IS) * v1[j]));
                        w.z = pk2(v1[0], v1[1]); w.w = pk2(v1[2], v1[3]); }
                    else { v0 = v0 * (scale * IS); v1 = v1 * (scale * IS); w.x = pk2(v0[0], v0[1]); w.y = pk2(v0[2], v0[3]); w.z = pk2(v1[0], v1[1]); w.w = pk2(v1[2], v1[3]); }
                    wt16(dst, ro + bj * 64, w);
                    __builtin_amdgcn_sched_barrier(0); } }
    }
    __device__ __forceinline__ void store_head(const f32x4 (&acc)[2][2][4][2], bf16* dst, int pitch, int rowbase, int colbase, int prow0, int fr, int fq, const float* g, float scale, bool do_rope) const {
        const bool upper = (fq & 2) != 0;
#pragma unroll
        for (int ai = 0; ai < 2; ++ai)
#pragma unroll
            for (int m = 0; m < 4; ++m) {
                float ss = 0.f;
#pragma unroll
                for (int bj = 0; bj < 2; ++bj)
#pragma unroll
                    for (int n = 0; n < 2; ++n) { const f32x4 v = acc[ai][bj][m][n]; ss += (v[0] * v[0] + v[1] * v[1]) + (v[2] * v[2] + v[3] * v[3]); }
                { auto r16 = __builtin_amdgcn_permlane16_swap(__float_as_uint(ss), __float_as_uint(ss), false, false); ss = __uint_as_float(r16[0]) + __uint_as_float(r16[1]);
                  auto r32 = __builtin_amdgcn_permlane32_swap(__float_as_uint(ss), __float_as_uint(ss), false, false); ss = __uint_as_float(r32[0]) + __uint_as_float(r32[1]); }
                constexpr float IS = PROJ_FP8 ? 1.0f / W8_SCALE : 1.0f;
                const float rs = rsqrtf(ss * (IS * IS / 64.0f) + EPS) * (scale * IS);
                const unsigned ro = (unsigned)((rowbase + ai * 128 + m * 16) * pitch + colbase + 8 * fq) * 2u;
                const int prow = (prow0 + 2 * ai) & 63, pcol = 16 * m + fr;
                int fq8 = 8 * fq; asm volatile("" : "+v"(fq8));
#pragma unroll
                for (int bj = 0; bj < 2; ++bj) {
                    f32x4 y[2];
#pragma unroll
                    for (int n = 0; n < 2; ++n) { y[n] = acc[ai][bj][m][n] * rs * *(const f32x4*)(g + bj * 32 + fq8 + 4 * n);
                        if (do_rope) {
                            const int pos = bj ? pcol : prow;
                            const LAS f32x4* tp = (const LAS f32x4*)(rope + pos * 32 + ((fq & 1) * 8 + n * 4) * 2);
                            const f32x4 t0 = tp[0], t1 = tp[1];
                            const f32x4 cs = (f32x4){t0[0], t0[2], t1[0], t1[2]}, sn = (f32x4){t0[1], t0[3], t1[1], t1[3]};
                            f32x4 p;
#pragma unroll
                            for (int j = 0; j < 4; ++j) { auto rr = __builtin_amdgcn_permlane32_swap(__float_as_uint(y[n][j]), __float_as_uint(y[n][j]), false, false); p[j] = __uint_as_float(upper ? rr[0] : rr[1]); }
                            y[n] = upper ? (y[n] * cs + p * sn) : (y[n] * cs - p * sn);
                        } }
                    u32x4 w; w.x = pk2(y[0][0], y[0][1]); w.y = pk2(y[0][2], y[0][3]); w.z = pk2(y[1][0], y[1][1]); w.w = pk2(y[1][2], y[1][3]);
                    wt16(dst, ro + bj * 64, w);
                }
                __builtin_amdgcn_sched_barrier(0);
            }
    }
    __device__ __forceinline__ void operator()(const f32x4 (&acc)[2][2][4][2], const pg8::GU& u, int wr, int wc) const {
        const int lane_ = lane_now(), fr = lane_ & 15, fq = lane_ >> 4;
        const int rowbase = u.pm * 256 + wr * 64 + fr, pn = u.pn, prow0 = 4 * u.pm + wr;
        if (pn < 2) store_plain(acc, KA, 512, rowbase, 256 * pn + 64 * wc, fq, 1.0f, false);
        else if (pn < 4) store_plain(acc, VA, 512, rowbase, 256 * (pn - 2) + 64 * wc, fq, 1.0f, false);
        else if (pn == 4) { if (wc < 2) store_head(acc, KB, 128, rowbase, 64 * wc, prow0, fr, fq, gk, 1.0f, u.pm < 64); else store_plain(acc, VB, 128, rowbase, 64 * (wc - 2), fq, 1.0f, false); }
        else if (pn < 7) store_plain(acc, QA, 512, rowbase, 256 * (pn - 5) + 64 * wc, fq, QSCALE, false);
        else if (pn < 9) store_head(acc, QB, 512, rowbase, 256 * (pn - 7) + 64 * wc, prow0, fr, fq, gq, QSCALE, true);
        else if (pn < 13) store_plain(acc, GA, 1024, rowbase, 256 * (pn - 9) + 64 * wc, fq, 1.0f, true);
        else store_plain(acc, GB, 1024, rowbase, 256 * (pn - 13) + 64 * wc, fq, 1.0f, true);
    }
};
struct ProjSched {
    static constexpr bool HAS_DEP = false, HAS_DONE = false;
    const char* Abase; const char* Bbase; const int* rowlist; int v, G;
    __device__ __forceinline__ bool next(int i, pg8::GU& u) const {
        const int id = i * G + v; constexpr int NL = 64 * 17, NC = 4 * 5;
        if (id >= NL + NC) return false;
        int pm, pn; if (id < NL) { pm = id / 17; pn = id % 17; } else { const int c = id - NL; pm = 64 + c / 5; pn = c % 5; }
        u.pm = pm; u.pn = pn; u.e = 0; u.cnt = 256; u.rows = 0u;
        u.a = (unsigned)pm * 256u * PROJ_PITCH; u.b = (unsigned)pn * 256u * PROJ_PITCH;
        return true;
    }
};


struct Dense4Sched {
    static constexpr bool HAS_DEP = false, HAS_DONE = false;
    const char* Abase; const char* Bbase; const int* rowlist; int v, G;
    __device__ __forceinline__ bool next(int i, pg8::GU& u) const {
        const int id = i * G + v; if (id >= 64 * 4) return false;
        u.pm = id >> 2; u.pn = id & 3; u.e = 0; u.cnt = 256; u.rows = 0u;
        u.a = (unsigned)u.pm * 256u * pg8::PITCH; u.b = (unsigned)u.pn * 256u * pg8::PITCH; return true;
    }
};
struct UEpi {
    static constexpr bool HAS_MID = true, HAS_PRE = false; struct Pre {};
    const bf16 *GA, *GB; bf16* U;
    __device__ __forceinline__ void mid(f32x4 (&acc)[2][2][4][2], const pg8::GU& u, int wr, int wc) const {
        const int lane_ = lane_now(), fr = lane_ & 15, fq = lane_ >> 4;
        const unsigned base = (unsigned)((u.pm * 256 + wr * 64 + fr) * 1024 + u.pn * 256 + wc * 32 + 8 * fq) * 2u;
#pragma unroll
        for (int ai = 0; ai < 2; ++ai)
#pragma unroll
            for (int m = 0; m < 4; ++m)
#pragma unroll
                for (int bj = 0; bj < 2; ++bj) { const unsigned o = base + (unsigned)((ai * 128 + m * 16) * 1024 + bj * 128) * 2u;
                    const u32x4 a = *(const u32x4*)((const char*)GA + o), b = *(const u32x4*)((const char*)GB + o);
                    f32x4 r0, r1;
                    r0[0] = bflo(a.x) * __builtin_amdgcn_rcpf(bflo(b.x)); r0[1] = bfhi(a.x) * __builtin_amdgcn_rcpf(bfhi(b.x)); r0[2] = bflo(a.y) * __builtin_amdgcn_rcpf(bflo(b.y)); r0[3] = bfhi(a.y) * __builtin_amdgcn_rcpf(bfhi(b.y));
                    r1[0] = bflo(a.z) * __builtin_amdgcn_rcpf(bflo(b.z)); r1[1] = bfhi(a.z) * __builtin_amdgcn_rcpf(bfhi(b.z)); r1[2] = bflo(a.w) * __builtin_amdgcn_rcpf(bflo(b.w)); r1[3] = bfhi(a.w) * __builtin_amdgcn_rcpf(bfhi(b.w));
                    acc[ai][bj][m][0] = acc[ai][bj][m][0] * r0; acc[ai][bj][m][1] = acc[ai][bj][m][1] * r1; }
    }
    __device__ __forceinline__ void operator()(const f32x4 (&acc)[2][2][4][2], const pg8::GU& u, int wr, int wc) const {
        const int lane_ = lane_now(), fr = lane_ & 15, fq = lane_ >> 4;
        const unsigned base = (unsigned)((u.pm * 256 + wr * 64 + fr) * 1024 + u.pn * 256 + wc * 32 + 8 * fq) * 2u;
#pragma unroll
        for (int ai = 0; ai < 2; ++ai)
#pragma unroll
            for (int m = 0; m < 4; ++m)
#pragma unroll
                for (int bj = 0; bj < 2; ++bj) { const unsigned o = base + (unsigned)((ai * 128 + m * 16) * 1024 + bj * 128) * 2u;
                    const u32x4 b = *(const u32x4*)((const char*)GB + o); const f32x4 v0 = acc[ai][bj][m][0], v1 = acc[ai][bj][m][1];
                    u32x4 w; w.x = pk2(v0[0] * bflo(b.x), v0[1] * bfhi(b.x)); w.y = pk2(v0[2] * bflo(b.y), v0[3] * bfhi(b.y)); w.z = pk2(v1[0] * bflo(b.z), v1[1] * bfhi(b.z)); w.w = pk2(v1[2] * bflo(b.w), v1[3] * bfhi(b.w));
                    wt16(U, o, w); }
    }
};
struct YEpi {
    static constexpr bool HAS_MID = false, HAS_PRE = false; struct Pre {};
    bf16* Y;
    __device__ __forceinline__ void operator()(const f32x4 (&acc)[2][2][4][2], const pg8::GU& u, int wr, int wc) const {
        const int lane_ = lane_now(), fr = lane_ & 15, fq = lane_ >> 4;
        const unsigned base = (unsigned)((u.pm * 256 + wr * 64 + fr) * 1024 + u.pn * 256 + wc * 32 + 8 * fq) * 2u;
#pragma unroll
        for (int ai = 0; ai < 2; ++ai)
#pragma unroll
            for (int m = 0; m < 4; ++m)
#pragma unroll
                for (int bj = 0; bj < 2; ++bj) { const f32x4 v0 = acc[ai][bj][m][0], v1 = acc[ai][bj][m][1]; u32x4 w; w.x = pk2(v0[0], v0[1]); w.y = pk2(v0[2], v0[3]); w.z = pk2(v1[0], v1[1]); w.w = pk2(v1[2], v1[3]);
                    wt16(Y, base + (unsigned)((ai * 128 + m * 16) * 1024 + bj * 128) * 2u, w); }
    }
};
constexpr int MW_TSTART = 900, MW_ECN = 940;
constexpr int GQ_SIDE_DN_ = 512 * NWAVES * attn_body::GQ_ND;
constexpr int CV_TAIL2 = NE * I_DN - GQ_SIDE_DN_, CV_TAIL7 = 0, CV_BAL0 = 3200;
constexpr int CV_HEAD = I_IN + 2 * I_OA + I_O, NA_SIDE_N = 256 * NWAVES * attn_body::NA_NSIDE, GQ_SIDE_N = 512 * NWAVES * attn_body::GQ_NJ, P3_SIDE_N = NA_SIDE_N + GQ_SIDE_N, GQ_SIDE_DN = 512 * NWAVES * attn_body::GQ_ND;
static_assert(P3_SIDE_N <= NE * I_GU && MOE_FP8, "NA side job converts w_gu items to e4m3");
#define CV_ITEM(j) ((j) < CV_HEAD ? (j) : (j) + P3_SIDE_N)
static_assert(CV_TAIL2 + CV_TAIL7 <= NE * I_DN, "only w_dn items may move behind P0");
__device__ __forceinline__ void moe_table(const Frame& F, const unsigned* ecnt) {
    if (FTID < 32) F.MISC[MW_ECN + FTID] = ecnt[FTID];
    __syncthreads();
    if (FTID == 0) { unsigned t = 0; for (int e = 0; e < 32; ++e) { F.MISC[MW_TSTART + e] = t; t += (F.MISC[MW_ECN + e] + 255u) >> 8; } F.MISC[MW_TSTART + 32] = t; }
    __syncthreads();
}
template <int NPN  , bool GU_PHASE>
struct MoeSched {
    static constexpr bool HAS_DEP = !GU_PHASE, HAS_DONE = GU_PHASE;
    const char* Abase; const char* Bbase; const int* rowlist; volatile LAS unsigned* MISC; int v, G; unsigned* cntA; unsigned* tmo;
    __device__ __forceinline__ void done(const pg8::GU& u) const { if (cntA != nullptr) panel_signal(cntA + 64 * u.pm); }
    __device__ __forceinline__ void a_ready(int i, const pg8::GU& u, int wid) const {
        if (cntA == nullptr || i < 4) return;
        if (wid == 0) { unsigned sp = 0u;
            while (__hip_atomic_load(cntA + 64 * u.pm, __ATOMIC_RELAXED, __HIP_MEMORY_SCOPE_AGENT) < 64u) { __builtin_amdgcn_s_sleep(2);
                if (++sp > (1u << 20)) { if (lane_now() == 0) __hip_atomic_store(tmo, 0xC0DEu, __ATOMIC_RELAXED, __HIP_MEMORY_SCOPE_AGENT); break; } }
            __builtin_amdgcn_fence(__ATOMIC_ACQUIRE, "agent"); }
        asm volatile("" ::: "memory"); __builtin_amdgcn_s_barrier(); asm volatile("" ::: "memory");
    }
    __device__ __forceinline__ bool next(int i, pg8::GU& u) const {
        const int id = i * G + v; const int tile = id / NPN, pn = id % NPN;
        if (tile >= (int)__builtin_amdgcn_readfirstlane(MISC[MW_TSTART + 32])) return false;
        int e = 0;
#pragma unroll
        for (int st = 16; st >= 1; st >>= 1) { if (tile >= (int)__builtin_amdgcn_readfirstlane(MISC[MW_TSTART + e + st])) e += st; }
        const int mt = tile - (int)__builtin_amdgcn_readfirstlane(MISC[MW_TSTART + e]);
        const int cnt_e = (int)__builtin_amdgcn_readfirstlane(MISC[MW_ECN + e]);
        u.pm = tile; u.pn = pn; u.e = e; u.cnt = min(256, cnt_e - mt * 256); u.rows = (unsigned)(e * ECAP + mt * 256);
        if (GU_PHASE) { u.a = 0u; u.b = (unsigned)(e * 2048 + pn * 128) * MOE_PITCH; }
        else { u.a = (unsigned)tile * 256u * MOE_PITCH; u.b = (unsigned)(e * 1024 + pn * 256) * MOE_PITCH; }
        return true;
    }
};
struct GuEpi {
    static constexpr bool HAS_MID = false, HAS_PRE = true; struct Pre { f32x4 g[2], l[2]; };
    const float* b_gu; bf16* ACT;
    __device__ __forceinline__ void prefetch(Pre& pre, const pg8::GU& u, int wr, int wc) const {
        const int c0 = u.pn * 128 + wc * 32 + 8 * (lane_now() >> 4);
#pragma unroll
        for (int bj = 0; bj < 2; ++bj) { const float* pg = b_gu + u.e * 2048 + c0 + bj * 4; const float* pl = pg + 1024;
            asm volatile("global_load_dwordx4 %0, %1, off" : "=v"(pre.g[bj]) : "v"(pg) : "memory"); asm volatile("global_load_dwordx4 %0, %1, off" : "=v"(pre.l[bj]) : "v"(pl) : "memory"); }
    }
    __device__ __forceinline__ void wait(Pre& pre) const { asm volatile("s_waitcnt vmcnt(16)" : "+v"(pre.g[0]), "+v"(pre.g[1]), "+v"(pre.l[0]), "+v"(pre.l[1]) :: "memory"); }
    __device__ __forceinline__ void operator()(const f32x4 (&acc)[2][2][4][2], const pg8::GU& u, int wr, int wc, const Pre& pre) const {
        using f32x2 = __attribute__((ext_vector_type(2))) float;
        const int lane_ = lane_now(), fr = lane_ & 15, fq = lane_ >> 4;
        const int c0 = u.pn * 128 + wc * 32 + 8 * fq;
        constexpr float ws_ = 1.0f / W8_SCALE, wl_ = ACT8_SCALE / W8_SCALE, cexp = -SW_ALPHA * LOG2E, llo = ACT8_SCALE * (1.0f - SW_LIMIT), lhi = ACT8_SCALE * (1.0f + SW_LIMIT);
        f32x2 bg[2][2], bl[2][2];
#pragma unroll
        for (int bj = 0; bj < 2; ++bj) { const f32x4 g4 = pre.g[bj], l4 = pre.l[bj];
            bg[bj][0] = (f32x2){g4[0], g4[1]}; bg[bj][1] = (f32x2){g4[2], g4[3]};
            bl[bj][0] = (f32x2){l4[0], l4[1]} * ACT8_SCALE + ACT8_SCALE; bl[bj][1] = (f32x2){l4[2], l4[3]} * ACT8_SCALE + ACT8_SCALE; }
        const int odd = fq & 1;
#pragma unroll
        for (int ai = 0; ai < 2; ++ai)
#pragma unroll
            for (int m2 = 0; m2 < 4; m2 += 2) { unsigned w[2][2];
#pragma unroll
                for (int q = 0; q < 2; ++q) { const int m = m2 + q;
#pragma unroll
                    for (int bj = 0; bj < 2; ++bj) { const f32x4 G = acc[ai][bj][m][0], L = acc[ai][bj][m][1]; f32x2 o2[2];
#pragma unroll
                        for (int hh = 0; hh < 2; ++hh) {
                            f32x2 g = (f32x2){G[2 * hh], G[2 * hh + 1]} * ws_ + bg[bj][hh];
                            g.x = fminf(g.x, SW_LIMIT); g.y = fminf(g.y, SW_LIMIT);
                            const f32x2 ea = g * cexp; f32x2 e; e.x = __builtin_amdgcn_exp2f(ea.x); e.y = __builtin_amdgcn_exp2f(ea.y);
                            e = e + 1.0f; f32x2 r; r.x = __builtin_amdgcn_rcpf(e.x); r.y = __builtin_amdgcn_rcpf(e.y);
                            f32x2 l = (f32x2){L[2 * hh], L[2 * hh + 1]} * wl_ + bl[bj][hh];
                            l.x = fminf(fmaxf(l.x, llo), lhi); l.y = fminf(fmaxf(l.y, llo), lhi);
                            o2[hh] = (l * g) * r; }
                        w[q][bj] = pk4_fp8(o2[0].x, o2[0].y, o2[1].x, o2[1].y); } }
                const auto rx = __builtin_amdgcn_permlane16_swap(w[0][0], w[1][0], false, false); const auto ry = __builtin_amdgcn_permlane16_swap(w[0][1], w[1][1], false, false);
                u32x4 o; o.x = rx[0]; o.y = ry[0]; o.z = rx[1]; o.w = ry[1];
                const int r = ai * 128 + wr * 64 + (m2 + odd) * 16 + fr;
                if (r < u.cnt) wt16(ACT, (unsigned)((u.pm * 256 + r) * DFF + c0 - 8 * odd), o); }
    }
};
struct DnEpi {
    static constexpr bool HAS_MID = false, HAS_PRE = false; struct Pre {};
    const float* b_dn; const int* LIST; const float* TOPW; bf16* YS;
    __device__ __forceinline__ void operator()(const f32x4 (&acc)[2][2][4][2], const pg8::GU& u, int wr, int wc) const {
        const int lane_ = lane_now(), fr = lane_ & 15, fq = lane_ >> 4;
        const int c0 = u.pn * 256 + wc * 32 + 8 * fq;
        f32x4 bb[2][2];
#pragma unroll
        for (int bj = 0; bj < 2; ++bj)
#pragma unroll
            for (int n = 0; n < 2; ++n) bb[bj][n] = *(const f32x4*)(b_dn + u.e * 1024 + c0 + bj * 128 + n * 4);
        u32x2 ent[2][4];
#pragma unroll
        for (int ai = 0; ai < 2; ++ai)
#pragma unroll
            for (int m = 0; m < 4; ++m) { const int r = ai * 128 + wr * 64 + m * 16 + fr; ent[ai][m] = *(const u32x2*)(LIST + 2 * (size_t)(u.rows + (r < u.cnt ? r : 0))); }
        const int odd = fq & 1;
#pragma unroll
        for (int ai = 0; ai < 2; ++ai)
#pragma unroll
            for (int m2 = 0; m2 < 4; m2 += 2) { unsigned o[2][2][2];
#pragma unroll
                for (int q = 0; q < 2; ++q) { const unsigned wbits = ent[ai][m2 + q].y; const float w = __builtin_bit_cast(float, wbits);
                    constexpr float ds_ = 1.0f / (W8_SCALE * ACT8_SCALE); const float w8 = w * YS8_SCALE;
#pragma unroll
                    for (int bj = 0; bj < 2; ++bj) { const f32x4 v0 = (acc[ai][bj][m2 + q][0] * ds_ + bb[bj][0]) * w8, v1 = (acc[ai][bj][m2 + q][1] * ds_ + bb[bj][1]) * w8;
                        o[q][bj][0] = pk4_fp8(v0[0], v0[1], v0[2], v0[3]); o[q][bj][1] = pk4_fp8(v1[0], v1[1], v1[2], v1[3]); } }
                const unsigned a = odd ? ent[ai][m2 + 1].x : ent[ai][m2].x;
                const int r = ai * 128 + wr * 64 + (m2 + odd) * 16 + fr;
#pragma unroll
                for (int bj = 0; bj < 2; ++bj) {
                    const auto rx = __builtin_amdgcn_permlane16_swap(o[0][bj][0], o[1][bj][0], false, false); const auto ry = __builtin_amdgcn_permlane16_swap(o[0][bj][1], o[1][bj][1], false, false);
                    u32x4 ov; ov.x = rx[0]; ov.y = ry[0]; ov.z = rx[1]; ov.w = ry[1];
                    if (r < u.cnt) *(u32x4*)((char*)YS + (a * (unsigned)DM + (unsigned)(c0 + bj * 128 - 8 * odd))) = ov; } }
    }
};

__global__ void __launch_bounds__(NWAVES * 64, 2) mk_fwd(MKArgs args) {
    extern __shared__ __attribute__((aligned(16))) unsigned char lds[];
    Frame F;
    F.lds = (LAS unsigned char*)lds; F.MISC = (volatile LAS unsigned*)(F.lds + MISC_OFF);
    F.wave = __builtin_amdgcn_readfirstlane(threadIdx.x >> 6);

    F.G = gridDim.x; { const int bx = blockIdx.x; F.vcu = (F.G % 8 == 0) ? (bx % 8) * (F.G / 8) + bx / 8 : bx; }
    unsigned char* ws = args.ws;
    F.ctl = (unsigned*)(ws + WS_CTL);
    const float* x = args.in[0]; const float* c = args.in[1]; const float* ctx = args.in[2]; const float* cctx = args.in[3];
    const float* w_mod = args.in[4]; const float* b_mod = args.in[5]; const float* g_pre_mix = args.in[6];
    const float* g_qn = args.in[12]; const float* g_kn = args.in[13];
    float* MOD = (float*)(ws + WS_MOD);
    bf16 *WTIN = (bf16*)(ws + WS_WTIN), *H = (bf16*)(ws + WS_H);
    for (int u = FTID; u < (LDS_BYTES - MISC_OFF) / 4; u += NWAVES * 64) ((LAS unsigned*)(F.lds + MISC_OFF))[u] = 0u;
    { LAS float* rt = (LAS float*)(F.lds + ROPE_OFF);
      for (int i = FTID; i < 64 * 16; i += NWAVES * 64) { const int pos = i >> 4, j = i & 15; const float f = powf(10000.0f, -(float)j / 16.0f); const float a = (float)pos * f; rt[2 * i] = cosf(a); rt[2 * i + 1] = sinf(a); } }
    __syncthreads();
    unsigned long long _pbstart = 0; if (PROBE_SEL >= 20) _pbstart = __builtin_amdgcn_s_memrealtime();
    const bool use_bar = (args.ph_hi - args.ph_lo) > 1;
    XcdBarrier bar; bar.bar = F.ctl + CW_BAR + args.li * XCD_BAR_WORDS; bar.x = 0; bar.st = nullptr;
    if (use_bar) bar = xcd_barrier_post(F.ctl + CW_BAR + args.li * XCD_BAR_WORDS, F.MISC + 8);
    const int lo = args.ph_lo, hi = args.ph_hi;
#define IN(k) (lo <= (k) && (k) < hi)
#define BOTH(k) (IN(k) && IN((k) + 1))
#define GRID_BAR() xcd_barrier(bar, F.wave)
    const bool handoff = (F.G == 256);

    const bool merge01 = handoff && IN(0) && IN(1);
    if (IN(0)) {
        if (F.vcu < 192) {
            LAS float* sil = (LAS float*)(F.lds + RING_OFF);
            LAS float* red = (LAS float*)(F.lds + RING_OFF + 20480);
            const int tid = FTID, n0 = F.vcu * 32;
            for (int i = tid; i < 5 * 1024; i += 512) { const int r = i >> 10, k = i & 1023; const float v = r < 4 ? c[r * 1024 + k] : cctx[k]; sil[i] = v / (1.0f + __expf(-v)); }
            __syncthreads();
            const int cg = tid & 7, kr = tid >> 3;
            float acc[5][4];
#pragma unroll
            for (int r = 0; r < 5; ++r)
#pragma unroll
                for (int j = 0; j < 4; ++j) acc[r][j] = 0.f;
#pragma unroll 8
            for (int k = kr; k < 1024; k += 64) {
                const f32x4 w = __builtin_nontemporal_load((const f32x4*)(w_mod + (size_t)k * 6144 + n0 + 4 * cg));
#pragma unroll
                for (int r = 0; r < 5; ++r) { const float s = sil[r * 1024 + k]; acc[r][0] += s * w[0]; acc[r][1] += s * w[1]; acc[r][2] += s * w[2]; acc[r][3] += s * w[3]; }
            }
#pragma unroll
            for (int r = 0; r < 5; ++r)
#pragma unroll
                for (int j = 0; j < 4; ++j) red[(kr * 5 + r) * 32 + 4 * cg + j] = acc[r][j];
            __syncthreads();
            if (tid < 160) { const int r = tid >> 5, n = tid & 31; float sm = 0.f; for (int i = 0; i < 64; ++i) sm += red[(i * 5 + r) * 32 + n];
                __hip_atomic_store((unsigned*)(MOD + r * 6144 + n0 + n), __builtin_bit_cast(unsigned, sm + b_mod[n0 + n]), __ATOMIC_RELAXED, __HIP_MEMORY_SCOPE_AGENT); }
            asm volatile("s_waitcnt vmcnt(0)" ::: "memory");
            __syncthreads();
            if (merge01 && F.wave == 0 && lane_now() < 8) (void)__hip_atomic_fetch_add(F.ctl + CW_CNTM + 64 * lane_now(), 1u, __ATOMIC_RELAXED, __HIP_MEMORY_SCOPE_AGENT);
            PROBE_MARK(37);
        }
        {
            WPtrs P{args.in[10], args.in[14], args.in[15], args.in[16], args.in[19], args.in[21], WTIN, (bf16*)(ws + WS_WTOAB), (bf16*)(ws + WS_WTO), (bf16*)(ws + WS_WTGU), (bf16*)(ws + WS_WTDN)};
            float* scr = (float*)(lds + RING_OFF + 61440 + F.wave * 8448);
            const int n0items = ((F.G == 256) ? NITEMS_W - CV_TAIL2 - CV_TAIL7 - GQ_SIDE_DN : NITEMS_W) - P3_SIDE_N;
            if (F.G == 256) {
                const int m1 = n0items - CV_BAL0;
                for (int it = F.vcu * NWAVES + F.wave; it < m1; it += 256 * NWAVES) convert_item(P, CV_ITEM(it), scr, FLANE);
                if (F.vcu >= 192) for (int it = m1 + (F.vcu - 192) * NWAVES + F.wave; it < n0items; it += 64 * NWAVES) convert_item(P, CV_ITEM(it), scr, FLANE);
            } else
            for (int it = F.vcu * NWAVES + F.wave; it < n0items; it += F.G * NWAVES) convert_item(P, CV_ITEM(it), scr, FLANE);
        }
        if (merge01) {
            __syncthreads();
            panel_wait(F.ctl + CW_CNTM + 64 * (F.vcu & 7), 192u, F.ctl + CW_TMO, F.wave);
            PROBE_MARK(38);
            { const int rb = F.vcu * NWAVES + F.wave;
              if (PROJ_FP8) { hnorm_rows4(rb, 2048, x, g_pre_mix, MOD, H, FLANE); hnorm_rows4(rb + 4 * 2048, 2048, x, g_pre_mix, MOD, H, FLANE);
                  for (int row = rb + 8 * 2048; row < TR; row += 2048) hnorm_row(row, x, ctx, g_pre_mix, MOD, H, FLANE); }
              else for (int row = rb; row < TR; row += F.G * NWAVES) hnorm_row(row, x, ctx, g_pre_mix, MOD, H, FLANE); }
        }
        if (BOTH(0)) GRID_BAR();
        PROBE_MARK(21);
    }
    if (IN(1) && !merge01) {
        for (int row = F.vcu * NWAVES + F.wave; row < TR; row += F.G * NWAVES) hnorm_row(row, x, ctx, g_pre_mix, MOD, H, FLANE);
        if (BOTH(1)) GRID_BAR();
        PROBE_MARK(22);
    }
    if (IN(2)) {
        ProjSched S{(const char*)H, (const char*)WTIN, nullptr, F.vcu, F.G};
        ProjEpi E{(bf16*)(ws + WS_QA), (bf16*)(ws + WS_KA), (bf16*)(ws + WS_VA), (bf16*)(ws + WS_QB), (bf16*)(ws + WS_KB), (bf16*)(ws + WS_VB), (bf16*)(ws + WS_GA), (bf16*)(ws + WS_GB), g_qn, g_kn, (const LAS float*)(F.lds + ROPE_OFF)};
        pg8::gemm_phase<ProjEpi, ProjSched, false, 1, PROJ_FP8 != 0>(F.lds + RING_OFF, S, E, F.wave);
        if (F.G == 256 && F.vcu >= (64 * 17 + 4 * 5) % 256) {
            constexpr int R2 = (64 * 17 + 4 * 5) % 256;
            WPtrs P{args.in[10], args.in[14], args.in[15], args.in[16], args.in[19], args.in[21], WTIN, (bf16*)(ws + WS_WTOAB), (bf16*)(ws + WS_WTO), (bf16*)(ws + WS_WTGU), (bf16*)(ws + WS_WTDN)};
            float* scr = (float*)(lds + RING_OFF + 61440 + F.wave * 8448);
            constexpr int A0 = NITEMS_W - CV_TAIL2 - CV_TAIL7;
            for (int it = A0 + (F.vcu - R2) * NWAVES + F.wave; it < A0 + CV_TAIL2; it += (256 - R2) * NWAVES) convert_item(P, it, scr, FLANE);
        }
        if (BOTH(2)) GRID_BAR();
        PROBE_MARK(23);
    }
    if (IN(3)) {
        { LAS float* rp = (LAS float*)(F.lds + NAX_OFF); const float* rpb = args.in[11];
          for (int i = FTID; i < 8 * 480; i += NWAVES * 64) { const int h = i / 480, rem = i % 480, ro = rem >> 5, co = rem & 31; rp[i] = co < 31 ? rpb[(h * 15 + ro) * 31 + co] * LOG2E : 0.f; } }
        __syncthreads();
        const bf16 *QAp = (const bf16*)(ws + WS_QA), *KAp = (const bf16*)(ws + WS_KA), *VAp = (const bf16*)(ws + WS_VA), *QBp = (const bf16*)(ws + WS_QB), *KBp = (const bf16*)(ws + WS_KB), *VBp = (const bf16*)(ws + WS_VB);
        bf16* Op = (bf16*)(ws + WS_O);
        PROBE_BEGIN(4)
        for (int id = F.vcu; id < 512; id += F.G) {
            const int v = id & 255, i2 = id >> 8, bk = v >> 5, local = (v & 31) + 32 * i2;
            attn_body::gqa_unit<8>(bk >> 1, (bk & 1) * 4 + (local >> 4), local & 15, QBp, KBp, VBp, Op, (char*)lds + RING_OFF, F.wave, handoff ? F.ctl + CW_CNTO : nullptr,
                                    args.in[19], (unsigned char*)(ws + WS_WTGU), NA_SIDE_N + (id * NWAVES + F.wave) * attn_body::GQ_NJ,
                                    args.in[21], (unsigned char*)(ws + WS_WTDN), (id * NWAVES + F.wave) * attn_body::GQ_ND);
        }
        if (F.wave == 0) PROBE_END(4, F.lds + MISC_OFF);
        PROBE_MARK(24);
        PROBE_BEGIN(5)
        for (int id = F.vcu; id < 256; id += F.G)
            attn_body::na_unit(id >> 6, id & 63, QAp, KAp, VAp, Op, (char*)lds + RING_OFF, (const float*)(lds + NAX_OFF), (float*)(lds + NAX_OFF + 15360), F.wave, args.in[19], (unsigned char*)(ws + WS_WTGU), (id * NWAVES + F.wave) * attn_body::NA_NSIDE, handoff ? F.ctl + CW_CNTO : nullptr);
        if (F.wave == 0) PROBE_END(5, F.lds + MISC_OFF);
        PROBE_MARK(25);
        if (BOTH(3) && !handoff) GRID_BAR();
    }
    if (IN(4)) {
        Dense4Sched S{(const char*)(ws + WS_O), (const char*)(ws + WS_WTOAB), nullptr, F.vcu, F.G};
        UEpi E{(const bf16*)(ws + WS_GA), (const bf16*)(ws + WS_GB), (bf16*)(ws + WS_U)};
        if (handoff) panel_wait(F.ctl + CW_CNTO + 64 * (F.vcu >> 2), 96u, F.ctl + CW_TMO, F.wave);
        PROBE_MARK(30);
        pg8::gemm_phase<UEpi, Dense4Sched, false, 3>(F.lds + RING_OFF, S, E, F.wave);
        if (handoff) panel_signal(F.ctl + CW_CNTU + 64 * (F.vcu >> 2));
        PROBE_MARK(31);
        if (BOTH(4) && !handoff) GRID_BAR();
    }
    if (IN(5)) {
        Dense4Sched S{(const char*)(ws + WS_U), (const char*)(ws + WS_WTO), nullptr, F.vcu, F.G};
        YEpi E{(bf16*)(ws + WS_Y)};
        if (handoff) panel_wait(F.ctl + CW_CNTU + 64 * (F.vcu >> 2), 32u, F.ctl + CW_TMO, F.wave);
        PROBE_MARK(32);
        pg8::gemm_phase<YEpi, Dense4Sched, false, 3>(F.lds + RING_OFF, S, E, F.wave);
        if (handoff) panel_signal(F.ctl + CW_CNTY + 64 * (F.vcu >> 2));
        PROBE_MARK(26);
        if (BOTH(5) && !handoff) GRID_BAR();
    }
    if (IN(6)) {
        for (int blk = F.vcu; blk < T / 64; blk += F.G) {
            if (handoff) panel_wait(F.ctl + CW_CNTY + 64 * (blk >> 2), 32u, F.ctl + CW_TMO, F.wave);
            PROBE_MARK(34);
            rowpass_block(blk, x, (const bf16*)(ws + WS_Y), MOD, args.in[7], args.in[8], args.in[17], args.in[18], (bf16*)(ws + WS_H2), (float*)(ws + WS_RSTD1), (int*)(ws + WS_TOPE), (float*)(ws + WS_TOPW),
                          F.ctl + CW_ECNT, (int*)(ws + WS_LIST), lds + RING_OFF, lds + MISC_OFF + 256, F.wave, (bf16*)(ws + WS_X1B)); }
        PROBE_MARK(35);
        if (BOTH(6)) GRID_BAR();
        PROBE_MARK(27);
    }
    if (IN(7)) {
        moe_table(F, F.ctl + CW_ECNT);
        const bool h78 = handoff && IN(8);
        MoeSched<8, true> S{(const char*)(ws + WS_H2), (const char*)(ws + WS_WTGU), (const int*)(ws + WS_LIST), F.MISC, F.vcu, F.G, h78 ? F.ctl + CW_CNTA : nullptr, F.ctl + CW_TMO};
        GuEpi E{args.in[20], (bf16*)(ws + WS_ACT)};
        PROBE_BEGIN(3)
        pg8::gemm_phase<GuEpi, MoeSched<8, true>, true, 2, MOE_FP8 != 0>(F.lds + RING_OFF, S, E, F.wave);
        if (F.G == 256 && CV_TAIL7 > 0) {
            int r7 = ((int)__builtin_amdgcn_readfirstlane(F.MISC[MW_TSTART + 32]) * 8) & 255;
            if (256 - r7 < 64) r7 = 0;
            if (F.vcu >= r7) {
                WPtrs P{args.in[10], args.in[14], args.in[15], args.in[16], args.in[19], args.in[21], WTIN, (bf16*)(ws + WS_WTOAB), (bf16*)(ws + WS_WTO), (bf16*)(ws + WS_WTGU), (bf16*)(ws + WS_WTDN)};
                float* scr = (float*)(lds + RING_OFF + 61440 + F.wave * 8448);
                for (int it = NITEMS_W - CV_TAIL7 + (F.vcu - r7) * NWAVES + F.wave; it < NITEMS_W; it += (256 - r7) * NWAVES) convert_item(P, it, scr, FLANE);
            }
        }
        if (F.wave == 0) PROBE_END(3, F.lds + MISC_OFF);
        PROBE_MARK(28);
        if (BOTH(7) && !handoff) GRID_BAR();
    }
    if (IN(8)) {
        moe_table(F, F.ctl + CW_ECNT);
        const bool h78 = handoff && IN(7);
        int v8 = F.vcu;
        if (h78) v8 = (F.vcu - (((int)__builtin_amdgcn_readfirstlane(F.MISC[MW_TSTART + 32]) * 8) & 255)) & 255;
        MoeSched<4, false> S{(const char*)(ws + WS_ACT), (const char*)(ws + WS_WTDN), (const int*)(ws + WS_LIST), F.MISC, v8, F.G, h78 ? F.ctl + CW_CNTA : nullptr, F.ctl + CW_TMO};
        if (h78) {
            if (F.wave == 0) {
                int t4[4]; pg8::GU u0;
#pragma unroll
                for (int i = 0; i < 4; ++i) t4[i] = S.next(i, u0) ? u0.pm : -1;
                const int l = lane_now(); const int mine = l == 0 ? t4[0] : l == 1 ? t4[1] : l == 2 ? t4[2] : l == 3 ? t4[3] : -1;
                bool ok = mine < 0; unsigned sp = 0u;
                for (;;) {
                    if (!ok) ok = __hip_atomic_load(S.cntA + 64 * mine, __ATOMIC_RELAXED, __HIP_MEMORY_SCOPE_AGENT) >= 64u;
                    if (__builtin_amdgcn_ballot_w64(!ok) == 0ull) break;
                    __builtin_amdgcn_s_sleep(2);
                    if (++sp > (1u << 20)) { if (l == 0) __hip_atomic_store(F.ctl + CW_TMO, 0xC0DEu, __ATOMIC_RELAXED, __HIP_MEMORY_SCOPE_AGENT); break; }
                }
                __builtin_amdgcn_fence(__ATOMIC_ACQUIRE, "agent"); asm volatile("s_waitcnt vmcnt(0)" ::: "memory");
            }
            __syncthreads();
        }
        DnEpi E{args.in[22], (const int*)(ws + WS_LIST), (const float*)(ws + WS_TOPW), (bf16*)(ws + WS_YS)};
        PROBE_BEGIN(13)
        pg8::gemm_phase<DnEpi, MoeSched<4, false>, false, 3, MOE_FP8 != 0>(F.lds + RING_OFF, S, E, F.wave);
        if (F.wave == 0) PROBE_END(13, F.lds + MISC_OFF);
        if (BOTH(8)) GRID_BAR();
        PROBE_MARK(29);
    }
    if (IN(9)) {
        if (F.G == 256) {
            for (int t = F.vcu * NWAVES + F.wave; t < T; t += 2 * F.G * NWAVES)
                final_rows2(t, t + F.G * NWAVES, (const bf16*)(ws + WS_X1B), (const bf16*)(ws + WS_YS), MOD, args.in[9], args.out, FLANE);
        } else
        for (int t = F.vcu * NWAVES + F.wave; t < T; t += F.G * NWAVES)
            final_row(t, x, (const bf16*)(ws + WS_Y), (const float*)(ws + WS_RSTD1), (const bf16*)(ws + WS_YS), MOD, args.in[7], args.in[9], args.out, FLANE);
    }
    if (PROBE_SEL != 0 && blockIdx.x == 0 && F.wave == 0) {
        const unsigned long long t0 = __builtin_amdgcn_s_memrealtime(); const unsigned long long want = 8ull * (unsigned long long)F.MISC[MW_PROBE];
        while (__builtin_amdgcn_s_memrealtime() - t0 < want) __builtin_amdgcn_s_sleep(8);
    }
#undef IN
#undef BOTH
#undef GRID_BAR
}

#ifndef MK_SPLIT
#define MK_SPLIT 0
#endif
extern "C" void kernel_launch(void* const* d_in, const int* in_sizes, int n_in, void* d_out, int out_size, void* d_ws, size_t ws_size, hipStream_t stream) {
    static int grid = 0;
    if (grid == 0) {
        grid = -1;
        if (n_in != 23 || in_sizes[0] != T * DM || out_size != T * DM || ws_size < WS_END) { fprintf(stderr, "kernel_launch: unexpected shapes/workspace (n_in %d, ws %zu)\n", n_in, ws_size); return; }
        if (hipFuncSetAttribute((const void*)mk_fwd, hipFuncAttributeMaxDynamicSharedMemorySize, LDS_BYTES) != hipSuccess) { fprintf(stderr, "kernel_launch: hipFuncSetAttribute(mk_fwd) failed\n"); return; }
        int dev = 0, cus = 0, per_cu = 0;
        if (hipGetDevice(&dev) != hipSuccess || hipDeviceGetAttribute(&cus, hipDeviceAttributeMultiprocessorCount, dev) != hipSuccess) return;
        if (hipOccupancyMaxActiveBlocksPerMultiprocessor(&per_cu, (const void*)mk_fwd, NWAVES * 64, LDS_BYTES) != hipSuccess || per_cu < 1) { fprintf(stderr, "kernel_launch: occupancy query says %d blocks per CU\n", per_cu); (void)hipGetLastError(); return; }
        grid = cus;
    }
    if (grid < 0) return;
    const float* x = (const float*)d_in[0];
    const float* g_post_mix = (const float*)d_in[7]; const float* g_pre_ffn = (const float*)d_in[8]; const float* g_post_ffn = (const float*)d_in[9];
    const float* rpb = (const float*)d_in[11];
    const float* w_router = (const float*)d_in[17]; const float* b_router = (const float*)d_in[18];
    const float* b_gu = (const float*)d_in[20]; const float* b_dn = (const float*)d_in[22];
    unsigned char* ws = (unsigned char*)d_ws;
    float* MOD = (float*)(ws + WS_MOD); float* RSTD1 = (float*)(ws + WS_RSTD1); int* TOPE = (int*)(ws + WS_TOPE); float* TOPW = (float*)(ws + WS_TOPW);
    int* LIST = (int*)(ws + WS_LIST); unsigned* ECNT = (unsigned*)(ws + WS_CTL) + CW_ECNT;
    bf16 *WTOAB = (bf16*)(ws + WS_WTOAB), *WTO = (bf16*)(ws + WS_WTO), *WTGU = (bf16*)(ws + WS_WTGU), *WTDN = (bf16*)(ws + WS_WTDN);
    bf16 *QA = (bf16*)(ws + WS_QA), *KA = (bf16*)(ws + WS_KA), *VA = (bf16*)(ws + WS_VA), *QB = (bf16*)(ws + WS_QB), *KB = (bf16*)(ws + WS_KB), *VB = (bf16*)(ws + WS_VB);
    bf16 *GA = (bf16*)(ws + WS_GA), *GB = (bf16*)(ws + WS_GB), *O = (bf16*)(ws + WS_O), *U = (bf16*)(ws + WS_U), *Y = (bf16*)(ws + WS_Y), *H2 = (bf16*)(ws + WS_H2), *ACT = (bf16*)(ws + WS_ACT), *YS = (bf16*)(ws + WS_YS);
    float *PA = (float*)(ws + WS_PA), *PB = (float*)(ws + WS_PB);

    (void)hipMemsetAsync(ws + WS_CTL, 0, CTL_ZERO_BYTES, stream);
    MKArgs a{};
    for (int i = 0; i < 23; ++i) a.in[i] = (const float*)d_in[i];
    a.out = (float*)d_out; a.ws = ws;
    auto run = [&](int lo, int hi, int li) {
        if (MK_SPLIT) { for (int p = lo; p < hi; ++p) { a.ph_lo = p; a.ph_hi = p + 1; a.li = p; hipLaunchKernelGGL(mk_fwd, dim3(grid), dim3(NWAVES * 64), LDS_BYTES, stream, a); } }
        else { a.ph_lo = lo; a.ph_hi = hi; a.li = li; hipLaunchKernelGGL(mk_fwd, dim3(grid), dim3(NWAVES * 64), LDS_BYTES, stream, a); } };
    run(0, 10, 0);
}
```

```cpp
#include <hip/hip_runtime.h>
#include <cstdint>
#include <cstdio>

#define DEV __device__ __forceinline__
typedef unsigned short bf16;
typedef short bf16x8 __attribute__((ext_vector_type(8)));
typedef float f32x4 __attribute__((ext_vector_type(4)));
typedef unsigned u32x4 __attribute__((ext_vector_type(4)));
typedef unsigned u32x2 __attribute__((ext_vector_type(2)));

constexpr int DM = 1024, NBATCH = 4, SEQ = 4096, T = NBATCH * SEQ, CTXL = 256, TC = NBATCH * CTXL, TR = T + TC;
constexpr int GRIDW = 64, HD = 64;
constexpr int INC = 4352, KVC = 1280;
constexpr int C_KA = 0, C_VA = 512, C_KB = 1024, C_VB = 1152, C_QA = 1280, C_QB = 1792, C_GA = 2304, C_GB = 3328;
constexpr int NE = 32, TOPK = 4, DFF = 1024;
constexpr int NASG = T * TOPK;
constexpr int ECAP = T;
constexpr int ACT_ROWS = NASG + NE * 256;
constexpr float EPS = 1e-6f, LOG2E = 1.4426950408889634f, QSCALE = 0.125f * LOG2E;
constexpr float SW_LIMIT = 7.0f, SW_ALPHA = 1.702f;

constexpr size_t MiB = 1u << 20;
constexpr size_t WS_CTL = 0, CTL_ZERO_BYTES = 1 * MiB;
constexpr size_t WS_MOD = 1 * MiB;
constexpr size_t WS_ROPE = 1 * MiB + 128 * 1024;
constexpr size_t WS_RSTD1 = 1 * MiB + 256 * 1024;
constexpr size_t WS_TOPE = 1 * MiB + 512 * 1024;
constexpr size_t WS_TOPW = 1 * MiB + 768 * 1024;
constexpr size_t WS_LIST = 2 * MiB;
constexpr size_t WS_WTIN = 783 * MiB;
constexpr size_t WS_WTOAB = 13 * MiB;
constexpr size_t WS_WTO = 15 * MiB;
constexpr size_t WS_WTGU = 17 * MiB;
constexpr size_t WS_WTDN = 145 * MiB;
constexpr size_t WS_H = 209 * MiB;
constexpr size_t WS_QA = 243 * MiB;
constexpr size_t WS_KA = 259 * MiB;
constexpr size_t WS_VA = 276 * MiB;
constexpr size_t WS_QB = 293 * MiB;
constexpr size_t WS_KB = 309 * MiB;
constexpr size_t WS_VB = 314 * MiB;
constexpr size_t WS_GA = 319 * MiB;
constexpr size_t WS_GB = 351 * MiB;
constexpr size_t WS_O = 383 * MiB;
constexpr size_t WS_U = 415 * MiB;
constexpr size_t WS_Y = 447 * MiB;
constexpr size_t WS_H2 = 479 * MiB;
constexpr size_t WS_ACT = 511 * MiB;
constexpr size_t WS_YS = 655 * MiB;
constexpr size_t WS_END = 792 * MiB;
constexpr size_t WS_X1B = WS_QA;
constexpr size_t WS_CF32 = 479 * MiB;
constexpr size_t WS_PA = 511 * MiB, WS_PB = 575 * MiB;
static_assert(WS_CF32 + (size_t)TR * INC * 4 <= WS_END, "cf32 overlay");
constexpr int CW_ECNT = 2048;

#ifndef MOE_FP8
#define MOE_FP8 1
#endif
#ifndef PROJ_FP8
#define PROJ_FP8 1
#endif
constexpr int PROJ_PITCH = PROJ_FP8 ? 1024 : 2048;
constexpr float W8_SCALE = 32.0f, ACT8_SCALE = 4.0f, YS8_SCALE = 16.0f;
constexpr int MOE_PITCH = MOE_FP8 ? 1024 : 2048;
DEV unsigned f2bf(float f) { unsigned u = __builtin_bit_cast(unsigned, f); return (u + 0x7fffu + ((u >> 16) & 1u)) >> 16; }
typedef float f32x2_t __attribute__((ext_vector_type(2))); typedef __bf16 bf16x2_t __attribute__((ext_vector_type(2)));
DEV unsigned pk2(float lo, float hi) { f32x2_t v = {lo, hi}; bf16x2_t b = __builtin_convertvector(v, bf16x2_t); return __builtin_bit_cast(unsigned, b); }
DEV float bflo(unsigned w) { return __builtin_bit_cast(float, w << 16); }
DEV float bfhi(unsigned w) { return __builtin_bit_cast(float, w & 0xffff0000u); }
DEV unsigned pk4_fp8(float a, float b, float c, float d) {
    int w = __builtin_amdgcn_cvt_pk_fp8_f32(a, b, 0, false); w = __builtin_amdgcn_cvt_pk_fp8_f32(c, d, w, true); return (unsigned)w; }
DEV float bf2f(bf16 b) { return __builtin_bit_cast(float, ((unsigned)b) << 16); }
#define DPPF(v, ctrl) __builtin_bit_cast(float, __builtin_amdgcn_update_dpp(0, __builtin_bit_cast(int, (v)), (ctrl), 0xF, 0xF, true))
DEV float wave_sum(float v) {
    v += DPPF(v, 0xB1); v += DPPF(v, 0x4E); v += DPPF(v, 0x141); v += DPPF(v, 0x140);
    { auto r = __builtin_amdgcn_permlane16_swap(__float_as_uint(v), __float_as_uint(v), false, false); v = __uint_as_float(r[0]) + __uint_as_float(r[1]); }
    { auto r = __builtin_amdgcn_permlane32_swap(__float_as_uint(v), __float_as_uint(v), false, false); v = __uint_as_float(r[0]) + __uint_as_float(r[1]); }
    return v;
}
DEV float wave_max(float v) {
    v = fmaxf(v, DPPF(v, 0xB1)); v = fmaxf(v, DPPF(v, 0x4E)); v = fmaxf(v, DPPF(v, 0x141)); v = fmaxf(v, DPPF(v, 0x140));
    { auto r = __builtin_amdgcn_permlane16_swap(__float_as_uint(v), __float_as_uint(v), false, false); v = fmaxf(__uint_as_float(r[0]), __uint_as_float(r[1])); }
    { auto r = __builtin_amdgcn_permlane32_swap(__float_as_uint(v), __float_as_uint(v), false, false); v = fmaxf(__uint_as_float(r[0]), __uint_as_float(r[1])); }
    return v;
}
#ifndef WT_STORES
#define WT_STORES 1
#endif
DEV void wt16(void* base, unsigned off, u32x4 v) { if (WT_STORES) __builtin_amdgcn_raw_buffer_store_b128(v, __builtin_amdgcn_make_buffer_rsrc(base, 0, 0x7fffffff, 0x00020000), (int)off, 0, 16); else *(u32x4*)((char*)base + off) = v; }
DEV void wt8(void* base, unsigned off, u32x2 v) { *(u32x2*)((char*)base + off) = v; }
DEV void wt4(void* base, unsigned off, unsigned v) { *(unsigned*)((char*)base + off) = v; }
DEV int lane_now() { int l; asm volatile("v_mbcnt_lo_u32_b32 %0, -1, 0\n\tv_mbcnt_hi_u32_b32 %0, -1, %0" : "=v"(l)); return l; }
DEV float sigmoidf_(float x) { return 1.0f / (1.0f + __expf(-x)); }


DEV void transpose_item(const float* __restrict__ W, int K, int N, bf16* __restrict__ WT, int ld, int koff, float* scr, int item, int lane) {
    const int nblk = N / 32, kb = item / nblk, nb = item % nblk, k0 = 64 * kb, n0 = 32 * nb;
#pragma unroll 8
    for (int i = 0; i < 32; ++i) { const int kk = 2 * i + (lane >> 5); scr[kk * 33 + (lane & 31)] = __builtin_nontemporal_load(&W[(size_t)(k0 + kk) * N + n0 + (lane & 31)]); }
    __builtin_amdgcn_s_waitcnt(0xC07F); asm volatile("" ::: "memory");
    const int cch = lane & 7;
#pragma unroll
    for (int j = 0; j < 4; ++j) { const int n = (lane >> 3) + 8 * j; const float* s = scr + (8 * cch) * 33 + n;
        u32x4 o; o.x = pk2(s[0 * 33], s[1 * 33]); o.y = pk2(s[2 * 33], s[3 * 33]); o.z = pk2(s[4 * 33], s[5 * 33]); o.w = pk2(s[6 * 33], s[7 * 33]);
        *(u32x4*)(WT + (size_t)(n0 + n) * ld + koff + k0 + 8 * cch) = o; }
    __builtin_amdgcn_s_waitcnt(0xC07F); asm volatile("" ::: "memory");
}
DEV void transpose_item_fp8(const float* __restrict__ W, int K, int N, unsigned char* __restrict__ WT, float scale, float* scr, int item, int lane) {
    const int nblk = N / 32, kb = item / nblk, nb = item % nblk, k0 = 64 * kb, n0 = 32 * nb;
#pragma unroll 8
    for (int i = 0; i < 32; ++i) { const int kk = 2 * i + (lane >> 5); scr[kk * 33 + (lane & 31)] = __builtin_nontemporal_load(&W[(size_t)(k0 + kk) * N + n0 + (lane & 31)]); }
    __builtin_amdgcn_s_waitcnt(0xC07F); asm volatile("" ::: "memory");
    const int cch = lane & 7;
#pragma unroll
    for (int j = 0; j < 4; ++j) { const int n = (lane >> 3) + 8 * j; const float* s = scr + (8 * cch) * 33 + n;
        u32x2 o; o.x = pk4_fp8(s[0 * 33] * scale, s[1 * 33] * scale, s[2 * 33] * scale, s[3 * 33] * scale); o.y = pk4_fp8(s[4 * 33] * scale, s[5 * 33] * scale, s[6 * 33] * scale, s[7 * 33] * scale);
        wt8(WT, (unsigned)((n0 + n) * K + k0 + 8 * cch), o); }
    __builtin_amdgcn_s_waitcnt(0xC07F); asm volatile("" ::: "memory");
}
struct WPtrs { const float *w_in, *w_oa, *w_ob, *w_o, *w_gu, *w_dn; bf16 *t_in, *t_oab, *t_o, *t_gu, *t_dn; };
constexpr int I_IN = 16 * 136, I_OA = 8 * 32, I_O = 16 * 32, I_GU = 16 * 64, I_DN = 16 * 32;
constexpr int NITEMS_W = I_IN + 2 * I_OA + I_O + NE * (I_GU + I_DN);
DEV void convert_item(const WPtrs& P, int it, float* scr, int lane) {
    int r = it;
    if (r < I_IN) { if (PROJ_FP8) transpose_item_fp8(P.w_in, 1024, INC, (unsigned char*)P.t_in, W8_SCALE, scr, r, lane); else transpose_item(P.w_in, 1024, INC, P.t_in, 1024, 0, scr, r, lane); return; } r -= I_IN;
    if (r < I_OA) { transpose_item(P.w_oa, 512, 1024, P.t_oab, 1024, 0, scr, r, lane); return; } r -= I_OA;
    if (r < I_OA) { transpose_item(P.w_ob, 512, 1024, P.t_oab, 1024, 512, scr, r, lane); return; } r -= I_OA;
    if (r < I_O) { transpose_item(P.w_o, 1024, 1024, P.t_o, 1024, 0, scr, r, lane); return; } r -= I_O;
    if (r < NE * I_GU) { const int e = r / I_GU;
        if (MOE_FP8) transpose_item_fp8(P.w_gu + (size_t)e * 1024 * 2048, 1024, 2048, (unsigned char*)P.t_gu + (size_t)e * 2048 * 1024, W8_SCALE, scr, r % I_GU, lane);
        else transpose_item(P.w_gu + (size_t)e * 1024 * 2048, 1024, 2048, P.t_gu + (size_t)e * 2048 * 1024, 1024, 0, scr, r % I_GU, lane);
        return; } r -= NE * I_GU;
    { const int e = r / I_DN;
        if (MOE_FP8) transpose_item_fp8(P.w_dn + (size_t)e * 1024 * 1024, 1024, 1024, (unsigned char*)P.t_dn + (size_t)e * 1024 * 1024, W8_SCALE, scr, r % I_DN, lane);
        else transpose_item(P.w_dn + (size_t)e * 1024 * 1024, 1024, 1024, P.t_dn + (size_t)e * 1024 * 1024, 1024, 0, scr, r % I_DN, lane); }
}


DEV void hnorm_rows4(int r0, int stride, const float* __restrict__ x, const float* __restrict__ g, const float* __restrict__ mod, bf16* __restrict__ H, int lane) {
    f32x4 v[4][4], sh[2][4], sc[2][4], gg[4];
#pragma unroll
    for (int a = 0; a < 4; ++a)
#pragma unroll
        for (int j = 0; j < 4; ++j) v[a][j] = __builtin_nontemporal_load((const f32x4*)(x + (size_t)(r0 + a * stride) * DM + 4 * lane + 256 * j));
#pragma unroll
    for (int p = 0; p < 2; ++p) { const float* mrow = mod + ((r0 + 2 * p * stride) / SEQ) * 6144;
#pragma unroll
        for (int j = 0; j < 4; ++j) { sh[p][j] = *(const f32x4*)(mrow + 4 * lane + 256 * j); sc[p][j] = *(const f32x4*)(mrow + 1024 + 4 * lane + 256 * j); } }
#pragma unroll
    for (int j = 0; j < 4; ++j) gg[j] = *(const f32x4*)(g + 4 * lane + 256 * j);
    float rstd[4];
#pragma unroll
    for (int a = 0; a < 4; ++a) { float ss = 0.f;
#pragma unroll
        for (int j = 0; j < 4; ++j) ss += v[a][j][0] * v[a][j][0] + v[a][j][1] * v[a][j][1] + v[a][j][2] * v[a][j][2] + v[a][j][3] * v[a][j][3];
        rstd[a] = rsqrtf(wave_sum(ss) * (1.0f / DM) + EPS); }
    unsigned d[4][4];
#pragma unroll
    for (int a = 0; a < 4; ++a)
#pragma unroll
        for (int j = 0; j < 4; ++j) { float o[4];
#pragma unroll
            for (int q = 0; q < 4; ++q) o[q] = v[a][j][q] * rstd[a] * gg[j][q] * (1.0f + sc[a >> 1][j][q]) + sh[a >> 1][j][q];
            d[a][j] = pk4_fp8(o[0], o[1], o[2], o[3]); }
    const bool b0 = (lane & 1) != 0, b1 = (lane & 2) != 0;
#pragma unroll
    for (int a = 0; a < 4; ++a) {
        unsigned pq[4], e[4];
#pragma unroll
        for (int j = 0; j < 4; ++j) pq[j] = (unsigned)__builtin_amdgcn_mov_dpp((int)d[a][j], 0xB1, 0xF, 0xF, true);
        e[0] = b0 ? pq[1] : d[a][0]; e[1] = b0 ? d[a][1] : pq[0]; e[2] = b0 ? pq[3] : d[a][2]; e[3] = b0 ? d[a][3] : pq[2];
#pragma unroll
        for (int j = 0; j < 4; ++j) pq[j] = (unsigned)__builtin_amdgcn_mov_dpp((int)e[j], 0x4E, 0xF, 0xF, true);
        u32x4 w; w.x = b1 ? pq[2] : e[0]; w.y = b1 ? pq[3] : e[1]; w.z = b1 ? e[2] : pq[0]; w.w = b1 ? e[3] : pq[1];
        wt16(H, (unsigned)((r0 + a * stride) * DM + 256 * (lane & 3) + 16 * (lane >> 2)), w);
    }
}
DEV void hnorm_row(int row, const float* __restrict__ x, const float* __restrict__ ctx, const float* __restrict__ g, const float* __restrict__ mod, bf16* __restrict__ H, int lane) {
    const float* src = row < T ? x + (size_t)row * DM : ctx + (size_t)(row - T) * DM;
    const float* mrow = mod + (row < T ? (row / SEQ) : 4) * 6144;
    f32x4 v[4]; float ss = 0.f;
#pragma unroll
    for (int j = 0; j < 4; ++j) { v[j] = __builtin_nontemporal_load((const f32x4*)(src + 4 * lane + 256 * j)); ss += v[j][0] * v[j][0] + v[j][1] * v[j][1] + v[j][2] * v[j][2] + v[j][3] * v[j][3]; }
    const float rstd = rsqrtf(wave_sum(ss) * (1.0f / DM) + EPS);
#pragma unroll
    for (int j = 0; j < 4; ++j) {
        const int cidx = 4 * lane + 256 * j;
        const f32x4 gg = *(const f32x4*)(g + cidx), sh = *(const f32x4*)(mrow + cidx), sc = *(const f32x4*)(mrow + 1024 + cidx);
        float o[4];
#pragma unroll
        for (int q = 0; q < 4; ++q) o[q] = v[j][q] * rstd * gg[q] * (1.0f + sc[q]) + sh[q];
        if (PROJ_FP8) wt4(H, (unsigned)(row * DM + cidx), pk4_fp8(o[0], o[1], o[2], o[3]));
        else { u32x2 w; w.x = pk2(o[0], o[1]); w.y = pk2(o[2], o[3]); *(u32x2*)(H + (size_t)row * DM + cidx) = w; }
    }
}


DEV void route_token(float (&pl)[32], int t, int la0, int lane, const float* __restrict__ b_router, int* __restrict__ TOPE, float* __restrict__ TOPW, unsigned* hist, unsigned* asg_e, unsigned* asg_p, float* asg_w) {
#define RP_STEP(D, H) _Pragma("unroll") for (int i = 0; i < H; ++i) { const bool up = (lane & D) != 0; const float snd = up ? pl[i] : pl[i + H]; const float kp = up ? pl[i + H] : pl[i]; pl[i] = kp + __shfl_xor(snd, D); }
#pragma unroll
    for (int i = 0; i < 16; ++i) { auto r = __builtin_amdgcn_permlane32_swap(__float_as_uint(pl[i]), __float_as_uint(pl[i + 16]), false, false); pl[i] = __uint_as_float(r[0]) + __uint_as_float(r[1]); }
#pragma unroll
    for (int i = 0; i < 8; ++i) { auto r = __builtin_amdgcn_permlane16_swap(__float_as_uint(pl[i]), __float_as_uint(pl[i + 8]), false, false); pl[i] = __uint_as_float(r[0]) + __uint_as_float(r[1]); }
    RP_STEP(8, 4) RP_STEP(4, 2) RP_STEP(2, 1)
#undef RP_STEP
    float logit = pl[0] + __shfl_xor(pl[0], 1);
    logit += b_router[lane >> 1];
    float val = (lane & 1) ? -INFINITY : logit;
    float tl[4]; int te[4];
#pragma unroll
    for (int k = 0; k < 4; ++k) {
        const float mx = wave_max(val);
        const unsigned long long bal = __ballot(val == mx);
        const int wl = __ffsll((long long)bal) - 1;
        tl[k] = mx; te[k] = wl >> 1;
        if (lane == wl) val = -INFINITY;
    }
    const float e1 = __expf(tl[1] - tl[0]), e2 = __expf(tl[2] - tl[0]), e3 = __expf(tl[3] - tl[0]);
    const float inv = 1.0f / (1.0f + e1 + e2 + e3);
    if (lane < 4) {
        const int ek = lane == 0 ? te[0] : lane == 1 ? te[1] : lane == 2 ? te[2] : te[3];
        const float wk = (lane == 0 ? 1.0f : lane == 1 ? e1 : lane == 2 ? e2 : e3) * inv;
        TOPE[t * 4 + lane] = ek; TOPW[t * 4 + lane] = wk;
        const unsigned p = atomicAdd(&hist[ek], 1u);
        asg_e[la0 + lane] = (unsigned)ek; asg_p[la0 + lane] = p; asg_w[la0 + lane] = wk;
    }
}
constexpr int RP_WSTRIDE = 1028;
DEV void rowpass_block(int blk, const float* __restrict__ x, const bf16* __restrict__ Y, const float* __restrict__ mod, const float* __restrict__ g_post_mix, const float* __restrict__ g_pre_ffn,
                       const float* __restrict__ w_router, const float* __restrict__ b_router, bf16* __restrict__ H2, float* __restrict__ RSTD1, int* __restrict__ TOPE, float* __restrict__ TOPW,
                       unsigned* __restrict__ ecnt, int* __restrict__ LIST, unsigned char* lds, unsigned char* lds_small, int wave, bf16* __restrict__ X1B) {
    float* wr = (float*)lds;
    unsigned* hist = (unsigned*)lds_small;
    unsigned* base = hist + 32;
    unsigned* asg_e = base + 32;
    unsigned* asg_p = asg_e + 256;
    float* asg_w = (float*)(asg_p + 256);
    const int lane = lane_now(), tid = wave * 64 + lane;
    for (int i = tid; i < 8 * 1024; i += 512) { const int k = i >> 3, c = i & 7; const f32x4 w = *(const f32x4*)(w_router + k * 32 + 4 * c);
        wr[(4 * c + 0) * RP_WSTRIDE + k] = w[0]; wr[(4 * c + 1) * RP_WSTRIDE + k] = w[1]; wr[(4 * c + 2) * RP_WSTRIDE + k] = w[2]; wr[(4 * c + 3) * RP_WSTRIDE + k] = w[3]; }
    if (tid < 32) hist[tid] = 0u;
    __syncthreads();
    const int t0 = blk * 64, b = t0 / SEQ;
    const float* mrow = mod + b * 6144;
    f32x4 xn[2][4]; u32x2 yn[2][4];
#pragma unroll
    for (int u = 0; u < 2; ++u)
#pragma unroll
        for (int j = 0; j < 4; ++j) { const int t = t0 + wave * 8 + u; xn[u][j] = __builtin_nontemporal_load((const f32x4*)(x + (size_t)t * DM + 4 * lane + 256 * j)); yn[u][j] = __builtin_nontemporal_load((const u32x2*)(Y + (size_t)t * DM + 4 * lane + 256 * j)); }
#pragma unroll 1
    for (int it = 0; it < 4; ++it) {
        float xv[2][16];
        int lofs = 4 * lane; asm volatile("" : "+v"(lofs));
        f32x4 xc[2][4]; u32x2 yc[2][4];
#pragma unroll
        for (int u = 0; u < 2; ++u)
#pragma unroll
            for (int j = 0; j < 4; ++j) { xc[u][j] = xn[u][j]; yc[u][j] = yn[u][j]; }
        if (it < 3) {
#pragma unroll
            for (int u = 0; u < 2; ++u)
#pragma unroll
                for (int j = 0; j < 4; ++j) { const int t = t0 + wave * 8 + (it + 1) * 2 + u; xn[u][j] = __builtin_nontemporal_load((const f32x4*)(x + (size_t)t * DM + lofs + 256 * j)); yn[u][j] = __builtin_nontemporal_load((const u32x2*)(Y + (size_t)t * DM + lofs + 256 * j)); }
        }
#pragma unroll
        for (int u = 0; u < 2; ++u) {
            const int t = t0 + wave * 8 + it * 2 + u;
            float yv[16]; float ss = 0.f;
#pragma unroll
            for (int j = 0; j < 4; ++j) {
                const u32x2 yw = yc[u][j];
                yv[4 * j] = bflo(yw.x); yv[4 * j + 1] = bfhi(yw.x); yv[4 * j + 2] = bflo(yw.y); yv[4 * j + 3] = bfhi(yw.y);
                const f32x4 xx = xc[u][j];
                xv[u][4 * j] = xx[0]; xv[u][4 * j + 1] = xx[1]; xv[u][4 * j + 2] = xx[2]; xv[u][4 * j + 3] = xx[3];
#pragma unroll
                for (int q = 0; q < 4; ++q) ss += yv[4 * j + q] * yv[4 * j + q];
            }
            const float rstd1 = rsqrtf(wave_sum(ss) * (1.0f / DM) + EPS);
            if (lane == 0) RSTD1[t] = rstd1;
            float ss2 = 0.f;
#pragma unroll
            for (int j = 0; j < 4; ++j) {
                const int cidx = lofs + 256 * j;
                const f32x4 gt = *(const f32x4*)(mrow + 2048 + cidx), gp = *(const f32x4*)(g_post_mix + cidx);
#pragma unroll
                for (int q = 0; q < 4; ++q) { const float x1 = xv[u][4 * j + q] + gt[q] * (yv[4 * j + q] * rstd1 * gp[q]); xv[u][4 * j + q] = x1; ss2 += x1 * x1; }
                { u32x2 xw; xw.x = pk2(xv[u][4 * j], xv[u][4 * j + 1]); xw.y = pk2(xv[u][4 * j + 2], xv[u][4 * j + 3]); *(u32x2*)(X1B + (size_t)t * DM + cidx) = xw; }
            }
            const float rstd2 = rsqrtf(wave_sum(ss2) * (1.0f / DM) + EPS);
#pragma unroll
            for (int j = 0; j < 4; ++j) {
                const int cidx = lofs + 256 * j;
                const f32x4 gf = *(const f32x4*)(g_pre_ffn + cidx), sh = *(const f32x4*)(mrow + 3072 + cidx), sc = *(const f32x4*)(mrow + 4096 + cidx);
#pragma unroll
                for (int q = 0; q < 4; ++q) xv[u][4 * j + q] = xv[u][4 * j + q] * rstd2 * gf[q] * (1.0f + sc[q]) + sh[q];
                if (MOE_FP8) wt4(H2, (unsigned)(t * DM + cidx), pk4_fp8(xv[u][4 * j], xv[u][4 * j + 1], xv[u][4 * j + 2], xv[u][4 * j + 3]));
                else { u32x2 w; w.x = pk2(xv[u][4 * j], xv[u][4 * j + 1]); w.y = pk2(xv[u][4 * j + 2], xv[u][4 * j + 3]); *(u32x2*)(H2 + (size_t)t * DM + cidx) = w; }
            }
        }
        using f32x2 = __attribute__((ext_vector_type(2))) float;
        f32x2 xp[16];
#pragma unroll
        for (int k = 0; k < 16; ++k) xp[k] = (f32x2){xv[0][k], xv[1][k]};
        float pl0[32], pl1[32];
#pragma unroll
        for (int e2 = 0; e2 < 32; e2 += 2) {
            f32x4 w[2][4];
#pragma unroll
            for (int q = 0; q < 2; ++q)
#pragma unroll
                for (int j = 0; j < 4; ++j) w[q][j] = *(const f32x4*)(wr + (e2 + q) * RP_WSTRIDE + lofs + 256 * j);
#pragma unroll
            for (int q = 0; q < 2; ++q) {
                f32x2 a = (f32x2){0.f, 0.f}, b2 = (f32x2){0.f, 0.f};
#pragma unroll
                for (int j = 0; j < 4; ++j) {
                    a = xp[4 * j] * (f32x2){w[q][j][0], w[q][j][0]} + a; b2 = xp[4 * j + 1] * (f32x2){w[q][j][1], w[q][j][1]} + b2;
                    a = xp[4 * j + 2] * (f32x2){w[q][j][2], w[q][j][2]} + a; b2 = xp[4 * j + 3] * (f32x2){w[q][j][3], w[q][j][3]} + b2; }
                a = a + b2;
                asm volatile("" : "+v"(a));
                pl0[e2 + q] = a.x; pl1[e2 + q] = a.y;
            }
            __builtin_amdgcn_sched_barrier(0);
        }
        route_token(pl0, t0 + wave * 8 + it * 2, (wave * 8 + it * 2) * 4, lane, b_router, TOPE, TOPW, hist, asg_e, asg_p, asg_w);
        route_token(pl1, t0 + wave * 8 + it * 2 + 1, (wave * 8 + it * 2 + 1) * 4, lane, b_router, TOPE, TOPW, hist, asg_e, asg_p, asg_w);
    }
    __syncthreads();
    if (tid < 32) base[tid] = atomicAdd(&ecnt[tid], hist[tid]);
    __syncthreads();
    if (tid < 256) { const unsigned e = asg_e[tid]; u32x2 ent; ent.x = (unsigned)(t0 * 4 + tid); ent.y = __builtin_bit_cast(unsigned, asg_w[tid]); *(u32x2*)(LIST + 2 * ((size_t)e * ECAP + base[e] + asg_p[tid])) = ent; }
    __syncthreads();
}

DEV void final_rows2(int t0, int t1, const bf16* __restrict__ X1B, const bf16* __restrict__ YS, const float* __restrict__ mod, const float* __restrict__ g_post_ffn, float* __restrict__ out, int lane) {
    const float* mrow = mod + (t0 / SEQ) * 6144;
    const int tt[2] = {t0, t1};
    unsigned w[2][4][4]; u32x2 xw[2][4];
#pragma unroll
    for (int a = 0; a < 2; ++a) {
#pragma unroll
        for (int j = 0; j < 4; ++j)
#pragma unroll
            for (int k = 0; k < 4; ++k) w[a][j][k] = __builtin_nontemporal_load((const unsigned*)((const unsigned char*)YS + (size_t)(tt[a] * 4 + k) * DM + 4 * lane + 256 * j));
#pragma unroll
        for (int j = 0; j < 4; ++j) xw[a][j] = __builtin_nontemporal_load((const u32x2*)(X1B + (size_t)tt[a] * DM + 4 * lane + 256 * j));
    }
    float f[2][16], ss[2];
#pragma unroll
    for (int a = 0; a < 2; ++a) { ss[a] = 0.f;
#pragma unroll
        for (int j = 0; j < 4; ++j) { float a0 = 0.f, a1 = 0.f, a2 = 0.f, a3 = 0.f;
#pragma unroll
            for (int k = 0; k < 4; ++k) { const auto lo = __builtin_amdgcn_cvt_pk_f32_fp8((int)w[a][j][k], false), hi = __builtin_amdgcn_cvt_pk_f32_fp8((int)w[a][j][k], true); a0 += lo[0]; a1 += lo[1]; a2 += hi[0]; a3 += hi[1]; }
            a0 *= 1.0f / YS8_SCALE; a1 *= 1.0f / YS8_SCALE; a2 *= 1.0f / YS8_SCALE; a3 *= 1.0f / YS8_SCALE;
            f[a][4 * j] = a0; f[a][4 * j + 1] = a1; f[a][4 * j + 2] = a2; f[a][4 * j + 3] = a3;
            ss[a] += a0 * a0 + a1 * a1 + a2 * a2 + a3 * a3; } }
    const float rstdf[2] = {rsqrtf(wave_sum(ss[0]) * (1.0f / DM) + EPS), rsqrtf(wave_sum(ss[1]) * (1.0f / DM) + EPS)};
#pragma unroll
    for (int j = 0; j < 4; ++j) {
        const int cidx = 4 * lane + 256 * j;
        const f32x4 gt2 = *(const f32x4*)(mrow + 5120 + cidx), gf = *(const f32x4*)(g_post_ffn + cidx);
#pragma unroll
        for (int a = 0; a < 2; ++a) {
            const float xv[4] = {bflo(xw[a][j].x), bfhi(xw[a][j].x), bflo(xw[a][j].y), bfhi(xw[a][j].y)};
            f32x4 o;
#pragma unroll
            for (int q = 0; q < 4; ++q) o[q] = xv[q] + gt2[q] * (f[a][4 * j + q] * rstdf[a] * gf[q]);
            __builtin_nontemporal_store(o, (f32x4*)(out + (size_t)tt[a] * DM + cidx)); }
    }
}
DEV void final_row(int t, const float* __restrict__ x, const bf16* __restrict__ Y, const float* __restrict__ RSTD1, const bf16* __restrict__ YS, const float* __restrict__ mod,
                   const float* __restrict__ g_post_mix, const float* __restrict__ g_post_ffn, float* __restrict__ out, int lane) {
    const float* mrow = mod + (t / SEQ) * 6144;
    const float rstd1 = RSTD1[t];
    float f[16]; float ss = 0.f;
#pragma unroll
    for (int j = 0; j < 4; ++j) {
        float a0 = 0.f, a1 = 0.f, a2 = 0.f, a3 = 0.f;
#pragma unroll
        for (int k = 0; k < 4; ++k) {
            if (MOE_FP8) { const unsigned w = __builtin_nontemporal_load((const unsigned*)((const unsigned char*)YS + (size_t)(t * 4 + k) * DM + 4 * lane + 256 * j));
                const auto lo = __builtin_amdgcn_cvt_pk_f32_fp8((int)w, false), hi = __builtin_amdgcn_cvt_pk_f32_fp8((int)w, true); a0 += lo[0]; a1 += lo[1]; a2 += hi[0]; a3 += hi[1]; }
            else { const u32x2 w = *(const u32x2*)(YS + (size_t)(t * 4 + k) * DM + 4 * lane + 256 * j); a0 += bflo(w.x); a1 += bfhi(w.x); a2 += bflo(w.y); a3 += bfhi(w.y); } }
        if (MOE_FP8) { a0 *= 1.0f / YS8_SCALE; a1 *= 1.0f / YS8_SCALE; a2 *= 1.0f / YS8_SCALE; a3 *= 1.0f / YS8_SCALE; }
        f[4 * j] = a0; f[4 * j + 1] = a1; f[4 * j + 2] = a2; f[4 * j + 3] = a3;
        ss += a0 * a0 + a1 * a1 + a2 * a2 + a3 * a3;
    }
    const float rstdf = rsqrtf(wave_sum(ss) * (1.0f / DM) + EPS);
#pragma unroll
    for (int j = 0; j < 4; ++j) {
        const int cidx = 4 * lane + 256 * j;
        const f32x4 xx = __builtin_nontemporal_load((const f32x4*)(x + (size_t)t * DM + cidx));
        const u32x2 yw = __builtin_nontemporal_load((const u32x2*)(Y + (size_t)t * DM + cidx));
        const f32x4 gt1 = *(const f32x4*)(mrow + 2048 + cidx), gt2 = *(const f32x4*)(mrow + 5120 + cidx), gp = *(const f32x4*)(g_post_mix + cidx), gf = *(const f32x4*)(g_post_ffn + cidx);
        const float yv[4] = {bflo(yw.x), bfhi(yw.x), bflo(yw.y), bfhi(yw.y)};
        f32x4 o;
#pragma unroll
        for (int q = 0; q < 4; ++q) o[q] = xx[q] + gt1[q] * (yv[q] * rstd1 * gp[q]) + gt2[q] * (f[4 * j + q] * rstdf * gf[q]);
        __builtin_nontemporal_store(o, (f32x4*)(out + (size_t)t * DM + cidx));
    }
}


#define LAS __attribute__((address_space(3)))
#define GAS __attribute__((address_space(1)))
typedef GAS unsigned gu32;
#define RLX_AGENT __ATOMIC_RELAXED, __HIP_MEMORY_SCOPE_AGENT
constexpr int NWAVES = 8;
#ifndef PROBE_SEL
#define PROBE_SEL 0
#endif
constexpr int MW_PROBE = 1000;
#define PROBE_BEGIN(id) unsigned long long _pb##id = 0; if (PROBE_SEL == (id)) _pb##id = __builtin_amdgcn_s_memrealtime();
#define PROBE_MARK(id) do { if (PROBE_SEL == (id) && F.wave == 0) { const unsigned _d = (unsigned)(__builtin_amdgcn_s_memrealtime() - _pbstart); if (lane_now() == 0) __hip_atomic_fetch_add((LAS unsigned*)(F.lds + MISC_OFF) + MW_PROBE, _d, __ATOMIC_RELAXED, __HIP_MEMORY_SCOPE_WORKGROUP); } } while (0)
#define PROBE_END(id, miscp) do { if (PROBE_SEL == (id)) { const unsigned _d = (unsigned)(__builtin_amdgcn_s_memrealtime() - _pb##id); if (lane_now() == 0) __hip_atomic_fetch_add((LAS unsigned*)(miscp) + MW_PROBE, _d, __ATOMIC_RELAXED, __HIP_MEMORY_SCOPE_WORKGROUP); } } while (0)

constexpr int RING_OFF = 0, RING_BYTES = 131072;
constexpr int ROPE_OFF = 131072;
constexpr int MISC_OFF = 139264;
constexpr int NAX_OFF = 143360;
constexpr int LDS_BYTES = 163840;
constexpr int CW_TMO = 0, CW_CODE = 1, CW_BAR = 4096;

#define XB_TMO      128
#define XB_XCNT(j)  (256  + 64 * (j))
#define XB_XSUB(j)  (1280 + 64 * (j))
#define XB_XGEN(j)  (2304 + 64 * (j))
#define XB_TOP      3328
#define XB_TOPGEN   3392
#define XCD_BAR_WORDS 3456
#define XB_SPIN_CAP (1u << 18)
__device__ __forceinline__ unsigned xb_ld(unsigned* p)              { return __hip_atomic_load(p, __ATOMIC_RELAXED, __HIP_MEMORY_SCOPE_AGENT); }
__device__ __forceinline__ unsigned xb_add(unsigned* p, unsigned v) { return __hip_atomic_fetch_add(p, v, __ATOMIC_RELAXED, __HIP_MEMORY_SCOPE_AGENT); }
__device__ __forceinline__ unsigned xb_xcc_id() { return (unsigned)__builtin_amdgcn_s_getreg((3 << 11) | 20) & 0xFu; }
#define XB_SPIN(cond, bar) do { unsigned _sp = 0; while (cond) { __builtin_amdgcn_s_sleep(1); \
    if ((++_sp & 255u) == 0u) { if (xb_ld(&(bar)[XB_TMO])) break; if (_sp > XB_SPIN_CAP) { atomicAdd(&(bar)[XB_TMO], 1u); break; } } } } while (0)
struct XcdBarrier { unsigned* bar; unsigned x; volatile LAS unsigned* st; };
__device__ __forceinline__ XcdBarrier xcd_barrier_post(unsigned* bar, volatile LAS unsigned* st) {
    XcdBarrier b; b.bar = bar; b.x = xb_xcc_id(); b.st = st;
    if (threadIdx.x == 0) (void)xb_add(&bar[XB_XCNT(b.x)], 1u);
    return b;
}
__device__ __forceinline__ void xcd_barrier_complete(unsigned* bar, unsigned x, unsigned& nloc, unsigned& nx) {
    const unsigned G = gridDim.x * gridDim.y * gridDim.z;
    unsigned sum, cnt, mine, sp = 0u;
    for (;;) {
        sum = 0u; cnt = 0u; mine = 0u;
#pragma unroll
        for (unsigned j = 0; j < 16; ++j) { const unsigned c = xb_ld(&bar[XB_XCNT(j)]); sum += c; cnt += (c > 0u) ? 1u : 0u; mine = (j == x) ? c : mine; }
        if (sum == G) break;
        __builtin_amdgcn_s_sleep(1);
        if ((++sp & 255u) == 0u) { if (xb_ld(&bar[XB_TMO])) break; if (sp > XB_SPIN_CAP) { atomicAdd(&bar[XB_TMO], 1u); break; } }
    }
    nloc = mine > 0u ? mine : 1u; nx = cnt > 0u ? cnt : 1u;
}
__device__ __forceinline__ void xcd_barrier(const XcdBarrier& b, int wave) {
    asm volatile("s_waitcnt vmcnt(0)" ::: "memory");
    __syncthreads();
    if (wave == 0 && lane_now() == 0) {
        unsigned* bar = b.bar;
        __builtin_amdgcn_s_waitcnt(0);
        unsigned nloc = b.st[0], nx = b.st[1];
        if (nloc == 0u) { xcd_barrier_complete(bar, b.x, nloc, nx); b.st[0] = nloc; b.st[1] = nx; }
        const unsigned old = xb_add(&bar[XB_XSUB(b.x)], 1u);
        const unsigned gen = old / nloc;
        if (old + 1u == (gen + 1u) * nloc) {
            __builtin_amdgcn_fence(__ATOMIC_RELEASE, "agent");
            asm volatile("s_waitcnt vmcnt(0)" ::: "memory");
            const unsigned og = xb_add(&bar[XB_TOP], 1u);
            const unsigned tg = og / nx;
            if (og + 1u == (tg + 1u) * nx) xb_add(&bar[XB_TOPGEN], 1u);
            else XB_SPIN(xb_ld(&bar[XB_TOPGEN]) == tg, bar);
            __builtin_amdgcn_fence(__ATOMIC_ACQUIRE, "agent");
            xb_add(&bar[XB_XGEN(b.x)], 1u);
            asm volatile("s_waitcnt vmcnt(0)" ::: "memory");
        } else {
            XB_SPIN(xb_ld(&bar[XB_XGEN(b.x)]) == gen, bar);
            __builtin_amdgcn_fence(__ATOMIC_ACQUIRE, "agent");
            asm volatile("s_waitcnt vmcnt(0)" ::: "memory");
        }
    }
    __syncthreads();
}


constexpr int CW_CNTO = 32768, CW_CNTU = 36864, CW_CNTY = 40960, CW_CNTM = 45056, CW_CNTA = 49152;
__device__ __forceinline__ void panel_signal(unsigned* cnt) {
    asm volatile("s_waitcnt vmcnt(0)" ::: "memory");
    if (lane_now() == 0) (void)__hip_atomic_fetch_add(cnt, 1u, __ATOMIC_RELAXED, __HIP_MEMORY_SCOPE_AGENT);
}
__device__ __forceinline__ void panel_wait(unsigned* cnt, unsigned want, unsigned* tmo, int wave) {
    if (wave == 0) {
        unsigned sp = 0u;
        while (__hip_atomic_load(cnt, __ATOMIC_RELAXED, __HIP_MEMORY_SCOPE_AGENT) < want) {
            __builtin_amdgcn_s_sleep(2);
            if (++sp > (1u << 20)) { if (lane_now() == 0) __hip_atomic_store(tmo, 0xC0DEu, __ATOMIC_RELAXED, __HIP_MEMORY_SCOPE_AGENT); break; }
        }
        __builtin_amdgcn_fence(__ATOMIC_ACQUIRE, "agent");
        asm volatile("s_waitcnt vmcnt(0)" ::: "memory");
    }
    __syncthreads();
}

namespace pg8 {
#define PG8_LAS __attribute__((address_space(3)))
constexpr int BM = 256, BK = 64, HALF = 128, HTB = HALF * BK * 2, STAGE_BYTES = 8 * HTB;
constexpr int KDIM = 1024, NT = KDIM / BK, PITCH = KDIM * 2;
__host__ __device__ __forceinline__ int lds_byte(int r, int c) { const int st = (r >> 4) * 2 + (c >> 5), rr = r & 15, cc = c & 31, ob = rr * 64 + cc * 2; return st * 1024 + (ob ^ (((ob >> 9) & 1) << 5)); }
__host__ __device__ __forceinline__ void stage_rc(int b, int& R, int& C) { const int st = b / 1024, sb = b % 1024, swz = sb ^ (((sb >> 9) & 1) << 5); R = (st >> 1) * 16 + swz / 64; C = (st & 1) * 32 + (swz % 64) / 2; }

struct GU {
    unsigned a;
    unsigned b;
    unsigned rows;
    int pm, pn, e, cnt;
};
__host__ __device__ __forceinline__ int perm32(int rho) { const int n = rho >> 4, i = rho & 15; return 8 * (i >> 2) + 4 * n + (i & 3); }
template <int BMAP> __device__ __forceinline__ int bmap_row(int R) { return BMAP == 0 ? R : BMAP == 1 ? (64 * (R >> 5) + perm32(R & 31)) : BMAP == 2 ? (32 * (R >> 5) + 8 * ((R & 15) >> 2) + (R & 3) + 1024 * ((R >> 4) & 1)) : ((R & ~31) + perm32(R & 31)); }
template <int BMAP> __device__ __forceinline__ int bmap_hrows() { return (BMAP == 0 || BMAP == 3) ? 128 : BMAP == 1 ? 32 : 4; }
typedef int v8i32 __attribute__((ext_vector_type(8)));
typedef int v4i32 __attribute__((ext_vector_type(4)));
__device__ __forceinline__ bf16x8 lo8(v8i32 v) { return __builtin_bit_cast(bf16x8, (v4i32)__builtin_shufflevector(v, v, 0, 1, 2, 3)); }
__device__ __forceinline__ bf16x8 hi8(v8i32 v) { return __builtin_bit_cast(bf16x8, (v4i32)__builtin_shufflevector(v, v, 4, 5, 6, 7)); }
__device__ __forceinline__ v8i32 cat8(bf16x8 lo, bf16x8 hi) { const v4i32 a = __builtin_bit_cast(v4i32, lo), b = __builtin_bit_cast(v4i32, hi); return __builtin_shufflevector(a, b, 0, 1, 2, 3, 4, 5, 6, 7); }

template <class Epi, class Sched, bool GATHER, int BMAP, bool FP8 = false>
__device__ __forceinline__ void gemm_phase(PG8_LAS unsigned char* lds, const Sched& S, const Epi& E, int wid) {
    const int lane = lane_now(), tid = wid * 64 + lane, wr = wid >> 2, wc = wid & 3, fr = lane & 15, fq = lane >> 4;
    constexpr int nt = FP8 ? 8 : NT; constexpr int RPITCH = FP8 ? 1024 : PITCH;
    int Rr[2], Cc[2]; unsigned voffB[2];
#pragma unroll
    for (int i = 0; i < 2; ++i) { stage_rc(tid * 16 + i * 8192, Rr[i], Cc[i]); voffB[i] = (unsigned)(bmap_row<BMAP>(Rr[i]) * RPITCH + Cc[i] * 2); }
    const size_t kstep = (size_t)(BK * 2);
    const size_t hstepB = (size_t)bmap_hrows<BMAP>() * RPITCH;
    const unsigned ldsw = (unsigned)wid * 1024u;
    const int aoff = lds_byte(wr * 64 + fr, fq * 8), boff = lds_byte(wc * 32 + fr, fq * 8);
#define PG8_SA(b, h) (((b) * 2 + (h)) * HTB)
#define PG8_SB(b, h) ((4 + (b) * 2 + (h)) * HTB)
#define PG8_STAGE(bufoff, gbase, voff) do { _Pragma("unroll") for (int _i = 0; _i < 2; ++_i) { unsigned _o = (voff)[_i]; asm volatile("" : "+v"(_o));     \
        __builtin_amdgcn_global_load_lds((const unsigned*)((const char*)(gbase) + _o), (PG8_LAS unsigned*)(lds + (bufoff) + ldsw + _i * 8192), 16, 0, 0); } } while (0)
#define PG8_LDA(dst, b, h) do { _Pragma("unroll") for (int m = 0; m < 4; ++m) dst[m] = cat8(*(const PG8_LAS bf16x8*)(lds + PG8_SA(b, h) + aoff + m * 2048), *(const PG8_LAS bf16x8*)(lds + PG8_SA(b, h) + aoff + m * 2048 + 1024)); } while (0)
#define PG8_LDB(dst, b, h) do { _Pragma("unroll") for (int n = 0; n < 2; ++n) dst[n] = cat8(*(const PG8_LAS bf16x8*)(lds + PG8_SB(b, h) + boff + n * 2048), *(const PG8_LAS bf16x8*)(lds + PG8_SB(b, h) + boff + n * 2048 + 1024)); } while (0)
#define PG8_MMA(ai, bj, At, Bt) do { __builtin_amdgcn_s_setprio(1); if constexpr (FP8) asm volatile("s_nop 1"); _Pragma("unroll") for (int m = 0; m < 4; ++m) _Pragma("unroll") for (int n = 0; n < 2; ++n) { \
        if constexpr (FP8) asm volatile("v_mfma_f32_16x16x128_f8f6f4 %0, %1, %2, %0" : "+v"(acc[ai][bj][m][n]) : "v"(Bt[n]), "v"(At[m]));   \
        else { acc[ai][bj][m][n] = __builtin_amdgcn_mfma_f32_16x16x32_bf16(lo8(Bt[n]), lo8(At[m]), acc[ai][bj][m][n], 0, 0, 0); acc[ai][bj][m][n] = __builtin_amdgcn_mfma_f32_16x16x32_bf16(hi8(Bt[n]), hi8(At[m]), acc[ai][bj][m][n], 0, 0, 0); } } \
        __builtin_amdgcn_s_setprio(0); } while (0)
#define PG8_WAIT_V(n) asm volatile("s_waitcnt vmcnt(" #n ")" ::: "memory")
#define PG8_WAIT_L(n) asm volatile("s_waitcnt lgkmcnt(" #n ")" ::: "memory")
#define PG8_BAR __builtin_amdgcn_s_barrier()
#define PG8_SCHED __builtin_amdgcn_sched_barrier(0)
#define PG8_AOFFS(dst, u) do { _Pragma("unroll") for (int _h = 0; _h < 2; ++_h) _Pragma("unroll") for (int _i = 0; _i < 2; ++_i) { \
        int _row = 128 * _h + Rr[_i]; if (GATHER) { const int _rr = _row < (u).cnt ? _row : 0; _row = S.rowlist[2 * ((u).rows + _rr)] >> 2; } \
        dst[_h][_i] = (unsigned)(_row * RPITCH + Cc[_i] * 2); } } while (0)
#define PG8_AREQ(raw, u) do { _Pragma("unroll") for (int _h = 0; _h < 2; ++_h) _Pragma("unroll") for (int _i = 0; _i < 2; ++_i) { \
        const int _row = 128 * _h + Rr[_i]; const int _rr = _row < (u).cnt ? _row : 0; const int* _p = S.rowlist + 2 * ((u).rows + _rr); \
        asm volatile("global_load_dword %0, %1, off" : "=v"(raw[_h][_i]) : "v"(_p) : "memory"); } } while (0)
#define PG8_AFIN(dst, raw) do { _Pragma("unroll") for (int _h = 0; _h < 2; ++_h) _Pragma("unroll") for (int _i = 0; _i < 2; ++_i) dst[_h][_i] = (unsigned)(((int)raw[_h][_i] >> 2) * RPITCH + Cc[_i] * 2); } while (0)
    GU cur, nxt; int ui = 0;
    if (!S.next(0, cur)) return;
    unsigned araw[2][2] = {{0u, 0u}, {0u, 0u}};
    typename Epi::Pre pre;
    f32x4 acc[2][2][4][2];
#pragma unroll
    for (int a = 0; a < 2; ++a)
#pragma unroll
        for (int b = 0; b < 2; ++b)
#pragma unroll
            for (int m = 0; m < 4; ++m)
#pragma unroll
                for (int n = 0; n < 2; ++n) acc[a][b][m][n] = (f32x4){0.f, 0.f, 0.f, 0.f};
    v8i32 At[4], B0[2], B1[2];
    unsigned voA[2][2], nvoA[2][2];
    if constexpr (GATHER) { PG8_AOFFS(voA, cur); } else {
#pragma unroll
        for (int h = 0; h < 2; ++h)
#pragma unroll
            for (int i = 0; i < 2; ++i) { voA[h][i] = (unsigned)((128 * h + Rr[i]) * RPITCH + Cc[i] * 2); nvoA[h][i] = voA[h][i]; } }
    const char* cA = S.Abase + cur.a; const char* cB = S.Bbase + cur.b;
    PG8_STAGE(PG8_SB(0, 0), cB, voffB); PG8_STAGE(PG8_SB(0, 1), cB + hstepB, voffB); PG8_STAGE(PG8_SA(0, 0), cA, voA[0]); PG8_STAGE(PG8_SA(0, 1), cA, voA[1]);
    if (wr == 1) PG8_BAR;
    PG8_WAIT_V(2); PG8_BAR;
    PG8_STAGE(PG8_SB(1, 0), cB + kstep, voffB); PG8_STAGE(PG8_SA(1, 0), cA + kstep, voA[0]); PG8_STAGE(PG8_SB(1, 1), cB + hstepB + kstep, voffB);
    PG8_WAIT_V(6); PG8_BAR;
    for (;;) {
        const bool has_next = S.next(ui + 1, nxt);
        const char* nA = has_next ? S.Abase + nxt.a : cA; const char* nB = has_next ? S.Bbase + nxt.b : cB;

        PROBE_BEGIN(1) PROBE_BEGIN(11)
#pragma unroll 1
        for (int t = 0; t < nt; t += 2) {
            const bool last = (t == nt - 2);
            const char* a1 = cA + (size_t)(t + 1) * kstep;
            const char* a2 = last ? nA : cA + (size_t)(t + 2) * kstep; const char* b2 = last ? nB : cB + (size_t)(t + 2) * kstep;
            const char* a3 = a2 + kstep; const char* b3 = b2 + kstep;
            unsigned vo2[2][2];
            if constexpr (GATHER) {
                if (t == nt - 4 && has_next) { PG8_AREQ(araw, nxt); }
                if (last && has_next) { asm volatile("s_waitcnt vmcnt(16)" : "+v"(araw[0][0]), "+v"(araw[0][1]), "+v"(araw[1][0]), "+v"(araw[1][1]) :: "memory"); PG8_AFIN(nvoA, araw); } }
#pragma unroll
            for (int h = 0; h < 2; ++h)
#pragma unroll
                for (int i = 0; i < 2; ++i) vo2[h][i] = GATHER ? ((last && has_next) ? nvoA[h][i] : voA[h][i]) : voA[h][i];
            if constexpr (Sched::HAS_DEP) { if (last && has_next) S.a_ready(ui + 1, nxt, wid); }
            if constexpr (Epi::HAS_MID) { if (t == nt / 2) E.mid(acc, cur, wr, wc); }
            if constexpr (Epi::HAS_PRE) { if (last) E.prefetch(pre, cur, wr, wc); }
            PG8_LDB(B0, 0, 0); PG8_LDB(B1, 0, 1); PG8_SCHED; PG8_LDA(At, 0, 0); PG8_STAGE(PG8_SA(1, 1), a1, voA[1]);
            PG8_WAIT_V(8); PG8_WAIT_L(0); PG8_BAR; PG8_MMA(0, 0, At, B0); PG8_MMA(0, 1, At, B1); PG8_BAR; PG8_SCHED;
            PG8_LDA(At, 0, 1); PG8_STAGE(PG8_SB(0, 0), b2, voffB); PG8_STAGE(PG8_SB(0, 1), b2 + hstepB, voffB); PG8_STAGE(PG8_SA(0, 0), a2, vo2[0]);
            PG8_WAIT_V(8); PG8_WAIT_L(0); PG8_BAR; PG8_MMA(1, 0, At, B0); PG8_MMA(1, 1, At, B1); PG8_BAR; PG8_SCHED;
            PG8_LDB(B0, 1, 0); PG8_LDB(B1, 1, 1); PG8_SCHED; PG8_LDA(At, 1, 0); PG8_STAGE(PG8_SA(0, 1), a2, vo2[1]);
            PG8_WAIT_V(8); PG8_WAIT_L(0); PG8_BAR; PG8_MMA(0, 0, At, B0); PG8_MMA(0, 1, At, B1); PG8_BAR; PG8_SCHED;
            PG8_LDA(At, 1, 1); PG8_STAGE(PG8_SB(1, 0), b3, voffB); PG8_STAGE(PG8_SB(1, 1), b3 + hstepB, voffB); PG8_STAGE(PG8_SA(1, 0), a3, vo2[0]);
            PG8_WAIT_V(8); PG8_WAIT_L(0); PG8_BAR; PG8_MMA(1, 0, At, B0); PG8_MMA(1, 1, At, B1); PG8_BAR; PG8_SCHED;
        }
        if (FP8 && GATHER && wid == 0) PROBE_END(1, lds + MISC_OFF); if (FP8 && !GATHER && wid == 0) PROBE_END(11, lds + MISC_OFF);
        PROBE_BEGIN(2) PROBE_BEGIN(12)
        if (wr == 0) PG8_BAR;
        if constexpr (FP8) asm volatile("s_nop 15\n\ts_nop 7" ::: "memory");
        if constexpr (Epi::HAS_PRE) { E.wait(pre); E(acc, cur, wr, wc, pre); } else E(acc, cur, wr, wc);
        if constexpr (Sched::HAS_DONE) S.done(cur);
        if (FP8 && GATHER && wid == 0) PROBE_END(2, lds + MISC_OFF); if (FP8 && !GATHER && wid == 0) PROBE_END(12, lds + MISC_OFF);
        if (!has_next) break;
#pragma unroll
        for (int a = 0; a < 2; ++a)
#pragma unroll
            for (int b = 0; b < 2; ++b)
#pragma unroll
                for (int m = 0; m < 4; ++m)
#pragma unroll
                    for (int n = 0; n < 2; ++n) acc[a][b][m][n] = (f32x4){0.f, 0.f, 0.f, 0.f};
        cur = nxt; cA = nA; cB = nB; ++ui;
        if constexpr (GATHER) {
#pragma unroll
        for (int h = 0; h < 2; ++h)
#pragma unroll
            for (int i = 0; i < 2; ++i) voA[h][i] = nvoA[h][i]; }
        if (wr == 1) PG8_BAR;
    }
    PG8_WAIT_V(0);
    PG8_BAR;
#undef PG8_SA
#undef PG8_SB
#undef PG8_STAGE
#undef PG8_LDA
#undef PG8_LDB
#undef PG8_MMA
#undef PG8_WAIT_V
#undef PG8_WAIT_L
#undef PG8_BAR
#undef PG8_SCHED
#undef PG8_AOFFS
}
}

namespace attn_body {
using bf16x8=__attribute__((ext_vector_type(8)))short;
using s16x4=__attribute__((ext_vector_type(4)))short;
using f32x16=__attribute__((ext_vector_type(16)))float;
using u32x4=__attribute__((ext_vector_type(4)))unsigned;
constexpr int D=64;
constexpr int NW=8,QBLK=32,QB=QBLK*NW,KVBLK=64;
__device__ __forceinline__ int crow(int r,int hi){return (r&3)+8*(r>>2)+4*hi;}
#define SBAR() __builtin_amdgcn_sched_barrier(0)
constexpr int NSLOT=3, SLOTB=8192;
constexpr int LDS_K=0, LDS_V=NSLOT*SLOTB, LDS_WS=2*NSLOT*SLOTB, LDS_OST=LDS_WS+NW*64*4, LDS_BYTES=LDS_OST+NW*4096;
__device__ __forceinline__ void glds16(const void*gsrc,unsigned lds_dst){unsigned keep;
  asm volatile("s_mov_b32 %0, m0\n\ts_mov_b32 m0, %2\n\ts_nop 0\n\tglobal_load_lds_dwordx4 %1, off\n\ts_mov_b32 m0, %0":"=&s"(keep):"v"(gsrc),"s"(lds_dst):"memory");}
__device__ __forceinline__ float max3f(float a,float b,float c){float r;asm("v_max3_f32 %0, %1, %2, %3":"=v"(r):"v"(a),"v"(b),"v"(c));return r;}
__device__ __forceinline__ float max2f(float a,float b){float r;asm("v_max_f32_e32 %0, %1, %2":"=v"(r):"v"(a),"v"(b));return r;}
__device__ __forceinline__ float fadd_s(float a,float b){float r;asm("v_add_f32_e32 %0, %1, %2":"=v"(r):"v"(a),"v"(b));return r;}
__device__ __forceinline__ float fsub_s(float a,float b){float r;asm("v_sub_f32_e32 %0, %1, %2":"=v"(r):"v"(a),"v"(b));return r;}
__device__ __forceinline__ unsigned cvtpk_s(float lo,float hi){f32x2_t v={lo,hi};bf16x2_t b=__builtin_convertvector(v,bf16x2_t);return __builtin_bit_cast(unsigned,b);}
#define WAIT_BAR(N) asm volatile("s_waitcnt vmcnt(" #N ") lgkmcnt(0)\n\ts_barrier":::"memory")
__device__ __forceinline__ void qkt(f32x16&p0,f32x16&p1,const char*Kslot,const bf16x8*qr,const f32x16&negm,int r32,int hi){
  const char*kb=Kslot+hi*1024+r32*16;
  #pragma unroll
  for(int d0=0;d0<4;++d0){
    const bf16x8 b0=*reinterpret_cast<const bf16x8*>(kb+d0*2048);
    const bf16x8 b1=*reinterpret_cast<const bf16x8*>(kb+d0*2048+512);
    if(d0==0){p0=__builtin_amdgcn_mfma_f32_32x32x16_bf16(b0,qr[0],negm,0,0,0);p1=__builtin_amdgcn_mfma_f32_32x32x16_bf16(b1,qr[0],negm,0,0,0);}
    else{p0=__builtin_amdgcn_mfma_f32_32x32x16_bf16(b0,qr[d0],p0,0,0,0);p1=__builtin_amdgcn_mfma_f32_32x32x16_bf16(b1,qr[d0],p1,0,0,0);}}
}
typedef __attribute__((address_space(3))) const char* lds_cptr;
typedef short v4i16_t __attribute__((ext_vector_type(4)));
__device__ __forceinline__ void kload8(bf16x8*kf,lds_cptr kp){
  kf[0]=*(const __attribute__((address_space(3))) bf16x8*)(kp);      kf[1]=*(const __attribute__((address_space(3))) bf16x8*)(kp+512);
  kf[2]=*(const __attribute__((address_space(3))) bf16x8*)(kp+2048); kf[3]=*(const __attribute__((address_space(3))) bf16x8*)(kp+2560);
  kf[4]=*(const __attribute__((address_space(3))) bf16x8*)(kp+4096); kf[5]=*(const __attribute__((address_space(3))) bf16x8*)(kp+4608);
  kf[6]=*(const __attribute__((address_space(3))) bf16x8*)(kp+6144); kf[7]=*(const __attribute__((address_space(3))) bf16x8*)(kp+6656);
}
__device__ __forceinline__ void kload2(bf16x8*kf,lds_cptr kp,int j){ kf[2*j]=*(const __attribute__((address_space(3))) bf16x8*)(kp+j*2048); kf[2*j+1]=*(const __attribute__((address_space(3))) bf16x8*)(kp+j*2048+512); }
__device__ __forceinline__ s16x4 vtr(lds_cptr p){ return __builtin_bit_cast(s16x4,__builtin_amdgcn_ds_read_tr16_b64_v4i16((__attribute__((address_space(3))) v4i16_t*)p)); }
__device__ __forceinline__ float rowmax(const f32x16&p0,const f32x16&p1){
  float a=max3f(p0[0],p0[1],p1[0]),b=max3f(p0[2],p0[3],p1[1]);a=max3f(a,p1[2],p1[3]);
  #pragma unroll
  for(int r=4;r<16;r+=4){a=max3f(a,p0[r],p0[r+1]);b=max3f(b,p0[r+2],p0[r+3]);a=max3f(a,p1[r],p1[r+1]);b=max3f(b,p1[r+2],p1[r+3]);}
  const float m=max2f(a,b);
  auto rr=__builtin_amdgcn_permlane32_swap(__float_as_uint(m),__float_as_uint(m),false,false);
  return max2f(__uint_as_float(rr[0]),__uint_as_float(rr[1]));
}
__device__ __forceinline__ void pv(f32x16*o,int vb,bf16x8 pa0,bf16x8 pa1,bf16x8 pa2,bf16x8 pa3){
  #pragma unroll
  for(int d0=0;d0<2;++d0){s16x4 lo[4],hi[4];
    #pragma unroll
    for(int ks=0;ks<4;++ks){
      asm volatile("ds_read_b64_tr_b16 %0,%1 offset:%c2":"=&v"(lo[ks]):"v"(vb),"i"(d0*4096+ks*1024):"memory");
      asm volatile("ds_read_b64_tr_b16 %0,%1 offset:%c2":"=&v"(hi[ks]):"v"(vb),"i"(d0*4096+ks*1024+512):"memory");}
    asm volatile("s_waitcnt lgkmcnt(0)":::"memory");SBAR();
    #define PK(k) (bf16x8){lo[k][0],lo[k][1],lo[k][2],lo[k][3],hi[k][0],hi[k][1],hi[k][2],hi[k][3]}
    o[d0]=__builtin_amdgcn_mfma_f32_32x32x16_bf16(pa0,PK(0),o[d0],0,0,0);
    o[d0]=__builtin_amdgcn_mfma_f32_32x32x16_bf16(pa1,PK(1),o[d0],0,0,0);
    o[d0]=__builtin_amdgcn_mfma_f32_32x32x16_bf16(pa2,PK(2),o[d0],0,0,0);
    o[d0]=__builtin_amdgcn_mfma_f32_32x32x16_bf16(pa3,PK(3),o[d0],0,0,0);
    #undef PK
  }
}
#define ATTN_STORE16(p,v) (*(u32x4*)(p)=(v))
constexpr int QP=512, KVP=128, OP=1024;
constexpr int GQ_NJ=5, GQ_ND=3, GQ_NH=2*(GQ_NJ+GQ_ND);
template<int THRL,bool FAST> __device__ __forceinline__ void gqa_unit(int b,int h,int qb,const bf16*Q,const bf16*__restrict__ K,const bf16*__restrict__ V,bf16*O,char*shm,int wid_in,unsigned*cntO,const float*sW,unsigned char*sWT,int sitem0,const float*sWd,unsigned char*sWTd,int sitemD){
  const int lane=lane_now(),r32=lane&31,hi=lane>>5; const int wid=wid_in;
  const int q0=qb*QB; const int kvh=h>>2;
  const bf16*Qw=Q+((long)b*SEQ+q0+wid*QBLK)*QP+h*D;
  const unsigned lds0=(unsigned)(uintptr_t)shm;
  float*wsf=(float*)(shm+LDS_WS)+wid*64;
  #define TROW(t) ((t)<64?(long)b*SEQ+(long)(t)*64:(long)T+(long)b*CTXL+(long)((t)-64)*64)
  const bf16*ksrc=K+(long)lane*KVP+kvh*D+wid*8;
  const bf16*vsrc=V+(long)(16*(wid&3)+(lane>>2))*KVP+kvh*D+(wid>>2)*32+(lane&3)*8;
  const unsigned kdst=lds0+LDS_K+wid*1024, vdst=lds0+LDS_V+wid*1024;
  #define DMA_K(t,slot) glds16(ksrc+TROW(t)*KVP,(unsigned)__builtin_amdgcn_readfirstlane(kdst+(slot)))
  #define DMA_V(t,slot) glds16(vsrc+TROW(t)*KVP,(unsigned)__builtin_amdgcn_readfirstlane(vdst+(slot)))
  const int vb0=(int)(lds0+LDS_V)+((lane>>4)&1)*32+(lane&3)*8+(4*hi+((lane&15)>>2))*64;
  const char*Kbase=shm+LDS_K; bf16x8 kf[8];
  const lds_cptr shm3=(lds_cptr)shm; const lds_cptr kp0=shm3+LDS_K+hi*1024+r32*16; const lds_cptr vp0=shm3+LDS_V+((lane>>4)&1)*32+(lane&3)*8+(4*hi+((lane&15)>>2))*64;
  constexpr int NT=(SEQ+CTXL)/KVBLK;
  DMA_K(0,0);DMA_V(0,0);DMA_K(1,SLOTB);
  bf16x8 qr[4];
  #pragma unroll
  for(int d0=0;d0<4;++d0)qr[d0]=*reinterpret_cast<const bf16x8*>(&Qw[(long)r32*QP+d0*16+hi*8]);
  float mhat=0.f,l_reg=0.f;f32x16 o[2];o[0]=f32x16{};o[1]=f32x16{};f32x16 negm=f32x16{};asm volatile("":"+v"(negm));
  bool resc=false;
  #define NEGM (FAST?f32x16{}:negm)
  #define START(P0,P1) do{ resc=false; \
    if(!FAST){ const float rm=rowmax(P0,P1); const float dl=rm; mhat=fadd_s(mhat,dl); \
      _Pragma("unroll") for(int r=0;r<16;++r){P0[r]=fsub_s(P0[r],dl);P1[r]=fsub_s(P1[r],dl);} \
      _Pragma("unroll") for(int r=0;r<16;++r)negm[r]=-mhat; asm volatile("":"+v"(negm)); } \
    _Pragma("unroll") for(int r=0;r<16;++r)P0[r]=__builtin_amdgcn_exp2f(P0[r]); }while(0)
  #define RESC() do{ if(!FAST&&resc){ asm volatile("s_waitcnt lgkmcnt(0)":::"memory"); \
      _Pragma("unroll") for(int d_=0;d_<2;++d_) _Pragma("unroll") for(int r=0;r<16;++r)o[d_][r]*=wsf[crow(r,hi)]; } }while(0)
  f32x16 pA0,pA1,pB0,pB1;
  int sl_prev=0,sl_cur=0,sl_next=SLOTB;
  #define ROT() do{sl_prev=sl_cur;sl_cur=sl_next;sl_next=(sl_next==(NSLOT-1)*SLOTB)?0:sl_next+SLOTB;}while(0)
  DMA_K(2,2*SLOTB);
  WAIT_BAR(3);
  qkt(pA0,pA1,Kbase,qr,negm,r32,hi);asm volatile("s_nop 15\n\ts_nop 7":"+v"(pA0),"+v"(pA1));
  START(pA0,pA1);
  _Pragma("unroll") for(int r=0;r<16;++r)pA1[r]=__builtin_amdgcn_exp2f(pA1[r]);
  WAIT_BAR(0);
  DMA_K(3,0);DMA_V(1,SLOTB);
  ROT();
  kload8(kf,kp0+sl_cur);
  WAIT_BAR(2);
  s16x4 vlo[8],vhi[8]; u32x4 pw0,pw1,pw2,pw3;
  #define PKW(P,B) cvtpk_s(P[B],P[B+1])
  #define PAF(k) __builtin_bit_cast(bf16x8,pw##k)
  #define VFR(i) (bf16x8){vlo[i][0],vlo[i][1],vlo[i][2],vlo[i][3],vhi[i][0],vhi[i][1],vhi[i][2],vhi[i][3]}
  #define PIN(x) asm volatile("":"+v"(x))
  #define MX3(a,b,c) __builtin_fmaxf(__builtin_fmaxf((a),(b)),(c))
  #define GAPA(MF,A0,A1,A2,A3,W0,W1,PW) do{ MF; sacc+=A0; sacc+=A1; sacc+=A2; sacc+=A3; PIN(sacc); W0; W1; PIN(PW); SBAR(); }while(0)
  #define EX(v) __builtin_amdgcn_exp2f(v)
  #define GAPB(MF,X,B) do{ MF; X[B]=EX(X[B]); X[B+1]=EX(X[B+1]); X[B+2]=EX(X[B+2]); X[B+3]=EX(X[B+3]); PIN(X); SBAR(); }while(0)
  #define VRD(i) do{ vlo[i]=vtr(vp_+(((i)>>2)*4096+((i)&3)*1024)); vhi[i]=vtr(vp_+(((i)>>2)*4096+((i)&3)*1024+512)); }while(0)
  #define KRD(G,j) do{ if(G){ kload2(kf,kp0+sl_next,j); SBAR(); } }while(0)
  #define STEP(C0,C1,P0,P1,t,GK,GV,GL) do{ SBAR(); \
    const lds_cptr vp_=vp0+sl_prev; \
    VRD(0); SBAR(); float sacc=(P0[0]+P0[1]); \
    GAPA(C0=__builtin_amdgcn_mfma_f32_32x32x16_bf16(kf[0],qr[0],NEGM,0,0,0), P0[2],P0[3],P0[4],P0[5],     pw0[0]=PKW(P0,0), pw0[1]=PKW(P0,2), pw0); \
    VRD(4); SBAR(); GAPA(C1=__builtin_amdgcn_mfma_f32_32x32x16_bf16(kf[1],qr[0],NEGM,0,0,0), P0[6],P0[7],P0[8],P0[9],     pw0[2]=PKW(P0,4), pw0[3]=PKW(P0,6), pw0); \
    VRD(1); SBAR(); GAPA(C0=__builtin_amdgcn_mfma_f32_32x32x16_bf16(kf[2],qr[1],C0,0,0,0),   P0[10],P0[11],P0[12],P0[13], pw1[0]=PKW(P0,8), pw1[1]=PKW(P0,10), pw1); \
    VRD(5); SBAR(); GAPA(C1=__builtin_amdgcn_mfma_f32_32x32x16_bf16(kf[3],qr[1],C1,0,0,0),   P0[14],P0[15],P1[0],P1[1],   pw1[2]=PKW(P0,12),pw1[3]=PKW(P0,14), pw1); \
    VRD(2); SBAR(); GAPA(C0=__builtin_amdgcn_mfma_f32_32x32x16_bf16(kf[4],qr[2],C0,0,0,0),   P1[2],P1[3],P1[4],P1[5],     pw2[0]=PKW(P1,0), pw2[1]=PKW(P1,2), pw2); \
    VRD(6); SBAR(); GAPA(C1=__builtin_amdgcn_mfma_f32_32x32x16_bf16(kf[5],qr[2],C1,0,0,0),   P1[6],P1[7],P1[8],P1[9],     pw2[2]=PKW(P1,4), pw2[3]=PKW(P1,6), pw2); \
    VRD(3); SBAR(); GAPA(C0=__builtin_amdgcn_mfma_f32_32x32x16_bf16(kf[6],qr[3],C0,0,0,0),   P1[10],P1[11],P1[12],P1[13], pw3[0]=PKW(P1,8), pw3[1]=PKW(P1,10), pw3); \
    VRD(7); SBAR(); GAPA(C1=__builtin_amdgcn_mfma_f32_32x32x16_bf16(kf[7],qr[3],C1,0,0,0),   P1[14],P1[15],0.f,0.f,       pw3[2]=PKW(P1,12),pw3[3]=PKW(P1,14), pw3); \
    l_reg+=sacc; \
    if(GK){DMA_K((t)+3,sl_cur);} if(GV){DMA_V((t)+1,sl_next);} \
    if(!FAST){ float a=MX3(C0[0],C0[1],C1[0]),b=MX3(C0[2],C0[3],C1[1]); a=MX3(a,C1[2],C1[3]); \
      _Pragma("unroll") for(int r=4;r<16;r+=4){a=MX3(a,C0[r],C0[r+1]);b=MX3(b,C0[r+2],C0[r+3]);a=MX3(a,C1[r],C1[r+1]);b=MX3(b,C1[r+2],C1[r+3]);} \
      float rm=__builtin_fmaxf(a,b); { auto rr=__builtin_amdgcn_permlane32_swap(__float_as_uint(rm),__float_as_uint(rm),false,false); rm=__builtin_fmaxf(__uint_as_float(rr[0]),__uint_as_float(rr[1])); } \
      resc=false; \
      if(__builtin_expect(__any(rm>(float)THRL),0)){ const float dl=__builtin_fmaxf(rm,0.f); mhat+=dl; \
        _Pragma("unroll") for(int r=0;r<16;++r){C0[r]-=dl;C1[r]-=dl;} \
        _Pragma("unroll") for(int r=0;r<16;++r)negm[r]=-mhat; asm volatile("":"+v"(negm)); \
        const float f=__builtin_amdgcn_exp2f(-dl); l_reg*=f; if(hi==0)wsf[r32]=f; resc=true; } } \
    SBAR(); \
    GAPB(o[0]=__builtin_amdgcn_mfma_f32_32x32x16_bf16(PAF(0),VFR(0),o[0],0,0,0), C0,0); \
    GAPB(o[1]=__builtin_amdgcn_mfma_f32_32x32x16_bf16(PAF(0),VFR(4),o[1],0,0,0), C0,4); \
    KRD(GL,0); GAPB(o[0]=__builtin_amdgcn_mfma_f32_32x32x16_bf16(PAF(1),VFR(1),o[0],0,0,0), C0,8); \
    KRD(GL,1); GAPB(o[1]=__builtin_amdgcn_mfma_f32_32x32x16_bf16(PAF(1),VFR(5),o[1],0,0,0), C0,12); \
    KRD(GL,2); GAPB(o[0]=__builtin_amdgcn_mfma_f32_32x32x16_bf16(PAF(2),VFR(2),o[0],0,0,0), C1,0); \
    KRD(GL,3); GAPB(o[1]=__builtin_amdgcn_mfma_f32_32x32x16_bf16(PAF(2),VFR(6),o[1],0,0,0), C1,4); \
    GAPB(o[0]=__builtin_amdgcn_mfma_f32_32x32x16_bf16(PAF(3),VFR(3),o[0],0,0,0), C1,8); \
    GAPB(o[1]=__builtin_amdgcn_mfma_f32_32x32x16_bf16(PAF(3),VFR(7),o[1],0,0,0), C1,12); \
    }while(0)
  f32x4 sv[4]; unsigned sw[4];
  #pragma unroll
  for(int i=0;i<4;++i){sv[i]=(f32x4){0.f,0.f,0.f,0.f};sw[i]=0u;}
  #define GQ_DN(bi) (((bi)>>1)>=GQ_NJ)
  #define GQ_I(bi) (GQ_DN(bi)?sitemD+((bi)>>1)-GQ_NJ:sitem0+((bi)>>1))
  #define GQ_LNB(bi) (GQ_DN(bi)?5:6)
  #define GQ_E(bi) (GQ_I(bi)>>(4+GQ_LNB(bi)))
  #define GQ_KB(bi) ((GQ_I(bi)>>GQ_LNB(bi))&15)
  #define GQ_NB(bi) (GQ_I(bi)&((1<<GQ_LNB(bi))-1))
  #define GQ_SBASE(bi) ((const char*)(GQ_DN(bi)?sWd:sW)+(((((size_t)GQ_E(bi)*1024+(size_t)(64*GQ_KB(bi)+4*((bi)&1)))<<(5+GQ_LNB(bi)))+(size_t)(32*GQ_NB(bi)))<<2))
  #define GQ_DBASE(bi) ((GQ_DN(bi)?sWTd:sWT)+((size_t)GQ_E(bi)<<(15+GQ_LNB(bi)))+(size_t)(32*GQ_NB(bi))*1024+64*GQ_KB(bi))
  #define GQ_ISSUE(bi) do{ const int l_=lane_now(); const unsigned vo_=((unsigned)(l_>>3)<<(10+GQ_LNB(bi)))|((unsigned)(l_&7)<<4); const char*sb_=GQ_SBASE(bi); \
      _Pragma("unroll") for(int i=0;i<4;++i){ const char*sbi_=sb_+((size_t)i<<(7+GQ_LNB(bi))); asm volatile("global_load_dwordx4 %0, %1, %2 nt":"=v"(sv[i]):"v"(vo_),"s"(sbi_):"memory"); } }while(0)
  #define GQ_CONSUME(bi) do{ const f32x4 t0_=sv[0]*W8_SCALE,t1_=sv[1]*W8_SCALE,t2_=sv[2]*W8_SCALE,t3_=sv[3]*W8_SCALE; \
      if(((bi)&1)==0){ _Pragma("unroll") for(int j=0;j<4;++j)sw[j]=pk4_fp8(t0_[j],t1_[j],t2_[j],t3_[j]); } \
      else { const int l_=lane_now(); const unsigned do_=((unsigned)(l_&7)<<12)|((unsigned)(l_>>3)<<3); unsigned char*db_=GQ_DBASE(bi); \
        _Pragma("unroll") for(int j=0;j<4;++j){ u32x2 ow; ow.x=sw[j]; ow.y=pk4_fp8(t0_[j],t1_[j],t2_[j],t3_[j]); *(u32x2*)(db_+do_+j*1024)=ow; } } }while(0)
  int t=1;
  #pragma unroll 1
  for(;t+5<NT;t+=2){
    const int it=(t-1)>>1;
    STEP(pB0,pB1,pA0,pA1,t,true,true,true);
    if(sW==nullptr||it<1||it>GQ_NH){ asm volatile("s_waitcnt vmcnt(2)":::"memory"); } else if(!((it&1)&&it>=3)){ asm volatile("s_waitcnt vmcnt(6)":::"memory"); }
    asm volatile("s_waitcnt vmcnt(10) lgkmcnt(0)\n\ts_barrier":"+v"(sv[0]),"+v"(sv[1]),"+v"(sv[2]),"+v"(sv[3])::"memory");
    RESC(); ROT();
    STEP(pA0,pA1,pB0,pB1,t+1,true,true,true);
    asm volatile("s_waitcnt vmcnt(2) lgkmcnt(0)\n\ts_barrier":"+v"(sv[0]),"+v"(sv[1]),"+v"(sv[2]),"+v"(sv[3])::"memory");
    if(sW!=nullptr){
      if(it>=1&&it<=GQ_NH) GQ_CONSUME(it-1);
      if(it<GQ_NH){
        GQ_ISSUE(it); } }
    RESC(); ROT();
  }
  #undef GQ_SBASE
  #undef GQ_DBASE
  #undef GQ_ISSUE
  #undef GQ_CONSUME
  #undef GQ_DN
  #undef GQ_I
  #undef GQ_LNB
  #undef GQ_E
  #undef GQ_KB
  #undef GQ_NB
  #define ENDW(tt) do{ if((tt)+3<NT){WAIT_BAR(2);} else if((tt)+2<NT){WAIT_BAR(1);} else {WAIT_BAR(0);} }while(0)
  for(;t+1<NT;t+=2){
    STEP(pB0,pB1,pA0,pA1,t,(t+3<NT),(t+1<NT),(t+1<NT));       ENDW(t);   RESC(); ROT();
    STEP(pA0,pA1,pB0,pB1,t+1,(t+4<NT),(t+2<NT),(t+2<NT));     ENDW(t+1); RESC(); ROT();
  }
  STEP(pB0,pB1,pA0,pA1,NT-1,false,false,false); RESC();
  { float sacc=pB0[0]+pB0[1]; _Pragma("unroll") for(int r=2;r<16;++r)sacc+=pB0[r]; _Pragma("unroll") for(int r=0;r<16;++r)sacc+=pB1[r]; l_reg+=sacc;
    pw0=(u32x4){PKW(pB0,0),PKW(pB0,2),PKW(pB0,4),PKW(pB0,6)};pw1=(u32x4){PKW(pB0,8),PKW(pB0,10),PKW(pB0,12),PKW(pB0,14)};pw2=(u32x4){PKW(pB1,0),PKW(pB1,2),PKW(pB1,4),PKW(pB1,6)};pw3=(u32x4){PKW(pB1,8),PKW(pB1,10),PKW(pB1,12),PKW(pB1,14)};
    SBAR(); pv(o,vb0+sl_cur,PAF(0),PAF(1),PAF(2),PAF(3)); }
  #undef PKW
  #undef PAF
  #undef VFR
  #undef PIN
  #undef MX3
  #undef GAPA
  #undef GAPB
  #undef EX
  #undef VRD
  #undef KRD
  #undef STEP
  #undef ENDW
  {auto rr=__builtin_amdgcn_permlane32_swap(__float_as_uint(l_reg),__float_as_uint(l_reg),false,false);l_reg=__uint_as_float(rr[0])+__uint_as_float(rr[1]);}
  if(hi==0)wsf[32+r32]=l_reg;asm volatile("s_waitcnt lgkmcnt(0)":::"memory");
  float rli[16];
  #pragma unroll
  for(int r=0;r<16;++r)rli[r]=__builtin_amdgcn_rcpf(wsf[32+crow(r,hi)]);
  bf16*Ow=O+((long)b*SEQ+q0+wid*QBLK)*OP+512+h*D;
  { bf16*stg=(bf16*)(shm+LDS_OST)+wid*2048;
    #pragma unroll
    for(int r=0;r<16;++r){const int orow=crow(r,hi);
      #pragma unroll
      for(int d0=0;d0<2;++d0)stg[orow*64+d0*32+r32]=(bf16)f2bf(o[d0][r]*rli[r]);}
    asm volatile("s_waitcnt lgkmcnt(0)":::"memory");
    #pragma unroll
    for(int i=0;i<4;++i){const int row=i*8+(lane>>3),ch=lane&7; const u32x4 v=*(const u32x4*)(stg+row*64+ch*8); wt16(O,(unsigned)(((b*SEQ+q0+wid*QBLK+row)*OP+512+h*D+ch*8)*2),v);} }
  if(cntO) panel_signal(cntO+64*((b*SEQ+q0)>>8));
  asm volatile("s_waitcnt lgkmcnt(0)\n\ts_barrier":::"memory");
  #undef DMA_K
  #undef DMA_V
  #undef TROW
  #undef START
  #undef NEGM
  #undef RESC
  #undef ROT
}

template<int MODE> __device__ __forceinline__ void na_softmax(f32x16&p0,f32x16&p1,float&mref,float&lrow,f32x16*o,float*wsf,const float*bp,int c0,int r32,int hi,u32x4*pw){
  #define NA_LIVE0(rr) (MODE!=2||(rr)>=12)
  #define NA_LIVE1(rr) (MODE!=1||(rr)<4)
  if(MODE!=0){
    #pragma unroll
    for(int rr=0;rr<16;++rr){ const int kc0=(rr&3)+8*(rr>>2)+4*hi;
      if(NA_LIVE0(rr))p0[rr]=((unsigned)(kc0-c0)<16u)?p0[rr]+bp[(rr&3)+8*(rr>>2)]:-INFINITY;
      if(NA_LIVE1(rr))p1[rr]=((unsigned)(kc0+32-c0)<16u)?p1[rr]+bp[(rr&3)+8*(rr>>2)+32]:-INFINITY; }
  }
  float rm=-INFINITY;
  #pragma unroll
  for(int rr=0;rr<16;++rr){ if(NA_LIVE0(rr))rm=fmaxf(rm,p0[rr]); if(NA_LIVE1(rr))rm=fmaxf(rm,p1[rr]); }
  { auto q=__builtin_amdgcn_permlane32_swap(__float_as_uint(rm),__float_as_uint(rm),false,false); rm=fmaxf(__uint_as_float(q[0]),__uint_as_float(q[1])); }
  if(__any(rm>mref+8.0f)){
    const float mn=fmaxf(mref,rm), f=__builtin_amdgcn_exp2f(mref-mn);
    mref=mn; lrow*=f;
    if(hi==0)wsf[r32]=f;
    asm volatile("s_waitcnt lgkmcnt(0)":::"memory");
    #pragma unroll
    for(int d_=0;d_<2;++d_)
      #pragma unroll
      for(int rr=0;rr<16;++rr)o[d_][rr]*=wsf[crow(rr,hi)];
    asm volatile("s_waitcnt lgkmcnt(0)":::"memory");
  }
  float sacc=0.f;
  #pragma unroll
  for(int rr=0;rr<16;++rr){
    if(NA_LIVE0(rr)){p0[rr]=__builtin_amdgcn_exp2f(p0[rr]-mref);sacc+=p0[rr];}else p0[rr]=0.f;
    if(NA_LIVE1(rr)){p1[rr]=__builtin_amdgcn_exp2f(p1[rr]-mref);sacc+=p1[rr];}else p1[rr]=0.f; }
  lrow+=sacc;
  pw[0]=(u32x4){cvtpk_s(p0[0],p0[1]),cvtpk_s(p0[2],p0[3]),cvtpk_s(p0[4],p0[5]),cvtpk_s(p0[6],p0[7])};
  pw[1]=(u32x4){cvtpk_s(p0[8],p0[9]),cvtpk_s(p0[10],p0[11]),cvtpk_s(p0[12],p0[13]),cvtpk_s(p0[14],p0[15])};
  pw[2]=(u32x4){cvtpk_s(p1[0],p1[1]),cvtpk_s(p1[2],p1[3]),cvtpk_s(p1[4],p1[5]),cvtpk_s(p1[6],p1[7])};
  pw[3]=(u32x4){cvtpk_s(p1[8],p1[9]),cvtpk_s(p1[10],p1[11]),cvtpk_s(p1[12],p1[13]),cvtpk_s(p1[14],p1[15])};
  #undef NA_LIVE0
  #undef NA_LIVE1
}
constexpr int NAP=512;
#ifndef NA_SJ_EVERY
#define NA_SJ_EVERY 2
#endif
constexpr int NA_NSIDE=6;
__device__ __forceinline__ void na_unit(int b,int r,const bf16*Q,const bf16*__restrict__ K,const bf16*__restrict__ V,bf16*O,char*shm,const float*rpbl_all,float*wsf_all,int wid_in,const float*sW,unsigned char*sWT,int sitem0,unsigned*cntO){
  const int lane=lane_now(),r32=lane&31,hi=lane>>5; const int h=wid_in;
  char*wl=shm+h*16384; const unsigned lds0=(unsigned)(uintptr_t)wl;
  const float*rpbl=rpbl_all+h*480;
  const int r0=min(max(r-4,0),56);
  const long qrow0=(long)b*SEQ+(long)r*GRIDW;
  bf16x8 qr[2][4];
  #pragma unroll
  for(int qb=0;qb<2;++qb)
    #pragma unroll
    for(int d0=0;d0<4;++d0)qr[qb][d0]=*reinterpret_cast<const bf16x8*>(&Q[(qrow0+qb*32+r32)*NAP+h*D+d0*16+hi*8]);
  f32x16 o[2][2]; float mrow[2],lrow[2];
  #pragma unroll
  for(int qb=0;qb<2;++qb){o[qb][0]=f32x16{};o[qb][1]=f32x16{};mrow[qb]=-INFINITY;lrow[qb]=0.f;}
  float*wsf=wsf_all+h*64;
  const f32x16 zero=f32x16{};
  const int vb0=(int)(lds0+8192)+((lane>>4)&1)*32+(lane&3)*8+(4*hi+((lane&15)>>2))*64;
  #define NA_KROW0(tt) ((tt)<8?(long)b*SEQ+(long)(r0+(tt))*GRIDW:(long)T+(long)b*CTXL+(long)((tt)-8)*64)
  #define NA_DMA_K(tt) do{ const long kr_=NA_KROW0(tt); _Pragma("unroll") for(int c=0;c<8;++c)glds16(K+(kr_+lane)*NAP+h*D+c*8,lds0+c*1024); }while(0)
  #define NA_DMA_V(tt) do{ const long kr_=NA_KROW0(tt); _Pragma("unroll") for(int p=0;p<8;++p)glds16(V+(kr_+16*(p&3)+(lane>>2))*NAP+h*D+(p>>2)*32+(lane&3)*8,lds0+8192+p*1024); }while(0)
  NA_DMA_K(0); NA_DMA_V(0);
  #pragma unroll
  for(int qb=0;qb<2;++qb)
    #pragma unroll
    for(int d0=0;d0<4;++d0)asm volatile("":"+v"(qr[qb][d0]));
  f32x4 sv[4]; unsigned sw[4];
  #pragma unroll
  for(int i=0;i<4;++i){sv[i]=(f32x4){0.f,0.f,0.f,0.f};sw[i]=0u;}
  #define NA_SJ_I(bi) (sitem0+((bi)>>1))
  #define NA_SJ_SBASE(bi) ((const char*)sW+((((size_t)(NA_SJ_I(bi)>>10)*1024+(size_t)(64*((NA_SJ_I(bi)&1023)>>6)+4*((bi)&1)))*2048+(size_t)(32*(NA_SJ_I(bi)&63)))<<2))
  #define NA_SJ_DBASE(bi) (sWT+((size_t)(NA_SJ_I(bi)>>10)<<21)+(size_t)(32*(NA_SJ_I(bi)&63))*1024+64*((NA_SJ_I(bi)&1023)>>6))
  #define NA_SJ_ISSUE(bi) do{ const int l_=lane_now(); const unsigned vo_=((unsigned)(l_>>3)<<16)|((unsigned)(l_&7)<<4); const char*sb_=NA_SJ_SBASE(bi); \
      _Pragma("unroll") for(int i=0;i<4;++i){ const char*sbi_=sb_+((size_t)i<<13); asm volatile("global_load_dwordx4 %0, %1, %2 nt":"=v"(sv[i]):"v"(vo_),"s"(sbi_):"memory"); } }while(0)
  #define NA_SJ_CONSUME(bi) do{ const f32x4 t0_=sv[0]*W8_SCALE,t1_=sv[1]*W8_SCALE,t2_=sv[2]*W8_SCALE,t3_=sv[3]*W8_SCALE; \
      if(((bi)&1)==0){ _Pragma("unroll") for(int j=0;j<4;++j)sw[j]=pk4_fp8(t0_[j],t1_[j],t2_[j],t3_[j]); } \
      else { const int l_=lane_now(); const unsigned do_=((unsigned)(l_&7)<<12)|((unsigned)(l_>>3)<<3); unsigned char*db_=NA_SJ_DBASE(bi); \
        _Pragma("unroll") for(int j=0;j<4;++j){ u32x2 ow; ow.x=sw[j]; ow.y=pk4_fp8(t0_[j],t1_[j],t2_[j],t3_[j]); *(u32x2*)(db_+do_+j*1024)=ow; } } }while(0)
  #pragma unroll 1
  for(int t=0;t<12;++t){
    if(t==0) asm volatile("s_waitcnt vmcnt(8)":::"memory"); else asm volatile("s_waitcnt vmcnt(12)":::"memory");
    u32x4 pw[2][4];
    #pragma unroll
    for(int qb=0;qb<2;++qb){
      f32x16 p0,p1;
      qkt(p0,p1,wl,qr[qb],zero,r32,hi);
      asm volatile("s_nop 15\n\ts_nop 7":"+v"(p0),"+v"(p1));
      if(qb==1){ asm volatile("s_waitcnt lgkmcnt(0)":::"memory");
                 if(t<11) NA_DMA_K(t+1); }
      { const int qc=qb*32+r32, c0=min(max(qc-8,0),48);
        const float*bp=rpbl+(r0+t-r+7)*32+15-qc+4*hi;
        if(t<8){ if(qb==0) na_softmax<1>(p0,p1,mrow[qb],lrow[qb],o[qb],wsf,bp,c0,r32,hi,pw[qb]); else na_softmax<2>(p0,p1,mrow[qb],lrow[qb],o[qb],wsf,bp,c0,r32,hi,pw[qb]); }
        else na_softmax<0>(p0,p1,mrow[qb],lrow[qb],o[qb],wsf,bp,c0,r32,hi,pw[qb]); }
    }
    if(t==11) asm volatile("s_waitcnt vmcnt(0)":::"memory");
    asm volatile("s_waitcnt vmcnt(8)":"+v"(sv[0]),"+v"(sv[1]),"+v"(sv[2]),"+v"(sv[3])::"memory");
    if(t>0) NA_SJ_CONSUME(t-1);
    NA_SJ_ISSUE(t);
    SBAR();
    #pragma unroll
    for(int qb=0;qb<2;++qb)
      pv(o[qb],vb0,__builtin_bit_cast(bf16x8,pw[qb][0]),__builtin_bit_cast(bf16x8,pw[qb][1]),__builtin_bit_cast(bf16x8,pw[qb][2]),__builtin_bit_cast(bf16x8,pw[qb][3]));
    asm volatile("s_waitcnt lgkmcnt(0)":::"memory");
    if(t<11) NA_DMA_V(t+1);
  }
  asm volatile("s_waitcnt vmcnt(0)":"+v"(sv[0]),"+v"(sv[1]),"+v"(sv[2]),"+v"(sv[3])::"memory");
  NA_SJ_CONSUME(11);
  #undef NA_SJ_CONSUME
  #undef NA_SJ_I
  #undef NA_SJ_SBASE
  #undef NA_SJ_DBASE
  #undef NA_SJ_ISSUE
  #undef NA_KROW0
  #undef NA_DMA_K
  #undef NA_DMA_V
  const int lane_e=lane_now(), hi_e=lane_e>>5, r32_e=lane_e&31;
  #pragma unroll
  for(int qb=0;qb<2;++qb){
    float l=lrow[qb];
    {auto rr=__builtin_amdgcn_permlane32_swap(__float_as_uint(l),__float_as_uint(l),false,false);l=__uint_as_float(rr[0])+__uint_as_float(rr[1]);}
    if(hi_e==0)wsf[r32_e]=l;asm volatile("s_waitcnt lgkmcnt(0)":::"memory");
    bf16*stg=(bf16*)wl+qb*2048;
    #pragma unroll
    for(int rr=0;rr<16;++rr){const int orow=crow(rr,hi_e); const float rl=__builtin_amdgcn_rcpf(wsf[orow]);
      #pragma unroll
      for(int d0=0;d0<2;++d0)stg[orow*64+d0*32+r32_e]=(bf16)f2bf(o[qb][d0][rr]*rl);}
    asm volatile("s_waitcnt lgkmcnt(0)":::"memory");
    bf16*Ow=O+(qrow0+qb*32)*OP+h*D;
    #pragma unroll
    for(int i=0;i<4;++i){const int row=i*8+(lane_e>>3),ch=lane_e&7; const u32x4 v=*(const u32x4*)(stg+row*64+ch*8); wt16(O,(unsigned)(((int)qrow0+qb*32+row)*OP+h*D+ch*8)*2u,v);}
  }
  if(cntO) panel_signal(cntO+64*((int)(qrow0>>8)));
  asm volatile("s_waitcnt lgkmcnt(0)":::"memory");
}
#undef SBAR
#undef WAIT_BAR
}

struct MKArgs { const float* in[23]; float* out; unsigned char* ws; int ph_lo, ph_hi, li, pad; };
struct Frame {
    LAS unsigned char* lds; volatile LAS unsigned* MISC; unsigned* ctl;
    int wave, vcu, G;
};
#define FLANE (lane_now())
#define FTID (F.wave * 64 + lane_now())

struct ProjEpi {
    static constexpr bool HAS_MID = false, HAS_PRE = false; struct Pre {};
    bf16 *QA, *KA, *VA, *QB, *KB, *VB, *GA, *GB; const float *gq, *gk; const LAS float* rope;
    __device__ __forceinline__ void store_plain(const f32x4 (&acc)[2][2][4][2], bf16* dst, int pitch, int rowbase, int colbase, int fq, float scale, bool sig) const {
#pragma unroll
        for (int ai = 0; ai < 2; ++ai)
#pragma unroll
            for (int m = 0; m < 4; ++m) { const unsigned ro = (unsigned)((rowbase + ai * 128 + m * 16) * pitch + colbase + 8 * fq) * 2u;
#pragma unroll
                for (int bj = 0; bj < 2; ++bj) { f32x4 v0 = acc[ai][bj][m][0], v1 = acc[ai][bj][m][1];
                    u32x4 w;
                    constexpr float IS = PROJ_FP8 ? 1.0f / W8_SCALE : 1.0f;
                    if (sig) {
#pragma unroll
                        for (int j = 0; j < 4; ++j) v0[j] = __builtin_amdgcn_rcpf(1.0f + __builtin_amdgcn_exp2f((-LOG2E * IS) * v0[j]));
                        w.x = pk2(v0[0], v0[1]); w.y = pk2(v0[2], v0[3]); __builtin_amdgcn_sched_barrier(0);
#pragma unroll
                        for (int j = 0; j < 4; ++j) v1[j] = __builtin_amdgcn_rcpf(1.0f + __builtin_amdgcn_exp2f((-LOG2E * IS) * v1[j]));
                        w.z = pk2(v1[0], v1[1]); w.w = pk2(v1[2], v1[3]); }
                    else { v0 = v0 * (scale * IS); v1 = v1 * (scale * IS); w.x = pk2(v0[0], v0[1]); w.y = pk2(v0[2], v0[3]); w.z = pk2(v1[0], v1[1]); w.w = pk2(v1[2], v1[3]); }
                    wt16(dst, ro + bj * 64, w);
                    __builtin_amdgcn_sched_barrier(0); } }
    }
    __device__ __forceinline__ void store_head(const f32x4 (&acc)[2][2][4][2], bf16* dst, int pitch, int rowbase, int colbase, int prow0, int fr, int fq, const float* g, float scale, bool do_rope) const {
        const bool upper = (fq & 2) != 0;
#pragma unroll
        for (int ai = 0; ai < 2; ++ai)
#pragma unroll
            for (int m = 0; m < 4; ++m) {
                float ss = 0.f;
#pragma unroll
                for (int bj = 0; bj < 2; ++bj)
#pragma unroll
                    for (int n = 0; n < 2; ++n) { const f32x4 v = acc[ai][bj][m][n]; ss += (v[0] * v[0] + v[1] * v[1]) + (v[2] * v[2] + v[3] * v[3]); }
                { auto r16 = __builtin_amdgcn_permlane16_swap(__float_as_uint(ss), __float_as_uint(ss), false, false); ss = __uint_as_float(r16[0]) + __uint_as_float(r16[1]);
                  auto r32 = __builtin_amdgcn_permlane32_swap(__float_as_uint(ss), __float_as_uint(ss), false, false); ss = __uint_as_float(r32[0]) + __uint_as_float(r32[1]); }
                constexpr float IS = PROJ_FP8 ? 1.0f / W8_SCALE : 1.0f;
                const float rs = rsqrtf(ss * (IS * IS / 64.0f) + EPS) * (scale * IS);
                const unsigned ro = (unsigned)((rowbase + ai * 128 + m * 16) * pitch + colbase + 8 * fq) * 2u;
                const int prow = (prow0 + 2 * ai) & 63, pcol = 16 * m + fr;
                int fq8 = 8 * fq; asm volatile("" : "+v"(fq8));
#pragma unroll
                for (int bj = 0; bj < 2; ++bj) {
                    f32x4 y[2];
#pragma unroll
                    for (int n = 0; n < 2; ++n) { y[n] = acc[ai][bj][m][n] * rs * *(const f32x4*)(g + bj * 32 + fq8 + 4 * n);
                        if (do_rope) {
                            const int pos = bj ? pcol : prow;
                            const LAS f32x4* tp = (const LAS f32x4*)(rope + pos * 32 + ((fq & 1) * 8 + n * 4) * 2);
                            const f32x4 t0 = tp[0], t1 = tp[1];
                            const f32x4 cs = (f32x4){t0[0], t0[2], t1[0], t1[2]}, sn = (f32x4){t0[1], t0[3], t1[1], t1[3]};
                            f32x4 p;
#pragma unroll
                            for (int j = 0; j < 4; ++j) { auto rr = __builtin_amdgcn_permlane32_swap(__float_as_uint(y[n][j]), __float_as_uint(y[n][j]), false, false); p[j] = __uint_as_float(upper ? rr[0] : rr[1]); }
                            y[n] = upper ? (y[n] * cs + p * sn) : (y[n] * cs - p * sn);
                        } }
                    u32x4 w; w.x = pk2(y[0][0], y[0][1]); w.y = pk2(y[0][2], y[0][3]); w.z = pk2(y[1][0], y[1][1]); w.w = pk2(y[1][2], y[1][3]);
                    wt16(dst, ro + bj * 64, w);
                }
                __builtin_amdgcn_sched_barrier(0);
            }
    }
    __device__ __forceinline__ void operator()(const f32x4 (&acc)[2][2][4][2], const pg8::GU& u, int wr, int wc) const {
        const int lane_ = lane_now(), fr = lane_ & 15, fq = lane_ >> 4;
        const int rowbase = u.pm * 256 + wr * 64 + fr, pn = u.pn, prow0 = 4 * u.pm + wr;
        if (pn < 2) store_plain(acc, KA, 512, rowbase, 256 * pn + 64 * wc, fq, 1.0f, false);
        else if (pn < 4) store_plain(acc, VA, 512, rowbase, 256 * (pn - 2) + 64 * wc, fq, 1.0f, false);
        else if (pn == 4) { if (wc < 2) store_head(acc, KB, 128, rowbase, 64 * wc, prow0, fr, fq, gk, 1.0f, u.pm < 64); else store_plain(acc, VB, 128, rowbase, 64 * (wc - 2), fq, 1.0f, false); }
        else if (pn < 7) store_plain(acc, QA, 512, rowbase, 256 * (pn - 5) + 64 * wc, fq, QSCALE, false);
        else if (pn < 9) store_head(acc, QB, 512, rowbase, 256 * (pn - 7) + 64 * wc, prow0, fr, fq, gq, QSCALE, true);
        else if (pn < 13) store_plain(acc, GA, 1024, rowbase, 256 * (pn - 9) + 64 * wc, fq, 1.0f, true);
        else store_plain(acc, GB, 1024, rowbase, 256 * (pn - 13) + 64 * wc, fq, 1.0f, true);
    }
};
struct ProjSched {
    static constexpr bool HAS_DEP = false, HAS_DONE = false;
    const char* Abase; const char* Bbase; const int* rowlist; int v, G;
    __device__ __forceinline__ bool next(int i, pg8::GU& u) const {
        const int id = i * G + v; constexpr int NL = 64 * 17, NC = 4 * 5;
        if (id >= NL + NC) return false;
        int pm, pn; if (id < NL) { pm = id / 17; pn = id % 17; } else { const int c = id - NL; pm = 64 + c / 5; pn = c % 5; }
        u.pm = pm; u.pn = pn; u.e = 0; u.cnt = 256; u.rows = 0u;
        u.a = (unsigned)pm * 256u * PROJ_PITCH; u.b = (unsigned)pn * 256u * PROJ_PITCH;
        return true;
    }
};


struct Dense4Sched {
    static constexpr bool HAS_DEP = false, HAS_DONE = false;
    const char* Abase; const char* Bbase; const int* rowlist; int v, G;
    __device__ __forceinline__ bool next(int i, pg8::GU& u) const {
        const int id = i * G + v; if (id >= 64 * 4) return false;
        u.pm = id >> 2; u.pn = id & 3; u.e = 0; u.cnt = 256; u.rows = 0u;
        u.a = (unsigned)u.pm * 256u * pg8::PITCH; u.b = (unsigned)u.pn * 256u * pg8::PITCH; return true;
    }
};
struct UEpi {
    static constexpr bool HAS_MID = true, HAS_PRE = false; struct Pre {};
    const bf16 *GA, *GB; bf16* U;
    __device__ __forceinline__ void mid(f32x4 (&acc)[2][2][4][2], const pg8::GU& u, int wr, int wc) const {
        const int lane_ = lane_now(), fr = lane_ & 15, fq = lane_ >> 4;
        const unsigned base = (unsigned)((u.pm * 256 + wr * 64 + fr) * 1024 + u.pn * 256 + wc * 32 + 8 * fq) * 2u;
#pragma unroll
        for (int ai = 0; ai < 2; ++ai)
#pragma unroll
            for (int m = 0; m < 4; ++m)
#pragma unroll
                for (int bj = 0; bj < 2; ++bj) { const unsigned o = base + (unsigned)((ai * 128 + m * 16) * 1024 + bj * 128) * 2u;
                    const u32x4 a = *(const u32x4*)((const char*)GA + o), b = *(const u32x4*)((const char*)GB + o);
                    f32x4 r0, r1;
                    r0[0] = bflo(a.x) * __builtin_amdgcn_rcpf(bflo(b.x)); r0[1] = bfhi(a.x) * __builtin_amdgcn_rcpf(bfhi(b.x)); r0[2] = bflo(a.y) * __builtin_amdgcn_rcpf(bflo(b.y)); r0[3] = bfhi(a.y) * __builtin_amdgcn_rcpf(bfhi(b.y));
                    r1[0] = bflo(a.z) * __builtin_amdgcn_rcpf(bflo(b.z)); r1[1] = bfhi(a.z) * __builtin_amdgcn_rcpf(bfhi(b.z)); r1[2] = bflo(a.w) * __builtin_amdgcn_rcpf(bflo(b.w)); r1[3] = bfhi(a.w) * __builtin_amdgcn_rcpf(bfhi(b.w));
                    acc[ai][bj][m][0] = acc[ai][bj][m][0] * r0; acc[ai][bj][m][1] = acc[ai][bj][m][1] * r1; }
    }
    __device__ __forceinline__ void operator()(const f32x4 (&acc)[2][2][4][2], const pg8::GU& u, int wr, int wc) const {
        const int lane_ = lane_now(), fr = lane_ & 15, fq = lane_ >> 4;
        const unsigned base = (unsigned)((u.pm * 256 + wr * 64 + fr) * 1024 + u.pn * 256 + wc * 32 + 8 * fq) * 2u;
#pragma unroll
        for (int ai = 0; ai < 2; ++ai)
#pragma unroll
            for (int m = 0; m < 4; ++m)
#pragma unroll
                for (int bj = 0; bj < 2; ++bj) { const unsigned o = base + (unsigned)((ai * 128 + m * 16) * 1024 + bj * 128) * 2u;
                    const u32x4 b = *(const u32x4*)((const char*)GB + o); const f32x4 v0 = acc[ai][bj][m][0], v1 = acc[ai][bj][m][1];
                    u32x4 w; w.x = pk2(v0[0] * bflo(b.x), v0[1] * bfhi(b.x)); w.y = pk2(v0[2] * bflo(b.y), v0[3] * bfhi(b.y)); w.z = pk2(v1[0] * bflo(b.z), v1[1] * bfhi(b.z)); w.w = pk2(v1[2] * bflo(b.w), v1[3] * bfhi(b.w));
                    wt16(U, o, w); }
    }
};
struct YEpi {
    static constexpr bool HAS_MID = false, HAS_PRE = false; struct Pre {};
    bf16* Y;
    __device__ __forceinline__ void operator()(const f32x4 (&acc)[2][2][4][2], const pg8::GU& u, int wr, int wc) const {
        const int lane_ = lane_now(), fr = lane_ & 15, fq = lane_ >> 4;
        const unsigned base = (unsigned)((u.pm * 256 + wr * 64 + fr) * 1024 + u.pn * 256 + wc * 32 + 8 * fq) * 2u;
#pragma unroll
        for (int ai = 0; ai < 2; ++ai)
#pragma unroll
            for (int m = 0; m < 4; ++m)
#pragma unroll
                for (int bj = 0; bj < 2; ++bj) { const f32x4 v0 = acc[ai][bj][m][0], v1 = acc[ai][bj][m][1]; u32x4 w; w.x = pk2(v0[0], v0[1]); w.y = pk2(v0[2], v0[3]); w.z = pk2(v1[0], v1[1]); w.w = pk2(v1[2], v1[3]);
                    wt16(Y, base + (unsigned)((ai * 128 + m * 16) * 1024 + bj * 128) * 2u, w); }
    }
};
constexpr int MW_TSTART = 900, MW_ECN = 940;
constexpr int GQ_SIDE_DN_ = 512 * NWAVES * attn_body::GQ_ND;
constexpr int CV_TAIL2 = NE * I_DN - GQ_SIDE_DN_, CV_TAIL7 = 0, CV_BAL0 = 3200;
constexpr int CV_HEAD = I_IN + 2 * I_OA + I_O, NA_SIDE_N = 256 * NWAVES * attn_body::NA_NSIDE, GQ_SIDE_N = 512 * NWAVES * attn_body::GQ_NJ, P3_SIDE_N = NA_SIDE_N + GQ_SIDE_N, GQ_SIDE_DN = 512 * NWAVES * attn_body::GQ_ND;
static_assert(P3_SIDE_N <= NE * I_GU && MOE_FP8, "NA side job converts w_gu items to e4m3");
#define CV_ITEM(j) ((j) < CV_HEAD ? (j) : (j) + P3_SIDE_N)
static_assert(CV_TAIL2 + CV_TAIL7 <= NE * I_DN, "only w_dn items may move behind P0");
__device__ __forceinline__ void moe_table(const Frame& F, const unsigned* ecnt) {
    if (FTID < 32) F.MISC[MW_ECN + FTID] = ecnt[FTID];
    __syncthreads();
    if (FTID == 0) { unsigned t = 0; for (int e = 0; e < 32; ++e) { F.MISC[MW_TSTART + e] = t; t += (F.MISC[MW_ECN + e] + 255u) >> 8; } F.MISC[MW_TSTART + 32] = t; }
    __syncthreads();
}
template <int NPN  , bool GU_PHASE>
struct MoeSched {
    static constexpr bool HAS_DEP = !GU_PHASE, HAS_DONE = GU_PHASE;
    const char* Abase; const char* Bbase; const int* rowlist; volatile LAS unsigned* MISC; int v, G; unsigned* cntA; unsigned* tmo;
    __device__ __forceinline__ void done(const pg8::GU& u) const { if (cntA != nullptr) panel_signal(cntA + 64 * u.pm); }
    __device__ __forceinline__ void a_ready(int i, const pg8::GU& u, int wid) const {
        if (cntA == nullptr || i < 4) return;
        if (wid == 0) { unsigned sp = 0u;
            while (__hip_atomic_load(cntA + 64 * u.pm, __ATOMIC_RELAXED, __HIP_MEMORY_SCOPE_AGENT) < 64u) { __builtin_amdgcn_s_sleep(2);
                if (++sp > (1u << 20)) { if (lane_now() == 0) __hip_atomic_store(tmo, 0xC0DEu, __ATOMIC_RELAXED, __HIP_MEMORY_SCOPE_AGENT); break; } }
            __builtin_amdgcn_fence(__ATOMIC_ACQUIRE, "agent"); }
        asm volatile("" ::: "memory"); __builtin_amdgcn_s_barrier(); asm volatile("" ::: "memory");
    }
    __device__ __forceinline__ bool next(int i, pg8::GU& u) const {
        const int id = i * G + v; const int tile = id / NPN, pn = id % NPN;
        if (tile >= (int)__builtin_amdgcn_readfirstlane(MISC[MW_TSTART + 32])) return false;
        int e = 0;
#pragma unroll
        for (int st = 16; st >= 1; st >>= 1) { if (tile >= (int)__builtin_amdgcn_readfirstlane(MISC[MW_TSTART + e + st])) e += st; }
        const int mt = tile - (int)__builtin_amdgcn_readfirstlane(MISC[MW_TSTART + e]);
        const int cnt_e = (int)__builtin_amdgcn_readfirstlane(MISC[MW_ECN + e]);
        u.pm = tile; u.pn = pn; u.e = e; u.cnt = min(256, cnt_e - mt * 256); u.rows = (unsigned)(e * ECAP + mt * 256);
        if (GU_PHASE) { u.a = 0u; u.b = (unsigned)(e * 2048 + pn * 128) * MOE_PITCH; }
        else { u.a = (unsigned)tile * 256u * MOE_PITCH; u.b = (unsigned)(e * 1024 + pn * 256) * MOE_PITCH; }
        return true;
    }
};
struct GuEpi {
    static constexpr bool HAS_MID = false, HAS_PRE = true; struct Pre { f32x4 g[2], l[2]; };
    const float* b_gu; bf16* ACT;
    __device__ __forceinline__ void prefetch(Pre& pre, const pg8::GU& u, int wr, int wc) const {
        const int c0 = u.pn * 128 + wc * 32 + 8 * (lane_now() >> 4);
#pragma unroll
        for (int bj = 0; bj < 2; ++bj) { const float* pg = b_gu + u.e * 2048 + c0 + bj * 4; const float* pl = pg + 1024;
            asm volatile("global_load_dwordx4 %0, %1, off" : "=v"(pre.g[bj]) : "v"(pg) : "memory"); asm volatile("global_load_dwordx4 %0, %1, off" : "=v"(pre.l[bj]) : "v"(pl) : "memory"); }
    }
    __device__ __forceinline__ void wait(Pre& pre) const { asm volatile("s_waitcnt vmcnt(16)" : "+v"(pre.g[0]), "+v"(pre.g[1]), "+v"(pre.l[0]), "+v"(pre.l[1]) :: "memory"); }
    __device__ __forceinline__ void operator()(const f32x4 (&acc)[2][2][4][2], const pg8::GU& u, int wr, int wc, const Pre& pre) const {
        using f32x2 = __attribute__((ext_vector_type(2))) float;
        const int lane_ = lane_now(), fr = lane_ & 15, fq = lane_ >> 4;
        const int c0 = u.pn * 128 + wc * 32 + 8 * fq;
        constexpr float ws_ = 1.0f / W8_SCALE, wl_ = ACT8_SCALE / W8_SCALE, cexp = -SW_ALPHA * LOG2E, llo = ACT8_SCALE * (1.0f - SW_LIMIT), lhi = ACT8_SCALE * (1.0f + SW_LIMIT);
        f32x2 bg[2][2], bl[2][2];
#pragma unroll
        for (int bj = 0; bj < 2; ++bj) { const f32x4 g4 = pre.g[bj], l4 = pre.l[bj];
            bg[bj][0] = (f32x2){g4[0], g4[1]}; bg[bj][1] = (f32x2){g4[2], g4[3]};
            bl[bj][0] = (f32x2){l4[0], l4[1]} * ACT8_SCALE + ACT8_SCALE; bl[bj][1] = (f32x2){l4[2], l4[3]} * ACT8_SCALE + ACT8_SCALE; }
        const int odd = fq & 1;
#pragma unroll
        for (int ai = 0; ai < 2; ++ai)
#pragma unroll
            for (int m2 = 0; m2 < 4; m2 += 2) { unsigned w[2][2];
#pragma unroll
                for (int q = 0; q < 2; ++q) { const int m = m2 + q;
#pragma unroll
                    for (int bj = 0; bj < 2; ++bj) { const f32x4 G = acc[ai][bj][m][0], L = acc[ai][bj][m][1]; f32x2 o2[2];
#pragma unroll
                        for (int hh = 0; hh < 2; ++hh) {
                            f32x2 g = (f32x2){G[2 * hh], G[2 * hh + 1]} * ws_ + bg[bj][hh];
                            g.x = fminf(g.x, SW_LIMIT); g.y = fminf(g.y, SW_LIMIT);
                            const f32x2 ea = g * cexp; f32x2 e; e.x = __builtin_amdgcn_exp2f(ea.x); e.y = __builtin_amdgcn_exp2f(ea.y);
                            e = e + 1.0f; f32x2 r; r.x = __builtin_amdgcn_rcpf(e.x); r.y = __builtin_amdgcn_rcpf(e.y);
                            f32x2 l = (f32x2){L[2 * hh], L[2 * hh + 1]} * wl_ + bl[bj][hh];
                            l.x = fminf(fmaxf(l.x, llo), lhi); l.y = fminf(fmaxf(l.y, llo), lhi);
                            o2[hh] = (l * g) * r; }
                        w[q][bj] = pk4_fp8(o2[0].x, o2[0].y, o2[1].x, o2[1].y); } }
                const auto rx = __builtin_amdgcn_permlane16_swap(w[0][0], w[1][0], false, false); const auto ry = __builtin_amdgcn_permlane16_swap(w[0][1], w[1][1], false, false);
                u32x4 o; o.x = rx[0]; o.y = ry[0]; o.z = rx[1]; o.w = ry[1];
                const int r = ai * 128 + wr * 64 + (m2 + odd) * 16 + fr;
                if (r < u.cnt) wt16(ACT, (unsigned)((u.pm * 256 + r) * DFF + c0 - 8 * odd), o); }
    }
};
struct DnEpi {
    static constexpr bool HAS_MID = false, HAS_PRE = false; struct Pre {};
    const float* b_dn; const int* LIST; const float* TOPW; bf16* YS;
    __device__ __forceinline__ void operator()(const f32x4 (&acc)[2][2][4][2], const pg8::GU& u, int wr, int wc) const {
        const int lane_ = lane_now(), fr = lane_ & 15, fq = lane_ >> 4;
        const int c0 = u.pn * 256 + wc * 32 + 8 * fq;
        f32x4 bb[2][2];
#pragma unroll
        for (int bj = 0; bj < 2; ++bj)
#pragma unroll
            for (int n = 0; n < 2; ++n) bb[bj][n] = *(const f32x4*)(b_dn + u.e * 1024 + c0 + bj * 128 + n * 4);
        u32x2 ent[2][4];
#pragma unroll
        for (int ai = 0; ai < 2; ++ai)
#pragma unroll
            for (int m = 0; m < 4; ++m) { const int r = ai * 128 + wr * 64 + m * 16 + fr; ent[ai][m] = *(const u32x2*)(LIST + 2 * (size_t)(u.rows + (r < u.cnt ? r : 0))); }
        const int odd = fq & 1;
#pragma unroll
        for (int ai = 0; ai < 2; ++ai)
#pragma unroll
            for (int m2 = 0; m2 < 4; m2 += 2) { unsigned o[2][2][2];
#pragma unroll
                for (int q = 0; q < 2; ++q) { const unsigned wbits = ent[ai][m2 + q].y; const float w = __builtin_bit_cast(float, wbits);
                    constexpr float ds_ = 1.0f / (W8_SCALE * ACT8_SCALE); const float w8 = w * YS8_SCALE;
#pragma unroll
                    for (int bj = 0; bj < 2; ++bj) { const f32x4 v0 = (acc[ai][bj][m2 + q][0] * ds_ + bb[bj][0]) * w8, v1 = (acc[ai][bj][m2 + q][1] * ds_ + bb[bj][1]) * w8;
                        o[q][bj][0] = pk4_fp8(v0[0], v0[1], v0[2], v0[3]); o[q][bj][1] = pk4_fp8(v1[0], v1[1], v1[2], v1[3]); } }
                const unsigned a = odd ? ent[ai][m2 + 1].x : ent[ai][m2].x;
                const int r = ai * 128 + wr * 64 + (m2 + odd) * 16 + fr;
#pragma unroll
                for (int bj = 0; bj < 2; ++bj) {
                    const auto rx = __builtin_amdgcn_permlane16_swap(o[0][bj][0], o[1][bj][0], false, false); const auto ry = __builtin_amdgcn_permlane16_swap(o[0][bj][1], o[1][bj][1], false, false);
                    u32x4 ov; ov.x = rx[0]; ov.y = ry[0]; ov.z = rx[1]; ov.w = ry[1];
                    if (r < u.cnt) *(u32x4*)((char*)YS + (a * (unsigned)DM + (unsigned)(c0 + bj * 128 - 8 * odd))) = ov; } }
    }
};

__global__ void __launch_bounds__(NWAVES * 64, 2) mk_fwd(MKArgs args) {
    extern __shared__ __attribute__((aligned(16))) unsigned char lds[];
    Frame F;
    F.lds = (LAS unsigned char*)lds; F.MISC = (volatile LAS unsigned*)(F.lds + MISC_OFF);
    F.wave = __builtin_amdgcn_readfirstlane(threadIdx.x >> 6);

    F.G = gridDim.x; { const int bx = blockIdx.x; F.vcu = (F.G % 8 == 0) ? (bx % 8) * (F.G / 8) + bx / 8 : bx; }
    unsigned char* ws = args.ws;
    F.ctl = (unsigned*)(ws + WS_CTL);
    const float* x = args.in[0]; const float* c = args.in[1]; const float* ctx = args.in[2]; const float* cctx = args.in[3];
    const float* w_mod = args.in[4]; const float* b_mod = args.in[5]; const float* g_pre_mix = args.in[6];
    const float* g_qn = args.in[12]; const float* g_kn = args.in[13];
    float* MOD = (float*)(ws + WS_MOD);
    bf16 *WTIN = (bf16*)(ws + WS_WTIN), *H = (bf16*)(ws + WS_H);
    for (int u = FTID; u < (LDS_BYTES - MISC_OFF) / 4; u += NWAVES * 64) ((LAS unsigned*)(F.lds + MISC_OFF))[u] = 0u;
    { LAS float* rt = (LAS float*)(F.lds + ROPE_OFF);
      for (int i = FTID; i < 64 * 16; i += NWAVES * 64) { const int pos = i >> 4, j = i & 15; const float f = powf(10000.0f, -(float)j / 16.0f); const float a = (float)pos * f; rt[2 * i] = cosf(a); rt[2 * i + 1] = sinf(a); } }
    __syncthreads();
    unsigned long long _pbstart = 0; if (PROBE_SEL >= 20) _pbstart = __builtin_amdgcn_s_memrealtime();
    const bool use_bar = (args.ph_hi - args.ph_lo) > 1;
    XcdBarrier bar; bar.bar = F.ctl + CW_BAR + args.li * XCD_BAR_WORDS; bar.x = 0; bar.st = nullptr;
    if (use_bar) bar = xcd_barrier_post(F.ctl + CW_BAR + args.li * XCD_BAR_WORDS, F.MISC + 8);
    const int lo = args.ph_lo, hi = args.ph_hi;
#define IN(k) (lo <= (k) && (k) < hi)
#define BOTH(k) (IN(k) && IN((k) + 1))
#define GRID_BAR() xcd_barrier(bar, F.wave)
    const bool handoff = (F.G == 256);

    const bool merge01 = handoff && IN(0) && IN(1);
    if (IN(0)) {
        if (F.vcu < 192) {
            LAS float* sil = (LAS float*)(F.lds + RING_OFF);
            LAS float* red = (LAS float*)(F.lds + RING_OFF + 20480);
            const int tid = FTID, n0 = F.vcu * 32;
            for (int i = tid; i < 5 * 1024; i += 512) { const int r = i >> 10, k = i & 1023; const float v = r < 4 ? c[r * 1024 + k] : cctx[k]; sil[i] = v / (1.0f + __expf(-v)); }
            __syncthreads();
            const int cg = tid & 7, kr = tid >> 3;
            float acc[5][4];
#pragma unroll
            for (int r = 0; r < 5; ++r)
#pragma unroll
                for (int j = 0; j < 4; ++j) acc[r][j] = 0.f;
#pragma unroll 8
            for (int k = kr; k < 1024; k += 64) {
                const f32x4 w = __builtin_nontemporal_load((const f32x4*)(w_mod + (size_t)k * 6144 + n0 + 4 * cg));
#pragma unroll
                for (int r = 0; r < 5; ++r) { const float s = sil[r * 1024 + k]; acc[r][0] += s * w[0]; acc[r][1] += s * w[1]; acc[r][2] += s * w[2]; acc[r][3] += s * w[3]; }
            }
#pragma unroll
            for (int r = 0; r < 5; ++r)
#pragma unroll
                for (int j = 0; j < 4; ++j) red[(kr * 5 + r) * 32 + 4 * cg + j] = acc[r][j];
            __syncthreads();
            if (tid < 160) { const int r = tid >> 5, n = tid & 31; float sm = 0.f; for (int i = 0; i < 64; ++i) sm += red[(i * 5 + r) * 32 + n];
                __hip_atomic_store((unsigned*)(MOD + r * 6144 + n0 + n), __builtin_bit_cast(unsigned, sm + b_mod[n0 + n]), __ATOMIC_RELAXED, __HIP_MEMORY_SCOPE_AGENT); }
            asm volatile("s_waitcnt vmcnt(0)" ::: "memory");
            __syncthreads();
            if (merge01 && F.wave == 0 && lane_now() < 8) (void)__hip_atomic_fetch_add(F.ctl + CW_CNTM + 64 * lane_now(), 1u, __ATOMIC_RELAXED, __HIP_MEMORY_SCOPE_AGENT);
            PROBE_MARK(37);
        }
        {
            WPtrs P{args.in[10], args.in[14], args.in[15], args.in[16], args.in[19], args.in[21], WTIN, (bf16*)(ws + WS_WTOAB), (bf16*)(ws + WS_WTO), (bf16*)(ws + WS_WTGU), (bf16*)(ws + WS_WTDN)};
            float* scr = (float*)(lds + RING_OFF + 61440 + F.wave * 8448);
            const int n0items = ((F.G == 256) ? NITEMS_W - CV_TAIL2 - CV_TAIL7 - GQ_SIDE_DN : NITEMS_W) - P3_SIDE_N;
            if (F.G == 256) {
                const int m1 = n0items - CV_BAL0;
                for (int it = F.vcu * NWAVES + F.wave; it < m1; it += 256 * NWAVES) convert_item(P, CV_ITEM(it), scr, FLANE);
                if (F.vcu >= 192) for (int it = m1 + (F.vcu - 192) * NWAVES + F.wave; it < n0items; it += 64 * NWAVES) convert_item(P, CV_ITEM(it), scr, FLANE);
            } else
            for (int it = F.vcu * NWAVES + F.wave; it < n0items; it += F.G * NWAVES) convert_item(P, CV_ITEM(it), scr, FLANE);
        }
        if (merge01) {
            __syncthreads();
            panel_wait(F.ctl + CW_CNTM + 64 * (F.vcu & 7), 192u, F.ctl + CW_TMO, F.wave);
            PROBE_MARK(38);
            { const int rb = F.vcu * NWAVES + F.wave;
              if (PROJ_FP8) { hnorm_rows4(rb, 2048, x, g_pre_mix, MOD, H, FLANE); hnorm_rows4(rb + 4 * 2048, 2048, x, g_pre_mix, MOD, H, FLANE);
                  for (int row = rb + 8 * 2048; row < TR; row += 2048) hnorm_row(row, x, ctx, g_pre_mix, MOD, H, FLANE); }
              else for (int row = rb; row < TR; row += F.G * NWAVES) hnorm_row(row, x, ctx, g_pre_mix, MOD, H, FLANE); }
        }
        if (BOTH(0)) GRID_BAR();
        PROBE_MARK(21);
    }
    if (IN(1) && !merge01) {
        for (int row = F.vcu * NWAVES + F.wave; row < TR; row += F.G * NWAVES) hnorm_row(row, x, ctx, g_pre_mix, MOD, H, FLANE);
        if (BOTH(1)) GRID_BAR();
        PROBE_MARK(22);
    }
    if (IN(2)) {
        ProjSched S{(const char*)H, (const char*)WTIN, nullptr, F.vcu, F.G};
        ProjEpi E{(bf16*)(ws + WS_QA), (bf16*)(ws + WS_KA), (bf16*)(ws + WS_VA), (bf16*)(ws + WS_QB), (bf16*)(ws + WS_KB), (bf16*)(ws + WS_VB), (bf16*)(ws + WS_GA), (bf16*)(ws + WS_GB), g_qn, g_kn, (const LAS float*)(F.lds + ROPE_OFF)};
        pg8::gemm_phase<ProjEpi, ProjSched, false, 1, PROJ_FP8 != 0>(F.lds + RING_OFF, S, E, F.wave);
        if (F.G == 256 && F.vcu >= (64 * 17 + 4 * 5) % 256) {
            constexpr int R2 = (64 * 17 + 4 * 5) % 256;
            WPtrs P{args.in[10], args.in[14], args.in[15], args.in[16], args.in[19], args.in[21], WTIN, (bf16*)(ws + WS_WTOAB), (bf16*)(ws + WS_WTO), (bf16*)(ws + WS_WTGU), (bf16*)(ws + WS_WTDN)};
            float* scr = (float*)(lds + RING_OFF + 61440 + F.wave * 8448);
            constexpr int A0 = NITEMS_W - CV_TAIL2 - CV_TAIL7;
            for (int it = A0 + (F.vcu - R2) * NWAVES + F.wave; it < A0 + CV_TAIL2; it += (256 - R2) * NWAVES) convert_item(P, it, scr, FLANE);
        }
        if (BOTH(2)) GRID_BAR();
        PROBE_MARK(23);
    }
    if (IN(3)) {
        { LAS float* rp = (LAS float*)(F.lds + NAX_OFF); const float* rpb = args.in[11];
          for (int i = FTID; i < 8 * 480; i += NWAVES * 64) { const int h = i / 480, rem = i % 480, ro = rem >> 5, co = rem & 31; rp[i] = co < 31 ? rpb[(h * 15 + ro) * 31 + co] * LOG2E : 0.f; } }
        __syncthreads();
        const bf16 *QAp = (const bf16*)(ws + WS_QA), *KAp = (const bf16*)(ws + WS_KA), *VAp = (const bf16*)(ws + WS_VA), *QBp = (const bf16*)(ws + WS_QB), *KBp = (const bf16*)(ws + WS_KB), *VBp = (const bf16*)(ws + WS_VB);
        bf16* Op = (bf16*)(ws + WS_O);
        bool gqa_fast;
        { const int l_ = lane_now(); const float gq_ = wave_max(fabsf(g_qn[l_])), gk_ = wave_max(fabsf(g_kn[l_]));
          const float bound_ = 64.0f * QSCALE * 1.02f * gq_ * gk_;
          gqa_fast = __builtin_amdgcn_readfirstlane((int)(bound_ < 30.0f)) != 0; }
        PROBE_BEGIN(4)
        for (int id = F.vcu; id < 512; id += F.G) {
            const int v = id & 255, i2 = id >> 8, bk = v >> 5, local = (v & 31) + 32 * i2;
            if (gqa_fast) attn_body::gqa_unit<8, true>(bk >> 1, (bk & 1) * 4 + (local >> 4), local & 15, QBp, KBp, VBp, Op, (char*)lds + RING_OFF, F.wave, handoff ? F.ctl + CW_CNTO : nullptr,
                                    args.in[19], (unsigned char*)(ws + WS_WTGU), NA_SIDE_N + (id * NWAVES + F.wave) * attn_body::GQ_NJ,
                                    args.in[21], (unsigned char*)(ws + WS_WTDN), (id * NWAVES + F.wave) * attn_body::GQ_ND);
            else attn_body::gqa_unit<8, false>(bk >> 1, (bk & 1) * 4 + (local >> 4), local & 15, QBp, KBp, VBp, Op, (char*)lds + RING_OFF, F.wave, handoff ? F.ctl + CW_CNTO : nullptr,
                                    args.in[19], (unsigned char*)(ws + WS_WTGU), NA_SIDE_N + (id * NWAVES + F.wave) * attn_body::GQ_NJ,
                                    args.in[21], (unsigned char*)(ws + WS_WTDN), (id * NWAVES + F.wave) * attn_body::GQ_ND);
        }
        if (F.wave == 0) PROBE_END(4, F.lds + MISC_OFF);
        PROBE_MARK(24);
        PROBE_BEGIN(5)
        for (int id = F.vcu; id < 256; id += F.G)
            attn_body::na_unit(id >> 6, id & 63, QAp, KAp, VAp, Op, (char*)lds + RING_OFF, (const float*)(lds + NAX_OFF), (float*)(lds + NAX_OFF + 15360), F.wave, args.in[19], (unsigned char*)(ws + WS_WTGU), (id * NWAVES + F.wave) * attn_body::NA_NSIDE, handoff ? F.ctl + CW_CNTO : nullptr);
        if (F.wave == 0) PROBE_END(5, F.lds + MISC_OFF);
        PROBE_MARK(25);
        if (BOTH(3) && !handoff) GRID_BAR();
    }
    if (IN(4)) {
        Dense4Sched S{(const char*)(ws + WS_O), (const char*)(ws + WS_WTOAB), nullptr, F.vcu, F.G};
        UEpi E{(const bf16*)(ws + WS_GA), (const bf16*)(ws + WS_GB), (bf16*)(ws + WS_U)};
        if (handoff) panel_wait(F.ctl + CW_CNTO + 64 * (F.vcu >> 2), 96u, F.ctl + CW_TMO, F.wave);
        PROBE_MARK(30);
        pg8::gemm_phase<UEpi, Dense4Sched, false, 3>(F.lds + RING_OFF, S, E, F.wave);
        if (handoff) panel_signal(F.ctl + CW_CNTU + 64 * (F.vcu >> 2));
        PROBE_MARK(31);
        if (BOTH(4) && !handoff) GRID_BAR();
    }
    if (IN(5)) {
        Dense4Sched S{(const char*)(ws + WS_U), (const char*)(ws + WS_WTO), nullptr, F.vcu, F.G};
        YEpi E{(bf16*)(ws + WS_Y)};
        if (handoff) panel_wait(F.ctl + CW_CNTU + 64 * (F.vcu >> 2), 32u, F.ctl + CW_TMO, F.wave);
        PROBE_MARK(32);
        pg8::gemm_phase<YEpi, Dense4Sched, false, 3>(F.lds + RING_OFF, S, E, F.wave);
        if (handoff) panel_signal(F.ctl + CW_CNTY + 64 * (F.vcu >> 2));
        PROBE_MARK(26);
        if (BOTH(5) && !handoff) GRID_BAR();
    }
    if (IN(6)) {
        for (int blk = F.vcu; blk < T / 64; blk += F.G) {
            if (handoff) panel_wait(F.ctl + CW_CNTY + 64 * (blk >> 2), 32u, F.ctl + CW_TMO, F.wave);
            PROBE_MARK(34);
            rowpass_block(blk, x, (const bf16*)(ws + WS_Y), MOD, args.in[7], args.in[8], args.in[17], args.in[18], (bf16*)(ws + WS_H2), (float*)(ws + WS_RSTD1), (int*)(ws + WS_TOPE), (float*)(ws + WS_TOPW),
                          F.ctl + CW_ECNT, (int*)(ws + WS_LIST), lds + RING_OFF, lds + MISC_OFF + 256, F.wave, (bf16*)(ws + WS_X1B)); }
        PROBE_MARK(35);
        if (BOTH(6)) GRID_BAR();
        PROBE_MARK(27);
    }
    if (IN(7)) {
        moe_table(F, F.ctl + CW_ECNT);
        const bool h78 = handoff && IN(8);
        MoeSched<8, true> S{(const char*)(ws + WS_H2), (const char*)(ws + WS_WTGU), (const int*)(ws + WS_LIST), F.MISC, F.vcu, F.G, h78 ? F.ctl + CW_CNTA : nullptr, F.ctl + CW_TMO};
        GuEpi E{args.in[20], (bf16*)(ws + WS_ACT)};
        PROBE_BEGIN(3)
        pg8::gemm_phase<GuEpi, MoeSched<8, true>, true, 2, MOE_FP8 != 0>(F.lds + RING_OFF, S, E, F.wave);
        if (F.G == 256 && CV_TAIL7 > 0) {
            int r7 = ((int)__builtin_amdgcn_readfirstlane(F.MISC[MW_TSTART + 32]) * 8) & 255;
            if (256 - r7 < 64) r7 = 0;
            if (F.vcu >= r7) {
                WPtrs P{args.in[10], args.in[14], args.in[15], args.in[16], args.in[19], args.in[21], WTIN, (bf16*)(ws + WS_WTOAB), (bf16*)(ws + WS_WTO), (bf16*)(ws + WS_WTGU), (bf16*)(ws + WS_WTDN)};
                float* scr = (float*)(lds + RING_OFF + 61440 + F.wave * 8448);
                for (int it = NITEMS_W - CV_TAIL7 + (F.vcu - r7) * NWAVES + F.wave; it < NITEMS_W; it += (256 - r7) * NWAVES) convert_item(P, it, scr, FLANE);
            }
        }
        if (F.wave == 0) PROBE_END(3, F.lds + MISC_OFF);
        PROBE_MARK(28);
        if (BOTH(7) && !handoff) GRID_BAR();
    }
    if (IN(8)) {
        moe_table(F, F.ctl + CW_ECNT);
        const bool h78 = handoff && IN(7);
        int v8 = F.vcu;
        if (h78) v8 = (F.vcu - (((int)__builtin_amdgcn_readfirstlane(F.MISC[MW_TSTART + 32]) * 8) & 255)) & 255;
        MoeSched<4, false> S{(const char*)(ws + WS_ACT), (const char*)(ws + WS_WTDN), (const int*)(ws + WS_LIST), F.MISC, v8, F.G, h78 ? F.ctl + CW_CNTA : nullptr, F.ctl + CW_TMO};
        if (h78) {
            if (F.wave == 0) {
                int t4[4]; pg8::GU u0;
#pragma unroll
                for (int i = 0; i < 4; ++i) t4[i] = S.next(i, u0) ? u0.pm : -1;
                const int l = lane_now(); const int mine = l == 0 ? t4[0] : l == 1 ? t4[1] : l == 2 ? t4[2] : l == 3 ? t4[3] : -1;
                bool ok = mine < 0; unsigned sp = 0u;
                for (;;) {
                    if (!ok) ok = __hip_atomic_load(S.cntA + 64 * mine, __ATOMIC_RELAXED, __HIP_MEMORY_SCOPE_AGENT) >= 64u;
                    if (__builtin_amdgcn_ballot_w64(!ok) == 0ull) break;
                    __builtin_amdgcn_s_sleep(2);
                    if (++sp > (1u << 20)) { if (l == 0) __hip_atomic_store(F.ctl + CW_TMO, 0xC0DEu, __ATOMIC_RELAXED, __HIP_MEMORY_SCOPE_AGENT); break; }
                }
                __builtin_amdgcn_fence(__ATOMIC_ACQUIRE, "agent"); asm volatile("s_waitcnt vmcnt(0)" ::: "memory");
            }
            __syncthreads();
        }
        DnEpi E{args.in[22], (const int*)(ws + WS_LIST), (const float*)(ws + WS_TOPW), (bf16*)(ws + WS_YS)};
        PROBE_BEGIN(13)
        pg8::gemm_phase<DnEpi, MoeSched<4, false>, false, 3, MOE_FP8 != 0>(F.lds + RING_OFF, S, E, F.wave);
        if (F.wave == 0) PROBE_END(13, F.lds + MISC_OFF);
        if (BOTH(8)) GRID_BAR();
        PROBE_MARK(29);
    }
    if (IN(9)) {
        if (F.G == 256) {
            for (int t = F.vcu * NWAVES + F.wave; t < T; t += 2 * F.G * NWAVES)
                final_rows2(t, t + F.G * NWAVES, (const bf16*)(ws + WS_X1B), (const bf16*)(ws + WS_YS), MOD, args.in[9], args.out, FLANE);
        } else
        for (int t = F.vcu * NWAVES + F.wave; t < T; t += F.G * NWAVES)
            final_row(t, x, (const bf16*)(ws + WS_Y), (const float*)(ws + WS_RSTD1), (const bf16*)(ws + WS_YS), MOD, args.in[7], args.in[9], args.out, FLANE);
    }
    if (PROBE_SEL != 0 && blockIdx.x == 0 && F.wave == 0) {
        const unsigned long long t0 = __builtin_amdgcn_s_memrealtime(); const unsigned long long want = 8ull * (unsigned long long)F.MISC[MW_PROBE];
        while (__builtin_amdgcn_s_memrealtime() - t0 < want) __builtin_amdgcn_s_sleep(8);
    }
#undef IN
#undef BOTH
#undef GRID_BAR
}

#ifndef MK_SPLIT
#define MK_SPLIT 0
#endif
extern "C" void kernel_launch(void* const* d_in, const int* in_sizes, int n_in, void* d_out, int out_size, void* d_ws, size_t ws_size, hipStream_t stream) {
    static int grid = 0;
    if (grid == 0) {
        grid = -1;
        if (n_in != 23 || in_sizes[0] != T * DM || out_size != T * DM || ws_size < WS_END) { fprintf(stderr, "kernel_launch: unexpected shapes/workspace (n_in %d, ws %zu)\n", n_in, ws_size); return; }
        if (hipFuncSetAttribute((const void*)mk_fwd, hipFuncAttributeMaxDynamicSharedMemorySize, LDS_BYTES) != hipSuccess) { fprintf(stderr, "kernel_launch: hipFuncSetAttribute(mk_fwd) failed\n"); return; }
        int dev = 0, cus = 0, per_cu = 0;
        if (hipGetDevice(&dev) != hipSuccess || hipDeviceGetAttribute(&cus, hipDeviceAttributeMultiprocessorCount, dev) != hipSuccess) return;
        if (hipOccupancyMaxActiveBlocksPerMultiprocessor(&per_cu, (const void*)mk_fwd, NWAVES * 64, LDS_BYTES) != hipSuccess || per_cu < 1) { fprintf(stderr, "kernel_launch: occupancy query says %d blocks per CU\n", per_cu); (void)hipGetLastError(); return; }
        grid = cus;
    }
    if (grid < 0) return;
    const float* x = (const float*)d_in[0];
    const float* g_post_mix = (const float*)d_in[7]; const float* g_pre_ffn = (const float*)d_in[8]; const float* g_post_ffn = (const float*)d_in[9];
    const float* rpb = (const float*)d_in[11];
    const float* w_router = (const float*)d_in[17]; const float* b_router = (const float*)d_in[18];
    const float* b_gu = (const float*)d_in[20]; const float* b_dn = (const float*)d_in[22];
    unsigned char* ws = (unsigned char*)d_ws;
    float* MOD = (float*)(ws + WS_MOD); float* RSTD1 = (float*)(ws + WS_RSTD1); int* TOPE = (int*)(ws + WS_TOPE); float* TOPW = (float*)(ws + WS_TOPW);
    int* LIST = (int*)(ws + WS_LIST); unsigned* ECNT = (unsigned*)(ws + WS_CTL) + CW_ECNT;
    bf16 *WTOAB = (bf16*)(ws + WS_WTOAB), *WTO = (bf16*)(ws + WS_WTO), *WTGU = (bf16*)(ws + WS_WTGU), *WTDN = (bf16*)(ws + WS_WTDN);
    bf16 *QA = (bf16*)(ws + WS_QA), *KA = (bf16*)(ws + WS_KA), *VA = (bf16*)(ws + WS_VA), *QB = (bf16*)(ws + WS_QB), *KB = (bf16*)(ws + WS_KB), *VB = (bf16*)(ws + WS_VB);
    bf16 *GA = (bf16*)(ws + WS_GA), *GB = (bf16*)(ws + WS_GB), *O = (bf16*)(ws + WS_O), *U = (bf16*)(ws + WS_U), *Y = (bf16*)(ws + WS_Y), *H2 = (bf16*)(ws + WS_H2), *ACT = (bf16*)(ws + WS_ACT), *YS = (bf16*)(ws + WS_YS);
    float *PA = (float*)(ws + WS_PA), *PB = (float*)(ws + WS_PB);

    (void)hipMemsetAsync(ws + WS_CTL, 0, CTL_ZERO_BYTES, stream);
    MKArgs a{};
    for (int i = 0; i < 23; ++i) a.in[i] = (const float*)d_in[i];
    a.out = (float*)d_out; a.ws = ws;
    auto run = [&](int lo, int hi, int li) {
        if (MK_SPLIT) { for (int p = lo; p < hi; ++p) { a.ph_lo = p; a.ph_hi = p + 1; a.li = p; hipLaunchKernelGGL(mk_fwd, dim3(grid), dim3(NWAVES * 64), LDS_BYTES, stream, a); } }
        else { a.ph_lo = lo; a.ph_hi = hi; a.li = li; hipLaunchKernelGGL(mk_fwd, dim3(grid), dim3(NWAVES * 64), LDS_BYTES, stream, a); } };
    run(0, 10, 0);
}
```

```cpp
#include <hip/hip_runtime.h>
#include <cstdint>
#include <cstdio>

#define DEV __device__ __forceinline__
typedef unsigned short bf16;
typedef short bf16x8 __attribute__((ext_vector_type(8)));
typedef float f32x4 __attribute__((ext_vector_type(4)));
typedef unsigned u32x4 __attribute__((ext_vector_type(4)));
typedef unsigned u32x2 __attribute__((ext_vector_type(2)));

constexpr int DM = 1024, NBATCH = 4, SEQ = 4096, T = NBATCH * SEQ, CTXL = 256, TC = NBATCH * CTXL, TR = T + TC;
constexpr int GRIDW = 64, HD = 64;
constexpr int INC = 4352, KVC = 1280;
constexpr int C_KA = 0, C_VA = 512, C_KB = 1024, C_VB = 1152, C_QA = 1280, C_QB = 1792, C_GA = 2304, C_GB = 3328;
constexpr int NE = 32, TOPK = 4, DFF = 1024;
constexpr int NASG = T * TOPK;
constexpr int ECAP = T;
constexpr int ACT_ROWS = NASG + NE * 256;
constexpr float EPS = 1e-6f, LOG2E = 1.4426950408889634f, QSCALE = 0.125f * LOG2E;
constexpr float SW_LIMIT = 7.0f, SW_ALPHA = 1.702f;

constexpr size_t MiB = 1u << 20;
constexpr size_t WS_CTL = 0, CTL_ZERO_BYTES = 1 * MiB;
constexpr size_t WS_MOD = 1 * MiB;
constexpr size_t WS_ROPE = 1 * MiB + 128 * 1024;
constexpr size_t WS_RSTD1 = 1 * MiB + 256 * 1024;
constexpr size_t WS_TOPE = 1 * MiB + 512 * 1024;
constexpr size_t WS_TOPW = 1 * MiB + 768 * 1024;
constexpr size_t WS_LIST = 2 * MiB;
constexpr size_t WS_WRS = 6 * MiB;
constexpr size_t WS_WTIN = 783 * MiB;
constexpr size_t WS_WTOAB = 13 * MiB;
constexpr size_t WS_WTO = 15 * MiB;
constexpr size_t WS_WTGU = 17 * MiB;
constexpr size_t WS_WTDN = 145 * MiB;
constexpr size_t WS_H = 209 * MiB;
constexpr size_t WS_QA = 243 * MiB;
constexpr size_t WS_KA = 259 * MiB;
constexpr size_t WS_VA = 276 * MiB;
constexpr size_t WS_QB = 293 * MiB;
constexpr size_t WS_KB = 309 * MiB;
constexpr size_t WS_VB = 314 * MiB;
constexpr size_t WS_GA = 319 * MiB;
constexpr size_t WS_GB = 351 * MiB;
constexpr size_t WS_O = 383 * MiB;
constexpr size_t WS_U = 415 * MiB;
constexpr size_t WS_Y = 447 * MiB;
constexpr size_t WS_H2 = 479 * MiB;
constexpr size_t WS_ACT = 511 * MiB;
constexpr size_t WS_YS = 655 * MiB;
constexpr size_t WS_END = 792 * MiB;
constexpr size_t WS_X1B = WS_QA;
constexpr size_t WS_CF32 = 479 * MiB;
constexpr size_t WS_PA = 511 * MiB, WS_PB = 575 * MiB;
static_assert(WS_CF32 + (size_t)TR * INC * 4 <= WS_END, "cf32 overlay");
constexpr int CW_ECNT = 2048;

#ifndef MOE_FP8
#define MOE_FP8 1
#endif
#ifndef PROJ_FP8
#define PROJ_FP8 1
#endif
constexpr int PROJ_PITCH = PROJ_FP8 ? 1024 : 2048;
#ifndef Y_FP8
#define Y_FP8 1
#endif
constexpr float U8_SCALE = 16.0f;
constexpr float W8_SCALE = 32.0f, ACT8_SCALE = 4.0f, YS8_SCALE = 16.0f;
constexpr int MOE_PITCH = MOE_FP8 ? 1024 : 2048;
DEV unsigned f2bf(float f) { unsigned u = __builtin_bit_cast(unsigned, f); return (u + 0x7fffu + ((u >> 16) & 1u)) >> 16; }
typedef float f32x2_t __attribute__((ext_vector_type(2))); typedef __bf16 bf16x2_t __attribute__((ext_vector_type(2)));
DEV unsigned pk2(float lo, float hi) { f32x2_t v = {lo, hi}; bf16x2_t b = __builtin_convertvector(v, bf16x2_t); return __builtin_bit_cast(unsigned, b); }
DEV float bflo(unsigned w) { return __builtin_bit_cast(float, w << 16); }
DEV float bfhi(unsigned w) { return __builtin_bit_cast(float, w & 0xffff0000u); }
DEV unsigned pk4_fp8(float a, float b, float c, float d) {
    int w = __builtin_amdgcn_cvt_pk_fp8_f32(a, b, 0, false); w = __builtin_amdgcn_cvt_pk_fp8_f32(c, d, w, true); return (unsigned)w; }
DEV float bf2f(bf16 b) { return __builtin_bit_cast(float, ((unsigned)b) << 16); }
#define DPPF(v, ctrl) __builtin_bit_cast(float, __builtin_amdgcn_update_dpp(0, __builtin_bit_cast(int, (v)), (ctrl), 0xF, 0xF, true))
DEV float wave_sum(float v) {
    v += DPPF(v, 0xB1); v += DPPF(v, 0x4E); v += DPPF(v, 0x141); v += DPPF(v, 0x140);
    { auto r = __builtin_amdgcn_permlane16_swap(__float_as_uint(v), __float_as_uint(v), false, false); v = __uint_as_float(r[0]) + __uint_as_float(r[1]); }
    { auto r = __builtin_amdgcn_permlane32_swap(__float_as_uint(v), __float_as_uint(v), false, false); v = __uint_as_float(r[0]) + __uint_as_float(r[1]); }
    return v;
}
DEV float wave_max(float v) {
    v = fmaxf(v, DPPF(v, 0xB1)); v = fmaxf(v, DPPF(v, 0x4E)); v = fmaxf(v, DPPF(v, 0x141)); v = fmaxf(v, DPPF(v, 0x140));
    { auto r = __builtin_amdgcn_permlane16_swap(__float_as_uint(v), __float_as_uint(v), false, false); v = fmaxf(__uint_as_float(r[0]), __uint_as_float(r[1])); }
    { auto r = __builtin_amdgcn_permlane32_swap(__float_as_uint(v), __float_as_uint(v), false, false); v = fmaxf(__uint_as_float(r[0]), __uint_as_float(r[1])); }
    return v;
}
#ifndef WT_STORES
#define WT_STORES 1
#endif
DEV void wt16(void* base, unsigned off, u32x4 v) { if (WT_STORES) __builtin_amdgcn_raw_buffer_store_b128(v, __builtin_amdgcn_make_buffer_rsrc(base, 0, 0x7fffffff, 0x00020000), (int)off, 0, 16); else *(u32x4*)((char*)base + off) = v; }
DEV void wt8(void* base, unsigned off, u32x2 v) { *(u32x2*)((char*)base + off) = v; }
DEV void wt4(void* base, unsigned off, unsigned v) { *(unsigned*)((char*)base + off) = v; }
DEV int lane_now() { int l; asm volatile("v_mbcnt_lo_u32_b32 %0, -1, 0\n\tv_mbcnt_hi_u32_b32 %0, -1, %0" : "=v"(l)); return l; }
DEV float sigmoidf_(float x) { return 1.0f / (1.0f + __expf(-x)); }


DEV void transpose_item(const float* __restrict__ W, int K, int N, bf16* __restrict__ WT, int ld, int koff, float* scr, int item, int lane) {
    const int nblk = N / 32, kb = item / nblk, nb = item % nblk, k0 = 64 * kb, n0 = 32 * nb;
#pragma unroll 8
    for (int i = 0; i < 32; ++i) { const int kk = 2 * i + (lane >> 5); scr[kk * 33 + (lane & 31)] = __builtin_nontemporal_load(&W[(size_t)(k0 + kk) * N + n0 + (lane & 31)]); }
    __builtin_amdgcn_s_waitcnt(0xC07F); asm volatile("" ::: "memory");
    const int cch = lane & 7;
#pragma unroll
    for (int j = 0; j < 4; ++j) { const int n = (lane >> 3) + 8 * j; const float* s = scr + (8 * cch) * 33 + n;
        u32x4 o; o.x = pk2(s[0 * 33], s[1 * 33]); o.y = pk2(s[2 * 33], s[3 * 33]); o.z = pk2(s[4 * 33], s[5 * 33]); o.w = pk2(s[6 * 33], s[7 * 33]);
        *(u32x4*)(WT + (size_t)(n0 + n) * ld + koff + k0 + 8 * cch) = o; }
    __builtin_amdgcn_s_waitcnt(0xC07F); asm volatile("" ::: "memory");
}
DEV void transpose_item_fp8(const float* __restrict__ W, int K, int N, unsigned char* __restrict__ WT, float scale, float* scr, int item, int lane) {
    const int nblk = N / 32, kb = item / nblk, nb = item % nblk, k0 = 64 * kb, n0 = 32 * nb;
#pragma unroll 8
    for (int i = 0; i < 32; ++i) { const int kk = 2 * i + (lane >> 5); scr[kk * 33 + (lane & 31)] = __builtin_nontemporal_load(&W[(size_t)(k0 + kk) * N + n0 + (lane & 31)]); }
    __builtin_amdgcn_s_waitcnt(0xC07F); asm volatile("" ::: "memory");
    const int cch = lane & 7;
#pragma unroll
    for (int j = 0; j < 4; ++j) { const int n = (lane >> 3) + 8 * j; const float* s = scr + (8 * cch) * 33 + n;
        u32x2 o; o.x = pk4_fp8(s[0 * 33] * scale, s[1 * 33] * scale, s[2 * 33] * scale, s[3 * 33] * scale); o.y = pk4_fp8(s[4 * 33] * scale, s[5 * 33] * scale, s[6 * 33] * scale, s[7 * 33] * scale);
        wt8(WT, (unsigned)((n0 + n) * K + k0 + 8 * cch), o); }
    __builtin_amdgcn_s_waitcnt(0xC07F); asm volatile("" ::: "memory");
}
struct WPtrs { const float *w_in, *w_oa, *w_ob, *w_o, *w_gu, *w_dn; bf16 *t_in, *t_oab, *t_o, *t_gu, *t_dn; };
constexpr int I_IN = 16 * 136, I_OA = 8 * 32, I_O = 16 * 32, I_GU = 16 * 64, I_DN = 16 * 32;
constexpr int NITEMS_W = I_IN + 2 * I_OA + I_O + NE * (I_GU + I_DN);
DEV void convert_item(const WPtrs& P, int it, float* scr, int lane) {
    int r = it;
    if (r < I_IN) { if (PROJ_FP8) transpose_item_fp8(P.w_in, 1024, INC, (unsigned char*)P.t_in, W8_SCALE, scr, r, lane); else transpose_item(P.w_in, 1024, INC, P.t_in, 1024, 0, scr, r, lane); return; } r -= I_IN;
    if (r < I_OA) { transpose_item(P.w_oa, 512, 1024, P.t_oab, 1024, 0, scr, r, lane); return; } r -= I_OA;
    if (r < I_OA) { transpose_item(P.w_ob, 512, 1024, P.t_oab, 1024, 512, scr, r, lane); return; } r -= I_OA;
    if (r < I_O) { if (Y_FP8) transpose_item_fp8(P.w_o, 1024, 1024, (unsigned char*)P.t_o, W8_SCALE, scr, r, lane); else transpose_item(P.w_o, 1024, 1024, P.t_o, 1024, 0, scr, r, lane); return; } r -= I_O;
    if (r < NE * I_GU) { const int e = r / I_GU;
        if (MOE_FP8) transpose_item_fp8(P.w_gu + (size_t)e * 1024 * 2048, 1024, 2048, (unsigned char*)P.t_gu + (size_t)e * 2048 * 1024, W8_SCALE, scr, r % I_GU, lane);
        else transpose_item(P.w_gu + (size_t)e * 1024 * 2048, 1024, 2048, P.t_gu + (size_t)e * 2048 * 1024, 1024, 0, scr, r % I_GU, lane);
        return; } r -= NE * I_GU;
    { const int e = r / I_DN;
        if (MOE_FP8) transpose_item_fp8(P.w_dn + (size_t)e * 1024 * 1024, 1024, 1024, (unsigned char*)P.t_dn + (size_t)e * 1024 * 1024, W8_SCALE, scr, r % I_DN, lane);
        else transpose_item(P.w_dn + (size_t)e * 1024 * 1024, 1024, 1024, P.t_dn + (size_t)e * 1024 * 1024, 1024, 0, scr, r % I_DN, lane); }
}


DEV void hnorm_rows4(int r0, int stride, const float* __restrict__ x, const float* __restrict__ g, const float* __restrict__ mod, bf16* __restrict__ H, int lane) {
    f32x4 v[4][4], sh[2][4], sc[2][4], gg[4];
#pragma unroll
    for (int a = 0; a < 4; ++a)
#pragma unroll
        for (int j = 0; j < 4; ++j) v[a][j] = __builtin_nontemporal_load((const f32x4*)(x + (size_t)(r0 + a * stride) * DM + 4 * lane + 256 * j));
#pragma unroll
    for (int p = 0; p < 2; ++p) { const float* mrow = mod + ((r0 + 2 * p * stride) / SEQ) * 6144;
#pragma unroll
        for (int j = 0; j < 4; ++j) { sh[p][j] = *(const f32x4*)(mrow + 4 * lane + 256 * j); sc[p][j] = *(const f32x4*)(mrow + 1024 + 4 * lane + 256 * j); } }
#pragma unroll
    for (int j = 0; j < 4; ++j) gg[j] = *(const f32x4*)(g + 4 * lane + 256 * j);
    float rstd[4];
#pragma unroll
    for (int a = 0; a < 4; ++a) { float ss = 0.f;
#pragma unroll
        for (int j = 0; j < 4; ++j) ss += v[a][j][0] * v[a][j][0] + v[a][j][1] * v[a][j][1] + v[a][j][2] * v[a][j][2] + v[a][j][3] * v[a][j][3];
        rstd[a] = rsqrtf(wave_sum(ss) * (1.0f / DM) + EPS); }
    unsigned d[4][4];
#pragma unroll
    for (int a = 0; a < 4; ++a)
#pragma unroll
        for (int j = 0; j < 4; ++j) { float o[4];
#pragma unroll
            for (int q = 0; q < 4; ++q) o[q] = v[a][j][q] * rstd[a] * gg[j][q] * (1.0f + sc[a >> 1][j][q]) + sh[a >> 1][j][q];
            d[a][j] = pk4_fp8(o[0], o[1], o[2], o[3]); }
    const bool b0 = (lane & 1) != 0, b1 = (lane & 2) != 0;
#pragma unroll
    for (int a = 0; a < 4; ++a) {
        unsigned pq[4], e[4];
#pragma unroll
        for (int j = 0; j < 4; ++j) pq[j] = (unsigned)__builtin_amdgcn_mov_dpp((int)d[a][j], 0xB1, 0xF, 0xF, true);
        e[0] = b0 ? pq[1] : d[a][0]; e[1] = b0 ? d[a][1] : pq[0]; e[2] = b0 ? pq[3] : d[a][2]; e[3] = b0 ? d[a][3] : pq[2];
#pragma unroll
        for (int j = 0; j < 4; ++j) pq[j] = (unsigned)__builtin_amdgcn_mov_dpp((int)e[j], 0x4E, 0xF, 0xF, true);
        u32x4 w; w.x = b1 ? pq[2] : e[0]; w.y = b1 ? pq[3] : e[1]; w.z = b1 ? e[2] : pq[0]; w.w = b1 ? e[3] : pq[1];
        wt16(H, (unsigned)((r0 + a * stride) * DM + 256 * (lane & 3) + 16 * (lane >> 2)), w);
    }
}
DEV void hnorm_load8(f32x4 (&v)[8][4], int rb, const float* __restrict__ x, int lane) {
#pragma unroll
    for (int a = 0; a < 8; ++a)
#pragma unroll
        for (int j = 0; j < 4; ++j) v[a][j] = __builtin_nontemporal_load((const f32x4*)(x + (size_t)(rb + a * 2048) * DM + 4 * lane + 256 * j));
}
DEV void hnorm_rows8(f32x4 (&v)[8][4], int rb, const float* vec, bf16* __restrict__ H, int lane) {
    const bool b0 = (lane & 1) != 0, b1 = (lane & 2) != 0;
#pragma unroll
    for (int a = 0; a < 8; ++a) {
        float ss = 0.f;
#pragma unroll
        for (int j = 0; j < 4; ++j) ss += v[a][j][0] * v[a][j][0] + v[a][j][1] * v[a][j][1] + v[a][j][2] * v[a][j][2] + v[a][j][3] * v[a][j][3];
        const float rstd = rsqrtf(wave_sum(ss) * (1.0f / DM) + EPS);
        unsigned d[4];
#pragma unroll
        for (int j = 0; j < 4; ++j) { const int cidx = 4 * lane + 256 * j;
            const f32x4 gg = *(const f32x4*)(vec + cidx), sh = *(const f32x4*)(vec + (1 + 2 * (a >> 1)) * 1024 + cidx), sc = *(const f32x4*)(vec + (2 + 2 * (a >> 1)) * 1024 + cidx);
            float o[4];
#pragma unroll
            for (int q = 0; q < 4; ++q) o[q] = v[a][j][q] * rstd * gg[q] * (1.0f + sc[q]) + sh[q];
            d[j] = pk4_fp8(o[0], o[1], o[2], o[3]); }
        unsigned pq[4], e[4];
#pragma unroll
        for (int j = 0; j < 4; ++j) pq[j] = (unsigned)__builtin_amdgcn_mov_dpp((int)d[j], 0xB1, 0xF, 0xF, true);
        e[0] = b0 ? pq[1] : d[0]; e[1] = b0 ? d[1] : pq[0]; e[2] = b0 ? pq[3] : d[2]; e[3] = b0 ? d[3] : pq[2];
#pragma unroll
        for (int j = 0; j < 4; ++j) pq[j] = (unsigned)__builtin_amdgcn_mov_dpp((int)e[j], 0x4E, 0xF, 0xF, true);
        u32x4 w; w.x = b1 ? pq[2] : e[0]; w.y = b1 ? pq[3] : e[1]; w.z = b1 ? e[2] : pq[0]; w.w = b1 ? e[3] : pq[1];
        wt16(H, (unsigned)((rb + a * 2048) * DM + 256 * (lane & 3) + 16 * (lane >> 2)), w);
    }
}
DEV void hnorm_row(int row, const float* __restrict__ x, const float* __restrict__ ctx, const float* __restrict__ g, const float* __restrict__ mod, bf16* __restrict__ H, int lane) {
    const float* src = row < T ? x + (size_t)row * DM : ctx + (size_t)(row - T) * DM;
    const float* mrow = mod + (row < T ? (row / SEQ) : 4) * 6144;
    f32x4 v[4]; float ss = 0.f;
#pragma unroll
    for (int j = 0; j < 4; ++j) { v[j] = __builtin_nontemporal_load((const f32x4*)(src + 4 * lane + 256 * j)); ss += v[j][0] * v[j][0] + v[j][1] * v[j][1] + v[j][2] * v[j][2] + v[j][3] * v[j][3]; }
    const float rstd = rsqrtf(wave_sum(ss) * (1.0f / DM) + EPS);
#pragma unroll
    for (int j = 0; j < 4; ++j) {
        const int cidx = 4 * lane + 256 * j;
        const f32x4 gg = *(const f32x4*)(g + cidx), sh = *(const f32x4*)(mrow + cidx), sc = *(const f32x4*)(mrow + 1024 + cidx);
        float o[4];
#pragma unroll
        for (int q = 0; q < 4; ++q) o[q] = v[j][q] * rstd * gg[q] * (1.0f + sc[q]) + sh[q];
        if (PROJ_FP8) wt4(H, (unsigned)(row * DM + cidx), pk4_fp8(o[0], o[1], o[2], o[3]));
        else { u32x2 w; w.x = pk2(o[0], o[1]); w.y = pk2(o[2], o[3]); *(u32x2*)(H + (size_t)row * DM + cidx) = w; }
    }
}


DEV void route_token(float (&pl)[32], int t, int la0, int lane, const float* __restrict__ b_router, int* __restrict__ TOPE, float* __restrict__ TOPW, unsigned* hist, unsigned* asg_e, unsigned* asg_p, float* asg_w) {
#define RP_STEP(D, H) _Pragma("unroll") for (int i = 0; i < H; ++i) { const bool up = (lane & D) != 0; const float snd = up ? pl[i] : pl[i + H]; const float kp = up ? pl[i + H] : pl[i]; pl[i] = kp + __shfl_xor(snd, D); }
#pragma unroll
    for (int i = 0; i < 16; ++i) { auto r = __builtin_amdgcn_permlane32_swap(__float_as_uint(pl[i]), __float_as_uint(pl[i + 16]), false, false); pl[i] = __uint_as_float(r[0]) + __uint_as_float(r[1]); }
#pragma unroll
    for (int i = 0; i < 8; ++i) { auto r = __builtin_amdgcn_permlane16_swap(__float_as_uint(pl[i]), __float_as_uint(pl[i + 8]), false, false); pl[i] = __uint_as_float(r[0]) + __uint_as_float(r[1]); }
    RP_STEP(8, 4) RP_STEP(4, 2) RP_STEP(2, 1)
#undef RP_STEP
    float logit = pl[0] + __shfl_xor(pl[0], 1);
    logit += b_router[lane >> 1];
    float val = (lane & 1) ? -INFINITY : logit;
    float tl[4]; int te[4];
#pragma unroll
    for (int k = 0; k < 4; ++k) {
        const float mx = wave_max(val);
        const unsigned long long bal = __ballot(val == mx);
        const int wl = __ffsll((long long)bal) - 1;
        tl[k] = mx; te[k] = wl >> 1;
        if (lane == wl) val = -INFINITY;
    }
    const float e1 = __expf(tl[1] - tl[0]), e2 = __expf(tl[2] - tl[0]), e3 = __expf(tl[3] - tl[0]);
    const float inv = 1.0f / (1.0f + e1 + e2 + e3);
    if (lane < 4) {
        const int ek = lane == 0 ? te[0] : lane == 1 ? te[1] : lane == 2 ? te[2] : te[3];
        const float wk = (lane == 0 ? 1.0f : lane == 1 ? e1 : lane == 2 ? e2 : e3) * inv;
        TOPE[t * 4 + lane] = ek; TOPW[t * 4 + lane] = wk;
        const unsigned p = atomicAdd(&hist[ek], 1u);
        asg_e[la0 + lane] = (unsigned)ek; asg_p[la0 + lane] = p; asg_w[la0 + lane] = wk;
    }
}
constexpr int RP_WSTRIDE = 1028;
DEV void rowpass_block(int blk, const float* __restrict__ x, const bf16* __restrict__ Y, const float* __restrict__ mod, const float* __restrict__ g_post_mix, const float* __restrict__ g_pre_ffn,
                       const float* __restrict__ w_router, const float* __restrict__ b_router, bf16* __restrict__ H2, float* __restrict__ RSTD1, int* __restrict__ TOPE, float* __restrict__ TOPW,
                       unsigned* __restrict__ ecnt, int* __restrict__ LIST, unsigned char* lds, unsigned char* lds_small, int wave, bf16* __restrict__ X1B, unsigned char* lds_vec) {
    float* wr = (float*)lds;
    unsigned* hist = (unsigned*)lds_small;
    unsigned* base = hist + 32;
    unsigned* asg_e = base + 32;
    unsigned* asg_p = asg_e + 256;
    float* asg_w = (float*)(asg_p + 256);
    const int lane = lane_now(), tid = wave * 64 + lane;
    for (int i = tid; i < 8 * 1024; i += 512) { const int k = i >> 3, c = i & 7; const f32x4 w = *(const f32x4*)(w_router + k * 32 + 4 * c);
        wr[(4 * c + 0) * RP_WSTRIDE + k] = w[0]; wr[(4 * c + 1) * RP_WSTRIDE + k] = w[1]; wr[(4 * c + 2) * RP_WSTRIDE + k] = w[2]; wr[(4 * c + 3) * RP_WSTRIDE + k] = w[3]; }
    const int t0 = blk * 64, b = t0 / SEQ;
    const float* mrow = mod + b * 6144;
    float* vec = (float*)lds_vec;
    for (int i = tid; i < 5 * 256; i += 512) { const int vsel = i >> 8, c4 = (i & 255) * 4;
        const float* src = vsel == 0 ? mrow + 2048 : vsel == 1 ? g_post_mix : vsel == 2 ? g_pre_ffn : vsel == 3 ? mrow + 3072 : mrow + 4096;
        *(f32x4*)(vec + vsel * 1024 + c4) = *(const f32x4*)(src + c4); }
    if (tid < 32) hist[tid] = 0u;
    __syncthreads();
    f32x4 xn[2][4]; u32x2 yn[2][4];
#pragma unroll
    for (int u = 0; u < 2; ++u)
#pragma unroll
        for (int j = 0; j < 4; ++j) { const int t = t0 + wave * 8 + u; xn[u][j] = __builtin_nontemporal_load((const f32x4*)(x + (size_t)t * DM + 4 * lane + 256 * j)); yn[u][j] = __builtin_nontemporal_load((const u32x2*)(Y + (size_t)t * DM + 4 * lane + 256 * j)); }
#pragma unroll 1
    for (int it = 0; it < 4; ++it) {
        float xv[2][16];
        int lofs = 4 * lane; asm volatile("" : "+v"(lofs));
        f32x4 xc[2][4]; u32x2 yc[2][4];
#pragma unroll
        for (int u = 0; u < 2; ++u)
#pragma unroll
            for (int j = 0; j < 4; ++j) { xc[u][j] = xn[u][j]; yc[u][j] = yn[u][j]; }
        if (it < 3) {
#pragma unroll
            for (int u = 0; u < 2; ++u)
#pragma unroll
                for (int j = 0; j < 4; ++j) { const int t = t0 + wave * 8 + (it + 1) * 2 + u; xn[u][j] = __builtin_nontemporal_load((const f32x4*)(x + (size_t)t * DM + lofs + 256 * j)); yn[u][j] = __builtin_nontemporal_load((const u32x2*)(Y + (size_t)t * DM + lofs + 256 * j)); }
        }
#pragma unroll
        for (int u = 0; u < 2; ++u) {
            const int t = t0 + wave * 8 + it * 2 + u;
            float yv[16]; float ss = 0.f;
#pragma unroll
            for (int j = 0; j < 4; ++j) {
                const u32x2 yw = yc[u][j];
                yv[4 * j] = bflo(yw.x); yv[4 * j + 1] = bfhi(yw.x); yv[4 * j + 2] = bflo(yw.y); yv[4 * j + 3] = bfhi(yw.y);
                const f32x4 xx = xc[u][j];
                xv[u][4 * j] = xx[0]; xv[u][4 * j + 1] = xx[1]; xv[u][4 * j + 2] = xx[2]; xv[u][4 * j + 3] = xx[3];
#pragma unroll
                for (int q = 0; q < 4; ++q) ss += yv[4 * j + q] * yv[4 * j + q];
            }
            const float rstd1 = rsqrtf(wave_sum(ss) * (1.0f / DM) + EPS);
            if (lane == 0) RSTD1[t] = rstd1;
            float ss2 = 0.f;
#pragma unroll
            for (int j = 0; j < 4; ++j) {
                const int cidx = lofs + 256 * j;
                const f32x4 gt = *(const f32x4*)(vec + cidx), gp = *(const f32x4*)(vec + 1024 + cidx);
#pragma unroll
                for (int q = 0; q < 4; ++q) { const float x1 = xv[u][4 * j + q] + gt[q] * (yv[4 * j + q] * rstd1 * gp[q]); xv[u][4 * j + q] = x1; ss2 += x1 * x1; }
                { u32x2 xw; xw.x = pk2(xv[u][4 * j], xv[u][4 * j + 1]); xw.y = pk2(xv[u][4 * j + 2], xv[u][4 * j + 3]); *(u32x2*)(X1B + (size_t)t * DM + cidx) = xw; }
            }
            const float rstd2 = rsqrtf(wave_sum(ss2) * (1.0f / DM) + EPS);
#pragma unroll
            for (int j = 0; j < 4; ++j) {
                const int cidx = lofs + 256 * j;
                const f32x4 gf = *(const f32x4*)(vec + 2048 + cidx), sh = *(const f32x4*)(vec + 3072 + cidx), sc = *(const f32x4*)(vec + 4096 + cidx);
#pragma unroll
                for (int q = 0; q < 4; ++q) xv[u][4 * j + q] = xv[u][4 * j + q] * rstd2 * gf[q] * (1.0f + sc[q]) + sh[q];
                if (MOE_FP8) wt4(H2, (unsigned)(t * DM + cidx), pk4_fp8(xv[u][4 * j], xv[u][4 * j + 1], xv[u][4 * j + 2], xv[u][4 * j + 3]));
                else { u32x2 w; w.x = pk2(xv[u][4 * j], xv[u][4 * j + 1]); w.y = pk2(xv[u][4 * j + 2], xv[u][4 * j + 3]); *(u32x2*)(H2 + (size_t)t * DM + cidx) = w; }
            }
        }
        using f32x2 = __attribute__((ext_vector_type(2))) float;
        f32x2 xp[16];
#pragma unroll
        for (int k = 0; k < 16; ++k) xp[k] = (f32x2){xv[0][k], xv[1][k]};
        float pl0[32], pl1[32];
#pragma unroll
        for (int e2 = 0; e2 < 32; e2 += 2) {
            f32x4 w[2][4];
#pragma unroll
            for (int q = 0; q < 2; ++q)
#pragma unroll
                for (int j = 0; j < 4; ++j) w[q][j] = *(const f32x4*)(wr + (e2 + q) * RP_WSTRIDE + lofs + 256 * j);
#pragma unroll
            for (int q = 0; q < 2; ++q) {
                f32x2 a = (f32x2){0.f, 0.f}, b2 = (f32x2){0.f, 0.f};
#pragma unroll
                for (int j = 0; j < 4; ++j) {
                    a = xp[4 * j] * (f32x2){w[q][j][0], w[q][j][0]} + a; b2 = xp[4 * j + 1] * (f32x2){w[q][j][1], w[q][j][1]} + b2;
                    a = xp[4 * j + 2] * (f32x2){w[q][j][2], w[q][j][2]} + a; b2 = xp[4 * j + 3] * (f32x2){w[q][j][3], w[q][j][3]} + b2; }
                a = a + b2;
                asm volatile("" : "+v"(a));
                pl0[e2 + q] = a.x; pl1[e2 + q] = a.y;
            }
            __builtin_amdgcn_sched_barrier(0);
        }
        route_token(pl0, t0 + wave * 8 + it * 2, (wave * 8 + it * 2) * 4, lane, b_router, TOPE, TOPW, hist, asg_e, asg_p, asg_w);
        route_token(pl1, t0 + wave * 8 + it * 2 + 1, (wave * 8 + it * 2 + 1) * 4, lane, b_router, TOPE, TOPW, hist, asg_e, asg_p, asg_w);
    }
    __syncthreads();
    if (tid < 32) base[tid] = atomicAdd(&ecnt[tid], hist[tid]);
    __syncthreads();
    if (tid < 256) { const unsigned e = asg_e[tid]; u32x2 ent; ent.x = (unsigned)(t0 * 4 + tid); ent.y = __builtin_bit_cast(unsigned, asg_w[tid]); *(u32x2*)(LIST + 2 * ((size_t)e * ECAP + base[e] + asg_p[tid])) = ent; }
    __syncthreads();
}

constexpr int RP_APITCH = 2064;
DEV u32x4 wrs_entry(const float* __restrict__ w_router, int en) {
    const int ln = en & 63, part = (en >> 6) & 1, st = (en >> 7) & 7, sl = en >> 10; const int m = ln & 31, k0 = 128 * sl + 16 * st + 8 * (ln >> 5);
    unsigned o[4];
#pragma unroll
    for (int i = 0; i < 4; ++i) { const float a = w_router[(k0 + 2 * i) * 32 + m], b = w_router[(k0 + 2 * i + 1) * 32 + m];
        const unsigned h = pk2(a, b); o[i] = part ? pk2(a - bflo(h), b - bfhi(h)) : h; }
    return (u32x4){o[0], o[1], o[2], o[3]};
}
DEV float half_max(float v) {
    v = fmaxf(v, DPPF(v, 0xB1)); v = fmaxf(v, DPPF(v, 0x4E)); v = fmaxf(v, DPPF(v, 0x141)); v = fmaxf(v, DPPF(v, 0x140));
    { auto r = __builtin_amdgcn_permlane16_swap(__float_as_uint(v), __float_as_uint(v), false, false); v = fmaxf(__uint_as_float(r[0]), __uint_as_float(r[1])); }
    return v;
}
DEV void route_tokens2x(float logit, float bias, int la0, int lane, unsigned* hist, unsigned* asg_e, unsigned* asg_p, float* asg_w) {
    float val = logit + bias;
    const int hb = lane & 32;
    float tl[4]; int te[4];
#pragma unroll
    for (int k = 0; k < 4; ++k) {
        const float mx = half_max(val);
        const unsigned long long bal = __ballot(val == mx);
        const unsigned mine = hb ? (unsigned)(bal >> 32) : (unsigned)bal;
        const int wl = __ffs((int)mine) - 1;
        tl[k] = mx; te[k] = wl;
        if ((lane & 31) == wl) val = -INFINITY;
    }
    const float e1 = __expf(tl[1] - tl[0]), e2 = __expf(tl[2] - tl[0]), e3 = __expf(tl[3] - tl[0]);
    const float inv = 1.0f / (1.0f + e1 + e2 + e3);
    const int l4 = lane & 31;
    if (l4 < 4) {
        const int ek = l4 == 0 ? te[0] : l4 == 1 ? te[1] : l4 == 2 ? te[2] : te[3];
        const float wk = (l4 == 0 ? 1.0f : l4 == 1 ? e1 : l4 == 2 ? e2 : e3) * inv;
        const unsigned p = atomicAdd(&hist[ek], 1u);
        const int slot = la0 + (hb ? 4 : 0) + l4;
        asg_e[slot] = (unsigned)ek; asg_p[slot] = p; asg_w[slot] = wk;
    }
}
DEV void route_token2(float logit, float bias, int t, int la0, int lane, unsigned* hist, unsigned* asg_e, unsigned* asg_p, float* asg_w) {
    float val = lane < 32 ? logit + bias : -INFINITY;
    float tl[4]; int te[4];
#pragma unroll
    for (int k = 0; k < 4; ++k) {
        const float mx = wave_max(val);
        const unsigned long long bal = __ballot(val == mx);
        const int wl = __ffsll((long long)bal) - 1;
        tl[k] = mx; te[k] = wl;
        if (lane == wl) val = -INFINITY;
    }
    const float e1 = __expf(tl[1] - tl[0]), e2 = __expf(tl[2] - tl[0]), e3 = __expf(tl[3] - tl[0]);
    const float inv = 1.0f / (1.0f + e1 + e2 + e3);
    if (lane < 4) {
        const int ek = lane == 0 ? te[0] : lane == 1 ? te[1] : lane == 2 ? te[2] : te[3];
        const float wk = (lane == 0 ? 1.0f : lane == 1 ? e1 : lane == 2 ? e2 : e3) * inv;
        const unsigned p = atomicAdd(&hist[ek], 1u);
        asg_e[la0 + lane] = (unsigned)ek; asg_p[la0 + lane] = p; asg_w[la0 + lane] = wk;
    }
}
DEV void rowpass_block2(int blk, const float* __restrict__ x, const bf16* __restrict__ Y, const float* __restrict__ mod, const float* __restrict__ g_post_mix, const float* __restrict__ g_pre_ffn,
                        const unsigned char* __restrict__ wrs, const float* __restrict__ b_router, bf16* __restrict__ H2, float* __restrict__ RSTD1,
                        unsigned* __restrict__ ecnt, int* __restrict__ LIST, unsigned char* lds, unsigned char* lds_small, int wave, bf16* __restrict__ X1B, unsigned char* lds_vec) {
    typedef float f32x16_ __attribute__((ext_vector_type(16)));
    unsigned char* abuf = lds;
    unsigned* hist = (unsigned*)lds_small;
    unsigned* base = hist + 32;
    unsigned* asg_e = base + 32;
    unsigned* asg_p = asg_e + 256;
    float* asg_w = (float*)(asg_p + 256);
    const int lane = lane_now(), tid = wave * 64 + lane;
    const int t0 = blk * 64, b = t0 / SEQ;
    const float* mrow = mod + b * 6144;
    float* vec = (float*)lds_vec;
    for (int i = tid; i < 5 * 256; i += 512) { const int vsel = i >> 8, c4 = (i & 255) * 4;
        const float* src = vsel == 0 ? mrow + 2048 : vsel == 1 ? g_post_mix : vsel == 2 ? g_pre_ffn : vsel == 3 ? mrow + 3072 : mrow + 4096;
        *(f32x4*)(vec + vsel * 1024 + c4) = *(const f32x4*)(src + c4); }
    if (tid < 32) hist[tid] = 0u;
    const float rbias = b_router[lane & 31];
    __syncthreads();
#define RP2_LT(p, u) (32 * ((p) >> 1) + 4 * wave + 2 * ((p) & 1) + (u))
    f32x4 xn[2][4]; u32x2 yn[2][4];
#pragma unroll
    for (int u = 0; u < 2; ++u)
#pragma unroll
        for (int j = 0; j < 4; ++j) { const int t = t0 + RP2_LT(0, u); xn[u][j] = __builtin_nontemporal_load((const f32x4*)(x + (size_t)t * DM + 4 * lane + 256 * j)); yn[u][j] = __builtin_nontemporal_load((const u32x2*)(Y + (size_t)t * DM + 4 * lane + 256 * j)); }
#pragma unroll 1
    for (int half = 0; half < 2; ++half) {
#pragma unroll 1
        for (int it2 = 0; it2 < 2; ++it2) {
            const int p = 2 * half + it2;
            float xv[2][16];
            int lofs = 4 * lane; asm volatile("" : "+v"(lofs));
            f32x4 xc[2][4]; u32x2 yc[2][4];
#pragma unroll
            for (int u = 0; u < 2; ++u)
#pragma unroll
                for (int j = 0; j < 4; ++j) { xc[u][j] = xn[u][j]; yc[u][j] = yn[u][j]; }
            if (p < 3) {
#pragma unroll
                for (int u = 0; u < 2; ++u)
#pragma unroll
                    for (int j = 0; j < 4; ++j) { const int t = t0 + RP2_LT(p + 1, u); xn[u][j] = __builtin_nontemporal_load((const f32x4*)(x + (size_t)t * DM + lofs + 256 * j)); yn[u][j] = __builtin_nontemporal_load((const u32x2*)(Y + (size_t)t * DM + lofs + 256 * j)); }
            }
#pragma unroll
            for (int u = 0; u < 2; ++u) {
                const int t = t0 + RP2_LT(p, u);
                float yv[16]; float ss = 0.f;
#pragma unroll
                for (int j = 0; j < 4; ++j) {
                    const u32x2 yw = yc[u][j];
                    yv[4 * j] = bflo(yw.x); yv[4 * j + 1] = bfhi(yw.x); yv[4 * j + 2] = bflo(yw.y); yv[4 * j + 3] = bfhi(yw.y);
                    const f32x4 xx = xc[u][j];
                    xv[u][4 * j] = xx[0]; xv[u][4 * j + 1] = xx[1]; xv[u][4 * j + 2] = xx[2]; xv[u][4 * j + 3] = xx[3];
#pragma unroll
                    for (int q = 0; q < 4; ++q) ss += yv[4 * j + q] * yv[4 * j + q];
                }
                const float rstd1 = rsqrtf(wave_sum(ss) * (1.0f / DM) + EPS);
                if (lane == 0) RSTD1[t] = rstd1;
                float ss2 = 0.f;
#pragma unroll
                for (int j = 0; j < 4; ++j) {
                    const int cidx = lofs + 256 * j;
                    const f32x4 gt = *(const f32x4*)(vec + cidx), gp = *(const f32x4*)(vec + 1024 + cidx);
#pragma unroll
                    for (int q = 0; q < 4; ++q) { const float x1 = xv[u][4 * j + q] + gt[q] * (yv[4 * j + q] * rstd1 * gp[q]); xv[u][4 * j + q] = x1; ss2 += x1 * x1; }
                    { u32x2 xw; xw.x = pk2(xv[u][4 * j], xv[u][4 * j + 1]); xw.y = pk2(xv[u][4 * j + 2], xv[u][4 * j + 3]); *(u32x2*)(X1B + (size_t)t * DM + cidx) = xw; }
                }
                const float rstd2 = rsqrtf(wave_sum(ss2) * (1.0f / DM) + EPS);
                unsigned char* arow = abuf + (4 * wave + 2 * it2 + u) * RP_APITCH;
#pragma unroll
                for (int j = 0; j < 4; ++j) {
                    const int cidx = lofs + 256 * j;
                    const f32x4 gf = *(const f32x4*)(vec + 2048 + cidx), sh = *(const f32x4*)(vec + 3072 + cidx), sc = *(const f32x4*)(vec + 4096 + cidx);
                    float h[4];
#pragma unroll
                    for (int q = 0; q < 4; ++q) h[q] = xv[u][4 * j + q] * rstd2 * gf[q] * (1.0f + sc[q]) + sh[q];
                    wt4(H2, (unsigned)(t * DM + cidx), pk4_fp8(h[0], h[1], h[2], h[3]));
                    u32x2 hi, lo; hi.x = pk2(h[0], h[1]); hi.y = pk2(h[2], h[3]);
                    lo.x = pk2(h[0] - bflo(hi.x), h[1] - bfhi(hi.x)); lo.y = pk2(h[2] - bflo(hi.y), h[3] - bfhi(hi.y));
                    *(u32x2*)(arow + cidx * 2) = hi; *(u32x2*)(arow + 32 * RP_APITCH + cidx * 2) = lo;
                }
            }
        }
        {
            const unsigned char* tb = wrs + ((size_t)wave * 16 * 64 + lane) * 16;
            bf16x8 th[8], tl[8];
#pragma unroll
            for (int s_ = 0; s_ < 8; ++s_) { th[s_] = *(const bf16x8*)(tb + (s_ * 2) * 1024); tl[s_] = *(const bf16x8*)(tb + (s_ * 2 + 1) * 1024); }
            __syncthreads();
            const unsigned char* brow = abuf + (lane & 31) * RP_APITCH + (128 * wave + 8 * (lane >> 5)) * 2;
            f32x16_ acc = {0.f, 0.f, 0.f, 0.f, 0.f, 0.f, 0.f, 0.f, 0.f, 0.f, 0.f, 0.f, 0.f, 0.f, 0.f, 0.f};
#pragma unroll
            for (int s_ = 0; s_ < 8; ++s_) {
                const bf16x8 bh = *(const bf16x8*)(brow + s_ * 32), bl = *(const bf16x8*)(brow + 32 * RP_APITCH + s_ * 32);
                acc = __builtin_amdgcn_mfma_f32_32x32x16_bf16(th[s_], bh, acc, 0, 0, 0);
                acc = __builtin_amdgcn_mfma_f32_32x32x16_bf16(th[s_], bl, acc, 0, 0, 0);
                acc = __builtin_amdgcn_mfma_f32_32x32x16_bf16(tl[s_], bh, acc, 0, 0, 0);
            }
            __syncthreads();
            f32x4* pw_ = (f32x4*)(abuf + (size_t)(wave * 64 + lane) * 64);
#pragma unroll
            for (int c = 0; c < 4; ++c) pw_[c] = (f32x4){acc[4 * c], acc[4 * c + 1], acc[4 * c + 2], acc[4 * c + 3]};
        }
        __syncthreads();
        {
            const int e = lane & 31, hi_e = (e >> 2) & 1, r_e = (e & 3) + 4 * (e >> 3);
            const float* pp = (const float*)abuf;
#pragma unroll 1
            for (int i = 0; i < 4; i += 2) {
                const int n = 4 * wave + i + (lane >> 5);
                float lg = 0.f;
#pragma unroll
                for (int wv = 0; wv < 8; ++wv) lg += pp[(wv * 64 + n + 32 * hi_e) * 16 + r_e];
                route_tokens2x(lg, rbias, (32 * half + 4 * wave + i) * 4, lane, hist, asg_e, asg_p, asg_w);
            }
        }
        __syncthreads();
    }
#undef RP2_LT
    if (tid < 32) base[tid] = atomicAdd(&ecnt[tid], hist[tid]);
    __syncthreads();
    if (tid < 256) { const unsigned e = asg_e[tid]; u32x2 ent; ent.x = (unsigned)(t0 * 4 + tid); ent.y = __builtin_bit_cast(unsigned, asg_w[tid]); *(u32x2*)(LIST + 2 * ((size_t)e * ECAP + base[e] + asg_p[tid])) = ent; }
    __syncthreads();
}

DEV void final_rows2(int t0, int t1, const bf16* __restrict__ X1B, const bf16* __restrict__ YS, const float* __restrict__ mod, const float* __restrict__ g_post_ffn, float* __restrict__ out, int lane) {
    const float* mrow = mod + (t0 / SEQ) * 6144;
    const int tt[2] = {t0, t1};
    unsigned w[2][4][4]; u32x2 xw[2][4];
#pragma unroll
    for (int a = 0; a < 2; ++a) {
#pragma unroll
        for (int j = 0; j < 4; ++j)
#pragma unroll
            for (int k = 0; k < 4; ++k) w[a][j][k] = __builtin_nontemporal_load((const unsigned*)((const unsigned char*)YS + (size_t)(tt[a] * 4 + k) * DM + 4 * lane + 256 * j));
#pragma unroll
        for (int j = 0; j < 4; ++j) xw[a][j] = __builtin_nontemporal_load((const u32x2*)(X1B + (size_t)tt[a] * DM + 4 * lane + 256 * j));
    }
    float f[2][16], ss[2];
#pragma unroll
    for (int a = 0; a < 2; ++a) { ss[a] = 0.f;
#pragma unroll
        for (int j = 0; j < 4; ++j) { float a0 = 0.f, a1 = 0.f, a2 = 0.f, a3 = 0.f;
#pragma unroll
            for (int k = 0; k < 4; ++k) { const auto lo = __builtin_amdgcn_cvt_pk_f32_fp8((int)w[a][j][k], false), hi = __builtin_amdgcn_cvt_pk_f32_fp8((int)w[a][j][k], true); a0 += lo[0]; a1 += lo[1]; a2 += hi[0]; a3 += hi[1]; }
            a0 *= 1.0f / YS8_SCALE; a1 *= 1.0f / YS8_SCALE; a2 *= 1.0f / YS8_SCALE; a3 *= 1.0f / YS8_SCALE;
            f[a][4 * j] = a0; f[a][4 * j + 1] = a1; f[a][4 * j + 2] = a2; f[a][4 * j + 3] = a3;
            ss[a] += a0 * a0 + a1 * a1 + a2 * a2 + a3 * a3; } }
    const float rstdf[2] = {rsqrtf(wave_sum(ss[0]) * (1.0f / DM) + EPS), rsqrtf(wave_sum(ss[1]) * (1.0f / DM) + EPS)};
#pragma unroll
    for (int j = 0; j < 4; ++j) {
        const int cidx = 4 * lane + 256 * j;
        const f32x4 gt2 = *(const f32x4*)(mrow + 5120 + cidx), gf = *(const f32x4*)(g_post_ffn + cidx);
#pragma unroll
        for (int a = 0; a < 2; ++a) {
            const float xv[4] = {bflo(xw[a][j].x), bfhi(xw[a][j].x), bflo(xw[a][j].y), bfhi(xw[a][j].y)};
            f32x4 o;
#pragma unroll
            for (int q = 0; q < 4; ++q) o[q] = xv[q] + gt2[q] * (f[a][4 * j + q] * rstdf[a] * gf[q]);
            __builtin_nontemporal_store(o, (f32x4*)(out + (size_t)tt[a] * DM + cidx)); }
    }
}
DEV void final_rows_all(int tb, const bf16* __restrict__ X1B, const bf16* __restrict__ YS, const float* vec, float* __restrict__ out, int lane) {
    unsigned w[2][2][4][4]; u32x2 xw[2][2][4];
#define FR_LOAD(buf, k) do { _Pragma("unroll") for (int a = 0; a < 2; ++a) { const int t_ = tb + 4096 * (k) + 2048 * a; \
        _Pragma("unroll") for (int j = 0; j < 4; ++j) _Pragma("unroll") for (int q = 0; q < 4; ++q) w[buf][a][j][q] = __builtin_nontemporal_load((const unsigned*)((const unsigned char*)YS + (size_t)(t_ * 4 + q) * DM + 4 * lane + 256 * j)); \
        _Pragma("unroll") for (int j = 0; j < 4; ++j) xw[buf][a][j] = __builtin_nontemporal_load((const u32x2*)(X1B + (size_t)t_ * DM + 4 * lane + 256 * j)); } } while (0)
    FR_LOAD(0, 0);
#pragma unroll
    for (int k = 0; k < 4; ++k) {
        const int cb = k & 1;
        if (k < 3) { if (cb == 0) FR_LOAD(1, k + 1); else FR_LOAD(0, k + 1); }
        float f[2][16], ss[2];
#pragma unroll
        for (int a = 0; a < 2; ++a) { ss[a] = 0.f;
#pragma unroll
            for (int j = 0; j < 4; ++j) { float a0 = 0.f, a1 = 0.f, a2 = 0.f, a3 = 0.f;
#pragma unroll
                for (int q = 0; q < 4; ++q) { const auto lo = __builtin_amdgcn_cvt_pk_f32_fp8((int)w[cb][a][j][q], false), hi = __builtin_amdgcn_cvt_pk_f32_fp8((int)w[cb][a][j][q], true); a0 += lo[0]; a1 += lo[1]; a2 += hi[0]; a3 += hi[1]; }
                a0 *= 1.0f / YS8_SCALE; a1 *= 1.0f / YS8_SCALE; a2 *= 1.0f / YS8_SCALE; a3 *= 1.0f / YS8_SCALE;
                f[a][4 * j] = a0; f[a][4 * j + 1] = a1; f[a][4 * j + 2] = a2; f[a][4 * j + 3] = a3;
                ss[a] += a0 * a0 + a1 * a1 + a2 * a2 + a3 * a3; } }
        const float rstdf[2] = {rsqrtf(wave_sum(ss[0]) * (1.0f / DM) + EPS), rsqrtf(wave_sum(ss[1]) * (1.0f / DM) + EPS)};
#pragma unroll
        for (int j = 0; j < 4; ++j) {
            const int cidx = 4 * lane + 256 * j;
            const f32x4 gt2 = *(const f32x4*)(vec + k * 1024 + cidx), gf = *(const f32x4*)(vec + 4096 + cidx);
#pragma unroll
            for (int a = 0; a < 2; ++a) {
                const float xv[4] = {bflo(xw[cb][a][j].x), bfhi(xw[cb][a][j].x), bflo(xw[cb][a][j].y), bfhi(xw[cb][a][j].y)};
                f32x4 o;
#pragma unroll
                for (int q = 0; q < 4; ++q) o[q] = xv[q] + gt2[q] * (f[a][4 * j + q] * rstdf[a] * gf[q]);
                __builtin_nontemporal_store(o, (f32x4*)(out + (size_t)(tb + 4096 * k + 2048 * a) * DM + cidx)); }
        }
    }
#undef FR_LOAD
}
DEV void final_row(int t, const float* __restrict__ x, const bf16* __restrict__ Y, const float* __restrict__ RSTD1, const bf16* __restrict__ YS, const float* __restrict__ mod,
                   const float* __restrict__ g_post_mix, const float* __restrict__ g_post_ffn, float* __restrict__ out, int lane) {
    const float* mrow = mod + (t / SEQ) * 6144;
    const float rstd1 = RSTD1[t];
    float f[16]; float ss = 0.f;
#pragma unroll
    for (int j = 0; j < 4; ++j) {
        float a0 = 0.f, a1 = 0.f, a2 = 0.f, a3 = 0.f;
#pragma unroll
        for (int k = 0; k < 4; ++k) {
            if (MOE_FP8) { const unsigned w = __builtin_nontemporal_load((const unsigned*)((const unsigned char*)YS + (size_t)(t * 4 + k) * DM + 4 * lane + 256 * j));
                const auto lo = __builtin_amdgcn_cvt_pk_f32_fp8((int)w, false), hi = __builtin_amdgcn_cvt_pk_f32_fp8((int)w, true); a0 += lo[0]; a1 += lo[1]; a2 += hi[0]; a3 += hi[1]; }
            else { const u32x2 w = *(const u32x2*)(YS + (size_t)(t * 4 + k) * DM + 4 * lane + 256 * j); a0 += bflo(w.x); a1 += bfhi(w.x); a2 += bflo(w.y); a3 += bfhi(w.y); } }
        if (MOE_FP8) { a0 *= 1.0f / YS8_SCALE; a1 *= 1.0f / YS8_SCALE; a2 *= 1.0f / YS8_SCALE; a3 *= 1.0f / YS8_SCALE; }
        f[4 * j] = a0; f[4 * j + 1] = a1; f[4 * j + 2] = a2; f[4 * j + 3] = a3;
        ss += a0 * a0 + a1 * a1 + a2 * a2 + a3 * a3;
    }
    const float rstdf = rsqrtf(wave_sum(ss) * (1.0f / DM) + EPS);
#pragma unroll
    for (int j = 0; j < 4; ++j) {
        const int cidx = 4 * lane + 256 * j;
        const f32x4 xx = __builtin_nontemporal_load((const f32x4*)(x + (size_t)t * DM + cidx));
        const u32x2 yw = __builtin_nontemporal_load((const u32x2*)(Y + (size_t)t * DM + cidx));
        const f32x4 gt1 = *(const f32x4*)(mrow + 2048 + cidx), gt2 = *(const f32x4*)(mrow + 5120 + cidx), gp = *(const f32x4*)(g_post_mix + cidx), gf = *(const f32x4*)(g_post_ffn + cidx);
        const float yv[4] = {bflo(yw.x), bfhi(yw.x), bflo(yw.y), bfhi(yw.y)};
        f32x4 o;
#pragma unroll
        for (int q = 0; q < 4; ++q) o[q] = xx[q] + gt1[q] * (yv[q] * rstd1 * gp[q]) + gt2[q] * (f[4 * j + q] * rstdf * gf[q]);
        __builtin_nontemporal_store(o, (f32x4*)(out + (size_t)t * DM + cidx));
    }
}


#define LAS __attribute__((address_space(3)))
#define GAS __attribute__((address_space(1)))
typedef GAS unsigned gu32;
#define RLX_AGENT __ATOMIC_RELAXED, __HIP_MEMORY_SCOPE_AGENT
constexpr int NWAVES = 8;
#ifndef PROBE_SEL
#define PROBE_SEL 0
#endif
constexpr int MW_PROBE = 1000;
#define PROBE_BEGIN(id) unsigned long long _pb##id = 0; if (PROBE_SEL == (id)) _pb##id = __builtin_amdgcn_s_memrealtime();
#define PROBE_MARK(id) do { if (PROBE_SEL == (id) && F.wave == 0) { const unsigned _d = (unsigned)(__builtin_amdgcn_s_memrealtime() - _pbstart); if (lane_now() == 0) __hip_atomic_fetch_add((LAS unsigned*)(F.lds + MISC_OFF) + MW_PROBE, _d, __ATOMIC_RELAXED, __HIP_MEMORY_SCOPE_WORKGROUP); } } while (0)
#define PROBE_END(id, miscp) do { if (PROBE_SEL == (id)) { const unsigned _d = (unsigned)(__builtin_amdgcn_s_memrealtime() - _pb##id); if (lane_now() == 0) __hip_atomic_fetch_add((LAS unsigned*)(miscp) + MW_PROBE, _d, __ATOMIC_RELAXED, __HIP_MEMORY_SCOPE_WORKGROUP); } } while (0)

constexpr int RING_OFF = 0, RING_BYTES = 131072;
constexpr int ROPE_OFF = 131072;
constexpr int MISC_OFF = 139264;
constexpr int NAX_OFF = 143360;
constexpr int LDS_BYTES = 163840;
constexpr int CW_TMO = 0, CW_CODE = 1, CW_BAR = 4096;

#define XB_TMO      128
#define XB_XCNT(j)  (256  + 64 * (j))
#define XB_XSUB(j)  (1280 + 64 * (j))
#define XB_XGEN(j)  (2304 + 64 * (j))
#define XB_TOP      3328
#define XB_TOPGEN   3392
#define XCD_BAR_WORDS 3456
#define XB_SPIN_CAP (1u << 18)
__device__ __forceinline__ unsigned xb_ld(unsigned* p)              { return __hip_atomic_load(p, __ATOMIC_RELAXED, __HIP_MEMORY_SCOPE_AGENT); }
__device__ __forceinline__ unsigned xb_add(unsigned* p, unsigned v) { return __hip_atomic_fetch_add(p, v, __ATOMIC_RELAXED, __HIP_MEMORY_SCOPE_AGENT); }
__device__ __forceinline__ unsigned xb_xcc_id() { return (unsigned)__builtin_amdgcn_s_getreg((3 << 11) | 20) & 0xFu; }
#define XB_SPIN(cond, bar) do { unsigned _sp = 0; while (cond) { __builtin_amdgcn_s_sleep(1); \
    if ((++_sp & 255u) == 0u) { if (xb_ld(&(bar)[XB_TMO])) break; if (_sp > XB_SPIN_CAP) { atomicAdd(&(bar)[XB_TMO], 1u); break; } } } } while (0)
struct XcdBarrier { unsigned* bar; unsigned x; volatile LAS unsigned* st; };
__device__ __forceinline__ XcdBarrier xcd_barrier_post(unsigned* bar, volatile LAS unsigned* st) {
    XcdBarrier b; b.bar = bar; b.x = xb_xcc_id(); b.st = st;
    if (threadIdx.x == 0) (void)xb_add(&bar[XB_XCNT(b.x)], 1u);
    return b;
}
__device__ __forceinline__ void xcd_barrier_complete(unsigned* bar, unsigned x, unsigned& nloc, unsigned& nx) {
    const unsigned G = gridDim.x * gridDim.y * gridDim.z;
    unsigned sum, cnt, mine, sp = 0u;
    for (;;) {
        sum = 0u; cnt = 0u; mine = 0u;
#pragma unroll
        for (unsigned j = 0; j < 16; ++j) { const unsigned c = xb_ld(&bar[XB_XCNT(j)]); sum += c; cnt += (c > 0u) ? 1u : 0u; mine = (j == x) ? c : mine; }
        if (sum == G) break;
        __builtin_amdgcn_s_sleep(1);
        if ((++sp & 255u) == 0u) { if (xb_ld(&bar[XB_TMO])) break; if (sp > XB_SPIN_CAP) { atomicAdd(&bar[XB_TMO], 1u); break; } }
    }
    nloc = mine > 0u ? mine : 1u; nx = cnt > 0u ? cnt : 1u;
}
__device__ __forceinline__ void xcd_barrier(const XcdBarrier& b, int wave) {
    asm volatile("s_waitcnt vmcnt(0)" ::: "memory");
    __syncthreads();
    if (wave == 0 && lane_now() == 0) {
        unsigned* bar = b.bar;
        __builtin_amdgcn_s_waitcnt(0);
        unsigned nloc = b.st[0], nx = b.st[1];
        if (nloc == 0u) { xcd_barrier_complete(bar, b.x, nloc, nx); b.st[0] = nloc; b.st[1] = nx; }
        const unsigned old = xb_add(&bar[XB_XSUB(b.x)], 1u);
        const unsigned gen = old / nloc;
        if (old + 1u == (gen + 1u) * nloc) {
            __builtin_amdgcn_fence(__ATOMIC_RELEASE, "agent");
            asm volatile("s_waitcnt vmcnt(0)" ::: "memory");
            const unsigned og = xb_add(&bar[XB_TOP], 1u);
            const unsigned tg = og / nx;
            if (og + 1u == (tg + 1u) * nx) xb_add(&bar[XB_TOPGEN], 1u);
            else XB_SPIN(xb_ld(&bar[XB_TOPGEN]) == tg, bar);
            __builtin_amdgcn_fence(__ATOMIC_ACQUIRE, "agent");
            xb_add(&bar[XB_XGEN(b.x)], 1u);
            asm volatile("s_waitcnt vmcnt(0)" ::: "memory");
        } else {
            XB_SPIN(xb_ld(&bar[XB_XGEN(b.x)]) == gen, bar);
            __builtin_amdgcn_fence(__ATOMIC_ACQUIRE, "agent");
            asm volatile("s_waitcnt vmcnt(0)" ::: "memory");
        }
    }
    __syncthreads();
}


constexpr int CW_CNTO = 32768, CW_CNTU = 36864, CW_CNTY = 40960, CW_CNTM = 45056, CW_CNTA = 49152, CW_CNTOB = 69632, CW_QMAX = 73728, CW_KMAX = 73792;
__device__ __forceinline__ void panel_signal(unsigned* cnt) {
    asm volatile("s_waitcnt vmcnt(0)" ::: "memory");
    if (lane_now() == 0) (void)__hip_atomic_fetch_add(cnt, 1u, __ATOMIC_RELAXED, __HIP_MEMORY_SCOPE_AGENT);
}
__device__ __forceinline__ void panel_wait(unsigned* cnt, unsigned want, unsigned* tmo, int wave) {
    if (wave == 0) {
        unsigned sp = 0u;
        while (__hip_atomic_load(cnt, __ATOMIC_RELAXED, __HIP_MEMORY_SCOPE_AGENT) < want) {
            __builtin_amdgcn_s_sleep(2);
            if (++sp > (1u << 20)) { if (lane_now() == 0) __hip_atomic_store(tmo, 0xC0DEu, __ATOMIC_RELAXED, __HIP_MEMORY_SCOPE_AGENT); break; }
        }
        __builtin_amdgcn_fence(__ATOMIC_ACQUIRE, "agent");
        asm volatile("s_waitcnt vmcnt(0)" ::: "memory");
    }
    __syncthreads();
}

namespace pg8 {
#define PG8_LAS __attribute__((address_space(3)))
constexpr int BM = 256, BK = 64, HALF = 128, HTB = HALF * BK * 2, STAGE_BYTES = 8 * HTB;
constexpr int KDIM = 1024, NT = KDIM / BK, PITCH = KDIM * 2;
__host__ __device__ __forceinline__ int lds_byte(int r, int c) { const int st = (r >> 4) * 2 + (c >> 5), rr = r & 15, cc = c & 31, ob = rr * 64 + cc * 2; return st * 1024 + (ob ^ (((ob >> 9) & 1) << 5)); }
__host__ __device__ __forceinline__ void stage_rc(int b, int& R, int& C) { const int st = b / 1024, sb = b % 1024, swz = sb ^ (((sb >> 9) & 1) << 5); R = (st >> 1) * 16 + swz / 64; C = (st & 1) * 32 + (swz % 64) / 2; }

struct GU {
    unsigned a;
    unsigned b;
    unsigned rows;
    int pm, pn, e, cnt;
};
__host__ __device__ __forceinline__ int perm32(int rho) { const int n = rho >> 4, i = rho & 15; return 8 * (i >> 2) + 4 * n + (i & 3); }
template <int BMAP> __device__ __forceinline__ int bmap_row(int R) { return BMAP == 0 ? R : BMAP == 1 ? (64 * (R >> 5) + perm32(R & 31)) : BMAP == 2 ? (32 * (R >> 5) + 8 * ((R & 15) >> 2) + (R & 3) + 1024 * ((R >> 4) & 1)) : ((R & ~31) + perm32(R & 31)); }
template <int BMAP> __device__ __forceinline__ int bmap_hrows() { return (BMAP == 0 || BMAP == 3) ? 128 : BMAP == 1 ? 32 : 4; }
typedef int v8i32 __attribute__((ext_vector_type(8)));
typedef int v4i32 __attribute__((ext_vector_type(4)));
__device__ __forceinline__ bf16x8 lo8(v8i32 v) { return __builtin_bit_cast(bf16x8, (v4i32)__builtin_shufflevector(v, v, 0, 1, 2, 3)); }
__device__ __forceinline__ bf16x8 hi8(v8i32 v) { return __builtin_bit_cast(bf16x8, (v4i32)__builtin_shufflevector(v, v, 4, 5, 6, 7)); }
__device__ __forceinline__ v8i32 cat8(bf16x8 lo, bf16x8 hi) { const v4i32 a = __builtin_bit_cast(v4i32, lo), b = __builtin_bit_cast(v4i32, hi); return __builtin_shufflevector(a, b, 0, 1, 2, 3, 4, 5, 6, 7); }

template <class Epi, class Sched, bool GATHER, int BMAP, bool FP8 = false>
__device__ __forceinline__ void gemm_phase(PG8_LAS unsigned char* lds, const Sched& S, const Epi& E, int wid) {
    const int lane = lane_now(), tid = wid * 64 + lane, wr = wid >> 2, wc = wid & 3, fr = lane & 15, fq = lane >> 4;
    constexpr int nt = FP8 ? 8 : NT; constexpr int RPITCH = FP8 ? 1024 : PITCH;
    int Rr[2], Cc[2]; unsigned voffB[2];
#pragma unroll
    for (int i = 0; i < 2; ++i) { stage_rc(tid * 16 + i * 8192, Rr[i], Cc[i]); voffB[i] = (unsigned)(bmap_row<BMAP>(Rr[i]) * RPITCH + Cc[i] * 2); }
    const size_t kstep = (size_t)(BK * 2);
    const size_t hstepB = (size_t)bmap_hrows<BMAP>() * RPITCH;
    const unsigned ldsw = (unsigned)wid * 1024u;
    const int aoff = lds_byte(wr * 64 + fr, fq * 8), boff = lds_byte(wc * 32 + fr, fq * 8);
#define PG8_SA(b, h) (((b) * 2 + (h)) * HTB)
#define PG8_SB(b, h) ((4 + (b) * 2 + (h)) * HTB)
#define PG8_STAGE(bufoff, gbase, voff) do { _Pragma("unroll") for (int _i = 0; _i < 2; ++_i) { unsigned _o = (voff)[_i]; asm volatile("" : "+v"(_o));     \
        __builtin_amdgcn_global_load_lds((const unsigned*)((const char*)(gbase) + _o), (PG8_LAS unsigned*)(lds + (bufoff) + ldsw + _i * 8192), 16, 0, 0); } } while (0)
#define PG8_LDA(dst, b, h) do { _Pragma("unroll") for (int m = 0; m < 4; ++m) dst[m] = cat8(*(const PG8_LAS bf16x8*)(lds + PG8_SA(b, h) + aoff + m * 2048), *(const PG8_LAS bf16x8*)(lds + PG8_SA(b, h) + aoff + m * 2048 + 1024)); } while (0)
#define PG8_LDB(dst, b, h) do { _Pragma("unroll") for (int n = 0; n < 2; ++n) dst[n] = cat8(*(const PG8_LAS bf16x8*)(lds + PG8_SB(b, h) + boff + n * 2048), *(const PG8_LAS bf16x8*)(lds + PG8_SB(b, h) + boff + n * 2048 + 1024)); } while (0)
#define PG8_MMA(ai, bj, At, Bt) do { __builtin_amdgcn_s_setprio(1); if constexpr (FP8) asm volatile("s_nop 1"); _Pragma("unroll") for (int m = 0; m < 4; ++m) _Pragma("unroll") for (int n = 0; n < 2; ++n) { \
        if constexpr (FP8) asm volatile("v_mfma_f32_16x16x128_f8f6f4 %0, %1, %2, %0" : "+v"(acc[ai][bj][m][n]) : "v"(Bt[n]), "v"(At[m]));   \
        else { acc[ai][bj][m][n] = __builtin_amdgcn_mfma_f32_16x16x32_bf16(lo8(Bt[n]), lo8(At[m]), acc[ai][bj][m][n], 0, 0, 0); acc[ai][bj][m][n] = __builtin_amdgcn_mfma_f32_16x16x32_bf16(hi8(Bt[n]), hi8(At[m]), acc[ai][bj][m][n], 0, 0, 0); } } \
        __builtin_amdgcn_s_setprio(0); } while (0)
#define PG8_WAIT_V(n) asm volatile("s_waitcnt vmcnt(" #n ")" ::: "memory")
#define PG8_WAIT_L(n) asm volatile("s_waitcnt lgkmcnt(" #n ")" ::: "memory")
#define PG8_BAR __builtin_amdgcn_s_barrier()
#define PG8_SCHED __builtin_amdgcn_sched_barrier(0)
#define PG8_AOFFS(dst, u) do { _Pragma("unroll") for (int _h = 0; _h < 2; ++_h) _Pragma("unroll") for (int _i = 0; _i < 2; ++_i) { \
        int _row = 128 * _h + Rr[_i]; if (GATHER) { const int _rr = _row < (u).cnt ? _row : 0; _row = S.rowlist[2 * ((u).rows + _rr)] >> 2; } \
        dst[_h][_i] = (unsigned)(_row * RPITCH + Cc[_i] * 2); } } while (0)
#define PG8_AREQ(raw, u) do { _Pragma("unroll") for (int _h = 0; _h < 2; ++_h) _Pragma("unroll") for (int _i = 0; _i < 2; ++_i) { \
        const int _row = 128 * _h + Rr[_i]; const int _rr = _row < (u).cnt ? _row : 0; const int* _p = S.rowlist + 2 * ((u).rows + _rr); \
        asm volatile("global_load_dword %0, %1, off" : "=v"(raw[_h][_i]) : "v"(_p) : "memory"); } } while (0)
#define PG8_AFIN(dst, raw) do { _Pragma("unroll") for (int _h = 0; _h < 2; ++_h) _Pragma("unroll") for (int _i = 0; _i < 2; ++_i) dst[_h][_i] = (unsigned)(((int)raw[_h][_i] >> 2) * RPITCH + Cc[_i] * 2); } while (0)
    GU cur, nxt; int ui = 0;
    if (!S.next(0, cur)) return;
    unsigned araw[2][2] = {{0u, 0u}, {0u, 0u}};
    int donepm = -1;
    typename Epi::Pre pre;
    f32x4 acc[2][2][4][2];
#pragma unroll
    for (int a = 0; a < 2; ++a)
#pragma unroll
        for (int b = 0; b < 2; ++b)
#pragma unroll
            for (int m = 0; m < 4; ++m)
#pragma unroll
                for (int n = 0; n < 2; ++n) acc[a][b][m][n] = (f32x4){0.f, 0.f, 0.f, 0.f};
    v8i32 At[4], B0[2], B1[2];
    unsigned voA[2][2], nvoA[2][2];
    if constexpr (GATHER) { PG8_AOFFS(voA, cur); } else {
#pragma unroll
        for (int h = 0; h < 2; ++h)
#pragma unroll
            for (int i = 0; i < 2; ++i) { voA[h][i] = (unsigned)((128 * h + Rr[i]) * RPITCH + Cc[i] * 2); nvoA[h][i] = voA[h][i]; } }
    const char* cA = S.Abase + cur.a; const char* cB = S.Bbase + cur.b;
    constexpr int KR = Sched::KROT;
    constexpr size_t kr0 = (size_t)KR * kstep;
    PG8_STAGE(PG8_SB(0, 0), cB + kr0, voffB); PG8_STAGE(PG8_SB(0, 1), cB + kr0 + hstepB, voffB); PG8_STAGE(PG8_SA(0, 0), cA + kr0, voA[0]); PG8_STAGE(PG8_SA(0, 1), cA + kr0, voA[1]);
    if (wr == 1) PG8_BAR;
    PG8_WAIT_V(2); PG8_BAR;
    PG8_STAGE(PG8_SB(1, 0), cB + kr0 + kstep, voffB); PG8_STAGE(PG8_SA(1, 0), cA + kr0 + kstep, voA[0]); PG8_STAGE(PG8_SB(1, 1), cB + kr0 + hstepB + kstep, voffB);
    PG8_WAIT_V(6); PG8_BAR;
    for (;;) {
        const bool has_next = S.next(ui + 1, nxt);
        const char* nA = has_next ? S.Abase + nxt.a : cA; const char* nB = has_next ? S.Bbase + nxt.b : cB;

        PROBE_BEGIN(1) PROBE_BEGIN(11)
#pragma unroll 1
        for (int t = 0; t < nt; t += 2) {
            const bool last = (t == nt - 2);
            if constexpr (Sched::HAS_KDEP) { if (t == nt / 2 - 2) S.k_ready(cur, wid); }
            const char* a1 = cA + (size_t)((t + 1 + KR) & (nt - 1)) * kstep;
            const char* a2 = last ? nA + kr0 : cA + (size_t)((t + 2 + KR) & (nt - 1)) * kstep; const char* b2 = last ? nB + kr0 : cB + (size_t)((t + 2 + KR) & (nt - 1)) * kstep;
            const char* a3 = a2 + kstep; const char* b3 = b2 + kstep;
            unsigned vo2[2][2];
            if constexpr (GATHER) {
                if (t == nt - 4 && has_next) { PG8_AREQ(araw, nxt); }
                if (last && has_next) { asm volatile("s_waitcnt vmcnt(16)" : "+v"(araw[0][0]), "+v"(araw[0][1]), "+v"(araw[1][0]), "+v"(araw[1][1]) :: "memory"); PG8_AFIN(nvoA, araw); } }
#pragma unroll
            for (int h = 0; h < 2; ++h)
#pragma unroll
                for (int i = 0; i < 2; ++i) vo2[h][i] = GATHER ? ((last && has_next) ? nvoA[h][i] : voA[h][i]) : voA[h][i];
            if constexpr (Sched::HAS_DEP) { if (last && has_next) S.a_ready(ui + 1, nxt, wid); }
            if constexpr (Epi::HAS_MID) { if (t == nt / 2) E.mid(acc, cur, wr, wc); }
            if constexpr (Epi::HAS_PRE) { if (last) E.prefetch(pre, cur, wr, wc); }
            const bool relax = Epi::NSTORE > 0 && ui > 0 && t == 0;
            const bool hfu = cur.cnt <= 128;
            PG8_LDB(B0, 0, 0); PG8_LDB(B1, 0, 1); PG8_SCHED; PG8_LDA(At, 0, 0); PG8_STAGE(PG8_SA(1, 1), a1, voA[1]);
            if (relax) asm volatile("s_waitcnt vmcnt(%0)" :: "n"(8 + Epi::NSTORE) : "memory"); else PG8_WAIT_V(8);
            PG8_WAIT_L(0); PG8_BAR; PG8_MMA(0, 0, At, B0); PG8_MMA(0, 1, At, B1); PG8_BAR; PG8_SCHED;
            if (!hfu) PG8_LDA(At, 0, 1);
            PG8_STAGE(PG8_SB(0, 0), b2, voffB); PG8_STAGE(PG8_SB(0, 1), b2 + hstepB, voffB); PG8_STAGE(PG8_SA(0, 0), a2, vo2[0]);
            if (relax) asm volatile("s_waitcnt vmcnt(%0)" :: "n"(8 + Epi::NSTORE) : "memory"); else PG8_WAIT_V(8);
            PG8_WAIT_L(0); PG8_BAR; if (!hfu) { PG8_MMA(1, 0, At, B0); PG8_MMA(1, 1, At, B1); } PG8_BAR; PG8_SCHED;
            PG8_LDB(B0, 1, 0); PG8_LDB(B1, 1, 1); PG8_SCHED; PG8_LDA(At, 1, 0); PG8_STAGE(PG8_SA(0, 1), a2, vo2[1]);
            PG8_WAIT_V(8); PG8_WAIT_L(0); PG8_BAR; PG8_MMA(0, 0, At, B0); PG8_MMA(0, 1, At, B1); PG8_BAR; PG8_SCHED;
            if (!hfu) PG8_LDA(At, 1, 1);
            PG8_STAGE(PG8_SB(1, 0), b3, voffB); PG8_STAGE(PG8_SB(1, 1), b3 + hstepB, voffB); PG8_STAGE(PG8_SA(1, 0), a3, vo2[0]);
            PG8_WAIT_V(8); PG8_WAIT_L(0); PG8_BAR; if (!hfu) { PG8_MMA(1, 0, At, B0); PG8_MMA(1, 1, At, B1); } PG8_BAR; PG8_SCHED;
        }
        if (FP8 && GATHER && wid == 0) PROBE_END(1, lds + MISC_OFF); if (FP8 && !GATHER && wid == 0) PROBE_END(11, lds + MISC_OFF);
        PROBE_BEGIN(2) PROBE_BEGIN(12)
        if constexpr (Sched::HAS_DONE) { if (donepm >= 0) S.done_nodrain(donepm); }
        if (wr == 0) PG8_BAR;
        if constexpr (FP8) asm volatile("s_nop 15\n\ts_nop 7" ::: "memory");
        if constexpr (Epi::HAS_PRE) { E.wait(pre); E(acc, cur, wr, wc, pre); } else E(acc, cur, wr, wc);
        if constexpr (Sched::HAS_DONE) donepm = cur.pm;
        if (FP8 && GATHER && wid == 0) PROBE_END(2, lds + MISC_OFF); if (FP8 && !GATHER && wid == 0) PROBE_END(12, lds + MISC_OFF);
        if (!has_next) break;
#pragma unroll
        for (int a = 0; a < 2; ++a)
#pragma unroll
            for (int b = 0; b < 2; ++b)
#pragma unroll
                for (int m = 0; m < 4; ++m)
#pragma unroll
                    for (int n = 0; n < 2; ++n) acc[a][b][m][n] = (f32x4){0.f, 0.f, 0.f, 0.f};
        cur = nxt; cA = nA; cB = nB; ++ui;
        if constexpr (GATHER) {
#pragma unroll
        for (int h = 0; h < 2; ++h)
#pragma unroll
            for (int i = 0; i < 2; ++i) voA[h][i] = nvoA[h][i]; }
        if (wr == 1) PG8_BAR;
    }
    PG8_WAIT_V(0);
    if constexpr (Sched::HAS_DONE) { if (donepm >= 0) S.done_nodrain(donepm); }
    PG8_BAR;
#undef PG8_SA
#undef PG8_SB
#undef PG8_STAGE
#undef PG8_LDA
#undef PG8_LDB
#undef PG8_MMA
#undef PG8_WAIT_V
#undef PG8_WAIT_L
#undef PG8_BAR
#undef PG8_SCHED
#undef PG8_AOFFS
}
}

namespace attn_body {
using bf16x8=__attribute__((ext_vector_type(8)))short;
using s16x4=__attribute__((ext_vector_type(4)))short;
using f32x16=__attribute__((ext_vector_type(16)))float;
using u32x4=__attribute__((ext_vector_type(4)))unsigned;
constexpr int D=64;
constexpr int NW=8,QBLK=32,QB=QBLK*NW,KVBLK=64;
__device__ __forceinline__ int crow(int r,int hi){return (r&3)+8*(r>>2)+4*hi;}
#define SBAR() __builtin_amdgcn_sched_barrier(0)
constexpr int NSLOT=3, SLOTB=8192;
constexpr int LDS_K=0, LDS_V=NSLOT*SLOTB, LDS_WS=2*NSLOT*SLOTB, LDS_OST=LDS_WS+NW*64*4, LDS_BYTES=LDS_OST+NW*4096;
__device__ __forceinline__ void glds16(const void*gsrc,unsigned lds_dst){unsigned keep;
  asm volatile("s_mov_b32 %0, m0\n\ts_mov_b32 m0, %2\n\ts_nop 0\n\tglobal_load_lds_dwordx4 %1, off\n\ts_mov_b32 m0, %0":"=&s"(keep):"v"(gsrc),"s"(lds_dst):"memory");}
__device__ __forceinline__ float max3f(float a,float b,float c){float r;asm("v_max3_f32 %0, %1, %2, %3":"=v"(r):"v"(a),"v"(b),"v"(c));return r;}
__device__ __forceinline__ float max2f(float a,float b){float r;asm("v_max_f32_e32 %0, %1, %2":"=v"(r):"v"(a),"v"(b));return r;}
__device__ __forceinline__ float fadd_s(float a,float b){float r;asm("v_add_f32_e32 %0, %1, %2":"=v"(r):"v"(a),"v"(b));return r;}
__device__ __forceinline__ float fsub_s(float a,float b){float r;asm("v_sub_f32_e32 %0, %1, %2":"=v"(r):"v"(a),"v"(b));return r;}
__device__ __forceinline__ unsigned cvtpk_s(float lo,float hi){f32x2_t v={lo,hi};bf16x2_t b=__builtin_convertvector(v,bf16x2_t);return __builtin_bit_cast(unsigned,b);}
#define WAIT_BAR(N) asm volatile("s_waitcnt vmcnt(" #N ") lgkmcnt(0)\n\ts_barrier":::"memory")
__device__ __forceinline__ void qkt(f32x16&p0,f32x16&p1,const char*Kslot,const bf16x8*qr,const f32x16&negm,int r32,int hi){
  const char*kb=Kslot+hi*1024+r32*16;
  #pragma unroll
  for(int d0=0;d0<4;++d0){
    const bf16x8 b0=*reinterpret_cast<const bf16x8*>(kb+d0*2048);
    const bf16x8 b1=*reinterpret_cast<const bf16x8*>(kb+d0*2048+512);
    if(d0==0){p0=__builtin_amdgcn_mfma_f32_32x32x16_bf16(b0,qr[0],negm,0,0,0);p1=__builtin_amdgcn_mfma_f32_32x32x16_bf16(b1,qr[0],negm,0,0,0);}
    else{p0=__builtin_amdgcn_mfma_f32_32x32x16_bf16(b0,qr[d0],p0,0,0,0);p1=__builtin_amdgcn_mfma_f32_32x32x16_bf16(b1,qr[d0],p1,0,0,0);}}
}
typedef __attribute__((address_space(3))) const char* lds_cptr;
typedef short v4i16_t __attribute__((ext_vector_type(4)));
__device__ __forceinline__ void kload8(bf16x8*kf,lds_cptr kp){
  kf[0]=*(const __attribute__((address_space(3))) bf16x8*)(kp);      kf[1]=*(const __attribute__((address_space(3))) bf16x8*)(kp+512);
  kf[2]=*(const __attribute__((address_space(3))) bf16x8*)(kp+2048); kf[3]=*(const __attribute__((address_space(3))) bf16x8*)(kp+2560);
  kf[4]=*(const __attribute__((address_space(3))) bf16x8*)(kp+4096); kf[5]=*(const __attribute__((address_space(3))) bf16x8*)(kp+4608);
  kf[6]=*(const __attribute__((address_space(3))) bf16x8*)(kp+6144); kf[7]=*(const __attribute__((address_space(3))) bf16x8*)(kp+6656);
}
__device__ __forceinline__ void kload2(bf16x8*kf,lds_cptr kp,int j){ kf[2*j]=*(const __attribute__((address_space(3))) bf16x8*)(kp+j*2048); kf[2*j+1]=*(const __attribute__((address_space(3))) bf16x8*)(kp+j*2048+512); }
__device__ __forceinline__ s16x4 vtr(lds_cptr p){ return __builtin_bit_cast(s16x4,__builtin_amdgcn_ds_read_tr16_b64_v4i16((__attribute__((address_space(3))) v4i16_t*)p)); }
__device__ __forceinline__ float rowmax(const f32x16&p0,const f32x16&p1){
  float a=max3f(p0[0],p0[1],p1[0]),b=max3f(p0[2],p0[3],p1[1]);a=max3f(a,p1[2],p1[3]);
  #pragma unroll
  for(int r=4;r<16;r+=4){a=max3f(a,p0[r],p0[r+1]);b=max3f(b,p0[r+2],p0[r+3]);a=max3f(a,p1[r],p1[r+1]);b=max3f(b,p1[r+2],p1[r+3]);}
  const float m=max2f(a,b);
  auto rr=__builtin_amdgcn_permlane32_swap(__float_as_uint(m),__float_as_uint(m),false,false);
  return max2f(__uint_as_float(rr[0]),__uint_as_float(rr[1]));
}
__device__ __forceinline__ void pv(f32x16*o,int vb,bf16x8 pa0,bf16x8 pa1,bf16x8 pa2,bf16x8 pa3){
  #pragma unroll
  for(int d0=0;d0<2;++d0){s16x4 lo[4],hi[4];
    #pragma unroll
    for(int ks=0;ks<4;++ks){
      asm volatile("ds_read_b64_tr_b16 %0,%1 offset:%c2":"=&v"(lo[ks]):"v"(vb),"i"(d0*4096+ks*1024):"memory");
      asm volatile("ds_read_b64_tr_b16 %0,%1 offset:%c2":"=&v"(hi[ks]):"v"(vb),"i"(d0*4096+ks*1024+512):"memory");}
    asm volatile("s_waitcnt lgkmcnt(0)":::"memory");SBAR();
    #define PK(k) (bf16x8){lo[k][0],lo[k][1],lo[k][2],lo[k][3],hi[k][0],hi[k][1],hi[k][2],hi[k][3]}
    o[d0]=__builtin_amdgcn_mfma_f32_32x32x16_bf16(pa0,PK(0),o[d0],0,0,0);
    o[d0]=__builtin_amdgcn_mfma_f32_32x32x16_bf16(pa1,PK(1),o[d0],0,0,0);
    o[d0]=__builtin_amdgcn_mfma_f32_32x32x16_bf16(pa2,PK(2),o[d0],0,0,0);
    o[d0]=__builtin_amdgcn_mfma_f32_32x32x16_bf16(pa3,PK(3),o[d0],0,0,0);
    #undef PK
  }
}
#define ATTN_STORE16(p,v) (*(u32x4*)(p)=(v))
constexpr int QP=512, KVP=128, OP=1024;
constexpr int GQ_NJ=8, GQ_ND=3, GQ_NH=2*(GQ_NJ+GQ_ND);
template<int THRL,bool FAST> __device__ __forceinline__ void gqa_unit(int b,int h,int qb,const bf16*Q,const bf16*__restrict__ K,const bf16*__restrict__ V,bf16*O,char*shm,int wid_in,unsigned*cntO,const float*sW,unsigned char*sWT,int sitem0,const float*sWd,unsigned char*sWTd,int sitemD){
  const int lane=lane_now(),r32=lane&31,hi=lane>>5; const int wid=wid_in;
  const int q0=qb*QB; const int kvh=h>>2;
  const bf16*Qw=Q+((long)b*SEQ+q0+wid*QBLK)*QP+h*D;
  const unsigned lds0=(unsigned)(uintptr_t)shm;
  float*wsf=(float*)(shm+LDS_WS)+wid*64;
  #define TROW(t) ((t)<64?(long)b*SEQ+(long)(t)*64:(long)T+(long)b*CTXL+(long)((t)-64)*64)
  const bf16*ksrc=K+(long)lane*KVP+kvh*D+wid*8;
  const bf16*vsrc=V+(long)(16*(wid&3)+(lane>>2))*KVP+kvh*D+(wid>>2)*32+(lane&3)*8;
  const unsigned kdst=lds0+LDS_K+wid*1024, vdst=lds0+LDS_V+wid*1024;
  #define DMA_K(t,slot) glds16(ksrc+TROW(t)*KVP,(unsigned)__builtin_amdgcn_readfirstlane(kdst+(slot)))
  #define DMA_V(t,slot) glds16(vsrc+TROW(t)*KVP,(unsigned)__builtin_amdgcn_readfirstlane(vdst+(slot)))
  const int vb0=(int)(lds0+LDS_V)+((lane>>4)&1)*32+(lane&3)*8+(4*hi+((lane&15)>>2))*64;
  const char*Kbase=shm+LDS_K; bf16x8 kf[8];
  const lds_cptr shm3=(lds_cptr)shm; const lds_cptr kp0=shm3+LDS_K+hi*1024+r32*16; const lds_cptr vp0=shm3+LDS_V+((lane>>4)&1)*32+(lane&3)*8+(4*hi+((lane&15)>>2))*64;
  constexpr int NT=(SEQ+CTXL)/KVBLK;
  DMA_K(0,0);DMA_V(0,0);DMA_K(1,SLOTB);
  bf16x8 qr[4];
  #pragma unroll
  for(int d0=0;d0<4;++d0)qr[d0]=*reinterpret_cast<const bf16x8*>(&Qw[(long)r32*QP+d0*16+hi*8]);
  float mhat=0.f,l_reg=0.f;f32x16 o[2];o[0]=f32x16{};o[1]=f32x16{};f32x16 negm=f32x16{};asm volatile("":"+v"(negm));
  bool resc=false;
  #define NEGM (FAST?f32x16{}:negm)
  #define START(P0,P1) do{ resc=false; \
    if(!FAST){ const float rm=rowmax(P0,P1); const float dl=rm; mhat=fadd_s(mhat,dl); \
      _Pragma("unroll") for(int r=0;r<16;++r){P0[r]=fsub_s(P0[r],dl);P1[r]=fsub_s(P1[r],dl);} \
      _Pragma("unroll") for(int r=0;r<16;++r)negm[r]=-mhat; asm volatile("":"+v"(negm)); } \
    _Pragma("unroll") for(int r=0;r<16;++r)P0[r]=__builtin_amdgcn_exp2f(P0[r]); }while(0)
  #define RESC() do{ if(!FAST&&resc){ asm volatile("s_waitcnt lgkmcnt(0)":::"memory"); \
      _Pragma("unroll") for(int d_=0;d_<2;++d_) _Pragma("unroll") for(int r=0;r<16;++r)o[d_][r]*=wsf[crow(r,hi)]; } }while(0)
  f32x16 pA0,pA1,pB0,pB1;
  int sl_prev=0,sl_cur=0,sl_next=SLOTB;
  #define ROT() do{sl_prev=sl_cur;sl_cur=sl_next;sl_next=(sl_next==(NSLOT-1)*SLOTB)?0:sl_next+SLOTB;}while(0)
  DMA_K(2,2*SLOTB);
  WAIT_BAR(3);
  qkt(pA0,pA1,Kbase,qr,negm,r32,hi);asm volatile("s_nop 15\n\ts_nop 7":"+v"(pA0),"+v"(pA1));
  START(pA0,pA1);
  _Pragma("unroll") for(int r=0;r<16;++r)pA1[r]=__builtin_amdgcn_exp2f(pA1[r]);
  WAIT_BAR(0);
  DMA_K(3,0);DMA_V(1,SLOTB);
  ROT();
  kload8(kf,kp0+sl_cur);
  WAIT_BAR(2);
  s16x4 vlo[8],vhi[8]; u32x4 pw0,pw1,pw2,pw3;
  #define PKW(P,B) cvtpk_s(P[B],P[B+1])
  #define PAF(k) __builtin_bit_cast(bf16x8,pw##k)
  #define VFR(i) (bf16x8){vlo[i][0],vlo[i][1],vlo[i][2],vlo[i][3],vhi[i][0],vhi[i][1],vhi[i][2],vhi[i][3]}
  #define PIN(x) asm volatile("":"+v"(x))
  #define MX3(a,b,c) __builtin_fmaxf(__builtin_fmaxf((a),(b)),(c))
  #define GAPA(MF,A0,A1,A2,A3,W0,W1,PW) do{ MF; sacc+=A0; sacc+=A1; sacc+=A2; sacc+=A3; PIN(sacc); W0; W1; PIN(PW); SBAR(); }while(0)
  #define EX(v) __builtin_amdgcn_exp2f(v)
  #define GAPB(MF,X,B) do{ MF; X[B]=EX(X[B]); X[B+1]=EX(X[B+1]); X[B+2]=EX(X[B+2]); X[B+3]=EX(X[B+3]); PIN(X); SBAR(); }while(0)
  #define VRD(i) do{ vlo[i]=vtr(vp_+(((i)>>2)*4096+((i)&3)*1024)); vhi[i]=vtr(vp_+(((i)>>2)*4096+((i)&3)*1024+512)); }while(0)
  #define KRD(G,j) do{ if(G){ kload2(kf,kp0+sl_next,j); SBAR(); } }while(0)
  #define STEP(C0,C1,P0,P1,t,GK,GV,GL,HOOK) do{ SBAR(); \
    const lds_cptr vp_=vp0+sl_prev; \
    VRD(0); SBAR(); float sacc=(P0[0]+P0[1]); \
    GAPA(C0=__builtin_amdgcn_mfma_f32_32x32x16_bf16(kf[0],qr[0],NEGM,0,0,0), P0[2],P0[3],P0[4],P0[5],     pw0[0]=PKW(P0,0), pw0[1]=PKW(P0,2), pw0); \
    VRD(4); SBAR(); GAPA(C1=__builtin_amdgcn_mfma_f32_32x32x16_bf16(kf[1],qr[0],NEGM,0,0,0), P0[6],P0[7],P0[8],P0[9],     pw0[2]=PKW(P0,4), pw0[3]=PKW(P0,6), pw0); \
    VRD(1); SBAR(); GAPA(C0=__builtin_amdgcn_mfma_f32_32x32x16_bf16(kf[2],qr[1],C0,0,0,0),   P0[10],P0[11],P0[12],P0[13], pw1[0]=PKW(P0,8), pw1[1]=PKW(P0,10), pw1); \
    VRD(5); SBAR(); GAPA(C1=__builtin_amdgcn_mfma_f32_32x32x16_bf16(kf[3],qr[1],C1,0,0,0),   P0[14],P0[15],P1[0],P1[1],   pw1[2]=PKW(P0,12),pw1[3]=PKW(P0,14), pw1); \
    VRD(2); SBAR(); GAPA(C0=__builtin_amdgcn_mfma_f32_32x32x16_bf16(kf[4],qr[2],C0,0,0,0),   P1[2],P1[3],P1[4],P1[5],     pw2[0]=PKW(P1,0), pw2[1]=PKW(P1,2), pw2); \
    VRD(6); SBAR(); GAPA(C1=__builtin_amdgcn_mfma_f32_32x32x16_bf16(kf[5],qr[2],C1,0,0,0),   P1[6],P1[7],P1[8],P1[9],     pw2[2]=PKW(P1,4), pw2[3]=PKW(P1,6), pw2); \
    VRD(3); SBAR(); GAPA(C0=__builtin_amdgcn_mfma_f32_32x32x16_bf16(kf[6],qr[3],C0,0,0,0),   P1[10],P1[11],P1[12],P1[13], pw3[0]=PKW(P1,8), pw3[1]=PKW(P1,10), pw3); \
    VRD(7); SBAR(); GAPA(C1=__builtin_amdgcn_mfma_f32_32x32x16_bf16(kf[7],qr[3],C1,0,0,0),   P1[14],P1[15],0.f,0.f,       pw3[2]=PKW(P1,12),pw3[3]=PKW(P1,14), pw3); \
    l_reg+=sacc; \
    if(GK){DMA_K((t)+3,sl_cur);} if(GV){DMA_V((t)+1,sl_next);} HOOK; \
    if(!FAST){ float a=MX3(C0[0],C0[1],C1[0]),b=MX3(C0[2],C0[3],C1[1]); a=MX3(a,C1[2],C1[3]); \
      _Pragma("unroll") for(int r=4;r<16;r+=4){a=MX3(a,C0[r],C0[r+1]);b=MX3(b,C0[r+2],C0[r+3]);a=MX3(a,C1[r],C1[r+1]);b=MX3(b,C1[r+2],C1[r+3]);} \
      float rm=__builtin_fmaxf(a,b); { auto rr=__builtin_amdgcn_permlane32_swap(__float_as_uint(rm),__float_as_uint(rm),false,false); rm=__builtin_fmaxf(__uint_as_float(rr[0]),__uint_as_float(rr[1])); } \
      resc=false; \
      if(__builtin_expect(__any(rm>(float)THRL),0)){ const float dl=__builtin_fmaxf(rm,0.f); mhat+=dl; \
        _Pragma("unroll") for(int r=0;r<16;++r){C0[r]-=dl;C1[r]-=dl;} \
        _Pragma("unroll") for(int r=0;r<16;++r)negm[r]=-mhat; asm volatile("":"+v"(negm)); \
        const float f=__builtin_amdgcn_exp2f(-dl); l_reg*=f; if(hi==0)wsf[r32]=f; resc=true; } } \
    SBAR(); \
    GAPB(o[0]=__builtin_amdgcn_mfma_f32_32x32x16_bf16(PAF(0),VFR(0),o[0],0,0,0), C0,0); \
    GAPB(o[1]=__builtin_amdgcn_mfma_f32_32x32x16_bf16(PAF(0),VFR(4),o[1],0,0,0), C0,4); \
    KRD(GL,0); GAPB(o[0]=__builtin_amdgcn_mfma_f32_32x32x16_bf16(PAF(1),VFR(1),o[0],0,0,0), C0,8); \
    KRD(GL,1); GAPB(o[1]=__builtin_amdgcn_mfma_f32_32x32x16_bf16(PAF(1),VFR(5),o[1],0,0,0), C0,12); \
    KRD(GL,2); GAPB(o[0]=__builtin_amdgcn_mfma_f32_32x32x16_bf16(PAF(2),VFR(2),o[0],0,0,0), C1,0); \
    KRD(GL,3); GAPB(o[1]=__builtin_amdgcn_mfma_f32_32x32x16_bf16(PAF(2),VFR(6),o[1],0,0,0), C1,4); \
    GAPB(o[0]=__builtin_amdgcn_mfma_f32_32x32x16_bf16(PAF(3),VFR(3),o[0],0,0,0), C1,8); \
    GAPB(o[1]=__builtin_amdgcn_mfma_f32_32x32x16_bf16(PAF(3),VFR(7),o[1],0,0,0), C1,12); \
    }while(0)
  f32x4 sv[4], sv2[4]; unsigned sw[4];
  #pragma unroll
  for(int i=0;i<4;++i){sv[i]=(f32x4){0.f,0.f,0.f,0.f};sv2[i]=(f32x4){0.f,0.f,0.f,0.f};sw[i]=0u;}
  #define GQ_DN(bi) (((bi)>>1)>=GQ_NJ)
  #define GQ_I(bi) (GQ_DN(bi)?sitemD+((bi)>>1)-GQ_NJ:sitem0+((bi)>>1))
  #define GQ_LNB(bi) (GQ_DN(bi)?5:6)
  #define GQ_E(bi) (GQ_I(bi)>>(4+GQ_LNB(bi)))
  #define GQ_KB(bi) ((GQ_I(bi)>>GQ_LNB(bi))&15)
  #define GQ_NB(bi) (GQ_I(bi)&((1<<GQ_LNB(bi))-1))
  #define GQ_SBASE(bi) ((const char*)(GQ_DN(bi)?sWd:sW)+(((((size_t)GQ_E(bi)*1024+(size_t)(64*GQ_KB(bi)+4*((bi)&1)))<<(5+GQ_LNB(bi)))+(size_t)(32*GQ_NB(bi)))<<2))
  #define GQ_DBASE(bi) ((GQ_DN(bi)?sWTd:sWT)+((size_t)GQ_E(bi)<<(15+GQ_LNB(bi)))+(size_t)(32*GQ_NB(bi))*1024+64*GQ_KB(bi))
  #define GQ_ISSUE(bi) do{ const int l_=lane_now(); const unsigned vo_=((unsigned)(l_>>3)<<(10+GQ_LNB(bi)))|((unsigned)(l_&7)<<4); const char*sb_=GQ_SBASE(bi); \
      _Pragma("unroll") for(int i=0;i<4;++i){ const char*sbi_=sb_+((size_t)i<<(7+GQ_LNB(bi))); asm volatile("global_load_dwordx4 %0, %1, %2 nt":"=v"(sv[i]):"v"(vo_),"s"(sbi_):"memory"); } }while(0)
  #define GQ_CONSUME(bi) do{ const f32x4 t0_=sv[0]*W8_SCALE,t1_=sv[1]*W8_SCALE,t2_=sv[2]*W8_SCALE,t3_=sv[3]*W8_SCALE; \
      if(((bi)&1)==0){ _Pragma("unroll") for(int j=0;j<4;++j)sw[j]=pk4_fp8(t0_[j],t1_[j],t2_[j],t3_[j]); } \
      else { const int l_=lane_now(); const unsigned do_=((unsigned)(l_&7)<<12)|((unsigned)(l_>>3)<<3); unsigned char*db_=GQ_DBASE(bi); \
        _Pragma("unroll") for(int j=0;j<4;++j){ u32x2 ow; ow.x=sw[j]; ow.y=pk4_fp8(t0_[j],t1_[j],t2_[j],t3_[j]); *(u32x2*)(db_+do_+j*1024)=ow; } } }while(0)
  #define GQ_ISSUE2(bi,par) do{ const int l_=lane_now(); const unsigned vo_=((unsigned)(l_>>3)<<(10+GQ_LNB(bi)))|((unsigned)(l_&7)<<4); const char*sb_=GQ_SBASE(bi); \
      const char*s1_=sb_+((size_t)1<<(7+GQ_LNB(bi))); const char*s2_=sb_+((size_t)2<<(7+GQ_LNB(bi))); const char*s3_=sb_+((size_t)3<<(7+GQ_LNB(bi))); const int par_=(par); \
      asm volatile("s_cmp_lg_u32 %13, 0\n\ts_cbranch_scc1 .Lgq2_%=\n\t" \
        "global_load_dwordx4 %0, %8, %9 nt\n\tglobal_load_dwordx4 %1, %8, %10 nt\n\tglobal_load_dwordx4 %2, %8, %11 nt\n\tglobal_load_dwordx4 %3, %8, %12 nt\n\ts_branch .Lgq3_%=\n" \
        ".Lgq2_%=:\n\tglobal_load_dwordx4 %4, %8, %9 nt\n\tglobal_load_dwordx4 %5, %8, %10 nt\n\tglobal_load_dwordx4 %6, %8, %11 nt\n\tglobal_load_dwordx4 %7, %8, %12 nt\n" \
        ".Lgq3_%=:" \
        :"+v"(sv[0]),"+v"(sv[1]),"+v"(sv[2]),"+v"(sv[3]),"+v"(sv2[0]),"+v"(sv2[1]),"+v"(sv2[2]),"+v"(sv2[3]) \
        :"v"(vo_),"s"(sb_),"s"(s1_),"s"(s2_),"s"(s3_),"s"(par_):"memory","scc"); }while(0)
  #define GQ_CONSUME_B(bi,SV) do{ const f32x4 t0_=SV[0]*W8_SCALE,t1_=SV[1]*W8_SCALE,t2_=SV[2]*W8_SCALE,t3_=SV[3]*W8_SCALE; \
      if(((bi)&1)==0){ _Pragma("unroll") for(int j=0;j<4;++j)sw[j]=pk4_fp8(t0_[j],t1_[j],t2_[j],t3_[j]); } \
      else { const int l_=lane_now(); const unsigned do_=((unsigned)(l_&7)<<12)|((unsigned)(l_>>3)<<3); unsigned char*db_=GQ_DBASE(bi); \
        _Pragma("unroll") for(int j=0;j<4;++j){ u32x2 ow; ow.x=sw[j]; ow.y=pk4_fp8(t0_[j],t1_[j],t2_[j],t3_[j]); *(u32x2*)(db_+do_+j*1024)=ow; } } }while(0)
  #define GQ_ALLSV "+v"(sv[0]),"+v"(sv[1]),"+v"(sv[2]),"+v"(sv[3]),"+v"(sv2[0]),"+v"(sv2[1]),"+v"(sv2[2]),"+v"(sv2[3])
  int t=1;
  #pragma unroll 1
  for(;t+5<NT;t+=2){
    const int it=(t-1)>>1;
    if(FAST){
      STEP(pB0,pB1,pA0,pA1,t,true,true,true,);
      { const bool bt_=sW!=nullptr&&it>=1&&it-1<GQ_NH, st_=sW!=nullptr&&it>=2&&it-2<GQ_NH&&((it-2)&1);
        const int cn_=2+(bt_?4:0)+(st_?4:0);
        if(cn_<=2){ asm volatile("s_waitcnt vmcnt(2)":::"memory"); } else if(cn_<=6){ asm volatile("s_waitcnt vmcnt(6)":::"memory"); }
        asm volatile("s_waitcnt vmcnt(10) lgkmcnt(0)\n\ts_barrier":GQ_ALLSV::"memory"); }
      RESC(); ROT();
      STEP(pA0,pA1,pB0,pB1,t+1,true,true,true, if(sW!=nullptr&&it<GQ_NH){ GQ_ISSUE2(it,it&1); });
      { if(!(sW!=nullptr&&it<GQ_NH)){ asm volatile("s_waitcnt vmcnt(2)":::"memory"); }
        asm volatile("s_waitcnt vmcnt(6) lgkmcnt(0)\n\ts_barrier":GQ_ALLSV::"memory"); }
      if(sW!=nullptr&&it>=1&&it<=GQ_NH){ if((it-1)&1){ GQ_CONSUME_B(it-1,sv2); } else { GQ_CONSUME_B(it-1,sv); } }
      RESC(); ROT();
    } else {
    STEP(pB0,pB1,pA0,pA1,t,true,true,true,);
    if(sW==nullptr||it<1||it>GQ_NH){ asm volatile("s_waitcnt vmcnt(2)":::"memory"); } else if(!((it&1)&&it>=3)){ asm volatile("s_waitcnt vmcnt(6)":::"memory"); }
    asm volatile("s_waitcnt vmcnt(10) lgkmcnt(0)\n\ts_barrier":"+v"(sv[0]),"+v"(sv[1]),"+v"(sv[2]),"+v"(sv[3])::"memory");
    RESC(); ROT();
    STEP(pA0,pA1,pB0,pB1,t+1,true,true,true,);
    asm volatile("s_waitcnt vmcnt(2) lgkmcnt(0)\n\ts_barrier":"+v"(sv[0]),"+v"(sv[1]),"+v"(sv[2]),"+v"(sv[3])::"memory");
    if(sW!=nullptr){
      if(it>=1&&it<=GQ_NH) GQ_CONSUME(it-1);
      if(it<GQ_NH){
        GQ_ISSUE(it); } }
    RESC(); ROT();
    }
  }
  #undef GQ_ISSUE2
  #undef GQ_CONSUME_B
  #undef GQ_ALLSV
  #undef GQ_SBASE
  #undef GQ_DBASE
  #undef GQ_ISSUE
  #undef GQ_CONSUME
  #undef GQ_DN
  #undef GQ_I
  #undef GQ_LNB
  #undef GQ_E
  #undef GQ_KB
  #undef GQ_NB
  #define ENDW(tt) do{ if((tt)+3<NT){WAIT_BAR(2);} else if((tt)+2<NT){WAIT_BAR(1);} else {WAIT_BAR(0);} }while(0)
  for(;t+1<NT;t+=2){
    STEP(pB0,pB1,pA0,pA1,t,(t+3<NT),(t+1<NT),(t+1<NT),);       ENDW(t);   RESC(); ROT();
    STEP(pA0,pA1,pB0,pB1,t+1,(t+4<NT),(t+2<NT),(t+2<NT),);     ENDW(t+1); RESC(); ROT();
  }
  STEP(pB0,pB1,pA0,pA1,NT-1,false,false,false,); RESC();
  { float sacc=pB0[0]+pB0[1]; _Pragma("unroll") for(int r=2;r<16;++r)sacc+=pB0[r]; _Pragma("unroll") for(int r=0;r<16;++r)sacc+=pB1[r]; l_reg+=sacc;
    pw0=(u32x4){PKW(pB0,0),PKW(pB0,2),PKW(pB0,4),PKW(pB0,6)};pw1=(u32x4){PKW(pB0,8),PKW(pB0,10),PKW(pB0,12),PKW(pB0,14)};pw2=(u32x4){PKW(pB1,0),PKW(pB1,2),PKW(pB1,4),PKW(pB1,6)};pw3=(u32x4){PKW(pB1,8),PKW(pB1,10),PKW(pB1,12),PKW(pB1,14)};
    SBAR(); pv(o,vb0+sl_cur,PAF(0),PAF(1),PAF(2),PAF(3)); }
  #undef PKW
  #undef PAF
  #undef VFR
  #undef PIN
  #undef MX3
  #undef GAPA
  #undef GAPB
  #undef EX
  #undef VRD
  #undef KRD
  #undef STEP
  #undef ENDW
  {auto rr=__builtin_amdgcn_permlane32_swap(__float_as_uint(l_reg),__float_as_uint(l_reg),false,false);l_reg=__uint_as_float(rr[0])+__uint_as_float(rr[1]);}
  if(hi==0)wsf[32+r32]=l_reg;asm volatile("s_waitcnt lgkmcnt(0)":::"memory");
  float rli[16];
  #pragma unroll
  for(int r=0;r<16;++r)rli[r]=__builtin_amdgcn_rcpf(wsf[32+crow(r,hi)]);
  bf16*Ow=O+((long)b*SEQ+q0+wid*QBLK)*OP+512+h*D;
  { bf16*stg=(bf16*)(shm+LDS_OST)+wid*2048;
    #pragma unroll
    for(int r=0;r<16;++r){const int orow=crow(r,hi);
      #pragma unroll
      for(int d0=0;d0<2;++d0)stg[orow*64+d0*32+r32]=(bf16)f2bf(o[d0][r]*rli[r]);}
    asm volatile("s_waitcnt lgkmcnt(0)":::"memory");
    #pragma unroll
    for(int i=0;i<4;++i){const int row=i*8+(lane>>3),ch=lane&7; const u32x4 v=*(const u32x4*)(stg+row*64+ch*8); wt16(O,(unsigned)(((b*SEQ+q0+wid*QBLK+row)*OP+512+h*D+ch*8)*2),v);} }
  if(cntO) panel_signal(cntO+64*((b*SEQ+q0)>>8));
  asm volatile("s_waitcnt lgkmcnt(0)\n\ts_barrier":::"memory");
  #undef DMA_K
  #undef DMA_V
  #undef TROW
  #undef START
  #undef NEGM
  #undef RESC
  #undef ROT
}

template<int MODE,bool FAST> __device__ __forceinline__ void na_softmax(f32x16&p0,f32x16&p1,float&mref,float&lrow,f32x16*o,float*wsf,const float*bp,int c0,int r32,int hi,u32x4*pw){
  #define NA_LIVE0(rr) (MODE!=2||(rr)>=12)
  #define NA_LIVE1(rr) (MODE!=1||(rr)<4)
  if(MODE!=0){
    #pragma unroll
    for(int rr=0;rr<16;++rr){ const int kc0=(rr&3)+8*(rr>>2)+4*hi;
      if(NA_LIVE0(rr))p0[rr]=((unsigned)(kc0-c0)<16u)?p0[rr]+bp[(rr&3)+8*(rr>>2)]:-INFINITY;
      if(NA_LIVE1(rr))p1[rr]=((unsigned)(kc0+32-c0)<16u)?p1[rr]+bp[(rr&3)+8*(rr>>2)+32]:-INFINITY; }
  }
  if(FAST){
    float sacc=0.f;
    #pragma unroll
    for(int rr=0;rr<16;++rr){
      if(NA_LIVE0(rr)){p0[rr]=__builtin_amdgcn_exp2f(p0[rr]);sacc+=p0[rr];}else p0[rr]=0.f;
      if(NA_LIVE1(rr)){p1[rr]=__builtin_amdgcn_exp2f(p1[rr]);sacc+=p1[rr];}else p1[rr]=0.f; }
    lrow+=sacc;
  } else {
  float rm=-INFINITY;
  #pragma unroll
  for(int rr=0;rr<16;++rr){ if(NA_LIVE0(rr))rm=fmaxf(rm,p0[rr]); if(NA_LIVE1(rr))rm=fmaxf(rm,p1[rr]); }
  { auto q=__builtin_amdgcn_permlane32_swap(__float_as_uint(rm),__float_as_uint(rm),false,false); rm=fmaxf(__uint_as_float(q[0]),__uint_as_float(q[1])); }
  if(__any(rm>mref+8.0f)){
    const float mn=fmaxf(mref,rm), f=__builtin_amdgcn_exp2f(mref-mn);
    mref=mn; lrow*=f;
    if(hi==0)wsf[r32]=f;
    asm volatile("s_waitcnt lgkmcnt(0)":::"memory");
    #pragma unroll
    for(int d_=0;d_<2;++d_)
      #pragma unroll
      for(int rr=0;rr<16;++rr)o[d_][rr]*=wsf[crow(rr,hi)];
    asm volatile("s_waitcnt lgkmcnt(0)":::"memory");
  }
  float sacc=0.f;
  #pragma unroll
  for(int rr=0;rr<16;++rr){
    if(NA_LIVE0(rr)){p0[rr]=__builtin_amdgcn_exp2f(p0[rr]-mref);sacc+=p0[rr];}else p0[rr]=0.f;
    if(NA_LIVE1(rr)){p1[rr]=__builtin_amdgcn_exp2f(p1[rr]-mref);sacc+=p1[rr];}else p1[rr]=0.f; }
  lrow+=sacc;
  }
  pw[0]=(u32x4){cvtpk_s(p0[0],p0[1]),cvtpk_s(p0[2],p0[3]),cvtpk_s(p0[4],p0[5]),cvtpk_s(p0[6],p0[7])};
  pw[1]=(u32x4){cvtpk_s(p0[8],p0[9]),cvtpk_s(p0[10],p0[11]),cvtpk_s(p0[12],p0[13]),cvtpk_s(p0[14],p0[15])};
  pw[2]=(u32x4){cvtpk_s(p1[0],p1[1]),cvtpk_s(p1[2],p1[3]),cvtpk_s(p1[4],p1[5]),cvtpk_s(p1[6],p1[7])};
  pw[3]=(u32x4){cvtpk_s(p1[8],p1[9]),cvtpk_s(p1[10],p1[11]),cvtpk_s(p1[12],p1[13]),cvtpk_s(p1[14],p1[15])};
  #undef NA_LIVE0
  #undef NA_LIVE1
}
constexpr int NAP=512;
#ifndef NA_SJ_EVERY
#define NA_SJ_EVERY 2
#endif
constexpr int NA_NSIDE=0;
template<bool FAST> __device__ __forceinline__ void na_unit(int b,int r,const bf16*Q,const bf16*__restrict__ K,const bf16*__restrict__ V,bf16*O,char*shm,const float*rpbl_all,float*wsf_all,int wid_in,const float*sW,unsigned char*sWT,int sitem0,unsigned*cntO){
  const int lane=lane_now(),r32=lane&31,hi=lane>>5; const int h=wid_in;
  char*wl=shm+h*16384; const unsigned lds0=(unsigned)(uintptr_t)wl;
  const float*rpbl=rpbl_all+h*480;
  const int r0=min(max(r-4,0),56);
  const long qrow0=(long)b*SEQ+(long)r*GRIDW;
  bf16x8 qr[2][4];
  #pragma unroll
  for(int qb=0;qb<2;++qb)
    #pragma unroll
    for(int d0=0;d0<4;++d0)qr[qb][d0]=*reinterpret_cast<const bf16x8*>(&Q[(qrow0+qb*32+r32)*NAP+h*D+d0*16+hi*8]);
  f32x16 o[2][2]; float mrow[2],lrow[2];
  #pragma unroll
  for(int qb=0;qb<2;++qb){o[qb][0]=f32x16{};o[qb][1]=f32x16{};mrow[qb]=-INFINITY;lrow[qb]=0.f;}
  float*wsf=wsf_all+h*64;
  const f32x16 zero=f32x16{};
  const int vb0=(int)(lds0+8192)+((lane>>4)&1)*32+(lane&3)*8+(4*hi+((lane&15)>>2))*64;
  #define NA_KROW0(tt) ((tt)<8?(long)b*SEQ+(long)(r0+(tt))*GRIDW:(long)T+(long)b*CTXL+(long)((tt)-8)*64)
  #define NA_DMA_K(tt) do{ const long kr_=NA_KROW0(tt); _Pragma("unroll") for(int c=0;c<8;++c)glds16(K+(kr_+lane)*NAP+h*D+c*8,lds0+c*1024); }while(0)
  #define NA_DMA_V(tt) do{ const long kr_=NA_KROW0(tt); _Pragma("unroll") for(int p=0;p<8;++p)glds16(V+(kr_+16*(p&3)+(lane>>2))*NAP+h*D+(p>>2)*32+(lane&3)*8,lds0+8192+p*1024); }while(0)
  NA_DMA_K(0); NA_DMA_V(0);
  #pragma unroll
  for(int qb=0;qb<2;++qb)
    #pragma unroll
    for(int d0=0;d0<4;++d0)asm volatile("":"+v"(qr[qb][d0]));
  f32x4 sv[4]; unsigned sw[4];
  #pragma unroll
  for(int i=0;i<4;++i){sv[i]=(f32x4){0.f,0.f,0.f,0.f};sw[i]=0u;}
  #define NA_SJ_I(bi) (sitem0+((bi)>>1))
  #define NA_SJ_SBASE(bi) ((const char*)sW+((((size_t)(NA_SJ_I(bi)>>10)*1024+(size_t)(64*((NA_SJ_I(bi)&1023)>>6)+4*((bi)&1)))*2048+(size_t)(32*(NA_SJ_I(bi)&63)))<<2))
  #define NA_SJ_DBASE(bi) (sWT+((size_t)(NA_SJ_I(bi)>>10)<<21)+(size_t)(32*(NA_SJ_I(bi)&63))*1024+64*((NA_SJ_I(bi)&1023)>>6))
  #define NA_SJ_ISSUE(bi) do{ const int l_=lane_now(); const unsigned vo_=((unsigned)(l_>>3)<<16)|((unsigned)(l_&7)<<4); const char*sb_=NA_SJ_SBASE(bi); \
      _Pragma("unroll") for(int i=0;i<4;++i){ const char*sbi_=sb_+((size_t)i<<13); asm volatile("global_load_dwordx4 %0, %1, %2 nt":"=v"(sv[i]):"v"(vo_),"s"(sbi_):"memory"); } }while(0)
  #define NA_SJ_CONSUME(bi) do{ const f32x4 t0_=sv[0]*W8_SCALE,t1_=sv[1]*W8_SCALE,t2_=sv[2]*W8_SCALE,t3_=sv[3]*W8_SCALE; \
      if(((bi)&1)==0){ _Pragma("unroll") for(int j=0;j<4;++j)sw[j]=pk4_fp8(t0_[j],t1_[j],t2_[j],t3_[j]); } \
      else { const int l_=lane_now(); const unsigned do_=((unsigned)(l_&7)<<12)|((unsigned)(l_>>3)<<3); unsigned char*db_=NA_SJ_DBASE(bi); \
        _Pragma("unroll") for(int j=0;j<4;++j){ u32x2 ow; ow.x=sw[j]; ow.y=pk4_fp8(t0_[j],t1_[j],t2_[j],t3_[j]); *(u32x2*)(db_+do_+j*1024)=ow; } } }while(0)
  #pragma unroll 1
  for(int t=0;t<12;++t){
    if(t==0||NA_NSIDE==0) asm volatile("s_waitcnt vmcnt(8)":::"memory"); else asm volatile("s_waitcnt vmcnt(12)":::"memory");
    u32x4 pw[2][4];
    #pragma unroll
    for(int qb=0;qb<2;++qb){
      f32x16 p0,p1;
      qkt(p0,p1,wl,qr[qb],zero,r32,hi);
      asm volatile("s_nop 15\n\ts_nop 7":"+v"(p0),"+v"(p1));
      if(qb==1){ asm volatile("s_waitcnt lgkmcnt(0)":::"memory");
                 if(t<11) NA_DMA_K(t+1); }
      { const int qc=qb*32+r32, c0=min(max(qc-8,0),48);
        const float*bp=rpbl+(r0+t-r+7)*32+15-qc+4*hi;
        if(t<8){ if(qb==0) na_softmax<1,FAST>(p0,p1,mrow[qb],lrow[qb],o[qb],wsf,bp,c0,r32,hi,pw[qb]); else na_softmax<2,FAST>(p0,p1,mrow[qb],lrow[qb],o[qb],wsf,bp,c0,r32,hi,pw[qb]); }
        else na_softmax<0,FAST>(p0,p1,mrow[qb],lrow[qb],o[qb],wsf,bp,c0,r32,hi,pw[qb]); }
    }
    if(t==11) asm volatile("s_waitcnt vmcnt(0)":::"memory");
    asm volatile("s_waitcnt vmcnt(8)":"+v"(sv[0]),"+v"(sv[1]),"+v"(sv[2]),"+v"(sv[3])::"memory");
    if(NA_NSIDE>0){ if(t>0) NA_SJ_CONSUME(t-1);
    NA_SJ_ISSUE(t); }
    SBAR();
    #pragma unroll
    for(int qb=0;qb<2;++qb)
      pv(o[qb],vb0,__builtin_bit_cast(bf16x8,pw[qb][0]),__builtin_bit_cast(bf16x8,pw[qb][1]),__builtin_bit_cast(bf16x8,pw[qb][2]),__builtin_bit_cast(bf16x8,pw[qb][3]));
    asm volatile("s_waitcnt lgkmcnt(0)":::"memory");
    if(t<11) NA_DMA_V(t+1);
  }
  asm volatile("s_waitcnt vmcnt(0)":"+v"(sv[0]),"+v"(sv[1]),"+v"(sv[2]),"+v"(sv[3])::"memory");
  if(NA_NSIDE>0) NA_SJ_CONSUME(11);
  #undef NA_SJ_CONSUME
  #undef NA_SJ_I
  #undef NA_SJ_SBASE
  #undef NA_SJ_DBASE
  #undef NA_SJ_ISSUE
  #undef NA_KROW0
  #undef NA_DMA_K
  #undef NA_DMA_V
  const int lane_e=lane_now(), hi_e=lane_e>>5, r32_e=lane_e&31;
  #pragma unroll
  for(int qb=0;qb<2;++qb){
    float l=lrow[qb];
    {auto rr=__builtin_amdgcn_permlane32_swap(__float_as_uint(l),__float_as_uint(l),false,false);l=__uint_as_float(rr[0])+__uint_as_float(rr[1]);}
    if(hi_e==0)wsf[r32_e]=l;asm volatile("s_waitcnt lgkmcnt(0)":::"memory");
    bf16*stg=(bf16*)wl+qb*2048;
    #pragma unroll
    for(int rr=0;rr<16;++rr){const int orow=crow(rr,hi_e); const float rl=__builtin_amdgcn_rcpf(wsf[orow]);
      #pragma unroll
      for(int d0=0;d0<2;++d0)stg[orow*64+d0*32+r32_e]=(bf16)f2bf(o[qb][d0][rr]*rl);}
    asm volatile("s_waitcnt lgkmcnt(0)":::"memory");
    bf16*Ow=O+(qrow0+qb*32)*OP+h*D;
    #pragma unroll
    for(int i=0;i<4;++i){const int row=i*8+(lane_e>>3),ch=lane_e&7; const u32x4 v=*(const u32x4*)(stg+row*64+ch*8); wt16(O,(unsigned)(((int)qrow0+qb*32+row)*OP+h*D+ch*8)*2u,v);}
  }
  if(cntO) panel_signal(cntO+64*((int)(qrow0>>8)));
  asm volatile("s_waitcnt lgkmcnt(0)":::"memory");
}
#undef SBAR
#undef WAIT_BAR
}

struct MKArgs { const float* in[23]; float* out; unsigned char* ws; int ph_lo, ph_hi, li, pad; };
struct Frame {
    LAS unsigned char* lds; volatile LAS unsigned* MISC; unsigned* ctl;
    int wave, vcu, G;
};
#define FLANE (lane_now())
#define FTID (F.wave * 64 + lane_now())

struct ProjEpi {
    static constexpr bool HAS_MID = false, HAS_PRE = false; struct Pre {}; static constexpr int NSTORE = 16;
    bf16 *QA, *KA, *VA, *QB, *KB, *VB, *GA, *GB; const LAS float *gq, *gk; const LAS float* rope; unsigned* nmax;
    __device__ __forceinline__ void store_plain(const f32x4 (&acc)[2][2][4][2], bf16* dst, int pitch, int rowbase, int colbase, int fq, float scale, bool sig, bool nm = false, unsigned* nmp = nullptr) const {
        float nmx = 0.f;
#pragma unroll
        for (int ai = 0; ai < 2; ++ai)
#pragma unroll
            for (int m = 0; m < 4; ++m) { const unsigned ro = (unsigned)((rowbase + ai * 128 + m * 16) * pitch + colbase + 8 * fq) * 2u;
                float ssn = 0.f;
#pragma unroll
                for (int bj = 0; bj < 2; ++bj) { f32x4 v0 = acc[ai][bj][m][0], v1 = acc[ai][bj][m][1];
                    u32x4 w;
                    constexpr float IS = PROJ_FP8 ? 1.0f / W8_SCALE : 1.0f;
                    if (sig) {
#pragma unroll
                        for (int j = 0; j < 4; ++j) v0[j] = __builtin_amdgcn_rcpf(1.0f + __builtin_amdgcn_exp2f((-LOG2E * IS) * v0[j]));
                        w.x = pk2(v0[0], v0[1]); w.y = pk2(v0[2], v0[3]); __builtin_amdgcn_sched_barrier(0);
#pragma unroll
                        for (int j = 0; j < 4; ++j) v1[j] = __builtin_amdgcn_rcpf(1.0f + __builtin_amdgcn_exp2f((-LOG2E * IS) * v1[j]));
                        w.z = pk2(v1[0], v1[1]); w.w = pk2(v1[2], v1[3]); }
                    else { v0 = v0 * (scale * IS); v1 = v1 * (scale * IS); w.x = pk2(v0[0], v0[1]); w.y = pk2(v0[2], v0[3]); w.z = pk2(v1[0], v1[1]); w.w = pk2(v1[2], v1[3]);
                        if (nm) ssn += (v0[0] * v0[0] + v0[1] * v0[1]) + (v0[2] * v0[2] + v0[3] * v0[3]) + (v1[0] * v1[0] + v1[1] * v1[1]) + (v1[2] * v1[2] + v1[3] * v1[3]); }
                    wt16(dst, ro + bj * 64, w);
                    __builtin_amdgcn_sched_barrier(0); }
                if (nm) {
                    { auto r16 = __builtin_amdgcn_permlane16_swap(__float_as_uint(ssn), __float_as_uint(ssn), false, false); ssn = __uint_as_float(r16[0]) + __uint_as_float(r16[1]);
                      auto r32 = __builtin_amdgcn_permlane32_swap(__float_as_uint(ssn), __float_as_uint(ssn), false, false); ssn = __uint_as_float(r32[0]) + __uint_as_float(r32[1]); }
                    nmx = fmaxf(nmx, ssn); } }
        if (nm) { nmx = wave_max(nmx); if (lane_now() == 0) (void)__hip_atomic_fetch_max(nmp, __float_as_uint(nmx), __ATOMIC_RELAXED, __HIP_MEMORY_SCOPE_AGENT); }
    }
    __device__ __forceinline__ void store_head(const f32x4 (&acc)[2][2][4][2], bf16* dst, int pitch, int rowbase, int colbase, int prow0, int fr, int fq, const LAS float* g, float scale, bool do_rope) const {
        const bool upper = (fq & 2) != 0;
#pragma unroll
        for (int ai = 0; ai < 2; ++ai)
#pragma unroll
            for (int m = 0; m < 4; ++m) {
                float ss = 0.f;
#pragma unroll
                for (int bj = 0; bj < 2; ++bj)
#pragma unroll
                    for (int n = 0; n < 2; ++n) { const f32x4 v = acc[ai][bj][m][n]; ss += (v[0] * v[0] + v[1] * v[1]) + (v[2] * v[2] + v[3] * v[3]); }
                { auto r16 = __builtin_amdgcn_permlane16_swap(__float_as_uint(ss), __float_as_uint(ss), false, false); ss = __uint_as_float(r16[0]) + __uint_as_float(r16[1]);
                  auto r32 = __builtin_amdgcn_permlane32_swap(__float_as_uint(ss), __float_as_uint(ss), false, false); ss = __uint_as_float(r32[0]) + __uint_as_float(r32[1]); }
                constexpr float IS = PROJ_FP8 ? 1.0f / W8_SCALE : 1.0f;
                const float rs = rsqrtf(ss * (IS * IS / 64.0f) + EPS) * (scale * IS);
                const unsigned ro = (unsigned)((rowbase + ai * 128 + m * 16) * pitch + colbase + 8 * fq) * 2u;
                const int prow = (prow0 + 2 * ai) & 63, pcol = 16 * m + fr;
                int fq8 = 8 * fq; asm volatile("" : "+v"(fq8));
#pragma unroll
                for (int bj = 0; bj < 2; ++bj) {
                    f32x4 y[2];
#pragma unroll
                    for (int n = 0; n < 2; ++n) { y[n] = acc[ai][bj][m][n] * rs * *(const LAS f32x4*)(g + bj * 32 + fq8 + 4 * n);
                        if (do_rope) {
                            const int pos = bj ? pcol : prow;
                            const LAS f32x4* tp = (const LAS f32x4*)(rope + pos * 32 + ((fq & 1) * 8 + n * 4) * 2);
                            const f32x4 t0 = tp[0], t1 = tp[1];
                            const f32x4 cs = (f32x4){t0[0], t0[2], t1[0], t1[2]}, sn = (f32x4){t0[1], t0[3], t1[1], t1[3]};
                            f32x4 p;
#pragma unroll
                            for (int j = 0; j < 4; ++j) { auto rr = __builtin_amdgcn_permlane32_swap(__float_as_uint(y[n][j]), __float_as_uint(y[n][j]), false, false); p[j] = __uint_as_float(upper ? rr[0] : rr[1]); }
                            y[n] = upper ? (y[n] * cs + p * sn) : (y[n] * cs - p * sn);
                        } }
                    u32x4 w; w.x = pk2(y[0][0], y[0][1]); w.y = pk2(y[0][2], y[0][3]); w.z = pk2(y[1][0], y[1][1]); w.w = pk2(y[1][2], y[1][3]);
                    wt16(dst, ro + bj * 64, w);
                }
                __builtin_amdgcn_sched_barrier(0);
            }
    }
    __device__ __forceinline__ void operator()(const f32x4 (&acc)[2][2][4][2], const pg8::GU& u, int wr, int wc) const {
        const int lane_ = lane_now(), fr = lane_ & 15, fq = lane_ >> 4;
        const int rowbase = u.pm * 256 + wr * 64 + fr, pn = u.pn, prow0 = 4 * u.pm + wr;
        if (pn < 2) store_plain(acc, KA, 512, rowbase, 256 * pn + 64 * wc, fq, 1.0f, false, true, nmax + 64);
        else if (pn < 4) store_plain(acc, VA, 512, rowbase, 256 * (pn - 2) + 64 * wc, fq, 1.0f, false);
        else if (pn == 4) { if (wc < 2) store_head(acc, KB, 128, rowbase, 64 * wc, prow0, fr, fq, gk, 1.0f, u.pm < 64); else store_plain(acc, VB, 128, rowbase, 64 * (wc - 2), fq, 1.0f, false); }
        else if (pn < 7) store_plain(acc, QA, 512, rowbase, 256 * (pn - 5) + 64 * wc, fq, QSCALE, false, true, nmax);
        else if (pn < 9) store_head(acc, QB, 512, rowbase, 256 * (pn - 7) + 64 * wc, prow0, fr, fq, gq, QSCALE, true);
        else if (pn < 13) store_plain(acc, GA, 1024, rowbase, 256 * (pn - 9) + 64 * wc, fq, 1.0f, true);
        else store_plain(acc, GB, 1024, rowbase, 256 * (pn - 13) + 64 * wc, fq, 1.0f, true);
    }
};
struct ProjSched {
    static constexpr bool HAS_DEP = false, HAS_DONE = false, HAS_KDEP = false; static constexpr int KROT = 0;
    const char* Abase; const char* Bbase; const int* rowlist; int v, G;
    __device__ __forceinline__ bool next(int i, pg8::GU& u) const {
        const int id = i * G + v; constexpr int NL = 64 * 17, NC = 4 * 5;
        if (id >= NL + NC) return false;
        int pm, pn; if (id < NL) { pm = id / 17; pn = ((id % 17) * 5) % 17; } else { const int c = id - NL; pm = 64 + c / 5; pn = c % 5; }
        u.pm = pm; u.pn = pn; u.e = 0; u.cnt = 256; u.rows = 0u;
        u.a = (unsigned)pm * 256u * PROJ_PITCH; u.b = (unsigned)pn * 256u * PROJ_PITCH;
        return true;
    }
};


struct ProjSchedA {
    static constexpr bool HAS_DEP = false, HAS_DONE = false, HAS_KDEP = false; static constexpr int KROT = 0;
    const char* Abase; const char* Bbase; const int* rowlist; int v, G;
    __device__ __forceinline__ bool next(int i, pg8::GU& u) const {
        const int id = i * G + v; constexpr int NL = 64 * 9, NC = 4 * 5;
        if (id >= NL + NC) return false;
        int pm, pn; if (id < NL) { pm = id / 9; pn = id % 9; } else { const int c = id - NL; pm = 64 + c / 5; pn = c % 5; }
        u.pm = pm; u.pn = pn; u.e = 0; u.cnt = 256; u.rows = 0u;
        u.a = (unsigned)pm * 256u * PROJ_PITCH; u.b = (unsigned)pn * 256u * PROJ_PITCH;
        return true;
    }
};
struct ProjSchedG {
    static constexpr bool HAS_DEP = false, HAS_DONE = false, HAS_KDEP = false; static constexpr int KROT = 0;
    const char* Abase; const char* Bbase; const int* rowlist; int v, G;
    __device__ __forceinline__ bool next(int i, pg8::GU& u) const {
        const int id = i * G + v; if (id >= 64 * 8) return false;
        u.pm = id >> 3; u.pn = id & 7; u.e = 0; u.cnt = 256; u.rows = 0u;
        u.a = (unsigned)u.pm * 256u * PROJ_PITCH; u.b = (unsigned)(C_GA + 128 * u.pn) * PROJ_PITCH;
        return true;
    }
};
struct GateEpi {
    static constexpr bool HAS_MID = false, HAS_PRE = false; struct Pre {}; static constexpr int NSTORE = 16;
    bf16 *XR, *SA;
    __device__ __forceinline__ void operator()(const f32x4 (&acc)[2][2][4][2], const pg8::GU& u, int wr, int wc) const {
        const int lane_ = lane_now(), fr = lane_ & 15, fq = lane_ >> 4;
        const unsigned base = (unsigned)((u.pm * 256 + wr * 64 + fr) * 1024 + u.pn * 128 + wc * 32 + 8 * fq) * 2u;
        constexpr float IS = PROJ_FP8 ? 1.0f / W8_SCALE : 1.0f;
#pragma unroll
        for (int ai = 0; ai < 2; ++ai)
#pragma unroll
            for (int m = 0; m < 4; ++m) { float xr[8], sa[8];
#pragma unroll
                for (int bj = 0; bj < 2; ++bj)
#pragma unroll
                    for (int j = 0; j < 4; ++j) { const float ea = __builtin_amdgcn_exp2f((-LOG2E * IS) * acc[ai][bj][m][0][j]), eb = __builtin_amdgcn_exp2f((-LOG2E * IS) * acc[ai][bj][m][1][j]);
                        const float da = 1.0f + ea; sa[4 * bj + j] = __builtin_amdgcn_rcpf(da); xr[4 * bj + j] = da * __builtin_amdgcn_rcpf(1.0f + eb); }
                const unsigned o = base + (unsigned)((ai * 128 + m * 16) * 1024) * 2u;
                u32x4 wx, ws; wx.x = pk2(xr[0], xr[1]); wx.y = pk2(xr[2], xr[3]); wx.z = pk2(xr[4], xr[5]); wx.w = pk2(xr[6], xr[7]);
                ws.x = pk2(sa[0], sa[1]); ws.y = pk2(sa[2], sa[3]); ws.z = pk2(sa[4], sa[5]); ws.w = pk2(sa[6], sa[7]);
                wt16(XR, o, wx); wt16(SA, o, ws);
                __builtin_amdgcn_sched_barrier(0); }
    }
};
struct Dense4Sched {
    static constexpr bool HAS_DEP = false, HAS_DONE = false, HAS_KDEP = false; static constexpr int KROT = 0;
    const char* Abase; const char* Bbase; const int* rowlist; int v, G;
    __device__ __forceinline__ bool next(int i, pg8::GU& u) const {
        const int id = i * G + v; if (id >= 64 * 4) return false;
        u.pm = id >> 2; u.pn = id & 3; u.e = 0; u.cnt = 256; u.rows = 0u;
        u.a = (unsigned)u.pm * 256u * pg8::PITCH; u.b = (unsigned)u.pn * 256u * pg8::PITCH; return true;
    }
};
struct Dense4Sched8 {
    static constexpr bool HAS_DEP = false, HAS_DONE = false, HAS_KDEP = false; static constexpr int KROT = 0;
    const char* Abase; const char* Bbase; const int* rowlist; int v, G;
    __device__ __forceinline__ bool next(int i, pg8::GU& u) const {
        const int id = i * G + v; if (id >= 64 * 4) return false;
        u.pm = id >> 2; u.pn = id & 3; u.e = 0; u.cnt = 256; u.rows = 0u;
        u.a = (unsigned)u.pm * 256u * 1024u; u.b = (unsigned)u.pn * 256u * 1024u; return true;
    }
};
struct DenseUSched {
    static constexpr bool HAS_DEP = false, HAS_DONE = false, HAS_KDEP = true; static constexpr int KROT = pg8::NT / 2;
    const char* Abase; const char* Bbase; const int* rowlist; int v, G; unsigned* cntA; unsigned* tmo;
    __device__ __forceinline__ bool next(int i, pg8::GU& u) const {
        const int id = i * G + v; if (id >= 64 * 4) return false;
        u.pm = id >> 2; u.pn = id & 3; u.e = 0; u.cnt = 256; u.rows = 0u;
        u.a = (unsigned)u.pm * 256u * pg8::PITCH; u.b = (unsigned)u.pn * 256u * pg8::PITCH; return true;
    }
    __device__ __forceinline__ void k_ready(const pg8::GU& u, int wid) const {
        if (cntA == nullptr) return;
        if (wid == 0) { unsigned sp = 0u;
            while (__hip_atomic_load(cntA + 64 * u.pm, __ATOMIC_RELAXED, __HIP_MEMORY_SCOPE_AGENT) < 32u) { __builtin_amdgcn_s_sleep(2);
                if (++sp > (1u << 20)) { if (lane_now() == 0) __hip_atomic_store(tmo, 0xC0DEu, __ATOMIC_RELAXED, __HIP_MEMORY_SCOPE_AGENT); break; } }
            __builtin_amdgcn_fence(__ATOMIC_ACQUIRE, "agent"); }
        asm volatile("" ::: "memory"); __builtin_amdgcn_s_barrier(); asm volatile("" ::: "memory");
    }
};
struct UEpi {
    static constexpr bool HAS_MID = true, HAS_PRE = false; struct Pre {}; static constexpr int NSTORE = 0;
    const bf16 *GA, *GB; bf16* U;
    __device__ __forceinline__ void mid(f32x4 (&acc)[2][2][4][2], const pg8::GU& u, int wr, int wc) const {
        const int lane_ = lane_now(), fr = lane_ & 15, fq = lane_ >> 4;
        const unsigned base = (unsigned)((u.pm * 256 + wr * 64 + fr) * 1024 + u.pn * 256 + wc * 32 + 8 * fq) * 2u;
#pragma unroll
        for (int ai = 0; ai < 2; ++ai)
#pragma unroll
            for (int m = 0; m < 4; ++m)
#pragma unroll
                for (int bj = 0; bj < 2; ++bj) { const unsigned o = base + (unsigned)((ai * 128 + m * 16) * 1024 + bj * 128) * 2u;
                    const u32x4 a = *(const u32x4*)((const char*)GA + o);
                    f32x4 r0, r1;
                    r0[0] = bflo(a.x); r0[1] = bfhi(a.x); r0[2] = bflo(a.y); r0[3] = bfhi(a.y);
                    r1[0] = bflo(a.z); r1[1] = bfhi(a.z); r1[2] = bflo(a.w); r1[3] = bfhi(a.w);
                    acc[ai][bj][m][0] = acc[ai][bj][m][0] * r0; acc[ai][bj][m][1] = acc[ai][bj][m][1] * r1; }
    }
    __device__ __forceinline__ void operator()(const f32x4 (&acc)[2][2][4][2], const pg8::GU& u, int wr, int wc) const {
        const int lane_ = lane_now(), fr = lane_ & 15, fq = lane_ >> 4;
        const unsigned base = (unsigned)((u.pm * 256 + wr * 64 + fr) * 1024 + u.pn * 256 + wc * 32 + 8 * fq) * 2u;
        u32x4 gb[2][4][2];
#pragma unroll
        for (int ai = 0; ai < 2; ++ai)
#pragma unroll
            for (int m = 0; m < 4; ++m)
#pragma unroll
                for (int bj = 0; bj < 2; ++bj) gb[ai][m][bj] = *(const u32x4*)((const char*)GB + base + (unsigned)((ai * 128 + m * 16) * 1024 + bj * 128) * 2u);
        asm volatile("s_waitcnt vmcnt(0)" ::: "memory");
        __builtin_amdgcn_sched_barrier(0);
        if (Y_FP8) {
            const int odd = fq & 1;
            const unsigned base8 = (unsigned)((u.pm * 256 + wr * 64 + fr) * 1024 + u.pn * 256 + wc * 32 + 8 * fq);
#pragma unroll
            for (int ai = 0; ai < 2; ++ai)
#pragma unroll
                for (int m2 = 0; m2 < 4; m2 += 2)
#pragma unroll
                    for (int bj = 0; bj < 2; ++bj) { unsigned wq[2][2];
#pragma unroll
                        for (int q = 0; q < 2; ++q) { const u32x4 b = gb[ai][m2 + q][bj]; const f32x4 v0 = acc[ai][bj][m2 + q][0] * U8_SCALE, v1 = acc[ai][bj][m2 + q][1] * U8_SCALE;
                            wq[q][0] = pk4_fp8(v0[0] * bflo(b.x), v0[1] * bfhi(b.x), v0[2] * bflo(b.y), v0[3] * bfhi(b.y)); wq[q][1] = pk4_fp8(v1[0] * bflo(b.z), v1[1] * bfhi(b.z), v1[2] * bflo(b.w), v1[3] * bfhi(b.w)); }
                        const auto rx = __builtin_amdgcn_permlane16_swap(wq[0][0], wq[1][0], false, false); const auto ry = __builtin_amdgcn_permlane16_swap(wq[0][1], wq[1][1], false, false);
                        u32x4 o; o.x = rx[0]; o.y = ry[0]; o.z = rx[1]; o.w = ry[1];
                        wt16(U, base8 + (unsigned)((ai * 128 + (m2 + odd) * 16) * 1024 + bj * 128) - 8u * odd, o); }
        } else {
#pragma unroll
        for (int ai = 0; ai < 2; ++ai)
#pragma unroll
            for (int m = 0; m < 4; ++m)
#pragma unroll
                for (int bj = 0; bj < 2; ++bj) { const unsigned o = base + (unsigned)((ai * 128 + m * 16) * 1024 + bj * 128) * 2u;
                    const u32x4 b = gb[ai][m][bj]; const f32x4 v0 = acc[ai][bj][m][0], v1 = acc[ai][bj][m][1];
                    u32x4 w; w.x = pk2(v0[0] * bflo(b.x), v0[1] * bfhi(b.x)); w.y = pk2(v0[2] * bflo(b.y), v0[3] * bfhi(b.y)); w.z = pk2(v1[0] * bflo(b.z), v1[1] * bfhi(b.z)); w.w = pk2(v1[2] * bflo(b.w), v1[3] * bfhi(b.w));
                    wt16(U, o, w); }
        }
    }
};
struct YEpi {
    static constexpr bool HAS_MID = false, HAS_PRE = false; struct Pre {}; static constexpr int NSTORE = 0;
    bf16* Y;
    __device__ __forceinline__ void operator()(const f32x4 (&acc)[2][2][4][2], const pg8::GU& u, int wr, int wc) const {
        const int lane_ = lane_now(), fr = lane_ & 15, fq = lane_ >> 4;
        const unsigned base = (unsigned)((u.pm * 256 + wr * 64 + fr) * 1024 + u.pn * 256 + wc * 32 + 8 * fq) * 2u;
#pragma unroll
        for (int ai = 0; ai < 2; ++ai)
#pragma unroll
            for (int m = 0; m < 4; ++m)
#pragma unroll
                for (int bj = 0; bj < 2; ++bj) { constexpr float ys_ = Y_FP8 ? 1.0f / (W8_SCALE * U8_SCALE) : 1.0f; const f32x4 v0 = acc[ai][bj][m][0] * ys_, v1 = acc[ai][bj][m][1] * ys_; u32x4 w; w.x = pk2(v0[0], v0[1]); w.y = pk2(v0[2], v0[3]); w.z = pk2(v1[0], v1[1]); w.w = pk2(v1[2], v1[3]);
                    wt16(Y, base + (unsigned)((ai * 128 + m * 16) * 1024 + bj * 128) * 2u, w); }
    }
};
constexpr int MW_TSTART = 900, MW_ECN = 940;
constexpr int GQ_SIDE_DN_ = 512 * NWAVES * attn_body::GQ_ND;
constexpr int CV_TAIL2 = NE * I_DN - GQ_SIDE_DN_, CV_TAIL7 = 0, CV_BAL0 = 1152;
constexpr int CV_HEAD = I_IN + 2 * I_OA + I_O, NA_SIDE_N = 256 * NWAVES * attn_body::NA_NSIDE, GQ_SIDE_N = 512 * NWAVES * attn_body::GQ_NJ, P3_SIDE_N = NA_SIDE_N + GQ_SIDE_N, GQ_SIDE_DN = 512 * NWAVES * attn_body::GQ_ND;
static_assert(P3_SIDE_N <= NE * I_GU && MOE_FP8, "NA side job converts w_gu items to e4m3");
#define CV_ITEM(j) ((j) < CV_HEAD ? (j) : (j) + P3_SIDE_N)
static_assert(CV_TAIL2 + CV_TAIL7 <= NE * I_DN, "only w_dn items may move behind P0");
__device__ __forceinline__ void moe_table(const Frame& F, const unsigned* ecnt) {
    if (F.wave == 0) {
        const int l = lane_now(); const unsigned c = l < 32 ? ecnt[l] : 0u; const unsigned tl = (c + 255u) >> 8; unsigned inc = tl;
#pragma unroll
        for (int d = 1; d < 32; d <<= 1) { const unsigned up = (unsigned)__shfl_up((int)inc, d); if (l >= d) inc += up; }
        if (l < 32) { F.MISC[MW_ECN + l] = c; F.MISC[MW_TSTART + l] = inc - tl; }
        if (l == 31) F.MISC[MW_TSTART + 32] = inc;
    }
    __syncthreads();
}
template <int NPN  , bool GU_PHASE>
struct MoeSched {
    static constexpr bool HAS_DEP = !GU_PHASE, HAS_DONE = GU_PHASE, HAS_KDEP = false; static constexpr int KROT = 0;
    const char* Abase; const char* Bbase; const int* rowlist; volatile LAS unsigned* MISC; int v, G; unsigned* cntA; unsigned* tmo;
    __device__ __forceinline__ void done(const pg8::GU& u) const { if (cntA != nullptr) panel_signal(cntA + 64 * u.pm); }
    __device__ __forceinline__ void done_nodrain(int pm) const { if (cntA != nullptr && lane_now() == 0) (void)__hip_atomic_fetch_add(cntA + 64 * pm, 1u, __ATOMIC_RELAXED, __HIP_MEMORY_SCOPE_AGENT); }
    __device__ __forceinline__ void a_ready(int i, const pg8::GU& u, int wid) const {
        if (cntA == nullptr || i < 4) return;
        if (wid == 0) { unsigned sp = 0u;
            while (__hip_atomic_load(cntA + 64 * u.pm, __ATOMIC_RELAXED, __HIP_MEMORY_SCOPE_AGENT) < 64u) { __builtin_amdgcn_s_sleep(2);
                if (++sp > (1u << 20)) { if (lane_now() == 0) __hip_atomic_store(tmo, 0xC0DEu, __ATOMIC_RELAXED, __HIP_MEMORY_SCOPE_AGENT); break; } }
            __builtin_amdgcn_fence(__ATOMIC_ACQUIRE, "agent"); }
        asm volatile("" ::: "memory"); __builtin_amdgcn_s_barrier(); asm volatile("" ::: "memory");
    }
    __device__ __forceinline__ bool next(int i, pg8::GU& u) const {
        const int id = i * G + v; const int tile = id / NPN, pn = id % NPN;
        if (tile >= (int)__builtin_amdgcn_readfirstlane(MISC[MW_TSTART + 32])) return false;
        int e = 0;
#pragma unroll
        for (int st = 16; st >= 1; st >>= 1) { if (tile >= (int)__builtin_amdgcn_readfirstlane(MISC[MW_TSTART + e + st])) e += st; }
        const int mt = tile - (int)__builtin_amdgcn_readfirstlane(MISC[MW_TSTART + e]);
        const int cnt_e = (int)__builtin_amdgcn_readfirstlane(MISC[MW_ECN + e]);
        u.pm = tile; u.pn = pn; u.e = e; u.cnt = min(256, cnt_e - mt * 256); u.rows = (unsigned)(e * ECAP + mt * 256);
        if (GU_PHASE) { u.a = 0u; u.b = (unsigned)(e * 2048 + pn * 128) * MOE_PITCH; }
        else { u.a = (unsigned)tile * 256u * MOE_PITCH; u.b = (unsigned)(e * 1024 + pn * 256) * MOE_PITCH; }
        return true;
    }
};
struct GuEpi {
    static constexpr bool HAS_MID = false, HAS_PRE = true; static constexpr int NSTORE = 4; struct Pre { f32x4 g[2], l[2]; };
    const float* b_gu; bf16* ACT;
    __device__ __forceinline__ void prefetch(Pre& pre, const pg8::GU& u, int wr, int wc) const {
        const int c0 = u.pn * 128 + wc * 32 + 8 * (lane_now() >> 4);
#pragma unroll
        for (int bj = 0; bj < 2; ++bj) { const float* pg = b_gu + u.e * 2048 + c0 + bj * 4; const float* pl = pg + 1024;
            asm volatile("global_load_dwordx4 %0, %1, off" : "=v"(pre.g[bj]) : "v"(pg) : "memory"); asm volatile("global_load_dwordx4 %0, %1, off" : "=v"(pre.l[bj]) : "v"(pl) : "memory"); }
    }
    __device__ __forceinline__ void wait(Pre& pre) const { asm volatile("s_waitcnt vmcnt(16)" : "+v"(pre.g[0]), "+v"(pre.g[1]), "+v"(pre.l[0]), "+v"(pre.l[1]) :: "memory"); }
    __device__ __forceinline__ void operator()(const f32x4 (&acc)[2][2][4][2], const pg8::GU& u, int wr, int wc, const Pre& pre) const {
        using f32x2 = __attribute__((ext_vector_type(2))) float;
        const int lane_ = lane_now(), fr = lane_ & 15, fq = lane_ >> 4;
        const int c0 = u.pn * 128 + wc * 32 + 8 * fq;
        constexpr float ws_ = 1.0f / W8_SCALE, wl_ = ACT8_SCALE / W8_SCALE, cexp = -SW_ALPHA * LOG2E, llo = ACT8_SCALE * (1.0f - SW_LIMIT), lhi = ACT8_SCALE * (1.0f + SW_LIMIT);
        f32x2 bg[2][2], bl[2][2];
#pragma unroll
        for (int bj = 0; bj < 2; ++bj) { const f32x4 g4 = pre.g[bj], l4 = pre.l[bj];
            bg[bj][0] = (f32x2){g4[0], g4[1]}; bg[bj][1] = (f32x2){g4[2], g4[3]};
            bl[bj][0] = (f32x2){l4[0], l4[1]} * ACT8_SCALE + ACT8_SCALE; bl[bj][1] = (f32x2){l4[2], l4[3]} * ACT8_SCALE + ACT8_SCALE; }
        const int odd = fq & 1;
#pragma unroll
        for (int ai = 0; ai < 2; ++ai)
#pragma unroll
            for (int m2 = 0; m2 < 4; m2 += 2) { unsigned w[2][2];
#pragma unroll
                for (int q = 0; q < 2; ++q) { const int m = m2 + q;
#pragma unroll
                    for (int bj = 0; bj < 2; ++bj) { const f32x4 G = acc[ai][bj][m][0], L = acc[ai][bj][m][1]; f32x2 o2[2];
#pragma unroll
                        for (int hh = 0; hh < 2; ++hh) {
                            f32x2 g = (f32x2){G[2 * hh], G[2 * hh + 1]} * ws_ + bg[bj][hh];
                            g.x = fminf(g.x, SW_LIMIT); g.y = fminf(g.y, SW_LIMIT);
                            const f32x2 ea = g * cexp; f32x2 e; e.x = __builtin_amdgcn_exp2f(ea.x); e.y = __builtin_amdgcn_exp2f(ea.y);
                            e = e + 1.0f; f32x2 r; r.x = __builtin_amdgcn_rcpf(e.x); r.y = __builtin_amdgcn_rcpf(e.y);
                            f32x2 l = (f32x2){L[2 * hh], L[2 * hh + 1]} * wl_ + bl[bj][hh];
                            l.x = fminf(fmaxf(l.x, llo), lhi); l.y = fminf(fmaxf(l.y, llo), lhi);
                            o2[hh] = (l * g) * r; }
                        w[q][bj] = pk4_fp8(o2[0].x, o2[0].y, o2[1].x, o2[1].y); } }
                const auto rx = __builtin_amdgcn_permlane16_swap(w[0][0], w[1][0], false, false); const auto ry = __builtin_amdgcn_permlane16_swap(w[0][1], w[1][1], false, false);
                u32x4 o; o.x = rx[0]; o.y = ry[0]; o.z = rx[1]; o.w = ry[1];
                const int r = ai * 128 + wr * 64 + (m2 + odd) * 16 + fr;
                wt16(ACT, (unsigned)((u.pm * 256 + r) * DFF + c0 - 8 * odd), o); }
    }
};
struct DnEpi {
    static constexpr bool HAS_MID = false, HAS_PRE = false; struct Pre {}; static constexpr int NSTORE = 0;
    const float* b_dn; const int* LIST; const float* TOPW; bf16* YS;
    __device__ __forceinline__ void operator()(const f32x4 (&acc)[2][2][4][2], const pg8::GU& u, int wr, int wc) const {
        const int lane_ = lane_now(), fr = lane_ & 15, fq = lane_ >> 4;
        const int c0 = u.pn * 256 + wc * 32 + 8 * fq;
        f32x4 bb[2][2];
#pragma unroll
        for (int bj = 0; bj < 2; ++bj)
#pragma unroll
            for (int n = 0; n < 2; ++n) bb[bj][n] = *(const f32x4*)(b_dn + u.e * 1024 + c0 + bj * 128 + n * 4);
        u32x2 ent[2][4];
#pragma unroll
        for (int ai = 0; ai < 2; ++ai)
#pragma unroll
            for (int m = 0; m < 4; ++m) { const int r = ai * 128 + wr * 64 + m * 16 + fr; ent[ai][m] = *(const u32x2*)(LIST + 2 * (size_t)(u.rows + (r < u.cnt ? r : 0))); }
        const int odd = fq & 1;
#pragma unroll
        for (int ai = 0; ai < 2; ++ai)
#pragma unroll
            for (int m2 = 0; m2 < 4; m2 += 2) { unsigned o[2][2][2];
#pragma unroll
                for (int q = 0; q < 2; ++q) { const unsigned wbits = ent[ai][m2 + q].y; const float w = __builtin_bit_cast(float, wbits);
                    constexpr float ds_ = 1.0f / (W8_SCALE * ACT8_SCALE); const float w8 = w * YS8_SCALE;
#pragma unroll
                    for (int bj = 0; bj < 2; ++bj) { const f32x4 v0 = (acc[ai][bj][m2 + q][0] * ds_ + bb[bj][0]) * w8, v1 = (acc[ai][bj][m2 + q][1] * ds_ + bb[bj][1]) * w8;
                        o[q][bj][0] = pk4_fp8(v0[0], v0[1], v0[2], v0[3]); o[q][bj][1] = pk4_fp8(v1[0], v1[1], v1[2], v1[3]); } }
                const unsigned a = odd ? ent[ai][m2 + 1].x : ent[ai][m2].x;
                const int r = ai * 128 + wr * 64 + (m2 + odd) * 16 + fr;
#pragma unroll
                for (int bj = 0; bj < 2; ++bj) {
                    const auto rx = __builtin_amdgcn_permlane16_swap(o[0][bj][0], o[1][bj][0], false, false); const auto ry = __builtin_amdgcn_permlane16_swap(o[0][bj][1], o[1][bj][1], false, false);
                    u32x4 ov; ov.x = rx[0]; ov.y = ry[0]; ov.z = rx[1]; ov.w = ry[1];
                    if (r < u.cnt) *(u32x4*)((char*)YS + (a * (unsigned)DM + (unsigned)(c0 + bj * 128 - 8 * odd))) = ov; } }
    }
};

__global__ void __launch_bounds__(NWAVES * 64, 2) mk_fwd(MKArgs args) {
    extern __shared__ __attribute__((aligned(16))) unsigned char lds[];
    Frame F;
    F.lds = (LAS unsigned char*)lds; F.MISC = (volatile LAS unsigned*)(F.lds + MISC_OFF);
    F.wave = __builtin_amdgcn_readfirstlane(threadIdx.x >> 6);

    F.G = gridDim.x; { const int bx = blockIdx.x; F.vcu = (F.G % 8 == 0) ? (bx % 8) * (F.G / 8) + bx / 8 : bx; }
    unsigned char* ws = args.ws;
    F.ctl = (unsigned*)(ws + WS_CTL);
    const float* x = args.in[0]; const float* c = args.in[1]; const float* ctx = args.in[2]; const float* cctx = args.in[3];
    const float* w_mod = args.in[4]; const float* b_mod = args.in[5]; const float* g_pre_mix = args.in[6];
    const float* g_qn = args.in[12]; const float* g_kn = args.in[13];
    float* MOD = (float*)(ws + WS_MOD);
    bf16 *WTIN = (bf16*)(ws + WS_WTIN), *H = (bf16*)(ws + WS_H);
    for (int u = FTID; u < (LDS_BYTES - MISC_OFF) / 4; u += NWAVES * 64) ((LAS unsigned*)(F.lds + MISC_OFF))[u] = 0u;
    auto build_tables = [&]() {
    { LAS float* rt = (LAS float*)(F.lds + ROPE_OFF);
      for (int i = FTID; i < 64 * 16; i += NWAVES * 64) { const int pos = i >> 4, j = i & 15; const float f = powf(10000.0f, -(float)j / 16.0f); const float a = (float)pos * f; rt[2 * i] = cosf(a); rt[2 * i + 1] = sinf(a); } }
    { LAS float* rp = (LAS float*)(F.lds + NAX_OFF); const float* rpb = args.in[11];
      for (int i = FTID; i < 8 * 480; i += NWAVES * 64) { const int h = i / 480, rem = i % 480, ro = rem >> 5, co = rem & 31; rp[i] = co < 31 ? rpb[(h * 15 + ro) * 31 + co] * LOG2E : 0.f; } }
    if (FTID >= 384) ((LAS float*)(F.lds + NAX_OFF + 17920))[FTID - 384] = FTID < 448 ? g_qn[FTID - 384] : g_kn[FTID - 448];
    };
    const bool tables_late = (args.ph_lo <= 0 && 1 < args.ph_hi) && F.G == 256 && PROJ_FP8 != 0;
    if (!tables_late) build_tables();
    __syncthreads();
    unsigned long long _pbstart = 0; if (PROBE_SEL >= 20) _pbstart = __builtin_amdgcn_s_memrealtime();
    const bool use_bar = (args.ph_hi - args.ph_lo) > 1;
    XcdBarrier bar; bar.bar = F.ctl + CW_BAR + args.li * XCD_BAR_WORDS; bar.x = 0; bar.st = nullptr;
    if (use_bar) bar = xcd_barrier_post(F.ctl + CW_BAR + args.li * XCD_BAR_WORDS, F.MISC + 8);
    const int lo = args.ph_lo, hi = args.ph_hi;
#define IN(k) (lo <= (k) && (k) < hi)
#define BOTH(k) (IN(k) && IN((k) + 1))
#define GRID_BAR() xcd_barrier(bar, F.wave)
    const bool handoff = (F.G == 256);

    const bool merge01 = handoff && IN(0) && IN(1);
    if (IN(0)) {
        if (F.vcu < 192) {
            LAS float* sil = (LAS float*)(F.lds + RING_OFF);
            LAS float* red = (LAS float*)(F.lds + RING_OFF + 20480);
            const int tid = FTID, n0 = F.vcu * 32;
            const int cg = tid & 7, kr = tid >> 3;
            float cv[10]; f32x4 wv[16];
#pragma unroll
            for (int q = 0; q < 10; ++q) { const int i = tid + 512 * q, r = i >> 10, k = i & 1023; cv[q] = r < 4 ? c[r * 1024 + k] : cctx[k]; }
#pragma unroll
            for (int q = 0; q < 16; ++q) wv[q] = __builtin_nontemporal_load((const f32x4*)(w_mod + (size_t)(kr + 64 * q) * 6144 + n0 + 4 * cg));
#pragma unroll
            for (int q = 0; q < 10; ++q) { const float v = cv[q]; sil[tid + 512 * q] = v / (1.0f + __expf(-v)); }
            __syncthreads();
            float acc[5][4];
#pragma unroll
            for (int r = 0; r < 5; ++r)
#pragma unroll
                for (int j = 0; j < 4; ++j) acc[r][j] = 0.f;
#pragma unroll
            for (int q = 0; q < 16; ++q) { const int k = kr + 64 * q; const f32x4 w = wv[q];
#pragma unroll
                for (int r = 0; r < 5; ++r) { const float s = sil[r * 1024 + k]; acc[r][0] += s * w[0]; acc[r][1] += s * w[1]; acc[r][2] += s * w[2]; acc[r][3] += s * w[3]; }
            }
#pragma unroll
            for (int r = 0; r < 5; ++r)
#pragma unroll
                for (int j = 0; j < 4; ++j) red[(kr * 5 + r) * 32 + 4 * cg + j] = acc[r][j];
            __syncthreads();
            if (tid < 160) { const int r = tid >> 5, n = tid & 31; float sm = 0.f; for (int i = 0; i < 64; ++i) sm += red[(i * 5 + r) * 32 + n];
                __hip_atomic_store((unsigned*)(MOD + r * 6144 + n0 + n), __builtin_bit_cast(unsigned, sm + b_mod[n0 + n]), __ATOMIC_RELAXED, __HIP_MEMORY_SCOPE_AGENT); }
            asm volatile("s_waitcnt vmcnt(0)" ::: "memory");
            __syncthreads();
            if (merge01 && F.wave == 0 && lane_now() < 8) (void)__hip_atomic_fetch_add(F.ctl + CW_CNTM + 64 * lane_now(), 1u, __ATOMIC_RELAXED, __HIP_MEMORY_SCOPE_AGENT);
            PROBE_MARK(37);
        }
        {
            WPtrs P{args.in[10], args.in[14], args.in[15], args.in[16], args.in[19], args.in[21], WTIN, (bf16*)(ws + WS_WTOAB), (bf16*)(ws + WS_WTO), (bf16*)(ws + WS_WTGU), (bf16*)(ws + WS_WTDN)};
            float* scr = (float*)(lds + RING_OFF + 61440 + F.wave * 8448);
            const int n0items = ((F.G == 256) ? NITEMS_W - CV_TAIL2 - CV_TAIL7 - GQ_SIDE_DN : NITEMS_W) - P3_SIDE_N;
            {
                u32x4* wrsd = (u32x4*)(ws + WS_WRS); const float* wrsrc = args.in[17];
                if (F.G == 256) { if (F.vcu >= 192 && F.vcu < 208) { const int en = (F.vcu - 192) * 512 + FTID; wrsd[en] = wrs_entry(wrsrc, en); } }
                else if (F.vcu == 0) for (int en = FTID; en < 8192; en += NWAVES * 64) wrsd[en] = wrs_entry(wrsrc, en);
            }
            if (F.G == 256) {
                const int m1 = n0items - CV_BAL0;
                for (int it = F.vcu * NWAVES + F.wave; it < m1; it += 256 * NWAVES) convert_item(P, CV_ITEM(it), scr, FLANE);
                if (F.vcu >= 192) for (int it = m1 + (F.vcu - 192) * NWAVES + F.wave; it < n0items; it += 64 * NWAVES) convert_item(P, CV_ITEM(it), scr, FLANE);
            } else
            for (int it = F.vcu * NWAVES + F.wave; it < n0items; it += F.G * NWAVES) convert_item(P, CV_ITEM(it), scr, FLANE);
        }
        if (merge01) {
            __syncthreads();
            panel_wait(F.ctl + CW_CNTM + 64 * (F.vcu & 7), 192u, F.ctl + CW_TMO, F.wave);
            PROBE_MARK(38);
            { const int rb = F.vcu * NWAVES + F.wave;
              if (PROJ_FP8) {
                  float* vec = (float*)(lds + RING_OFF);
                  for (int i = FTID; i < 11 * 256; i += 512) { const int vsel = i >> 8, c4 = (i & 255) * 4; const float* src = vsel == 0 ? g_pre_mix : MOD + ((vsel - 1) >> 1) * 6144 + ((vsel - 1) & 1) * 1024;
                      *(f32x4*)(vec + vsel * 1024 + c4) = *(const f32x4*)(src + c4); }
                  __syncthreads();
                  f32x4 xv[8][4]; hnorm_load8(xv, rb, x, FLANE);
                  if (tables_late) build_tables();
                  hnorm_rows8(xv, rb, vec, H, FLANE);
                  for (int row = rb + 8 * 2048; row < TR; row += 2048) hnorm_row(row, x, ctx, g_pre_mix, MOD, H, FLANE); }
              else for (int row = rb; row < TR; row += F.G * NWAVES) hnorm_row(row, x, ctx, g_pre_mix, MOD, H, FLANE); }
        }
        if (BOTH(0)) GRID_BAR();
        PROBE_MARK(21);
    }
    if (IN(1) && !merge01) {
        for (int row = F.vcu * NWAVES + F.wave; row < TR; row += F.G * NWAVES) hnorm_row(row, x, ctx, g_pre_mix, MOD, H, FLANE);
        if (BOTH(1)) GRID_BAR();
        PROBE_MARK(22);
    }
    if (IN(2)) {
        ProjSchedA S{(const char*)H, (const char*)WTIN, nullptr, F.vcu, F.G};
        ProjEpi E{(bf16*)(ws + WS_QA), (bf16*)(ws + WS_KA), (bf16*)(ws + WS_VA), (bf16*)(ws + WS_QB), (bf16*)(ws + WS_KB), (bf16*)(ws + WS_VB), (bf16*)(ws + WS_GA), (bf16*)(ws + WS_GB), (const LAS float*)(F.lds + NAX_OFF + 17920), (const LAS float*)(F.lds + NAX_OFF + 17920 + 256), (const LAS float*)(F.lds + ROPE_OFF), F.ctl + CW_QMAX};
        pg8::gemm_phase<ProjEpi, ProjSchedA, false, 1, PROJ_FP8 != 0>(F.lds + RING_OFF, S, E, F.wave);
        { ProjSchedG SG{(const char*)H, (const char*)WTIN, nullptr, F.vcu, F.G};
          GateEpi EG{(bf16*)(ws + WS_GA), (bf16*)(ws + WS_GB)};
          pg8::gemm_phase<GateEpi, ProjSchedG, false, 2, PROJ_FP8 != 0>(F.lds + RING_OFF, SG, EG, F.wave); }
        if (F.G == 256 && F.vcu >= (64 * 17 + 4 * 5) % 256) {
            constexpr int R2 = (64 * 17 + 4 * 5) % 256;
            WPtrs P{args.in[10], args.in[14], args.in[15], args.in[16], args.in[19], args.in[21], WTIN, (bf16*)(ws + WS_WTOAB), (bf16*)(ws + WS_WTO), (bf16*)(ws + WS_WTGU), (bf16*)(ws + WS_WTDN)};
            float* scr = (float*)(lds + RING_OFF + 61440 + F.wave * 8448);
            constexpr int A0 = NITEMS_W - CV_TAIL2 - CV_TAIL7;
            for (int it = A0 + (F.vcu - R2) * NWAVES + F.wave; it < A0 + CV_TAIL2; it += (256 - R2) * NWAVES) convert_item(P, it, scr, FLANE);
        }
        if (BOTH(2)) GRID_BAR();
        PROBE_MARK(23);
    }
    if (IN(3)) {
        const bf16 *QAp = (const bf16*)(ws + WS_QA), *KAp = (const bf16*)(ws + WS_KA), *VAp = (const bf16*)(ws + WS_VA), *QBp = (const bf16*)(ws + WS_QB), *KBp = (const bf16*)(ws + WS_KB), *VBp = (const bf16*)(ws + WS_VB);
        bf16* Op = (bf16*)(ws + WS_O);
        bool gqa_fast;
        { const int l_ = lane_now(); const float gq_ = wave_max(fabsf(g_qn[l_])), gk_ = wave_max(fabsf(g_kn[l_]));
          const float bound_ = 64.0f * QSCALE * 1.02f * gq_ * gk_;
          gqa_fast = __builtin_amdgcn_readfirstlane((int)(bound_ < 30.0f)) != 0; }
        PROBE_BEGIN(4)
        for (int id = F.vcu; id < 512; id += F.G) {
            const int v = id & 255, i2 = id >> 8, bk = v >> 5, local = (v & 31) + 32 * i2;
            if (gqa_fast) attn_body::gqa_unit<8, true>(bk >> 1, (bk & 1) * 4 + (local >> 4), local & 15, QBp, KBp, VBp, Op, (char*)lds + RING_OFF, F.wave, handoff ? F.ctl + CW_CNTOB : nullptr,
                                    args.in[19], (unsigned char*)(ws + WS_WTGU), NA_SIDE_N + (id * NWAVES + F.wave) * attn_body::GQ_NJ,
                                    args.in[21], (unsigned char*)(ws + WS_WTDN), (id * NWAVES + F.wave) * attn_body::GQ_ND);
            else attn_body::gqa_unit<8, false>(bk >> 1, (bk & 1) * 4 + (local >> 4), local & 15, QBp, KBp, VBp, Op, (char*)lds + RING_OFF, F.wave, handoff ? F.ctl + CW_CNTOB : nullptr,
                                    args.in[19], (unsigned char*)(ws + WS_WTGU), NA_SIDE_N + (id * NWAVES + F.wave) * attn_body::GQ_NJ,
                                    args.in[21], (unsigned char*)(ws + WS_WTDN), (id * NWAVES + F.wave) * attn_body::GQ_ND);
        }
        if (F.wave == 0) PROBE_END(4, F.lds + MISC_OFF);
        PROBE_MARK(24);
        PROBE_BEGIN(5)
        bool na_fast;
        { const float qm2 = __uint_as_float(__hip_atomic_load(F.ctl + CW_QMAX, __ATOMIC_RELAXED, __HIP_MEMORY_SCOPE_AGENT)), km2 = __uint_as_float(__hip_atomic_load(F.ctl + CW_KMAX, __ATOMIC_RELAXED, __HIP_MEMORY_SCOPE_AGENT));
          const LAS float* rph = (const LAS float*)(F.lds + NAX_OFF) + F.wave * 480; float bm = 0.f;
          for (int i = lane_now(); i < 480; i += 64) bm = fmaxf(bm, fabsf(rph[i]));
          bm = wave_max(bm);
          const float bound_ = 1.02f * sqrtf(qm2 * km2) + bm;
          na_fast = __builtin_amdgcn_readfirstlane((int)(bound_ < 30.0f)) != 0; }
        for (int id = F.vcu; id < 256; id += F.G) {
            if (na_fast) attn_body::na_unit<true>(id >> 6, id & 63, QAp, KAp, VAp, Op, (char*)lds + RING_OFF, (const float*)(lds + NAX_OFF), (float*)(lds + NAX_OFF + 15360), F.wave, args.in[19], (unsigned char*)(ws + WS_WTGU), (id * NWAVES + F.wave) * attn_body::NA_NSIDE, handoff ? F.ctl + CW_CNTO : nullptr);
            else attn_body::na_unit<false>(id >> 6, id & 63, QAp, KAp, VAp, Op, (char*)lds + RING_OFF, (const float*)(lds + NAX_OFF), (float*)(lds + NAX_OFF + 15360), F.wave, args.in[19], (unsigned char*)(ws + WS_WTGU), (id * NWAVES + F.wave) * attn_body::NA_NSIDE, handoff ? F.ctl + CW_CNTO : nullptr); }
        if (F.wave == 0) PROBE_END(5, F.lds + MISC_OFF);
        PROBE_MARK(25);
        if (BOTH(3) && !handoff) GRID_BAR();
    }
    if (IN(4)) {
        UEpi E{(const bf16*)(ws + WS_GA)  , (const bf16*)(ws + WS_GB)  , (bf16*)(ws + WS_U)};
        if (handoff) {
            DenseUSched S{(const char*)(ws + WS_O), (const char*)(ws + WS_WTOAB), nullptr, F.vcu, F.G, F.ctl + CW_CNTO, F.ctl + CW_TMO};
            panel_wait(F.ctl + CW_CNTOB + 64 * (F.vcu >> 2), 64u, F.ctl + CW_TMO, F.wave);
            PROBE_MARK(30);
            pg8::gemm_phase<UEpi, DenseUSched, false, 3>(F.lds + RING_OFF, S, E, F.wave);
        } else {
            DenseUSched S{(const char*)(ws + WS_O), (const char*)(ws + WS_WTOAB), nullptr, F.vcu, F.G, nullptr, nullptr};
            pg8::gemm_phase<UEpi, DenseUSched, false, 3>(F.lds + RING_OFF, S, E, F.wave);
        }
        if (handoff) panel_signal(F.ctl + CW_CNTU + 64 * (F.vcu >> 2));
        PROBE_MARK(31);
        if (BOTH(4) && !handoff) GRID_BAR();
    }
    if (IN(5)) {
        YEpi E{(bf16*)(ws + WS_Y)};
        if (handoff) panel_wait(F.ctl + CW_CNTU + 64 * (F.vcu >> 2), 32u, F.ctl + CW_TMO, F.wave);
        PROBE_MARK(32);
        if (Y_FP8) { Dense4Sched8 S{(const char*)(ws + WS_U), (const char*)(ws + WS_WTO), nullptr, F.vcu, F.G};
            pg8::gemm_phase<YEpi, Dense4Sched8, false, 3, true>(F.lds + RING_OFF, S, E, F.wave); }
        else { Dense4Sched S{(const char*)(ws + WS_U), (const char*)(ws + WS_WTO), nullptr, F.vcu, F.G};
            pg8::gemm_phase<YEpi, Dense4Sched, false, 3>(F.lds + RING_OFF, S, E, F.wave); }
        if (handoff) panel_signal(F.ctl + CW_CNTY + 64 * (F.vcu >> 2));
        PROBE_MARK(26);
        if (BOTH(5) && !handoff) GRID_BAR();
    }
    if (IN(6)) {
        for (int blk = F.vcu; blk < T / 64; blk += F.G) {
            if (handoff) panel_wait(F.ctl + CW_CNTY + 64 * (blk >> 2), 32u, F.ctl + CW_TMO, F.wave);
            PROBE_MARK(34);
            rowpass_block2(blk, x, (const bf16*)(ws + WS_Y), MOD, args.in[7], args.in[8], (const unsigned char*)(ws + WS_WRS), args.in[18], (bf16*)(ws + WS_H2), (float*)(ws + WS_RSTD1),
                           F.ctl + CW_ECNT, (int*)(ws + WS_LIST), lds + RING_OFF, lds + MISC_OFF + 256, F.wave, (bf16*)(ws + WS_X1B), lds + NAX_OFF); }
        PROBE_MARK(35);
        if (BOTH(6)) GRID_BAR();
        PROBE_MARK(27);
    }
    if (IN(7)) {
        moe_table(F, F.ctl + CW_ECNT);
        const bool h78 = handoff && IN(8);
        MoeSched<8, true> S{(const char*)(ws + WS_H2), (const char*)(ws + WS_WTGU), (const int*)(ws + WS_LIST), F.MISC, F.vcu, F.G, h78 ? F.ctl + CW_CNTA : nullptr, F.ctl + CW_TMO};
        GuEpi E{args.in[20], (bf16*)(ws + WS_ACT)};
        PROBE_BEGIN(3)
        pg8::gemm_phase<GuEpi, MoeSched<8, true>, true, 2, MOE_FP8 != 0>(F.lds + RING_OFF, S, E, F.wave);
        if (F.G == 256 && CV_TAIL7 > 0) {
            int r7 = ((int)__builtin_amdgcn_readfirstlane(F.MISC[MW_TSTART + 32]) * 8) & 255;
            if (256 - r7 < 64) r7 = 0;
            if (F.vcu >= r7) {
                WPtrs P{args.in[10], args.in[14], args.in[15], args.in[16], args.in[19], args.in[21], WTIN, (bf16*)(ws + WS_WTOAB), (bf16*)(ws + WS_WTO), (bf16*)(ws + WS_WTGU), (bf16*)(ws + WS_WTDN)};
                float* scr = (float*)(lds + RING_OFF + 61440 + F.wave * 8448);
                for (int it = NITEMS_W - CV_TAIL7 + (F.vcu - r7) * NWAVES + F.wave; it < NITEMS_W; it += (256 - r7) * NWAVES) convert_item(P, it, scr, FLANE);
            }
        }
        if (F.wave == 0) PROBE_END(3, F.lds + MISC_OFF);
        PROBE_MARK(28);
        if (BOTH(7) && !handoff) GRID_BAR();
    }
    if (IN(8)) {
        if (!IN(7)) moe_table(F, F.ctl + CW_ECNT);
        const bool h78 = handoff && IN(7);
        int v8 = F.vcu;
        if (h78) v8 = (F.vcu - (((int)__builtin_amdgcn_readfirstlane(F.MISC[MW_TSTART + 32]) * 8) & 255)) & 255;
        MoeSched<4, false> S{(const char*)(ws + WS_ACT), (const char*)(ws + WS_WTDN), (const int*)(ws + WS_LIST), F.MISC, v8, F.G, h78 ? F.ctl + CW_CNTA : nullptr, F.ctl + CW_TMO};
        if (h78) {
            if (F.wave == 0) {
                int t4[4]; pg8::GU u0;
#pragma unroll
                for (int i = 0; i < 4; ++i) t4[i] = S.next(i, u0) ? u0.pm : -1;
                const int l = lane_now(); const int mine = l == 0 ? t4[0] : l == 1 ? t4[1] : l == 2 ? t4[2] : l == 3 ? t4[3] : -1;
                bool ok = mine < 0; unsigned sp = 0u;
                for (;;) {
                    if (!ok) ok = __hip_atomic_load(S.cntA + 64 * mine, __ATOMIC_RELAXED, __HIP_MEMORY_SCOPE_AGENT) >= 64u;
                    if (__builtin_amdgcn_ballot_w64(!ok) == 0ull) break;
                    __builtin_amdgcn_s_sleep(2);
                    if (++sp > (1u << 20)) { if (l == 0) __hip_atomic_store(F.ctl + CW_TMO, 0xC0DEu, __ATOMIC_RELAXED, __HIP_MEMORY_SCOPE_AGENT); break; }
                }
                __builtin_amdgcn_fence(__ATOMIC_ACQUIRE, "agent"); asm volatile("s_waitcnt vmcnt(0)" ::: "memory");
            }
            __syncthreads();
        }
        DnEpi E{args.in[22], (const int*)(ws + WS_LIST), (const float*)(ws + WS_TOPW), (bf16*)(ws + WS_YS)};
        PROBE_BEGIN(13)
        pg8::gemm_phase<DnEpi, MoeSched<4, false>, false, 3, MOE_FP8 != 0>(F.lds + RING_OFF, S, E, F.wave);
        if (F.wave == 0) PROBE_END(13, F.lds + MISC_OFF);
        if (BOTH(8)) GRID_BAR();
        PROBE_MARK(29);
    }
    if (IN(9)) {
        if (F.G == 256) {
            { float* vec = (float*)(lds + NAX_OFF);
              for (int i = FTID; i < 5 * 256; i += 512) { const int vsel = i >> 8, c4 = (i & 255) * 4; const float* src = vsel < 4 ? MOD + vsel * 6144 + 5120 : args.in[9];
                  *(f32x4*)(vec + vsel * 1024 + c4) = *(const f32x4*)(src + c4); }
              __syncthreads();
              final_rows_all(F.vcu * NWAVES + F.wave, (const bf16*)(ws + WS_X1B), (const bf16*)(ws + WS_YS), vec, args.out, FLANE); }
        } else
        for (int t = F.vcu * NWAVES + F.wave; t < T; t += F.G * NWAVES)
            final_row(t, x, (const bf16*)(ws + WS_Y), (const float*)(ws + WS_RSTD1), (const bf16*)(ws + WS_YS), MOD, args.in[7], args.in[9], args.out, FLANE);
    }
    if (PROBE_SEL != 0 && blockIdx.x == 0 && F.wave == 0) {
        const unsigned long long t0 = __builtin_amdgcn_s_memrealtime(); const unsigned long long want = 8ull * (unsigned long long)F.MISC[MW_PROBE];
        while (__builtin_amdgcn_s_memrealtime() - t0 < want) __builtin_amdgcn_s_sleep(8);
    }
#undef IN
#undef BOTH
#undef GRID_BAR
}

#ifndef MK_SPLIT
#define MK_SPLIT 0
#endif
extern "C" void kernel_launch(void* const* d_in, const int* in_sizes, int n_in, void* d_out, int out_size, void* d_ws, size_t ws_size, hipStream_t stream) {
    static int grid = 0;
    if (grid == 0) {
        grid = -1;
        if (n_in != 23 || in_sizes[0] != T * DM || out_size != T * DM || ws_size < WS_END) { fprintf(stderr, "kernel_launch: unexpected shapes/workspace (n_in %d, ws %zu)\n", n_in, ws_size); return; }
        if (hipFuncSetAttribute((const void*)mk_fwd, hipFuncAttributeMaxDynamicSharedMemorySize, LDS_BYTES) != hipSuccess) { fprintf(stderr, "kernel_launch: hipFuncSetAttribute(mk_fwd) failed\n"); return; }
        int dev = 0, cus = 0, per_cu = 0;
        if (hipGetDevice(&dev) != hipSuccess || hipDeviceGetAttribute(&cus, hipDeviceAttributeMultiprocessorCount, dev) != hipSuccess) return;
        if (hipOccupancyMaxActiveBlocksPerMultiprocessor(&per_cu, (const void*)mk_fwd, NWAVES * 64, LDS_BYTES) != hipSuccess || per_cu < 1) { fprintf(stderr, "kernel_launch: occupancy query says %d blocks per CU\n", per_cu); (void)hipGetLastError(); return; }
        grid = cus;
    }
    if (grid < 0) return;
    const float* x = (const float*)d_in[0];
    const float* g_post_mix = (const float*)d_in[7]; const float* g_pre_ffn = (const float*)d_in[8]; const float* g_post_ffn = (const float*)d_in[9];
    const float* rpb = (const float*)d_in[11];
    const float* w_router = (const float*)d_in[17]; const float* b_router = (const float*)d_in[18];
    const float* b_gu = (const float*)d_in[20]; const float* b_dn = (const float*)d_in[22];
    unsigned char* ws = (unsigned char*)d_ws;
    float* MOD = (float*)(ws + WS_MOD); float* RSTD1 = (float*)(ws + WS_RSTD1); int* TOPE = (int*)(ws + WS_TOPE); float* TOPW = (float*)(ws + WS_TOPW);
    int* LIST = (int*)(ws + WS_LIST); unsigned* ECNT = (unsigned*)(ws + WS_CTL) + CW_ECNT;
    bf16 *WTOAB = (bf16*)(ws + WS_WTOAB), *WTO = (bf16*)(ws + WS_WTO), *WTGU = (bf16*)(ws + WS_WTGU), *WTDN = (bf16*)(ws + WS_WTDN);
    bf16 *QA = (bf16*)(ws + WS_QA), *KA = (bf16*)(ws + WS_KA), *VA = (bf16*)(ws + WS_VA), *QB = (bf16*)(ws + WS_QB), *KB = (bf16*)(ws + WS_KB), *VB = (bf16*)(ws + WS_VB);
    bf16 *GA = (bf16*)(ws + WS_GA), *GB = (bf16*)(ws + WS_GB), *O = (bf16*)(ws + WS_O), *U = (bf16*)(ws + WS_U), *Y = (bf16*)(ws + WS_Y), *H2 = (bf16*)(ws + WS_H2), *ACT = (bf16*)(ws + WS_ACT), *YS = (bf16*)(ws + WS_YS);
    float *PA = (float*)(ws + WS_PA), *PB = (float*)(ws + WS_PB);

    (void)hipMemsetAsync(ws + WS_CTL, 0, CTL_ZERO_BYTES, stream);
    MKArgs a{};
    for (int i = 0; i < 23; ++i) a.in[i] = (const float*)d_in[i];
    a.out = (float*)d_out; a.ws = ws;
    auto run = [&](int lo, int hi, int li) {
        if (MK_SPLIT) { for (int p = lo; p < hi; ++p) { a.ph_lo = p; a.ph_hi = p + 1; a.li = p; hipLaunchKernelGGL(mk_fwd, dim3(grid), dim3(NWAVES * 64), LDS_BYTES, stream, a); } }
        else { a.ph_lo = lo; a.ph_hi = hi; a.li = li; hipLaunchKernelGGL(mk_fwd, dim3(grid), dim3(NWAVES * 64), LDS_BYTES, stream, a); } };
    run(0, 10, 0);
}
```
